# Optimizing an MI355X kernel written in HIP

```python
import jax, jax.numpy as jnp
from jax import lax
import numpy as np

D_MODEL = 1024
BATCH = 8
SEQ = 4096
DEPTH = 4

CHUNK = 64
EPS = 1e-6

RET_HEADS = 4
RET_QK_DIM = 128
RET_V_DIM = 128
RET_QK_WIDTH = RET_HEADS * RET_QK_DIM
RET_V_WIDTH = RET_HEADS * RET_V_DIM
ROPE_BASE = 10000.0

SGU_GROUPS = 4
SGU_GROUP_DIM = 128
SGU_WIDTH = SGU_GROUPS * SGU_GROUP_DIM
SGU_BLOCK = 128

AB_IN = 2 * RET_QK_WIDTH + 2 * RET_V_WIDTH + 2 * SGU_WIDTH
AB_MIX = RET_V_WIDTH + SGU_WIDTH

MLSTM_HEADS = 4
MLSTM_QK_DIM = 128
MLSTM_V_DIM = 256
MLSTM_QK_WIDTH = MLSTM_HEADS * MLSTM_QK_DIM
MLSTM_V_WIDTH = MLSTM_HEADS * MLSTM_V_DIM
C_IN = 2 * MLSTM_QK_WIDTH + 2 * MLSTM_V_WIDTH + 2 * MLSTM_HEADS

D_FF = -(-8 * D_MODEL // (3 * 256)) * 256

kernel_name = "hybrid_retention_sgu_mlstm_trunk"


def rmsnorm(t, g):
    tf = t.astype(jnp.float32)
    y = tf * lax.rsqrt(jnp.mean(tf * tf, axis=-1, keepdims=True) + EPS)
    return (y * g.astype(jnp.float32)).astype(t.dtype)


def norm_last(t):
    mu = jnp.mean(t, axis=-1, keepdims=True)
    c = t - mu
    return c * lax.rsqrt(jnp.mean(c * c, axis=-1, keepdims=True) + EPS)


def rope(t, pos):
    half = t.shape[-1] // 2
    inv = ROPE_BASE ** (-jnp.arange(half, dtype=jnp.float32) / half)
    ang = pos[:, None] * inv[None, :]
    cos = jnp.cos(ang)[None, :, None, :]
    sin = jnp.sin(ang)[None, :, None, :]
    t1, t2 = t[..., :half], t[..., half:]
    return jnp.concatenate([t1 * cos - t2 * sin, t1 * sin + t2 * cos], axis=-1)


def retention(q, k, v):
    B, S, H, dk = q.shape
    dv = v.shape[-1]
    n = S // CHUNK
    log_g = jnp.log1p(-jnp.power(2.0, -5.0 - jnp.arange(H, dtype=jnp.float32)))
    idx = jnp.arange(CHUNK, dtype=jnp.float32)
    d_intra = jnp.exp(log_g[:, None, None] * jnp.abs(idx[:, None] - idx[None, :]))
    q_dec = jnp.exp(log_g[:, None] * (idx + 1.0)).T
    k_dec = jnp.exp(log_g[:, None] * (CHUNK - 1.0 - idx)).T
    chunk_dec = jnp.exp(log_g * CHUNK)
    qc = q.reshape(B, n, CHUNK, H, dk)
    kc = k.reshape(B, n, CHUNK, H, dk)
    vc = v.reshape(B, n, CHUNK, H, dv)
    scores = jnp.einsum('bnchd,bnshd->bnhcs', qc, kc) * d_intra
    intra = jnp.einsum('bnhcs,bnshe->bnche', scores, vc)
    kv = jnp.einsum('bnshd,bnshe->bnhde', kc * k_dec[:, :, None], vc)

    def step(state, kv_j):
        return state * chunk_dec[None, :, None, None] + kv_j, state

    _, prev = lax.scan(step, jnp.zeros((B, H, dk, dv), jnp.float32), jnp.moveaxis(kv, 1, 0))
    prev = jnp.moveaxis(prev, 0, 1)
    cross = jnp.einsum('bnchd,bnhde->bnche', qc * q_dec[:, :, None], prev)
    return (intra + cross).reshape(B, S, H, dv)


def spatial_gating(u, v, w_s, b_s):
    B, S, G, dg = v.shape
    nb = S // SGU_BLOCK
    chunk_id = jnp.arange(SGU_BLOCK) // CHUNK
    mask = chunk_id[None, :] <= chunk_id[:, None]
    w = jnp.where(mask[None], w_s, 0.0)
    vb = v.reshape(B, nb, SGU_BLOCK, G, dg)
    s = jnp.einsum('gpq,bnqgd->bnpgd', w, vb) + b_s.T[:, :, None]
    return u * s.reshape(B, S, G, dg)


def retention_sgu_mixer(hn, w_in, w_out, ret_norm_g, sgu_ln_g, sgu_ln_b, w_s, b_s):
    B, S, _ = hn.shape
    f32 = jnp.float32
    proj = (hn @ w_in).astype(f32)
    cuts = np.cumsum([RET_QK_WIDTH, RET_QK_WIDTH, RET_V_WIDTH, RET_V_WIDTH, SGU_WIDTH]).tolist()
    q, k, v, g, u, vs = jnp.split(proj, cuts, axis=-1)
    pos = jnp.arange(S, dtype=f32)
    q = rope(q.reshape(B, S, RET_HEADS, RET_QK_DIM), pos)
    k = rope(k.reshape(B, S, RET_HEADS, RET_QK_DIM), pos) * (RET_QK_DIM ** -0.5)
    v = v.reshape(B, S, RET_HEADS, RET_V_DIM)
    r = norm_last(retention(q, k, v)) * ret_norm_g.astype(f32)
    a = jax.nn.silu(g) * r.reshape(B, S, RET_V_WIDTH)
    u = jax.nn.gelu(u)
    vs = norm_last(jax.nn.gelu(vs)) * sgu_ln_g.astype(f32) + sgu_ln_b.astype(f32)
    bo = spatial_gating(u.reshape(B, S, SGU_GROUPS, SGU_GROUP_DIM),
                        vs.reshape(B, S, SGU_GROUPS, SGU_GROUP_DIM),
                        w_s.astype(f32), b_s.astype(f32)).reshape(B, S, SGU_WIDTH)
    mixed = jnp.concatenate([a, bo], axis=-1).astype(hn.dtype)
    return mixed @ w_out


def mlstm(q, k, v, log_i, log_f):
    B, S, H, dk = q.shape
    dv = v.shape[-1]
    n = S // CHUNK
    causal = jnp.tril(jnp.ones((CHUNK, CHUNK), dtype=bool))

    def to_chunks(t):
        return jnp.moveaxis(t.reshape((B, n, CHUNK) + t.shape[2:]), 1, 0)

    def step(carry, xs):
        c_st, n_st, m_st = carry
        qj, kj, vj, lij, lfj = xs
        b_h = jnp.moveaxis(jnp.cumsum(lfj, axis=1), 1, 2)
        li_h = jnp.moveaxis(lij, 1, 2)
        d = b_h[:, :, :, None] - b_h[:, :, None, :] + li_h[:, :, None, :]
        d = jnp.where(causal, d, -jnp.inf)
        inter = b_h + m_st[:, :, None]
        m_t = jnp.maximum(inter, jnp.max(d, axis=-1))
        w_intra = jnp.exp(d - m_t[..., None])
        w_inter = jnp.exp(inter - m_t)
        qk = jnp.einsum('bthd,bshd->bhts', qj, kj) * w_intra
        num = (jnp.einsum('bhts,bshe->bthe', qk, vj)
               + jnp.einsum('bthd,bhde->bthe', qj, c_st) * jnp.moveaxis(w_inter, 1, 2)[..., None])
        den = jnp.sum(qk, axis=-1) + jnp.einsum('bthd,bhd->bht', qj, n_st) * w_inter
        lower = jnp.maximum(jnp.abs(den), jnp.exp(-m_t))
        h = num / jnp.moveaxis(lower, 1, 2)[..., None]
        b_last = b_h[:, :, -1]
        w_k = b_last[:, :, None] - b_h + li_h
        m_new = jnp.maximum(b_last + m_st, jnp.max(w_k, axis=-1))
        e_k = jnp.exp(w_k - m_new[:, :, None])
        decay = jnp.exp(b_last + m_st - m_new)
        c_new = c_st * decay[..., None, None] + jnp.einsum('bshd,bshe->bhde', kj * jnp.moveaxis(e_k, 1, 2)[..., None], vj)
        n_new = n_st * decay[..., None] + jnp.einsum('bhs,bshd->bhd', e_k, kj)
        return (c_new, n_new, m_new), h

    init = (jnp.zeros((B, H, dk, dv), jnp.float32), jnp.zeros((B, H, dk), jnp.float32),
            jnp.zeros((B, H), jnp.float32))
    _, hs = lax.scan(step, init, (to_chunks(q), to_chunks(k), to_chunks(v),
                                  to_chunks(log_i), to_chunks(log_f)))
    return jnp.moveaxis(hs, 0, 1).reshape(B, S, H, dv)


def mlstm_mixer(hn, w_in, w_out, b_i, b_f, norm_g):
    B, S, _ = hn.shape
    f32 = jnp.float32
    proj = (hn @ w_in).astype(f32)
    cuts = np.cumsum([MLSTM_QK_WIDTH, MLSTM_QK_WIDTH, MLSTM_V_WIDTH, MLSTM_V_WIDTH, MLSTM_HEADS]).tolist()
    q, k, v, o, ig, fg = jnp.split(proj, cuts, axis=-1)
    q = q.reshape(B, S, MLSTM_HEADS, MLSTM_QK_DIM)
    k = k.reshape(B, S, MLSTM_HEADS, MLSTM_QK_DIM) * (MLSTM_QK_DIM ** -0.5)
    v = v.reshape(B, S, MLSTM_HEADS, MLSTM_V_DIM)
    log_i = ig + b_i.astype(f32)
    log_f = jax.nn.log_sigmoid(fg + b_f.astype(f32))
    hh = norm_last(mlstm(q, k, v, log_i, log_f)) * norm_g.astype(f32)
    out = jax.nn.sigmoid(o) * hh.reshape(B, S, MLSTM_V_WIDTH)
    return out.astype(hn.dtype) @ w_out


def swiglu(hn, w_gate, w_up, w_down):
    return (jax.nn.silu(hn @ w_gate) * (hn @ w_up)) @ w_down


def setup_inputs(seed: int = 0) -> dict:
    key = jax.random.key(seed)
    ks = jax.random.split(key, 20)
    f32 = jnp.float32
    n_even = (DEPTH + 1) // 2
    n_odd = DEPTH // 2

    def dense(k, shape, fan_in):
        return jax.random.normal(k, shape, f32) * (fan_in ** -0.5)

    def gain(k, shape):
        return 1.0 + 0.02 * jax.random.normal(k, shape, f32)

    return {
        "x": jax.random.normal(ks[0], (BATCH, SEQ, D_MODEL), f32),
        "mix_norm_g": gain(ks[1], (DEPTH, D_MODEL)),
        "ffn_norm_g": gain(ks[2], (DEPTH, D_MODEL)),
        "final_norm_g": gain(ks[3], (D_MODEL,)),
        "ab_w_in": dense(ks[4], (n_even, D_MODEL, AB_IN), D_MODEL),
        "ab_w_out": dense(ks[5], (n_even, AB_MIX, D_MODEL), AB_MIX),
        "ret_norm_g": gain(ks[6], (n_even, RET_HEADS, RET_V_DIM)),
        "sgu_ln_g": gain(ks[7], (n_even, SGU_WIDTH)),
        "sgu_ln_b": 0.02 * jax.random.normal(ks[8], (n_even, SGU_WIDTH), f32),
        "sgu_w": dense(ks[9], (n_even, SGU_GROUPS, SGU_BLOCK, SGU_BLOCK), SGU_BLOCK),
        "sgu_b": gain(ks[10], (n_even, SGU_GROUPS, SGU_BLOCK)),
        "c_w_in": dense(ks[11], (n_odd, D_MODEL, C_IN), D_MODEL),
        "c_w_out": dense(ks[12], (n_odd, MLSTM_V_WIDTH, D_MODEL), MLSTM_V_WIDTH),
        "c_b_i": 0.1 * jax.random.normal(ks[13], (n_odd, MLSTM_HEADS), f32),
        "c_b_f": jnp.linspace(3.0, 6.0, MLSTM_HEADS, dtype=f32)[None, :]
                 + 0.01 * jax.random.normal(ks[14], (n_odd, MLSTM_HEADS), f32),
        "c_norm_g": gain(ks[15], (n_odd, MLSTM_HEADS, MLSTM_V_DIM)),
        "ffn_w_gate": dense(ks[16], (DEPTH, D_MODEL, D_FF), D_MODEL),
        "ffn_w_up": dense(ks[17], (DEPTH, D_MODEL, D_FF), D_MODEL),
        "ffn_w_down": dense(ks[18], (DEPTH, D_FF, D_MODEL), D_FF),
    }


def reference(x, mix_norm_g, ffn_norm_g, final_norm_g, ab_w_in, ab_w_out, ret_norm_g,
              sgu_ln_g, sgu_ln_b, sgu_w, sgu_b, c_w_in, c_w_out, c_b_i, c_b_f, c_norm_g,
              ffn_w_gate, ffn_w_up, ffn_w_down):
    h = x
    for layer in range(DEPTH):
        j = layer // 2
        hn = rmsnorm(h, mix_norm_g[layer])
        if layer % 2 == 0:
            h = h + retention_sgu_mixer(hn, ab_w_in[j], ab_w_out[j], ret_norm_g[j],
                                        sgu_ln_g[j], sgu_ln_b[j], sgu_w[j], sgu_b[j])
        else:
            h = h + mlstm_mixer(hn, c_w_in[j], c_w_out[j], c_b_i[j], c_b_f[j], c_norm_g[j])
        h = h + swiglu(rmsnorm(h, ffn_norm_g[layer]), ffn_w_gate[layer], ffn_w_up[layer],
                       ffn_w_down[layer])
    return rmsnorm(h, final_norm_g)
```

```cpp
#include <hip/hip_runtime.h>
#include <cstdio>
#include <cstdint>

#ifndef PH_MASK
#define PH_MASK 8191
#endif
#ifndef ONE_LAUNCH
#define ONE_LAUNCH 0
#endif

namespace pg8 {
#define PG8_LAS __attribute__((address_space(3)))
typedef unsigned short bf16_t;
typedef short bf16x8 __attribute__((ext_vector_type(8)));
typedef float f32x4 __attribute__((ext_vector_type(4)));
typedef unsigned u32x4 __attribute__((ext_vector_type(4)));
constexpr int BM = 256, BK = 64, HALF = 128, HTB = HALF * BK * 2  , STAGE_BYTES = 8 * HTB, NXCD = 8, WGM = 8;

__host__ __device__ __forceinline__ int lds_byte(int r, int c) { const int st = (r >> 4) * 2 + (c >> 5), rr = r & 15, cc = c & 31, ob = rr * 64 + cc * 2; return st * 1024 + (ob ^ (((ob >> 9) & 1) << 5)); }
__host__ __device__ __forceinline__ void stage_rc(int b, int& R, int& C) { const int st = b / 1024, sb = b % 1024, swz = sb ^ (((sb >> 9) & 1) << 5); R = (st >> 1) * 16 + swz / 64; C = (st & 1) * 32 + (swz % 64) / 2; }
__host__ __device__ __forceinline__ int perm32(int rho) { const int n = rho >> 4, i = rho & 15; return 8 * (i >> 2) + 4 * n + (i & 3); }

struct Unit { int pm, pn; };
struct Gemm { const bf16_t* A; const bf16_t* Bt; int M, N, K; };

struct StaticOrder {
    int nM, nN, nwg, G, c;
    __host__ __device__ void init(int M, int N, int G_, int c_) { nM = M / BM; nN = N / BM; nwg = nM * nN; G = G_; c = c_; }
    __host__ __device__ bool next(int i, Unit& u) const {
        const long L = (long)i * G + c; if (L >= nwg) return false;
        int wgid = (int)L; { const int q = nwg / NXCD, r = nwg % NXCD, xcd = wgid % NXCD, off = wgid / NXCD; wgid = (xcd < r ? xcd * (q + 1) : r * (q + 1) + (xcd - r) * q) + off; }
        const int nig = WGM * nN, gid = wgid / nig, fm = gid * WGM, gsz = (nM - fm) < WGM ? (nM - fm) : WGM;
        u.pm = fm + ((wgid % nig) % gsz); u.pn = (wgid % nig) / gsz; return true;
    }
    __device__ __forceinline__ void a_ready(const Unit&) const {}
    __device__ __forceinline__ void done(const Unit&) const {}
};

template <class Epi, class Sched, bool ALIGN_EPI = false, bool SP2 = false>
__device__ __forceinline__ void gemm_phase(PG8_LAS unsigned char* lds, const Gemm g, const Sched& S, const Epi& E, int tid_) {
    asm volatile("" : "+v"(tid_));
    const int tid = tid_, wid = __builtin_amdgcn_readfirstlane(tid >> 6), lane = tid & 63, wr = wid >> 2, wc = wid & 3, fr = lane & 15, fq = lane >> 4;
    const int K = g.K, nt = K / BK;
    unsigned voffA[2], voffB[2];
#pragma unroll
    for (int i = 0; i < 2; ++i) { int R, C; stage_rc(tid * 16 + i * 8192, R, C); const int Rb = Epi::PERM ? ((R & ~31) + perm32(R & 31)) : R;
        voffA[i] = (unsigned)(R * K + C) * 2u; voffB[i] = (unsigned)(Rb * K + C) * 2u; }
    const size_t kstep = (size_t)(BK * 2);
    const size_t hstep = (size_t)HALF * K * 2;
    const size_t tstep = 2 * hstep;
    const unsigned ldsw = (unsigned)wid * 1024u;
    const int aoff = lds_byte(wr * 64 + fr, fq * 8), boff = lds_byte(wc * 32 + fr, fq * 8);
#define PG8_SA(b, h) (((b) * 2 + (h)) * HTB)
#define PG8_SB(b, h) ((4 + (b) * 2 + (h)) * HTB)
#define PG8_STAGE(bufoff, gbase, voff) do { _Pragma("unroll") for (int _i = 0; _i < 2; ++_i) \
        __builtin_amdgcn_global_load_lds((const unsigned*)((const char*)(gbase) + (voff)[_i]), (PG8_LAS unsigned*)(lds + (bufoff) + ldsw + _i * 8192), 16, 0, 0); } while (0)
#define PG8_LDA(dst, b, h) do { _Pragma("unroll") for (int m = 0; m < 4; ++m) _Pragma("unroll") for (int k = 0; k < 2; ++k) dst[m][k] = *(const PG8_LAS bf16x8*)(lds + PG8_SA(b, h) + aoff + m * 2048 + k * 1024); } while (0)
#define PG8_LDB(dst, b, h) do { _Pragma("unroll") for (int n = 0; n < 2; ++n) _Pragma("unroll") for (int k = 0; k < 2; ++k) dst[n][k] = *(const PG8_LAS bf16x8*)(lds + PG8_SB(b, h) + boff + n * 2048 + k * 1024); } while (0)
#define PG8_MMA(ai, bj, At, Bt) do { __builtin_amdgcn_s_setprio(1); _Pragma("unroll") for (int m = 0; m < 4; ++m) _Pragma("unroll") for (int n = 0; n < 2; ++n) _Pragma("unroll") for (int k = 0; k < 2; ++k) \
        acc[ai][bj][m][n] = __builtin_amdgcn_mfma_f32_16x16x32_bf16(Bt[n][k], At[m][k], acc[ai][bj][m][n], 0, 0, 0); __builtin_amdgcn_s_setprio(0); } while (0)
#define PG8_WAIT_V(n) asm volatile("s_waitcnt vmcnt(" #n ")" ::: "memory")
#define PG8_WAIT_L(n) asm volatile("s_waitcnt lgkmcnt(" #n ")" ::: "memory")
#define PG8_BAR __builtin_amdgcn_s_barrier()
#define PG8_SCHED __builtin_amdgcn_sched_barrier(0)
    Unit cur, nxt; int ui = 0;
    if (!S.next(0, cur)) return;
    f32x4 acc[2][2][4][2];
#pragma unroll
    for (int a = 0; a < 2; ++a)
#pragma unroll
        for (int b = 0; b < 2; ++b)
#pragma unroll
            for (int m = 0; m < 4; ++m)
#pragma unroll
                for (int n = 0; n < 2; ++n) acc[a][b][m][n] = (f32x4){0.f, 0.f, 0.f, 0.f};
    bf16x8 At[4][2], B0[2][2], B1[2][2];
    const char* cA = (const char*)g.A + (size_t)cur.pm * tstep; const char* cB = (const char*)g.Bt + (size_t)cur.pn * tstep;
    S.a_ready(cur);
    if constexpr (SP2) {
        PG8_STAGE(PG8_SB(0, 0), cB, voffB); PG8_STAGE(PG8_SB(0, 1), cB + hstep, voffB); PG8_STAGE(PG8_SA(0, 0), cA, voffA); PG8_STAGE(PG8_SA(0, 1), cA + hstep, voffA);
        if (wr == 1) PG8_BAR;
        PG8_WAIT_V(2); PG8_BAR;
        PG8_STAGE(PG8_SB(1, 0), cB + kstep, voffB); PG8_STAGE(PG8_SA(1, 0), cA + kstep, voffA); PG8_STAGE(PG8_SB(1, 1), cB + hstep + kstep, voffB);
        PG8_WAIT_V(6); PG8_BAR;
    } else {
        PG8_STAGE(PG8_SB(0, 0), cB, voffB); PG8_STAGE(PG8_SA(0, 0), cA, voffA); PG8_STAGE(PG8_SB(0, 1), cB + hstep, voffB); PG8_STAGE(PG8_SA(0, 1), cA + hstep, voffA);
        if (wr == 1) PG8_BAR;
        PG8_WAIT_V(4); PG8_BAR;
        PG8_STAGE(PG8_SB(1, 0), cB + kstep, voffB); PG8_STAGE(PG8_SA(1, 0), cA + kstep, voffA); PG8_STAGE(PG8_SB(1, 1), cB + hstep + kstep, voffB);
        PG8_WAIT_V(6); PG8_BAR;
    }
    for (;;) {
        const bool has_next = S.next(ui + 1, nxt);
        const char* nA = has_next ? (const char*)g.A + (size_t)nxt.pm * tstep : cA; const char* nB = has_next ? (const char*)g.Bt + (size_t)nxt.pn * tstep : cB;
        for (int t = 0; t < nt; t += 2) {
            const bool last = (t == nt - 2);
            const char* a1 = cA + (size_t)(t + 1) * kstep;
            const char* a2 = last ? nA : cA + (size_t)(t + 2) * kstep; const char* b2 = last ? nB : cB + (size_t)(t + 2) * kstep;
            const char* a3 = a2 + kstep; const char* b3 = b2 + kstep;
            if (last && has_next) S.a_ready(nxt);
            if constexpr (SP2) {
            PG8_LDB(B0, 0, 0); PG8_LDB(B1, 0, 1); PG8_SCHED; PG8_LDA(At, 0, 0); PG8_STAGE(PG8_SA(1, 1), a1 + hstep, voffA);
            PG8_WAIT_V(8); PG8_WAIT_L(0); PG8_BAR; PG8_MMA(0, 0, At, B0); PG8_MMA(0, 1, At, B1); PG8_BAR; PG8_SCHED;
            PG8_LDA(At, 0, 1); PG8_STAGE(PG8_SB(0, 0), b2, voffB); PG8_STAGE(PG8_SB(0, 1), b2 + hstep, voffB); PG8_STAGE(PG8_SA(0, 0), a2, voffA);
            PG8_WAIT_V(8); PG8_WAIT_L(0); PG8_BAR; PG8_MMA(1, 0, At, B0); PG8_MMA(1, 1, At, B1); PG8_BAR; PG8_SCHED;
            PG8_LDB(B0, 1, 0); PG8_LDB(B1, 1, 1); PG8_SCHED; PG8_LDA(At, 1, 0); PG8_STAGE(PG8_SA(0, 1), a2 + hstep, voffA);
            PG8_WAIT_V(8); PG8_WAIT_L(0); PG8_BAR; PG8_MMA(0, 0, At, B0); PG8_MMA(0, 1, At, B1); PG8_BAR; PG8_SCHED;
            PG8_LDA(At, 1, 1); PG8_STAGE(PG8_SB(1, 0), b3, voffB); PG8_STAGE(PG8_SB(1, 1), b3 + hstep, voffB); PG8_STAGE(PG8_SA(1, 0), a3, voffA);
            PG8_WAIT_V(8); PG8_WAIT_L(0); PG8_BAR; PG8_MMA(1, 0, At, B0); PG8_MMA(1, 1, At, B1); PG8_BAR; PG8_SCHED;
            } else {
            PG8_LDB(B0, 0, 0); PG8_SCHED; PG8_LDA(At, 0, 0); PG8_STAGE(PG8_SA(1, 1), a1 + hstep, voffA);
            PG8_WAIT_L(8); PG8_BAR; PG8_WAIT_L(0); PG8_MMA(0, 0, At, B0); PG8_BAR; PG8_SCHED;
            PG8_LDB(B1, 0, 1); PG8_STAGE(PG8_SB(0, 0), b2, voffB);
            PG8_BAR; PG8_WAIT_L(0); PG8_MMA(0, 1, At, B1); PG8_BAR;
            PG8_LDA(At, 0, 1); PG8_STAGE(PG8_SA(0, 0), a2, voffA);
            PG8_BAR; PG8_WAIT_L(0); PG8_MMA(1, 0, At, B0); PG8_BAR; PG8_SCHED;
            PG8_STAGE(PG8_SB(0, 1), b2 + hstep, voffB);
            PG8_WAIT_V(6); PG8_BAR; PG8_MMA(1, 1, At, B1); PG8_BAR;
            PG8_LDB(B0, 1, 0); PG8_SCHED; PG8_LDA(At, 1, 0); PG8_STAGE(PG8_SA(0, 1), a2 + hstep, voffA);
            PG8_WAIT_L(8); PG8_BAR; PG8_WAIT_L(0); PG8_MMA(0, 0, At, B0); PG8_BAR; PG8_SCHED;
            PG8_LDB(B1, 1, 1); PG8_STAGE(PG8_SB(1, 0), b3, voffB);
            PG8_BAR; PG8_WAIT_L(0); PG8_MMA(0, 1, At, B1); PG8_BAR;
            PG8_LDA(At, 1, 1); PG8_STAGE(PG8_SA(1, 0), a3, voffA);
            PG8_BAR; PG8_WAIT_L(0); PG8_MMA(1, 0, At, B0); PG8_BAR; PG8_SCHED;
            PG8_STAGE(PG8_SB(1, 1), b3 + hstep, voffB);
            PG8_WAIT_V(6); PG8_BAR; PG8_MMA(1, 1, At, B1); PG8_BAR;
            }
        }
        if constexpr (ALIGN_EPI) { if (wr == 0) PG8_BAR; }
        E(acc, cur, wr, wc, fr, fq); S.done(cur);
        if (!has_next) break;
#pragma unroll
        for (int a = 0; a < 2; ++a)
#pragma unroll
            for (int b = 0; b < 2; ++b)
#pragma unroll
                for (int m = 0; m < 4; ++m)
#pragma unroll
                    for (int n = 0; n < 2; ++n) acc[a][b][m][n] = (f32x4){0.f, 0.f, 0.f, 0.f};
        cur = nxt; cA = nA; cB = nB; ++ui;
        if constexpr (ALIGN_EPI) { if (wr == 1) PG8_BAR; }
    }
    PG8_WAIT_V(0);
    if constexpr (!ALIGN_EPI) { if (wr == 0) PG8_BAR; }
    PG8_BAR;
#undef PG8_SA
#undef PG8_SB
#undef PG8_STAGE
#undef PG8_LDA
#undef PG8_LDB
#undef PG8_MMA
#undef PG8_WAIT_V
#undef PG8_WAIT_L
#undef PG8_BAR
#undef PG8_SCHED
}
}

constexpr int BATCH = 8, SEQ = 4096, DM = 1024, MROWS = BATCH * SEQ, DEPTH = 4;
constexpr int NIN = 3072, CIN = 3080, DFF = 2816, NUP = 2 * DFF;
constexpr float EPS = 1e-6f;
constexpr int NPHASE = 2 + 6 * DEPTH;

constexpr size_t MiB = 1u << 20;
constexpr size_t WS_CTL = 0, CTL_ZERO_BYTES = 64 * 1024;
constexpr size_t WS_COS = 1 * MiB, WS_SIN = 2 * MiB;
constexpr size_t WS_SS = 3 * MiB;
constexpr size_t WS_GLI = 5 * MiB, WS_GLF = 5 * MiB + 512 * 1024;
constexpr size_t WS_WG = 6 * MiB;
constexpr size_t WS_WM = 6 * MiB + 256 * 1024;
constexpr size_t WS_NST = 7 * MiB;
constexpr size_t WS_W = 8 * MiB;
constexpr size_t W_IN_OFF = 0, W_OUT_OFF = (size_t)NIN * DM * 2, W_UP_OFF = W_OUT_OFF + (size_t)DM * DM * 2, W_DOWN_OFF = W_UP_OFF + (size_t)NUP * DM * 2, W_LAYER = W_DOWN_OFF + (size_t)DM * DFF * 2;
constexpr size_t WS_HB = 106 * MiB;
constexpr size_t WS_MIX = 170 * MiB;
constexpr size_t WS_PROJ = 234 * MiB;
constexpr size_t WS_TST = 426 * MiB;
constexpr size_t WS_END = 460 * MiB;
static_assert(WS_W + 4 * W_LAYER <= WS_HB && WS_TST + (size_t)256 * 256 * 128 * 4 <= WS_END, "ws map");

constexpr int RING_BYTES = 131072;
constexpr int LDSCTL_OFF = RING_BYTES;
constexpr int LDS_BYTES = 147456;

#define GAS __attribute__((address_space(1)))
#define LAS __attribute__((address_space(3)))
#define DI __device__ __forceinline__
typedef unsigned short bf16_t;
typedef short bf16x8 __attribute__((ext_vector_type(8)));
typedef short bf16x4 __attribute__((ext_vector_type(4)));
typedef float f32x4 __attribute__((ext_vector_type(4)));
typedef float f32x16 __attribute__((ext_vector_type(16)));
typedef unsigned u32x4 __attribute__((ext_vector_type(4)));
typedef unsigned u32x2 __attribute__((ext_vector_type(2)));

DI unsigned pk2(float lo, float hi) { typedef __bf16 b2 __attribute__((ext_vector_type(2))); b2 v; v.x = (__bf16)lo; v.y = (__bf16)hi; return __builtin_bit_cast(unsigned, v); }
DI float bf2f(unsigned short x) { return __uint_as_float(((unsigned)x) << 16); }
DI float bflo(unsigned w) { return __uint_as_float(w << 16); }
DI float bfhi(unsigned w) { return __uint_as_float(w & 0xffff0000u); }
DI float fexp(float x) { return __builtin_amdgcn_exp2f(x * 1.4426950408889634f); }
DI float frcp(float x) { return __builtin_amdgcn_rcpf(x); }
DI float sigmoid_f(float x) { return frcp(1.f + fexp(-x)); }
DI float silu_f(float x) { return x * sigmoid_f(x); }
DI float gelu_tanh_f(float x) { return x * sigmoid_f(1.5957691216057308f * (x + 0.044715f * x * x * x)); }
DI float wave_sum(float v) {
#pragma unroll
    for (int o = 1; o < 64; o <<= 1) v += __shfl_xor(v, o);
    return v;
}

#define XB_TMO      128
#define XB_XCNT(j)  (256  + 64 * (j))
#define XB_XSUB(j)  (1280 + 64 * (j))
#define XB_XGEN(j)  (2304 + 64 * (j))
#define XB_TOP      3328
#define XB_TOPGEN   3392
#define XCD_BAR_WORDS 3456
#define XB_SPIN_CAP (1u << 18)

__device__ __forceinline__ unsigned xb_ld(unsigned* p)              { return __hip_atomic_load(p, __ATOMIC_RELAXED, __HIP_MEMORY_SCOPE_AGENT); }
__device__ __forceinline__ unsigned xb_add(unsigned* p, unsigned v) { return __hip_atomic_fetch_add(p, v, __ATOMIC_RELAXED, __HIP_MEMORY_SCOPE_AGENT); }
__device__ __forceinline__ unsigned xb_xcc_id() { return (unsigned)__builtin_amdgcn_s_getreg((3 << 11) | 20) & 0xFu; }
#define XB_SPIN(cond, bar) do { unsigned _sp = 0; while (cond) { __builtin_amdgcn_s_sleep(1); \
    if ((++_sp & 255u) == 0u) { if (xb_ld(&(bar)[XB_TMO])) break; if (_sp > XB_SPIN_CAP) { atomicAdd(&(bar)[XB_TMO], 1u); break; } } } } while (0)

struct XcdBarrier { unsigned* bar; unsigned x; volatile LAS unsigned* st; };

__device__ __forceinline__ XcdBarrier xcd_barrier_post(unsigned* bar, volatile LAS unsigned* st) {
    XcdBarrier b; b.bar = bar; b.x = xb_xcc_id(); b.st = st;
    if (threadIdx.x == 0) (void)xb_add(&bar[XB_XCNT(b.x)], 1u);
    return b;
}
__device__ __forceinline__ void xcd_barrier_complete(unsigned* bar, unsigned x, unsigned& nloc, unsigned& nx) {
    const unsigned G = gridDim.x * gridDim.y * gridDim.z;
    unsigned sum, cnt, mine, sp = 0u;
    for (;;) {
        sum = 0u; cnt = 0u; mine = 0u;
#pragma unroll
        for (unsigned j = 0; j < 16; ++j) { const unsigned c = xb_ld(&bar[XB_XCNT(j)]); sum += c; cnt += (c > 0u) ? 1u : 0u; mine = (j == x) ? c : mine; }
        if (sum == G) break;
        __builtin_amdgcn_s_sleep(1);
        if ((++sp & 255u) == 0u) { if (xb_ld(&bar[XB_TMO])) break; if (sp > XB_SPIN_CAP) { atomicAdd(&bar[XB_TMO], 1u); break; } }
    }
    nloc = mine > 0u ? mine : 1u; nx = cnt > 0u ? cnt : 1u;
}
__device__ __forceinline__ void xcd_barrier(const XcdBarrier& b) {
    asm volatile("s_waitcnt vmcnt(0)" ::: "memory");
    __syncthreads();
    if (threadIdx.x == 0) {
        unsigned* bar = b.bar;
        __builtin_amdgcn_s_waitcnt(0);
        unsigned nloc = b.st[0], nx = b.st[1];
        if (nloc == 0u) { xcd_barrier_complete(bar, b.x, nloc, nx); b.st[0] = nloc; b.st[1] = nx; }
        const unsigned old = xb_add(&bar[XB_XSUB(b.x)], 1u);
        const unsigned gen = old / nloc;
        if (old + 1u == (gen + 1u) * nloc) {
            __builtin_amdgcn_fence(__ATOMIC_RELEASE, "agent");
            asm volatile("s_waitcnt vmcnt(0)" ::: "memory");
            const unsigned og = xb_add(&bar[XB_TOP], 1u);
            const unsigned tg = og / nx;
            if (og + 1u == (tg + 1u) * nx) xb_add(&bar[XB_TOPGEN], 1u);
            else XB_SPIN(xb_ld(&bar[XB_TOPGEN]) == tg, bar);
            __builtin_amdgcn_fence(__ATOMIC_ACQUIRE, "agent");
            xb_add(&bar[XB_XGEN(b.x)], 1u);
            asm volatile("s_waitcnt vmcnt(0)" ::: "memory");
        } else {
            XB_SPIN(xb_ld(&bar[XB_XGEN(b.x)]) == gen, bar);
            __builtin_amdgcn_fence(__ATOMIC_ACQUIRE, "agent");
            asm volatile("s_waitcnt vmcnt(0)" ::: "memory");
        }
    }
    __syncthreads();
}

struct Frame {
    LAS unsigned char* lds;
    int tid, lane, wave, G;
    const float* const __attribute__((address_space(4)))* in;
    float* H;
    unsigned char* ws;
};
DI bf16_t* W_in(const Frame& F, int L)   { return (bf16_t*)(F.ws + WS_W + (size_t)L * W_LAYER + W_IN_OFF); }
DI bf16_t* W_out(const Frame& F, int L)  { return (bf16_t*)(F.ws + WS_W + (size_t)L * W_LAYER + W_OUT_OFF); }
DI bf16_t* W_up(const Frame& F, int L)   { return (bf16_t*)(F.ws + WS_W + (size_t)L * W_LAYER + W_UP_OFF); }
DI bf16_t* W_down(const Frame& F, int L) { return (bf16_t*)(F.ws + WS_W + (size_t)L * W_LAYER + W_DOWN_OFF); }

DI float row_rstd(const float* SS, int row, int fq) {
    const f32x4 sp = *(const f32x4*)(SS + (size_t)row * 16 + 4 * fq);
    float s = (sp.x + sp.y) + (sp.z + sp.w); s += __shfl_xor(s, 16); s += __shfl_xor(s, 32);
    return 1.0f / sqrtf(s * (1.0f / DM) + EPS);
}
DI void store8(bf16_t* p, const f32x4& v0, const f32x4& v1) { u32x4 w; w.x = pk2(v0[0], v0[1]); w.y = pk2(v0[2], v0[3]); w.z = pk2(v1[0], v1[1]); w.w = pk2(v1[2], v1[3]); *(u32x4*)p = w; }

struct EpiInA {
    static constexpr bool PERM = true;
    bf16_t* P; const float* SS; const float* COS; const float* SIN;
    DI void operator()(const f32x4 (&acc)[2][2][4][2], const pg8::Unit& u, int wr, int wc, int fr, int fq) const {
        const int row0 = u.pm * 256 + wr * 64 + fr, colw = wc * 32 + 8 * fq, typ = u.pn >> 1;
#pragma unroll
        for (int ai = 0; ai < 2; ++ai)
#pragma unroll
            for (int m = 0; m < 4; ++m) {
                const int row = row0 + ai * 128 + m * 16;
                const float rs = row_rstd(SS, row, fq);
                bf16_t* rowp = P + (size_t)row * NIN + u.pn * 256 + colw;
                if (typ < 2) {
                    const int pos = row & (SEQ - 1);
                    const f32x4 c4 = *(const f32x4*)(COS + pos * 64 + (colw >> 1)), s4 = *(const f32x4*)(SIN + pos * 64 + (colw >> 1));
#pragma unroll
                    for (int bj = 0; bj < 2; ++bj) { const f32x4 a0 = acc[ai][bj][m][0] * rs, a1 = acc[ai][bj][m][1] * rs; f32x4 v0, v1;
                        v0[0] = a0[0] * c4[0] - a0[1] * s4[0]; v0[1] = a0[0] * s4[0] + a0[1] * c4[0];
                        v0[2] = a0[2] * c4[1] - a0[3] * s4[1]; v0[3] = a0[2] * s4[1] + a0[3] * c4[1];
                        v1[0] = a1[0] * c4[2] - a1[1] * s4[2]; v1[1] = a1[0] * s4[2] + a1[1] * c4[2];
                        v1[2] = a1[2] * c4[3] - a1[3] * s4[3]; v1[3] = a1[2] * s4[3] + a1[3] * c4[3];
                        store8(rowp + bj * 128, v0, v1); }
                } else {
#pragma unroll
                    for (int bj = 0; bj < 2; ++bj) { f32x4 v0 = acc[ai][bj][m][0] * rs, v1 = acc[ai][bj][m][1] * rs;
                        if (typ == 3) {
#pragma unroll
                            for (int j = 0; j < 4; ++j) { v0[j] = silu_f(v0[j]); v1[j] = silu_f(v1[j]); } }
                        else if (typ >= 4) {
#pragma unroll
                            for (int j = 0; j < 4; ++j) { v0[j] = gelu_tanh_f(v0[j]); v1[j] = gelu_tanh_f(v1[j]); } }
                        store8(rowp + bj * 128, v0, v1); }
                }
            }
    }
};
struct EpiInC {
    static constexpr bool PERM = true;
    bf16_t* P; const float* SS;
    DI void operator()(const f32x4 (&acc)[2][2][4][2], const pg8::Unit& u, int wr, int wc, int fr, int fq) const {
        const int row0 = u.pm * 256 + wr * 64 + fr, colw = wc * 32 + 8 * fq; const bool sg = u.pn >= 8;
#pragma unroll
        for (int ai = 0; ai < 2; ++ai)
#pragma unroll
            for (int m = 0; m < 4; ++m) {
                const int row = row0 + ai * 128 + m * 16;
                const float rs = row_rstd(SS, row, fq);
                bf16_t* rowp = P + (size_t)row * NIN + u.pn * 256 + colw;
#pragma unroll
                for (int bj = 0; bj < 2; ++bj) { f32x4 v0 = acc[ai][bj][m][0] * rs, v1 = acc[ai][bj][m][1] * rs;
                    if (sg) {
#pragma unroll
                        for (int j = 0; j < 4; ++j) { v0[j] = sigmoid_f(v0[j]); v1[j] = sigmoid_f(v1[j]); } }
                    store8(rowp + bj * 128, v0, v1); }
            }
    }
};
struct EpiRes {
    static constexpr bool PERM = true;
    float* H; bf16_t* HB; float* SS;
    DI void operator()(const f32x4 (&acc)[2][2][4][2], const pg8::Unit& u, int wr, int wc, int fr, int fq) const {
        const int row0 = u.pm * 256 + wr * 64 + fr, col0 = u.pn * 256 + wc * 32 + 8 * fq;
#pragma unroll
        for (int ai = 0; ai < 2; ++ai)
#pragma unroll
            for (int m = 0; m < 4; ++m) {
                const int row = row0 + ai * 128 + m * 16;
                float* hp = H + (size_t)row * DM + col0; bf16_t* bp = HB + (size_t)row * DM + col0; float ssum = 0.f;
#pragma unroll
                for (int bj = 0; bj < 2; ++bj) {
                    f32x4 h0 = *(const f32x4*)(hp + bj * 128), h1 = *(const f32x4*)(hp + bj * 128 + 4);
                    h0 = h0 + acc[ai][bj][m][0]; h1 = h1 + acc[ai][bj][m][1];
                    *(f32x4*)(hp + bj * 128) = h0; *(f32x4*)(hp + bj * 128 + 4) = h1;
                    store8(bp + bj * 128, h0, h1);
                    ssum += (h0[0] * h0[0] + h0[1] * h0[1]) + (h0[2] * h0[2] + h0[3] * h0[3]) + (h1[0] * h1[0] + h1[1] * h1[1]) + (h1[2] * h1[2] + h1[3] * h1[3]);
                }
                ssum += __shfl_xor(ssum, 16); ssum += __shfl_xor(ssum, 32);
                if (fq == 0) SS[(size_t)row * 16 + u.pn * 4 + wc] = ssum;
            }
    }
};
struct EpiSwiGLU {
    static constexpr bool PERM = true;
    bf16_t* ACT; const float* SS;
    DI void operator()(const f32x4 (&acc)[2][2][4][2], const pg8::Unit& u, int wr, int wc, int fr, int fq) const {
        const int row0 = u.pm * 256 + wr * 64 + fr, col0 = u.pn * 128 + wc * 32 + 8 * fq;
#pragma unroll
        for (int ai = 0; ai < 2; ++ai)
#pragma unroll
            for (int m = 0; m < 4; ++m) {
                const int row = row0 + ai * 128 + m * 16;
                const float rs = row_rstd(SS, row, fq);
                const f32x4 g0 = acc[ai][0][m][0] * rs, g1 = acc[ai][0][m][1] * rs, u0 = acc[ai][1][m][0] * rs, u1 = acc[ai][1][m][1] * rs; f32x4 v0, v1;
#pragma unroll
                for (int j = 0; j < 4; ++j) { v0[j] = silu_f(g0[j]) * u0[j]; v1[j] = silu_f(g1[j]) * u1[j]; }
                store8(ACT + (size_t)row * DFF + col0, v0, v1);
            }
    }
};

template <class Map>
DI void cvt_item(const float* src, int ld, const float* gain, bf16_t* WT, int K, int n0, int k0, const Map& mp, LAS float* scr, int lane) {
    const int nn = lane & 31; const int sc = mp.col(n0 + nn); const float scale = mp.scale(n0 + nn);
#pragma unroll 8
    for (int i = 0; i < 32; ++i) { const int kk = 2 * i + (lane >> 5); const float gk = gain ? gain[k0 + kk] : 1.0f; scr[kk * 33 + nn] = src[(size_t)(k0 + kk) * ld + sc] * (gk * scale); }
    asm volatile("s_waitcnt lgkmcnt(0)" ::: "memory");
    const int c = lane & 7;
#pragma unroll
    for (int j = 0; j < 4; ++j) { const int n = (lane >> 3) + 8 * j; const LAS float* s = scr + (8 * c) * 33 + n;
        u32x4 o; o.x = pk2(s[0 * 33], s[1 * 33]); o.y = pk2(s[2 * 33], s[3 * 33]); o.z = pk2(s[4 * 33], s[5 * 33]); o.w = pk2(s[6 * 33], s[7 * 33]);
        *(u32x4*)(WT + (size_t)(n0 + n) * K + k0 + 8 * c) = o; }
    asm volatile("s_waitcnt lgkmcnt(0)" ::: "memory");
}
struct MapId { DI int col(int n) const { return n; } DI float scale(int) const { return 1.0f; } };
struct MapInA { DI int col(int n) const { if (n >= 1024) return n; const int p = n & 127; return (n & ~127) + (p >> 1) + 64 * (p & 1); } DI float scale(int n) const { return (n >= 512 && n < 1024) ? 0.08838834764831845f : 1.0f; } };
struct MapInC { DI int col(int n) const { return n; } DI float scale(int n) const { return (n >= 512 && n < 1024) ? 0.08838834764831845f : 1.0f; } };
struct MapUp  { DI int col(int n) const { return 128 * (n >> 8) + (n & 127); } DI float scale(int) const { return 1.0f; } };

DI void p0_prologue(Frame& F) {
    LAS float* scr = (LAS float*)(F.lds + F.wave * 16384);
    const int gw = blockIdx.x * 8 + F.wave, NGW = F.G * 8;
    constexpr int I_IN = 16 * 96, I_OUT = 16 * 32, I_UP = 16 * 176, I_DOWN = 44 * 32, I_LAYER = I_IN + I_OUT + I_UP + I_DOWN;
    for (int it = gw; it < DEPTH * I_LAYER; it += NGW) {
        const int L = it / I_LAYER; int r = it % I_LAYER; const int j = L >> 1;
        if (r < I_IN) { const int kb = r / 96, nb = r % 96;
            if (L & 1) cvt_item(F.in[11] + (size_t)j * DM * CIN, CIN, F.in[1] + L * DM, W_in(F, L), DM, 32 * nb, 64 * kb, MapInC(), scr, F.lane);
            else       cvt_item(F.in[4] + (size_t)j * DM * NIN, NIN, F.in[1] + L * DM, W_in(F, L), DM, 32 * nb, 64 * kb, MapInA(), scr, F.lane);
            continue; }
        r -= I_IN;
        if (r < I_OUT) { const int kb = r / 32, nb = r % 32;
            cvt_item(((L & 1) ? F.in[12] : F.in[5]) + (size_t)j * DM * DM, DM, nullptr, W_out(F, L), DM, 32 * nb, 64 * kb, MapId(), scr, F.lane); continue; }
        r -= I_OUT;
        if (r < I_UP) { const int kb = r / 176, nb = r % 176; const int n0 = 32 * nb; const bool up = (n0 >> 7) & 1;
            cvt_item((up ? F.in[17] : F.in[16]) + (size_t)L * DM * DFF, DFF, F.in[2] + L * DM, W_up(F, L), DM, n0, 64 * kb, MapUp(), scr, F.lane); continue; }
        r -= I_UP;
        { const int kb = r / 32, nb = r % 32;
          cvt_item(F.in[18] + (size_t)L * DFF * DM, DM, nullptr, W_down(F, L), DFF, 32 * nb, 64 * kb, MapId(), scr, F.lane); }
    }
    float* SS = (float*)(F.ws + WS_SS); bf16_t* HB = (bf16_t*)(F.ws + WS_HB);
    for (int m = gw; m < MROWS; m += NGW) {
        const f32x4* xr = (const f32x4*)(F.in[0] + (size_t)m * DM) + F.lane; f32x4* hr = (f32x4*)(F.H + (size_t)m * DM) + F.lane; u32x2* br = (u32x2*)(HB + (size_t)m * DM) + F.lane;
        f32x4 v[4]; float s = 0.f;
#pragma unroll
        for (int q = 0; q < 4; ++q) { v[q] = xr[64 * q]; s += (v[q].x * v[q].x + v[q].y * v[q].y) + (v[q].z * v[q].z + v[q].w * v[q].w); }
        s = wave_sum(s);
#pragma unroll
        for (int q = 0; q < 4; ++q) { hr[64 * q] = v[q]; u32x2 o; o.x = pk2(v[q].x, v[q].y); o.y = pk2(v[q].z, v[q].w); br[64 * q] = o; }
        if (F.lane < 16) SS[(size_t)m * 16 + F.lane] = (F.lane == 0) ? s : 0.f;
    }
    const int gt = blockIdx.x * 512 + F.tid, NGT = F.G * 512;
    float* COS = (float*)(F.ws + WS_COS); float* SIN = (float*)(F.ws + WS_SIN);
    for (int e = gt; e < SEQ * 64; e += NGT) {
        const int pos = e >> 6, i = e & 63;
        const float inv = exp2f(-(float)i * (13.287712379549449f / 64.0f));
        const float ang = (float)pos * inv;
        const double a = (double)ang; const double n = rint(a * 0.15915494309189535); const float rr = (float)(a - n * 6.283185307179586);
        COS[e] = cosf(rr); SIN[e] = sinf(rr);
    }
    float* WG = (float*)(F.ws + WS_WG);
    for (int e = gt; e < 2 * 8 * DM; e += NGT) { const int j = e >> 13, c = (e >> 10) & 7, k = e & 1023;
        WG[e] = F.in[11][(size_t)j * DM * CIN + (size_t)k * CIN + 3072 + c] * F.in[1][(2 * j + 1) * DM + k]; }
    bf16_t* WM = (bf16_t*)(F.ws + WS_WM);
    for (int e = gt; e < 2 * 4 * 128 * 128; e += NGT) { const int p = (e >> 7) & 127, q = e & 127; const float w = ((q >> 6) <= (p >> 6)) ? F.in[9][e] : 0.f; WM[e] = (bf16_t)(pk2(w, 0.f) & 0xffffu); }
}

DI void gate_step(Frame& F, int L) {
    const int j = L >> 1; const int gw = blockIdx.x * 8 + F.wave, NGW = F.G * 8;
    const float* SS = (const float*)(F.ws + WS_SS); const bf16_t* HB = (const bf16_t*)(F.ws + WS_HB); const float* WG = (const float*)(F.ws + WS_WG) + j * 8 * DM;
    float* GLI = (float*)(F.ws + WS_GLI); float* GLF = (float*)(F.ws + WS_GLF);
    for (int m = gw; m < MROWS; m += NGW) {
        const u32x4 a0 = *((const u32x4*)(HB + (size_t)m * DM) + F.lane), a1 = *((const u32x4*)(HB + (size_t)m * DM + 512) + F.lane);
        float x[16];
        x[0] = bflo(a0.x); x[1] = bfhi(a0.x); x[2] = bflo(a0.y); x[3] = bfhi(a0.y); x[4] = bflo(a0.z); x[5] = bfhi(a0.z); x[6] = bflo(a0.w); x[7] = bfhi(a0.w);
        x[8] = bflo(a1.x); x[9] = bfhi(a1.x); x[10] = bflo(a1.y); x[11] = bfhi(a1.y); x[12] = bflo(a1.z); x[13] = bfhi(a1.z); x[14] = bflo(a1.w); x[15] = bfhi(a1.w);
        float ssp = (F.lane < 16) ? SS[(size_t)m * 16 + F.lane] : 0.f; ssp = wave_sum(ssp);
        const float rs = 1.0f / sqrtf(ssp * (1.0f / DM) + EPS);
        float myv = 0.f;
#pragma unroll
        for (int c = 0; c < 8; ++c) {
            const f32x4* w0 = (const f32x4*)(WG + c * DM + 8 * F.lane); const f32x4* w1 = (const f32x4*)(WG + c * DM + 512 + 8 * F.lane);
            const f32x4 wa = w0[0], wb = w0[1], wc2 = w1[0], wd = w1[1];
            float d = x[0] * wa.x + x[1] * wa.y + x[2] * wa.z + x[3] * wa.w + x[4] * wb.x + x[5] * wb.y + x[6] * wb.z + x[7] * wb.w
                    + x[8] * wc2.x + x[9] * wc2.y + x[10] * wc2.z + x[11] * wc2.w + x[12] * wd.x + x[13] * wd.y + x[14] * wd.z + x[15] * wd.w;
            d = wave_sum(d);
            if (F.lane == c) myv = d * rs;
        }
        if (F.lane < 8) {
            const int hh = F.lane & 3; const int b = m >> 12, t = m & (SEQ - 1); const size_t idx = (size_t)(b * 4 + hh) * SEQ + t;
            if (F.lane < 4) GLI[idx] = myv + F.in[13][j * 4 + hh];
            else { const float xx = myv + F.in[14][j * 4 + hh]; GLF[idx] = (xx >= 0.f) ? -log1pf(expf(-xx)) : (xx - log1pf(expf(xx))); }
        }
    }
}

DI void final_norm(Frame& F) {
    const int gw = blockIdx.x * 8 + F.wave, NGW = F.G * 8; const float* SS = (const float*)(F.ws + WS_SS); const f32x4* gv = (const f32x4*)F.in[3] + F.lane;
    for (int m = gw; m < MROWS; m += NGW) {
        f32x4* hr = (f32x4*)(F.H + (size_t)m * DM) + F.lane;
        float ssp = (F.lane < 16) ? SS[(size_t)m * 16 + F.lane] : 0.f; ssp = wave_sum(ssp);
        const float rs = 1.0f / sqrtf(ssp * (1.0f / DM) + EPS);
#pragma unroll
        for (int q = 0; q < 4; ++q) { const f32x4 v = hr[64 * q], g = gv[64 * q]; hr[64 * q] = v * rs * g; }
    }
}

DI int opaque(int x) { asm volatile("" : "+v"(x)); return x; }
DI int crow(int i, int h) { return (i & 3) + 8 * (i >> 2) + 4 * h; }
constexpr int QLD = 136, PLD = 72;
constexpr int QS_OFF = 0, KS_OFF = 17408, KW_OFF = 34816, VS_OFF = 52224, PS_OFF = 86016;
constexpr int SA_OFF = 95232, SCM_OFF = SA_OFF + 2048, SMT_OFF = SCM_OFF + 2048, SMISC_OFF = SMT_OFF + 2048;
constexpr int STAT_OFF = SMISC_OFF + 256, NV_OFF = STAT_OFF + 4096, LA_END = NV_OFF + 512;
static_assert(LA_END <= RING_BYTES, "mixer LDS");

DI bf16x8 gather_col(const LAS bf16_t* base, int ld, int col, int s0) {
    bf16x8 r;
#pragma unroll
    for (int j = 0; j < 8; ++j) r[j] = (short)base[(s0 + j) * ld + col];
    return r;
}
DI bf16x8 pack_acc(const f32x16& x, int s) {
    u32x4 p; p.x = pk2(x[8 * s + 0], x[8 * s + 1]); p.y = pk2(x[8 * s + 2], x[8 * s + 3]); p.z = pk2(x[8 * s + 4], x[8 * s + 5]); p.w = pk2(x[8 * s + 6], x[8 * s + 7]);
    return __builtin_bit_cast(bf16x8, p);
}
#define MFMA32(a, b, c) __builtin_amdgcn_mfma_f32_32x32x16_bf16((a), (b), (c), 0, 0, 0)
#define MFMA16(a, b, c) __builtin_amdgcn_mfma_f32_16x16x32_bf16((a), (b), (c), 0, 0, 0)

DI void mlstm_scan(Frame& F, int b, int h, int g) {
    LAS float* SA = (LAS float*)(F.lds + SA_OFF); LAS float* SCM = (LAS float*)(F.lds + SCM_OFF); LAS float* SMT = (LAS float*)(F.lds + SMT_OFF); LAS float* SM = (LAS float*)(F.lds + SMISC_OFF);
    const float* GLI = (const float*)(F.ws + WS_GLI) + (size_t)(b * 4 + h) * SEQ; const float* GLF = (const float*)(F.ws + WS_GLF) + (size_t)(b * 4 + h) * SEQ;
    float mprev = 0.f, Lc = 0.f; const int lane = F.lane;
    for (int gg = 0; gg <= g; ++gg) {
        float li[8], lf[8]; const int lo = opaque(lane);
        const float* gli = GLI + gg * 512 + lo; const float* glf = GLF + gg * 512 + lo;
#pragma unroll
        for (int c = 0; c < 8; ++c) { li[c] = gli[c * 64]; lf[c] = glf[c * 64]; }
        if (lane == 0) SM[16 + gg] = Lc;
#pragma unroll
        for (int c = 0; c < 8; ++c) {
            float bs = lf[c];
#pragma unroll
            for (int o = 1; o < 64; o <<= 1) { const float t = __shfl_up(bs, o); if (lane >= o) bs += t; }
            const float a = li[c] - bs; float cmx = a;
#pragma unroll
            for (int o = 1; o < 64; o <<= 1) { const float t = __shfl_up(cmx, o); if (lane >= o) cmx = fmaxf(cmx, t); }
            const float cm = fmaxf(mprev, cmx);
            const float cm63 = __shfl(cm, 63), b63 = __shfl(bs, 63);
            if (gg == g) { (SA + lo)[c * 64] = a; (SCM + lo)[c * 64] = cm; (SMT + lo)[c * 64] = bs + cm; if (lane == 0) SM[c] = mprev; }
            Lc += mprev - cm63; mprev = b63 + cm63;
        }
    }
}

template <int MODE, bool PASS2>
DI void la_stage(Frame& F, const bf16_t* PROJ, int R0, int h, int c, float lg2) {
    constexpr int DV = MODE ? 256 : 128, VLD = DV + 8;
    LAS bf16_t* Qs = (LAS bf16_t*)(F.lds + QS_OFF); LAS bf16_t* Ks = (LAS bf16_t*)(F.lds + KS_OFF); LAS bf16_t* Kw = (LAS bf16_t*)(F.lds + KW_OFF); LAS bf16_t* Vs = (LAS bf16_t*)(F.lds + VS_OFF);
    const LAS float* SA = (const LAS float*)(F.lds + SA_OFF); const LAS float* SCM = (const LAS float*)(F.lds + SCM_OFF);
    const int qcol = 128 * h, kcol = 512 + 128 * h, vcol = 1024 + DV * h; const int tid_o = opaque(F.tid);
#pragma unroll
    for (int i = 0; i < 2; ++i) { const int p = tid_o + 512 * i, t = p >> 4, cp = (p & 15) * 8;
        const u32x4 kv = *(const u32x4*)(PROJ + (size_t)(R0 + t) * NIN + kcol + cp);
        float ck;
        if (MODE) ck = fexp(SA[c * 64 + t] - SCM[c * 64 + 63]); else ck = __builtin_amdgcn_exp2f(lg2 * (float)(63 - t));
        u32x4 kw; kw.x = pk2(bflo(kv.x) * ck, bfhi(kv.x) * ck); kw.y = pk2(bflo(kv.y) * ck, bfhi(kv.y) * ck); kw.z = pk2(bflo(kv.z) * ck, bfhi(kv.z) * ck); kw.w = pk2(bflo(kv.w) * ck, bfhi(kv.w) * ck);
        *(LAS u32x4*)(Kw + t * QLD + cp) = kw;
        if (PASS2) { *(LAS u32x4*)(Ks + t * QLD + cp) = kv;
            const u32x4 qv = *(const u32x4*)(PROJ + (size_t)(R0 + t) * NIN + qcol + cp); *(LAS u32x4*)(Qs + t * QLD + cp) = qv; }
    }
#pragma unroll
    for (int i = 0; i < DV / 64; ++i) { const int p = tid_o + 512 * i, t = p / (DV / 8), cp = (p % (DV / 8)) * 8;
        const u32x4 vv = *(const u32x4*)(PROJ + (size_t)(R0 + t) * NIN + vcol + cp); *(LAS u32x4*)(Vs + t * VLD + cp) = vv; }
}

template <int MODE>
DI void la_pass1(Frame& F, int unit) {
    constexpr int DV = MODE ? 256 : 128, VLD = DV + 8, ND = MODE ? 4 : 2;
    const int b = unit >> 5, h = (unit >> 3) & 3, g = unit & 7, row0 = b * SEQ + g * 512;
    const int w = F.wave; int lane = F.lane, r = lane & 31, hh = lane >> 5;
    const int eb = MODE ? w : (w & 3), dt0 = MODE ? 0 : 2 * (w >> 2), e0 = 32 * eb;
    const bf16_t* PROJ = (const bf16_t*)(F.ws + WS_PROJ);
    LAS bf16_t* Kw = (LAS bf16_t*)(F.lds + KW_OFF); LAS bf16_t* Vs = (LAS bf16_t*)(F.lds + VS_OFF);
    const LAS float* SCM = (const LAS float*)(F.lds + SCM_OFF); const LAS float* SM = (const LAS float*)(F.lds + SMISC_OFF); LAS float* NV = (LAS float*)(F.lds + NV_OFF);
    const float lg2 = log2f(1.0f - exp2f(-5.0f - (float)h));
    if (MODE) { if (w == 0) mlstm_scan(F, b, h, g); if (F.tid < 128) NV[F.tid] = 0.f; }
    __syncthreads();
    f32x16 C[ND];
#pragma unroll
    for (int d = 0; d < ND; ++d)
#pragma unroll
        for (int i = 0; i < 16; ++i) C[d][i] = 0.f;
    for (int c = 0; c < 8; ++c) {
        lane = opaque(F.lane); r = lane & 31; hh = lane >> 5;
        la_stage<MODE, false>(F, PROJ, row0 + 64 * c, h, c, lg2);
        __syncthreads();
        const float alpha = MODE ? fexp(SM[c] - SCM[c * 64 + 63]) : __builtin_amdgcn_exp2f(lg2 * 64.0f);
        bf16x8 vf[4];
#pragma unroll
        for (int ks = 0; ks < 4; ++ks) vf[ks] = gather_col(Vs, VLD, e0 + r, 16 * ks + 8 * hh);
#pragma unroll
        for (int d = 0; d < ND; ++d) {
#pragma unroll
            for (int i = 0; i < 16; ++i) C[d][i] *= alpha;
#pragma unroll
            for (int ks = 0; ks < 4; ++ks) { const bf16x8 ka = gather_col(Kw, QLD, 32 * (dt0 + d) + r, 16 * ks + 8 * hh); C[d] = MFMA32(ka, vf[ks], C[d]); }
            asm volatile("" ::: "memory");
        }
        if (MODE) {
            const int dd = 16 * w + (lane & 15), sq = lane >> 4; float s = 0.f;
#pragma unroll
            for (int q = 0; q < 16; ++q) s += bf2f(Kw[(16 * sq + q) * QLD + dd]);
            s += __shfl_xor(s, 16); s += __shfl_xor(s, 32);
            if (lane < 16) NV[dd] = alpha * NV[dd] + s;
        }
        __syncthreads();
    }
    float* T = (float*)(F.ws + WS_TST) + (size_t)unit * DV * 128;
#pragma unroll
    for (int d = 0; d < ND; ++d)
#pragma unroll
        for (int q = 0; q < 4; ++q) { const f32x4 v = {C[d][4 * q], C[d][4 * q + 1], C[d][4 * q + 2], C[d][4 * q + 3]};
            *(f32x4*)(T + (size_t)(e0 + r) * 128 + 32 * (dt0 + d) + 8 * q + 4 * hh) = v; }
    if (MODE && F.tid < 128) ((float*)(F.ws + WS_NST))[unit * 128 + F.tid] = NV[F.tid];
    __syncthreads();
}

template <int MODE>
DI void la_pass2(Frame& F, int unit, int j) {
    constexpr int DV = MODE ? 256 : 128, VLD = DV + 8, NT = MODE ? 2 : 1;
    const int b = unit >> 5, h = (unit >> 3) & 3, g = unit & 7, row0 = b * SEQ + g * 512;
    const int w = F.wave; int lane = F.lane, r = lane & 31, hh = lane >> 5, r16 = lane & 15, q4 = lane >> 4;
    const int eb = MODE ? w : (w & 3), tb0 = MODE ? 0 : (w >> 2), e0 = 32 * eb;
    const int gcol = MODE ? (2048 + 256 * h) : (1536 + 128 * h), ocol = DV * h;
    const bf16_t* PROJ = (const bf16_t*)(F.ws + WS_PROJ); bf16_t* MIX = (bf16_t*)(F.ws + WS_MIX);
    const float* gain = MODE ? (F.in[15] + (j * 4 + h) * 256) : (F.in[6] + (j * 4 + h) * 128);
    LAS bf16_t* Qs = (LAS bf16_t*)(F.lds + QS_OFF); LAS bf16_t* Ks = (LAS bf16_t*)(F.lds + KS_OFF); LAS bf16_t* Kw = (LAS bf16_t*)(F.lds + KW_OFF); LAS bf16_t* Vs = (LAS bf16_t*)(F.lds + VS_OFF); LAS bf16_t* Ps = (LAS bf16_t*)(F.lds + PS_OFF);
    const LAS float* SA = (const LAS float*)(F.lds + SA_OFF); const LAS float* SCM = (const LAS float*)(F.lds + SCM_OFF); const LAS float* SMT = (const LAS float*)(F.lds + SMT_OFF); const LAS float* SM = (const LAS float*)(F.lds + SMISC_OFF);
    LAS float* STAT = (LAS float*)(F.lds + STAT_OFF); LAS float* NV = (LAS float*)(F.lds + NV_OFF);
    const float lg2 = log2f(1.0f - exp2f(-5.0f - (float)h));
    if (MODE) { if (w == 0) mlstm_scan(F, b, h, g); }
    __syncthreads();
    f32x16 C[4];
#pragma unroll
    for (int d = 0; d < 4; ++d)
#pragma unroll
        for (int i = 0; i < 16; ++i) C[d][i] = 0.f;
    float nacc = 0.f;
    for (int gp = 0; gp < g; ++gp) {
        const float coef = MODE ? fexp(SM[16 + g] - SM[16 + gp + 1]) : __builtin_amdgcn_exp2f(lg2 * (float)(512 * (g - 1 - gp)));
        const float* T = (const float*)(F.ws + WS_TST) + (size_t)(unit - g + gp) * DV * 128 + (size_t)(e0 + r) * 128 + 4 * hh;
#pragma unroll
        for (int d = 0; d < 4; ++d)
#pragma unroll
            for (int q = 0; q < 4; ++q) { const f32x4 v = *(const f32x4*)(T + 32 * d + 8 * q);
                C[d][4 * q] += coef * v.x; C[d][4 * q + 1] += coef * v.y; C[d][4 * q + 2] += coef * v.z; C[d][4 * q + 3] += coef * v.w; }
        if (MODE && F.tid < 128) nacc += coef * ((const float*)(F.ws + WS_NST))[(unit - g + gp) * 128 + F.tid];
    }
    if (MODE && F.tid < 128) NV[F.tid] = nacc;
    for (int c = 0; c < 8; ++c) {
        const int R0 = row0 + 64 * c;
        lane = opaque(F.lane); r = lane & 31; hh = lane >> 5; r16 = lane & 15; q4 = lane >> 4;
        la_stage<MODE, true>(F, PROJ, R0, h, c, lg2);
        __syncthreads();
#pragma unroll
        for (int i = 0; i < 2; ++i) {
            const int tt = 2 * w + i, si = tt >> 2, ti = tt & 3;
            f32x4 x = {0.f, 0.f, 0.f, 0.f};
#pragma unroll
            for (int kk = 0; kk < 4; ++kk) { const bf16x8 ka = *(const LAS bf16x8*)(Ks + (16 * si + r16) * QLD + 32 * kk + 8 * q4); const bf16x8 qb = *(const LAS bf16x8*)(Qs + (16 * ti + r16) * QLD + 32 * kk + 8 * q4); x = MFMA16(ka, qb, x); }
            const int t = 16 * ti + r16; float p[4];
#pragma unroll
            for (int q = 0; q < 4; ++q) { const int s = 16 * si + 4 * q4 + q; float wgt;
                if (MODE) wgt = (s <= t) ? fexp(SA[c * 64 + s] - SCM[c * 64 + t]) : 0.f;
                else { const int dlt = t > s ? t - s : s - t; wgt = __builtin_amdgcn_exp2f(lg2 * (float)dlt); }
                p[q] = x[q] * wgt; }
            u32x2 pw; pw.x = pk2(p[0], p[1]); pw.y = pk2(p[2], p[3]);
            *(LAS u32x2*)(Ps + t * PLD + 16 * si + 4 * q4) = pw;
        }
        __syncthreads();
        bf16x8 vf[4];
#pragma unroll
        for (int ks = 0; ks < 4; ++ks) vf[ks] = gather_col(Vs, VLD, e0 + r, 16 * ks + 8 * hh);
        __builtin_amdgcn_sched_barrier(0);
        float cqv[NT], rinvv[NT];
#pragma unroll
        for (int tt = 0; tt < NT; ++tt) {
            const int t = 32 * (tb0 + tt) + r;
            if (MODE) {
                const float cq = fexp(SM[c] - SCM[c * 64 + t]);
                float ps = 0.f, qn = 0.f;
#pragma unroll
                for (int q = 0; q < 4; ++q) { const u32x4 pv = *(const LAS u32x4*)(Ps + t * PLD + 32 * hh + 8 * q);
                    ps += (bflo(pv.x) + bfhi(pv.x)) + (bflo(pv.y) + bfhi(pv.y)) + (bflo(pv.z) + bfhi(pv.z)) + (bflo(pv.w) + bfhi(pv.w)); }
#pragma unroll
                for (int q = 0; q < 8; ++q) { const u32x4 qv = *(const LAS u32x4*)(Qs + t * QLD + 64 * hh + 8 * q); const f32x4 n0 = *(const LAS f32x4*)(NV + 64 * hh + 8 * q), n1 = *(const LAS f32x4*)(NV + 64 * hh + 8 * q + 4);
                    qn += bflo(qv.x) * n0.x + bfhi(qv.x) * n0.y + bflo(qv.y) * n0.z + bfhi(qv.y) * n0.w + bflo(qv.z) * n1.x + bfhi(qv.z) * n1.y + bflo(qv.w) * n1.z + bfhi(qv.w) * n1.w;
                    if (q & 1) asm volatile("" ::: "memory"); }
                float den = ps + cq * qn; den += __shfl_xor(den, 32);
                cqv[tt] = cq; rinvv[tt] = 1.0f / fmaxf(fabsf(den), fexp(-SMT[c * 64 + t]));
            } else { cqv[tt] = __builtin_amdgcn_exp2f(lg2 * (float)(t + 1)); rinvv[tt] = 1.f; }
        }
        __builtin_amdgcn_sched_barrier(0);
        f32x16 o2[NT], val[NT];
#pragma unroll
        for (int tt = 0; tt < NT; ++tt)
#pragma unroll
            for (int i = 0; i < 16; ++i) { o2[tt][i] = 0.f; val[tt][i] = 0.f; }
#pragma unroll
        for (int d = 0; d < 4; ++d) {
#pragma unroll
            for (int s2 = 0; s2 < 2; ++s2) { const bf16x8 ca = pack_acc(C[d], s2);
#pragma unroll
                for (int tt = 0; tt < NT; ++tt) { const int t = 32 * (tb0 + tt) + r;
                    const bf16x4 qlo = *(const LAS bf16x4*)(Qs + t * QLD + 32 * d + 16 * s2 + 4 * hh), qhi = *(const LAS bf16x4*)(Qs + t * QLD + 32 * d + 16 * s2 + 4 * hh + 8);
                    const bf16x8 qb = __builtin_shufflevector(qlo, qhi, 0, 1, 2, 3, 4, 5, 6, 7);
                    o2[tt] = MFMA32(ca, qb, o2[tt]); } }
            __builtin_amdgcn_sched_barrier(0);
        }
#pragma unroll
        for (int tt = 0; tt < NT; ++tt) { const int t = 32 * (tb0 + tt) + r;
#pragma unroll
            for (int ks = 0; ks < 4; ++ks) { const bf16x8 pb = *(const LAS bf16x8*)(Ps + t * PLD + 16 * ks + 8 * hh); val[tt] = MFMA32(vf[ks], pb, val[tt]); } }
#pragma unroll
        for (int tt = 0; tt < NT; ++tt) { const int t = 32 * (tb0 + tt) + r;
            float s1 = 0.f, s2s = 0.f;
#pragma unroll
            for (int i = 0; i < 16; ++i) { const float v = (val[tt][i] + cqv[tt] * o2[tt][i]) * rinvv[tt]; val[tt][i] = v; s1 += v; s2s += v * v; }
            s1 += __shfl_xor(s1, 32); s2s += __shfl_xor(s2s, 32);
            if (hh == 0) { STAT[(w * 64 + t) * 2] = s1; STAT[(w * 64 + t) * 2 + 1] = s2s; }
        }
        __syncthreads();
#pragma unroll
        for (int tt = 0; tt < NT; ++tt) {
            const int t = 32 * (tb0 + tt) + r; float S1 = 0.f, S2 = 0.f;
#pragma unroll
            for (int ww = 0; ww < (MODE ? 8 : 4); ++ww) { const int wi = MODE ? ww : (4 * tb0 + ww); S1 += STAT[(wi * 64 + t) * 2]; S2 += STAT[(wi * 64 + t) * 2 + 1]; }
            const float mean = S1 * (1.0f / DV); const float var = fmaxf(S2 * (1.0f / DV) - mean * mean, 0.f); const float rs = 1.0f / sqrtf(var + EPS);
            const size_t rowoff = (size_t)(R0 + t);
#pragma unroll
            for (int q = 0; q < 4; ++q) { const int e = e0 + 8 * q + 4 * hh;
                const f32x4 gn = *(const f32x4*)(gain + e); const u32x2 gt = *(const u32x2*)(PROJ + rowoff * NIN + gcol + e);
                const float y0 = (val[tt][4 * q] - mean) * rs * gn.x * bflo(gt.x), y1 = (val[tt][4 * q + 1] - mean) * rs * gn.y * bfhi(gt.x);
                const float y2 = (val[tt][4 * q + 2] - mean) * rs * gn.z * bflo(gt.y), y3 = (val[tt][4 * q + 3] - mean) * rs * gn.w * bfhi(gt.y);
                u32x2 o; o.x = pk2(y0, y1); o.y = pk2(y2, y3); *(u32x2*)(MIX + rowoff * DM + ocol + e) = o; asm volatile("" ::: "memory"); }
        }
        __builtin_amdgcn_sched_barrier(0);
        const float alpha = MODE ? fexp(SM[c] - SCM[c * 64 + 63]) : __builtin_amdgcn_exp2f(lg2 * 64.0f);
#pragma unroll
        for (int d = 0; d < 4; ++d) {
#pragma unroll
            for (int i = 0; i < 16; ++i) C[d][i] *= alpha;
#pragma unroll
            for (int ks = 0; ks < 4; ++ks) { const bf16x8 ka = gather_col(Kw, QLD, 32 * d + r, 16 * ks + 8 * hh); C[d] = MFMA32(ka, vf[ks], C[d]); }
            __builtin_amdgcn_sched_barrier(0);
        }
        if (MODE) {
            const int dd = 16 * w + (lane & 15), sq = lane >> 4; float s = 0.f;
#pragma unroll
            for (int q = 0; q < 16; ++q) s += bf2f(Kw[(16 * sq + q) * QLD + dd]);
            s += __shfl_xor(s, 16); s += __shfl_xor(s, 32);
            if (lane < 16) NV[dd] = alpha * NV[dd] + s;
        }
        __syncthreads();
    }
}

constexpr int VN_OFF = 0, SGST_OFF = 34816;
DI void sgu_unit(Frame& F, int unit, int j) {
    const int row0 = unit * 128; const int w = F.wave; int lane = F.lane, r = lane & 31, hh = lane >> 5;
    const bf16_t* PROJ = (const bf16_t*)(F.ws + WS_PROJ); bf16_t* MIX = (bf16_t*)(F.ws + WS_MIX);
    LAS bf16_t* Vn = (LAS bf16_t*)(F.lds + VN_OFF); LAS float* ST = (LAS float*)(F.lds + SGST_OFF);
    const float* lng = F.in[7] + j * 512; const float* lnb = F.in[8] + j * 512;
    for (int i = 0; i < 16; ++i) { const int p = 16 * w + i;
        const u32x4 v = *((const u32x4*)(PROJ + (size_t)(row0 + p) * NIN + 2560) + lane);
        const float x0 = bflo(v.x), x1 = bfhi(v.x), x2 = bflo(v.y), x3 = bfhi(v.y), x4 = bflo(v.z), x5 = bfhi(v.z), x6 = bflo(v.w), x7 = bfhi(v.w);
        float s = ((x0 + x1) + (x2 + x3)) + ((x4 + x5) + (x6 + x7)); s = wave_sum(s); const float mean = s * (1.0f / 512.0f);
        const float d0 = x0 - mean, d1 = x1 - mean, d2 = x2 - mean, d3 = x3 - mean, d4 = x4 - mean, d5 = x5 - mean, d6 = x6 - mean, d7 = x7 - mean;
        float q = ((d0 * d0 + d1 * d1) + (d2 * d2 + d3 * d3)) + ((d4 * d4 + d5 * d5) + (d6 * d6 + d7 * d7)); q = wave_sum(q);
        if (lane == 0) { ST[2 * p] = mean; ST[2 * p + 1] = 1.0f / sqrtf(q * (1.0f / 512.0f) + EPS); } }
    __syncthreads();
    const int dtl = w & 3, pt0 = 2 * (w >> 2);
    for (int gq = 0; gq < 4; ++gq) {
        lane = opaque(F.lane); r = lane & 31; hh = lane >> 5; const int tid_o = opaque(F.tid);
#pragma unroll
        for (int i = 0; i < 4; ++i) { const int pc = tid_o + 512 * i, q = pc >> 4, cp = (pc & 15) * 8; const int col = 128 * gq + cp;
            const u32x4 v = *(const u32x4*)(PROJ + (size_t)(row0 + q) * NIN + 2560 + col); const float mean = ST[2 * q], rs = ST[2 * q + 1];
            const f32x4 g0 = *(const f32x4*)(lng + col), g1 = *(const f32x4*)(lng + col + 4), b0 = *(const f32x4*)(lnb + col), b1 = *(const f32x4*)(lnb + col + 4);
            u32x4 o; o.x = pk2((bflo(v.x) - mean) * rs * g0.x + b0.x, (bfhi(v.x) - mean) * rs * g0.y + b0.y); o.y = pk2((bflo(v.y) - mean) * rs * g0.z + b0.z, (bfhi(v.y) - mean) * rs * g0.w + b0.w);
            o.z = pk2((bflo(v.z) - mean) * rs * g1.x + b1.x, (bfhi(v.z) - mean) * rs * g1.y + b1.y); o.w = pk2((bflo(v.w) - mean) * rs * g1.z + b1.z, (bfhi(v.w) - mean) * rs * g1.w + b1.w);
            *(LAS u32x4*)(Vn + q * QLD + cp) = o; }
        __syncthreads();
        const bf16_t* WM = (const bf16_t*)(F.ws + WS_WM) + (size_t)(j * 4 + gq) * 128 * 128;
        f32x16 acc[2];
#pragma unroll
        for (int i = 0; i < 16; ++i) { acc[0][i] = 0.f; acc[1][i] = 0.f; }
#pragma unroll
        for (int ks = 0; ks < 8; ++ks) { const bf16x8 vb = gather_col(Vn, QLD, 32 * dtl + r, 16 * ks + 8 * hh);
#pragma unroll
            for (int pt = 0; pt < 2; ++pt) { const bf16x8 wa = *(const bf16x8*)(WM + (size_t)(32 * (pt0 + pt) + r) * 128 + 16 * ks + 8 * hh); acc[pt] = MFMA32(wa, vb, acc[pt]); } }
        const float* bs = F.in[10] + (j * 4 + gq) * 128;
#pragma unroll
        for (int pt = 0; pt < 2; ++pt)
#pragma unroll
            for (int i = 0; i < 16; ++i) { const int p = 32 * (pt0 + pt) + crow(i, hh); const int col = 128 * gq + 32 * dtl + r;
                const float uu = bf2f(PROJ[(size_t)(row0 + p) * NIN + 2048 + col]);
                MIX[(size_t)(row0 + p) * DM + 512 + col] = (bf16_t)(pk2(uu * (acc[pt][i] + bs[p]), 0.f) & 0xffffu); if ((i & 3) == 3) asm volatile("" ::: "memory"); }
        __syncthreads();
    }
}

struct Args { const float* in[19]; float* out; unsigned char* ws; int ph_lo, ph_hi; };
__global__ void __launch_bounds__(512, 2) fwd(Args args) {
    extern __shared__ __attribute__((aligned(16))) unsigned char lds_raw[];
    Frame F;
    F.lds = (LAS unsigned char*)lds_raw;
    const int wave_s = __builtin_amdgcn_readfirstlane(threadIdx.x >> 6);
    F.tid = threadIdx.x; F.lane = F.tid & 63; F.wave = wave_s; F.G = gridDim.x;
    F.in = (const float* const __attribute__((address_space(4)))*)__builtin_amdgcn_kernarg_segment_ptr();
    F.H = args.out; F.ws = args.ws;
    volatile LAS unsigned* MISC = (volatile LAS unsigned*)(F.lds + LDSCTL_OFF);
    if (F.tid < 64) MISC[F.tid] = 0u;
    __syncthreads();
    XcdBarrier bar; bar.bar = (unsigned*)(F.ws + WS_CTL); bar.x = 0; bar.st = nullptr;
    if (ONE_LAUNCH) bar = xcd_barrier_post((unsigned*)(F.ws + WS_CTL), MISC + 8);
    const int lo = args.ph_lo, hi = args.ph_hi;
#define IN(k) (lo <= (k) && (k) < hi)
#define REFRESH() do { F.lane = opaque((int)__builtin_amdgcn_mbcnt_hi(~0u, __builtin_amdgcn_mbcnt_lo(~0u, 0u))); F.wave = wave_s; F.tid = wave_s * 64 + F.lane; } while (0)
#define SEAM(k) do { if (ONE_LAUNCH && IN((k) + 1)) xcd_barrier(bar); } while (0)
    const float* SS = (const float*)(F.ws + WS_SS); bf16_t* HB = (bf16_t*)(F.ws + WS_HB); bf16_t* MIX = (bf16_t*)(F.ws + WS_MIX); bf16_t* PROJ = (bf16_t*)(F.ws + WS_PROJ);

    if ((PH_MASK & 1) && IN(0)) { REFRESH(); p0_prologue(F); SEAM(0); }
    for (int L = 0; L < DEPTH; ++L) {
        const int pb = 1 + 6 * L, j = L >> 1;
        if (IN(pb)) {
            REFRESH();
            pg8::Gemm g{HB, W_in(F, L), MROWS, NIN, DM}; pg8::StaticOrder S; S.init(MROWS, NIN, F.G, (int)blockIdx.x);
            if (L & 1) { if (PH_MASK & 2) { EpiInC E{PROJ, SS}; pg8::gemm_phase<EpiInC, pg8::StaticOrder, true, true>(F.lds, g, S, E, F.tid); } if (PH_MASK & 4) gate_step(F, L); }
            else if (PH_MASK & 8) { EpiInA E{PROJ, SS, (const float*)(F.ws + WS_COS), (const float*)(F.ws + WS_SIN)}; pg8::gemm_phase<EpiInA, pg8::StaticOrder, true, true>(F.lds, g, S, E, F.tid); }
            SEAM(pb);
        }
        if (IN(pb + 1)) {
            REFRESH();
            for (int u = blockIdx.x; u < 256; u += F.G) { if (L & 1) { if (PH_MASK & 16) la_pass1<1>(F, u); } else { if (PH_MASK & 32) la_pass1<0>(F, u); if (PH_MASK & 64) sgu_unit(F, u, j); } }
            SEAM(pb + 1);
        }
        if (IN(pb + 2)) {
            REFRESH();
            for (int u = blockIdx.x; u < 256; u += F.G) { if (L & 1) { if (PH_MASK & 128) la_pass2<1>(F, u, j); } else { if (PH_MASK & 256) la_pass2<0>(F, u, j); } }
            SEAM(pb + 2);
        }
        if (IN(pb + 3)) {
            REFRESH();
            pg8::Gemm g{MIX, W_out(F, L), MROWS, DM, DM}; pg8::StaticOrder S; S.init(MROWS, DM, F.G, (int)blockIdx.x);
            if (PH_MASK & 512) { EpiRes E{F.H, HB, (float*)(F.ws + WS_SS)}; pg8::gemm_phase<EpiRes, pg8::StaticOrder, true, true>(F.lds, g, S, E, F.tid); }
            SEAM(pb + 3);
        }
        if (IN(pb + 4)) {
            REFRESH();
            pg8::Gemm g{HB, W_up(F, L), MROWS, NUP, DM}; pg8::StaticOrder S; S.init(MROWS, NUP, F.G, (int)blockIdx.x);
            if (PH_MASK & 1024) { EpiSwiGLU E{PROJ, SS}; pg8::gemm_phase<EpiSwiGLU, pg8::StaticOrder, true, true>(F.lds, g, S, E, F.tid); }
            SEAM(pb + 4);
        }
        if (IN(pb + 5)) {
            REFRESH();
            pg8::Gemm g{PROJ, W_down(F, L), MROWS, DM, DFF}; pg8::StaticOrder S; S.init(MROWS, DM, F.G, (int)blockIdx.x);
            if (PH_MASK & 2048) { EpiRes E{F.H, HB, (float*)(F.ws + WS_SS)}; pg8::gemm_phase<EpiRes, pg8::StaticOrder, true, true>(F.lds, g, S, E, F.tid); }
            SEAM(pb + 5);
        }
    }
    if ((PH_MASK & 4096) && IN(NPHASE - 1)) { REFRESH(); final_norm(F); }
#undef IN
#undef SEAM
#undef REFRESH
}

extern "C" void kernel_launch(void* const* d_in, const int* in_sizes, int n_in, void* d_out, int out_size, void* d_ws, size_t ws_size, hipStream_t stream) {
    static int grid = 0;
    if (grid == 0) {
        if (n_in != 19 || out_size != MROWS * DM || ws_size < WS_END) { fprintf(stderr, "kernel_launch: unexpected problem shape (n_in %d, out %d, ws %zu)\n", n_in, out_size, ws_size); grid = -1; return; }
        int dev = 0, cus = 0, per_cu = 0;
        if (hipGetDevice(&dev) != hipSuccess || hipDeviceGetAttribute(&cus, hipDeviceAttributeMultiprocessorCount, dev) != hipSuccess) { grid = -1; return; }
        if (hipFuncSetAttribute((const void*)fwd, hipFuncAttributeMaxDynamicSharedMemorySize, LDS_BYTES) != hipSuccess) { fprintf(stderr, "kernel_launch: hipFuncSetAttribute failed\n"); grid = -1; return; }
        if (hipOccupancyMaxActiveBlocksPerMultiprocessor(&per_cu, (const void*)fwd, 512, LDS_BYTES) != hipSuccess || per_cu < 1) { fprintf(stderr, "kernel_launch: occupancy query says %d\n", per_cu); (void)hipGetLastError(); grid = -1; return; }
        grid = cus;
    }
    if (grid < 0) return;
    (void)hipMemsetAsync((char*)d_ws + WS_CTL, 0, CTL_ZERO_BYTES, stream);
    Args a{};
    for (int i = 0; i < 19; ++i) a.in[i] = (const float*)d_in[i];
    a.out = (float*)d_out; a.ws = (unsigned char*)d_ws;
    if (ONE_LAUNCH) { a.ph_lo = 0; a.ph_hi = NPHASE; hipLaunchKernelGGL(fwd, dim3(grid), dim3(512), LDS_BYTES, stream, a); }
    else for (int p = 0; p < NPHASE; ++p) { a.ph_lo = p; a.ph_hi = p + 1; hipLaunchKernelGGL(fwd, dim3(grid), dim3(512), LDS_BYTES, stream, a); }
}
```

```cpp
#include <hip/hip_runtime.h>
#include <cstdio>
#include <cstdint>

#ifndef PH_MASK
#define PH_MASK 8191
#endif
#ifndef ONE_LAUNCH
#define ONE_LAUNCH 1
#endif

namespace pg8 {
#define PG8_LAS __attribute__((address_space(3)))
typedef unsigned short bf16_t;
typedef short bf16x8 __attribute__((ext_vector_type(8)));
typedef float f32x4 __attribute__((ext_vector_type(4)));
typedef unsigned u32x4 __attribute__((ext_vector_type(4)));
constexpr int BM = 256, BK = 64, HALF = 128, HTB = HALF * BK * 2  , STAGE_BYTES = 8 * HTB, NXCD = 8, WGM = 8;

__host__ __device__ __forceinline__ int lds_byte(int r, int c) { const int st = (r >> 4) * 2 + (c >> 5), rr = r & 15, cc = c & 31, ob = rr * 64 + cc * 2; return st * 1024 + (ob ^ (((ob >> 9) & 1) << 5)); }
__host__ __device__ __forceinline__ void stage_rc(int b, int& R, int& C) { const int st = b / 1024, sb = b % 1024, swz = sb ^ (((sb >> 9) & 1) << 5); R = (st >> 1) * 16 + swz / 64; C = (st & 1) * 32 + (swz % 64) / 2; }
__host__ __device__ __forceinline__ int perm32(int rho) { const int n = rho >> 4, i = rho & 15; return 8 * (i >> 2) + 4 * n + (i & 3); }

struct Unit { int pm, pn; };
struct Gemm { const bf16_t* A; const bf16_t* Bt; int M, N, K; };

struct StaticOrder {
    int nM, nN, nwg, G, c;
    __host__ __device__ void init(int M, int N, int G_, int c_) { nM = M / BM; nN = N / BM; nwg = nM * nN; G = G_; c = c_; }
    __host__ __device__ bool next(int i, Unit& u) const {
        const long L = (long)i * G + c; if (L >= nwg) return false;
        int wgid = (int)L; { const int q = nwg / NXCD, r = nwg % NXCD, xcd = wgid % NXCD, off = wgid / NXCD; wgid = (xcd < r ? xcd * (q + 1) : r * (q + 1) + (xcd - r) * q) + off; }
        const int nig = WGM * nN, gid = wgid / nig, fm = gid * WGM, gsz = (nM - fm) < WGM ? (nM - fm) : WGM;
        u.pm = fm + ((wgid % nig) % gsz); u.pn = (wgid % nig) / gsz; return true;
    }
    __device__ __forceinline__ void a_ready(const Unit&) const {}
    __device__ __forceinline__ void done(const Unit&) const {}
};

template <class Epi, class Sched, bool ALIGN_EPI = false, bool SP2 = false>
__device__ __forceinline__ void gemm_phase(PG8_LAS unsigned char* lds, const Gemm g, const Sched& S, const Epi& E, int tid_) {
    asm volatile("" : "+v"(tid_));
    const int tid = tid_, wid = __builtin_amdgcn_readfirstlane(tid >> 6), lane = tid & 63, wr = wid >> 2, wc = wid & 3, fr = lane & 15, fq = lane >> 4;
    const int K = g.K, nt = K / BK;
    unsigned voffA[2], voffB[2];
#pragma unroll
    for (int i = 0; i < 2; ++i) { int R, C; stage_rc(tid * 16 + i * 8192, R, C); const int Rb = Epi::PERM ? ((R & ~31) + perm32(R & 31)) : R;
        voffA[i] = (unsigned)(R * K + C) * 2u; voffB[i] = (unsigned)(Rb * K + C) * 2u; }
    const size_t kstep = (size_t)(BK * 2);
    const size_t hstep = (size_t)HALF * K * 2;
    const size_t tstep = 2 * hstep;
    const unsigned ldsw = (unsigned)wid * 1024u;
    const int aoff = lds_byte(wr * 64 + fr, fq * 8), boff = lds_byte(wc * 32 + fr, fq * 8);
#define PG8_SA(b, h) (((b) * 2 + (h)) * HTB)
#define PG8_SB(b, h) ((4 + (b) * 2 + (h)) * HTB)
#define PG8_STAGE(bufoff, gbase, voff) do { _Pragma("unroll") for (int _i = 0; _i < 2; ++_i) \
        __builtin_amdgcn_global_load_lds((const unsigned*)((const char*)(gbase) + (voff)[_i]), (PG8_LAS unsigned*)(lds + (bufoff) + ldsw + _i * 8192), 16, 0, 0); } while (0)
#define PG8_LDA(dst, b, h) do { _Pragma("unroll") for (int m = 0; m < 4; ++m) _Pragma("unroll") for (int k = 0; k < 2; ++k) dst[m][k] = *(const PG8_LAS bf16x8*)(lds + PG8_SA(b, h) + aoff + m * 2048 + k * 1024); } while (0)
#define PG8_LDB(dst, b, h) do { _Pragma("unroll") for (int n = 0; n < 2; ++n) _Pragma("unroll") for (int k = 0; k < 2; ++k) dst[n][k] = *(const PG8_LAS bf16x8*)(lds + PG8_SB(b, h) + boff + n * 2048 + k * 1024); } while (0)
#define PG8_MMA(ai, bj, At, Bt) do { __builtin_amdgcn_s_setprio(1); _Pragma("unroll") for (int m = 0; m < 4; ++m) _Pragma("unroll") for (int n = 0; n < 2; ++n) _Pragma("unroll") for (int k = 0; k < 2; ++k) \
        acc[ai][bj][m][n] = __builtin_amdgcn_mfma_f32_16x16x32_bf16(Bt[n][k], At[m][k], acc[ai][bj][m][n], 0, 0, 0); __builtin_amdgcn_s_setprio(0); } while (0)
#define PG8_WAIT_V(n) asm volatile("s_waitcnt vmcnt(" #n ")" ::: "memory")
#define PG8_WAIT_L(n) asm volatile("s_waitcnt lgkmcnt(" #n ")" ::: "memory")
#define PG8_BAR __builtin_amdgcn_s_barrier()
#define PG8_SCHED __builtin_amdgcn_sched_barrier(0)
    Unit cur, nxt; int ui = 0;
    if (!S.next(0, cur)) return;
    f32x4 acc[2][2][4][2];
#pragma unroll
    for (int a = 0; a < 2; ++a)
#pragma unroll
        for (int b = 0; b < 2; ++b)
#pragma unroll
            for (int m = 0; m < 4; ++m)
#pragma unroll
                for (int n = 0; n < 2; ++n) acc[a][b][m][n] = (f32x4){0.f, 0.f, 0.f, 0.f};
    bf16x8 At[4][2], B0[2][2], B1[2][2];
    const char* cA = (const char*)g.A + (size_t)cur.pm * tstep; const char* cB = (const char*)g.Bt + (size_t)cur.pn * tstep;
    S.a_ready(cur);
    if constexpr (SP2) {
        PG8_STAGE(PG8_SB(0, 0), cB, voffB); PG8_STAGE(PG8_SB(0, 1), cB + hstep, voffB); PG8_STAGE(PG8_SA(0, 0), cA, voffA); PG8_STAGE(PG8_SA(0, 1), cA + hstep, voffA);
        if (wr == 1) PG8_BAR;
        PG8_WAIT_V(2); PG8_BAR;
        PG8_STAGE(PG8_SB(1, 0), cB + kstep, voffB); PG8_STAGE(PG8_SA(1, 0), cA + kstep, voffA); PG8_STAGE(PG8_SB(1, 1), cB + hstep + kstep, voffB);
        PG8_WAIT_V(6); PG8_BAR;
    } else {
        PG8_STAGE(PG8_SB(0, 0), cB, voffB); PG8_STAGE(PG8_SA(0, 0), cA, voffA); PG8_STAGE(PG8_SB(0, 1), cB + hstep, voffB); PG8_STAGE(PG8_SA(0, 1), cA + hstep, voffA);
        if (wr == 1) PG8_BAR;
        PG8_WAIT_V(4); PG8_BAR;
        PG8_STAGE(PG8_SB(1, 0), cB + kstep, voffB); PG8_STAGE(PG8_SA(1, 0), cA + kstep, voffA); PG8_STAGE(PG8_SB(1, 1), cB + hstep + kstep, voffB);
        PG8_WAIT_V(6); PG8_BAR;
    }
    for (;;) {
        const bool has_next = S.next(ui + 1, nxt);
        const char* nA = has_next ? (const char*)g.A + (size_t)nxt.pm * tstep : cA; const char* nB = has_next ? (const char*)g.Bt + (size_t)nxt.pn * tstep : cB;
        for (int t = 0; t < nt; t += 2) {
            const bool last = (t == nt - 2);
            const char* a1 = cA + (size_t)(t + 1) * kstep;
            const char* a2 = last ? nA : cA + (size_t)(t + 2) * kstep; const char* b2 = last ? nB : cB + (size_t)(t + 2) * kstep;
            const char* a3 = a2 + kstep; const char* b3 = b2 + kstep;
            if (last && has_next) S.a_ready(nxt);
            if constexpr (SP2) {
            PG8_LDB(B0, 0, 0); PG8_LDB(B1, 0, 1); PG8_SCHED; PG8_LDA(At, 0, 0); PG8_STAGE(PG8_SA(1, 1), a1 + hstep, voffA);
            PG8_WAIT_V(8); PG8_WAIT_L(0); PG8_BAR; PG8_MMA(0, 0, At, B0); PG8_MMA(0, 1, At, B1); PG8_BAR; PG8_SCHED;
            PG8_LDA(At, 0, 1); PG8_STAGE(PG8_SB(0, 0), b2, voffB); PG8_STAGE(PG8_SB(0, 1), b2 + hstep, voffB); PG8_STAGE(PG8_SA(0, 0), a2, voffA);
            PG8_WAIT_V(8); PG8_WAIT_L(0); PG8_BAR; PG8_MMA(1, 0, At, B0); PG8_MMA(1, 1, At, B1); PG8_BAR; PG8_SCHED;
            PG8_LDB(B0, 1, 0); PG8_LDB(B1, 1, 1); PG8_SCHED; PG8_LDA(At, 1, 0); PG8_STAGE(PG8_SA(0, 1), a2 + hstep, voffA);
            PG8_WAIT_V(8); PG8_WAIT_L(0); PG8_BAR; PG8_MMA(0, 0, At, B0); PG8_MMA(0, 1, At, B1); PG8_BAR; PG8_SCHED;
            PG8_LDA(At, 1, 1); PG8_STAGE(PG8_SB(1, 0), b3, voffB); PG8_STAGE(PG8_SB(1, 1), b3 + hstep, voffB); PG8_STAGE(PG8_SA(1, 0), a3, voffA);
            PG8_WAIT_V(8); PG8_WAIT_L(0); PG8_BAR; PG8_MMA(1, 0, At, B0); PG8_MMA(1, 1, At, B1); PG8_BAR; PG8_SCHED;
            } else {
            PG8_LDB(B0, 0, 0); PG8_SCHED; PG8_LDA(At, 0, 0); PG8_STAGE(PG8_SA(1, 1), a1 + hstep, voffA);
            PG8_WAIT_L(8); PG8_BAR; PG8_WAIT_L(0); PG8_MMA(0, 0, At, B0); PG8_BAR; PG8_SCHED;
            PG8_LDB(B1, 0, 1); PG8_STAGE(PG8_SB(0, 0), b2, voffB);
            PG8_BAR; PG8_WAIT_L(0); PG8_MMA(0, 1, At, B1); PG8_BAR;
            PG8_LDA(At, 0, 1); PG8_STAGE(PG8_SA(0, 0), a2, voffA);
            PG8_BAR; PG8_WAIT_L(0); PG8_MMA(1, 0, At, B0); PG8_BAR; PG8_SCHED;
            PG8_STAGE(PG8_SB(0, 1), b2 + hstep, voffB);
            PG8_WAIT_V(6); PG8_BAR; PG8_MMA(1, 1, At, B1); PG8_BAR;
            PG8_LDB(B0, 1, 0); PG8_SCHED; PG8_LDA(At, 1, 0); PG8_STAGE(PG8_SA(0, 1), a2 + hstep, voffA);
            PG8_WAIT_L(8); PG8_BAR; PG8_WAIT_L(0); PG8_MMA(0, 0, At, B0); PG8_BAR; PG8_SCHED;
            PG8_LDB(B1, 1, 1); PG8_STAGE(PG8_SB(1, 0), b3, voffB);
            PG8_BAR; PG8_WAIT_L(0); PG8_MMA(0, 1, At, B1); PG8_BAR;
            PG8_LDA(At, 1, 1); PG8_STAGE(PG8_SA(1, 0), a3, voffA);
            PG8_BAR; PG8_WAIT_L(0); PG8_MMA(1, 0, At, B0); PG8_BAR; PG8_SCHED;
            PG8_STAGE(PG8_SB(1, 1), b3 + hstep, voffB);
            PG8_WAIT_V(6); PG8_BAR; PG8_MMA(1, 1, At, B1); PG8_BAR;
            }
        }
        if constexpr (ALIGN_EPI) { if (wr == 0) PG8_BAR; }
        E(acc, cur, wr, wc, fr, fq); S.done(cur);
        if (!has_next) break;
#pragma unroll
        for (int a = 0; a < 2; ++a)
#pragma unroll
            for (int b = 0; b < 2; ++b)
#pragma unroll
                for (int m = 0; m < 4; ++m)
#pragma unroll
                    for (int n = 0; n < 2; ++n) acc[a][b][m][n] = (f32x4){0.f, 0.f, 0.f, 0.f};
        cur = nxt; cA = nA; cB = nB; ++ui;
        if constexpr (ALIGN_EPI) { if (wr == 1) PG8_BAR; }
    }
    PG8_WAIT_V(0);
    if constexpr (!ALIGN_EPI) { if (wr == 0) PG8_BAR; }
    PG8_BAR;
#undef PG8_SA
#undef PG8_SB
#undef PG8_STAGE
#undef PG8_LDA
#undef PG8_LDB
#undef PG8_MMA
#undef PG8_WAIT_V
#undef PG8_WAIT_L
#undef PG8_BAR
#undef PG8_SCHED
}
}

constexpr int BATCH = 8, SEQ = 4096, DM = 1024, MROWS = BATCH * SEQ, DEPTH = 4;
constexpr int NIN = 3072, CIN = 3080, DFF = 2816, NUP = 2 * DFF;
constexpr float EPS = 1e-6f;
constexpr int NPHASE = 2 + 6 * DEPTH;

constexpr size_t MiB = 1u << 20;
constexpr size_t WS_CTL = 0, CTL_ZERO_BYTES = 64 * 1024;
constexpr size_t WS_COS = 1 * MiB, WS_SIN = 2 * MiB;
constexpr size_t WS_SS = 3 * MiB;
constexpr size_t WS_GLI = 5 * MiB, WS_GLF = 5 * MiB + 512 * 1024;
constexpr size_t WS_WG = 6 * MiB;
constexpr size_t WS_WM = 6 * MiB + 256 * 1024;
constexpr size_t WS_NST = 7 * MiB;
constexpr size_t WS_W = 8 * MiB;
constexpr size_t W_IN_OFF = 0, W_OUT_OFF = (size_t)NIN * DM * 2, W_UP_OFF = W_OUT_OFF + (size_t)DM * DM * 2, W_DOWN_OFF = W_UP_OFF + (size_t)NUP * DM * 2, W_LAYER = W_DOWN_OFF + (size_t)DM * DFF * 2;
constexpr size_t WS_HB = 106 * MiB;
constexpr size_t WS_MIX = 170 * MiB;
constexpr size_t WS_PROJ = 234 * MiB;
constexpr size_t WS_TST = 426 * MiB;
constexpr size_t WS_END = 460 * MiB;
static_assert(WS_W + 4 * W_LAYER <= WS_HB && WS_TST + (size_t)256 * 256 * 128 * 4 <= WS_END, "ws map");

constexpr int RING_BYTES = 131072;
constexpr int LDSCTL_OFF = RING_BYTES;
constexpr int LDS_BYTES = 147456;

#define GAS __attribute__((address_space(1)))
#define LAS __attribute__((address_space(3)))
#define DI __device__ __forceinline__
typedef unsigned short bf16_t;
typedef short bf16x8 __attribute__((ext_vector_type(8)));
typedef short bf16x4 __attribute__((ext_vector_type(4)));
typedef float f32x4 __attribute__((ext_vector_type(4)));
typedef float f32x16 __attribute__((ext_vector_type(16)));
typedef unsigned u32x4 __attribute__((ext_vector_type(4)));
typedef unsigned u32x2 __attribute__((ext_vector_type(2)));

DI unsigned pk2(float lo, float hi) { typedef __bf16 b2 __attribute__((ext_vector_type(2))); b2 v; v.x = (__bf16)lo; v.y = (__bf16)hi; return __builtin_bit_cast(unsigned, v); }
DI float bf2f(unsigned short x) { return __uint_as_float(((unsigned)x) << 16); }
DI float bflo(unsigned w) { return __uint_as_float(w << 16); }
DI float bfhi(unsigned w) { return __uint_as_float(w & 0xffff0000u); }
DI float fexp(float x) { return __builtin_amdgcn_exp2f(x * 1.4426950408889634f); }
DI float frcp(float x) { return __builtin_amdgcn_rcpf(x); }
DI float sigmoid_f(float x) { return frcp(1.f + fexp(-x)); }
DI float silu_f(float x) { return x * sigmoid_f(x); }
DI float gelu_tanh_f(float x) { return x * sigmoid_f(1.5957691216057308f * (x + 0.044715f * x * x * x)); }
template <int CTRL> DI float dpp_f(float v) { return __int_as_float(__builtin_amdgcn_mov_dpp(__float_as_int(v), CTRL, 0xF, 0xF, true)); }
DI float xor16_f(float v) { return __int_as_float(__builtin_amdgcn_ds_swizzle(__float_as_int(v), 0x401F)); }
DI float sum_xor32(float v) { const auto r = __builtin_amdgcn_permlane32_swap(__float_as_uint(v), __float_as_uint(v), false, false); return __uint_as_float(r[0]) + __uint_as_float(r[1]); }
DI float sum_xor16_32(float v) { v += xor16_f(v); return sum_xor32(v); }
DI float wave_sum(float v) {
    v += dpp_f<0xB1>(v); v += dpp_f<0x4E>(v); v += dpp_f<0x141>(v); v += dpp_f<0x140>(v);
    return sum_xor16_32(v);
}
template <int CTRL, int ROWMASK, bool IS_MAX> DI float scan_step(float v, const float ident) {
    const float t = __int_as_float(__builtin_amdgcn_update_dpp(__float_as_int(ident), __float_as_int(v), CTRL, ROWMASK, 0xF, false));
    return IS_MAX ? fmaxf(v, t) : v + t;
}
template <bool IS_MAX> DI float wave_scan(float v) {
    const float id = IS_MAX ? -3.0e38f : 0.f;
    v = scan_step<0x111, 0xF, IS_MAX>(v, id); v = scan_step<0x112, 0xF, IS_MAX>(v, id); v = scan_step<0x114, 0xF, IS_MAX>(v, id); v = scan_step<0x118, 0xF, IS_MAX>(v, id);
    v = scan_step<0x142, 0xA, IS_MAX>(v, id);
    v = scan_step<0x143, 0xC, IS_MAX>(v, id);
    return v;
}
DI float lane63(float v) { return __int_as_float(__builtin_amdgcn_readlane(__float_as_int(v), 63)); }

#define XB_TMO      128
#define XB_XCNT(j)  (256  + 64 * (j))
#define XB_XSUB(j)  (1280 + 64 * (j))
#define XB_XGEN(j)  (2304 + 64 * (j))
#define XB_TOP      3328
#define XB_TOPGEN   3392
#define XCD_BAR_WORDS 3456
#define XB_SPIN_CAP (1u << 18)

__device__ __forceinline__ unsigned xb_ld(unsigned* p)              { return __hip_atomic_load(p, __ATOMIC_RELAXED, __HIP_MEMORY_SCOPE_AGENT); }
__device__ __forceinline__ unsigned xb_add(unsigned* p, unsigned v) { return __hip_atomic_fetch_add(p, v, __ATOMIC_RELAXED, __HIP_MEMORY_SCOPE_AGENT); }
__device__ __forceinline__ unsigned xb_xcc_id() { return (unsigned)__builtin_amdgcn_s_getreg((3 << 11) | 20) & 0xFu; }
#define XB_SPIN(cond, bar) do { unsigned _sp = 0; while (cond) { __builtin_amdgcn_s_sleep(1); \
    if ((++_sp & 255u) == 0u) { if (xb_ld(&(bar)[XB_TMO])) break; if (_sp > XB_SPIN_CAP) { atomicAdd(&(bar)[XB_TMO], 1u); break; } } } } while (0)

struct XcdBarrier { unsigned* bar; unsigned x; volatile LAS unsigned* st; };

__device__ __forceinline__ XcdBarrier xcd_barrier_post(unsigned* bar, volatile LAS unsigned* st, int tid) {
    XcdBarrier b; b.bar = bar; b.x = xb_xcc_id(); b.st = st;
    if (tid == 0) (void)xb_add(&bar[XB_XCNT(b.x)], 1u);
    return b;
}
__device__ __forceinline__ void xcd_barrier_complete(unsigned* bar, unsigned x, unsigned& nloc, unsigned& nx) {
    const unsigned G = gridDim.x * gridDim.y * gridDim.z;
    unsigned sum, cnt, mine, sp = 0u;
    for (;;) {
        sum = 0u; cnt = 0u; mine = 0u;
#pragma unroll
        for (unsigned j = 0; j < 16; ++j) { const unsigned c = xb_ld(&bar[XB_XCNT(j)]); sum += c; cnt += (c > 0u) ? 1u : 0u; mine = (j == x) ? c : mine; }
        if (sum == G) break;
        __builtin_amdgcn_s_sleep(1);
        if ((++sp & 255u) == 0u) { if (xb_ld(&bar[XB_TMO])) break; if (sp > XB_SPIN_CAP) { atomicAdd(&bar[XB_TMO], 1u); break; } }
    }
    nloc = mine > 0u ? mine : 1u; nx = cnt > 0u ? cnt : 1u;
}
__device__ __forceinline__ void xcd_barrier(const XcdBarrier& b, int tid) {
    asm volatile("s_waitcnt vmcnt(0)" ::: "memory");
    __syncthreads();
    if (tid == 0) {
        unsigned* bar = b.bar;
        __builtin_amdgcn_s_waitcnt(0);
        unsigned nloc = b.st[0], nx = b.st[1];
        if (nloc == 0u) { xcd_barrier_complete(bar, b.x, nloc, nx); b.st[0] = nloc; b.st[1] = nx; }
        const unsigned old = xb_add(&bar[XB_XSUB(b.x)], 1u);
        const unsigned gen = old / nloc;
        if (old + 1u == (gen + 1u) * nloc) {
            __builtin_amdgcn_fence(__ATOMIC_RELEASE, "agent");
            asm volatile("s_waitcnt vmcnt(0)" ::: "memory");
            const unsigned og = xb_add(&bar[XB_TOP], 1u);
            const unsigned tg = og / nx;
            if (og + 1u == (tg + 1u) * nx) xb_add(&bar[XB_TOPGEN], 1u);
            else XB_SPIN(xb_ld(&bar[XB_TOPGEN]) == tg, bar);
            __builtin_amdgcn_fence(__ATOMIC_ACQUIRE, "agent");
            xb_add(&bar[XB_XGEN(b.x)], 1u);
            asm volatile("s_waitcnt vmcnt(0)" ::: "memory");
        } else {
            XB_SPIN(xb_ld(&bar[XB_XGEN(b.x)]) == gen, bar);
            __builtin_amdgcn_fence(__ATOMIC_ACQUIRE, "agent");
            asm volatile("s_waitcnt vmcnt(0)" ::: "memory");
        }
    }
    __syncthreads();
}

struct Frame {
    LAS unsigned char* lds;
    int tid, lane, wave, G;
    const float* const __attribute__((address_space(4)))* in;
    float* H;
    unsigned char* ws;
};
DI bf16_t* W_in(const Frame& F, int L)   { return (bf16_t*)(F.ws + WS_W + (size_t)L * W_LAYER + W_IN_OFF); }
DI bf16_t* W_out(const Frame& F, int L)  { return (bf16_t*)(F.ws + WS_W + (size_t)L * W_LAYER + W_OUT_OFF); }
DI bf16_t* W_up(const Frame& F, int L)   { return (bf16_t*)(F.ws + WS_W + (size_t)L * W_LAYER + W_UP_OFF); }
DI bf16_t* W_down(const Frame& F, int L) { return (bf16_t*)(F.ws + WS_W + (size_t)L * W_LAYER + W_DOWN_OFF); }

DI float row_rstd(const float* SS, int row, int fq) {
    const f32x4 sp = *(const f32x4*)(SS + (size_t)row * 16 + 4 * fq);
    float s = (sp.x + sp.y) + (sp.z + sp.w); s = sum_xor16_32(s);
    return 1.0f / sqrtf(s * (1.0f / DM) + EPS);
}
DI void store8(bf16_t* p, const f32x4& v0, const f32x4& v1) { u32x4 w; w.x = pk2(v0[0], v0[1]); w.y = pk2(v0[2], v0[3]); w.z = pk2(v1[0], v1[1]); w.w = pk2(v1[2], v1[3]); *(u32x4*)p = w; }

struct EpiInA {
    static constexpr bool PERM = true;
    bf16_t* P; const float* SS; const float* COS; const float* SIN;
    DI void operator()(const f32x4 (&acc)[2][2][4][2], const pg8::Unit& u, int wr, int wc, int fr, int fq) const {
        const int row0 = u.pm * 256 + wr * 64 + fr, colw = wc * 32 + 8 * fq, typ = u.pn >> 1;
#pragma unroll
        for (int ai = 0; ai < 2; ++ai)
#pragma unroll
            for (int m = 0; m < 4; ++m) {
                const int row = row0 + ai * 128 + m * 16;
                const float rs = row_rstd(SS, row, fq);
                bf16_t* rowp = P + (size_t)row * NIN + u.pn * 256 + colw;
                if (typ < 2) {
                    const int pos = row & (SEQ - 1);
                    const f32x4 c4 = *(const f32x4*)(COS + pos * 64 + (colw >> 1)), s4 = *(const f32x4*)(SIN + pos * 64 + (colw >> 1));
#pragma unroll
                    for (int bj = 0; bj < 2; ++bj) { const f32x4 a0 = acc[ai][bj][m][0] * rs, a1 = acc[ai][bj][m][1] * rs; f32x4 v0, v1;
                        v0[0] = a0[0] * c4[0] - a0[1] * s4[0]; v0[1] = a0[0] * s4[0] + a0[1] * c4[0];
                        v0[2] = a0[2] * c4[1] - a0[3] * s4[1]; v0[3] = a0[2] * s4[1] + a0[3] * c4[1];
                        v1[0] = a1[0] * c4[2] - a1[1] * s4[2]; v1[1] = a1[0] * s4[2] + a1[1] * c4[2];
                        v1[2] = a1[2] * c4[3] - a1[3] * s4[3]; v1[3] = a1[2] * s4[3] + a1[3] * c4[3];
                        store8(rowp + bj * 128, v0, v1); }
                } else {
#pragma unroll
                    for (int bj = 0; bj < 2; ++bj) { f32x4 v0 = acc[ai][bj][m][0] * rs, v1 = acc[ai][bj][m][1] * rs;
                        if (typ == 3) {
#pragma unroll
                            for (int j = 0; j < 4; ++j) { v0[j] = silu_f(v0[j]); v1[j] = silu_f(v1[j]); } }
                        else if (typ >= 4) {
#pragma unroll
                            for (int j = 0; j < 4; ++j) { v0[j] = gelu_tanh_f(v0[j]); v1[j] = gelu_tanh_f(v1[j]); } }
                        store8(rowp + bj * 128, v0, v1); }
                }
            }
    }
};
struct EpiInC {
    static constexpr bool PERM = true;
    bf16_t* P; const float* SS;
    DI void operator()(const f32x4 (&acc)[2][2][4][2], const pg8::Unit& u, int wr, int wc, int fr, int fq) const {
        const int row0 = u.pm * 256 + wr * 64 + fr, colw = wc * 32 + 8 * fq; const bool sg = u.pn >= 8;
#pragma unroll
        for (int ai = 0; ai < 2; ++ai)
#pragma unroll
            for (int m = 0; m < 4; ++m) {
                const int row = row0 + ai * 128 + m * 16;
                const float rs = row_rstd(SS, row, fq);
                bf16_t* rowp = P + (size_t)row * NIN + u.pn * 256 + colw;
#pragma unroll
                for (int bj = 0; bj < 2; ++bj) { f32x4 v0 = acc[ai][bj][m][0] * rs, v1 = acc[ai][bj][m][1] * rs;
                    if (sg) {
#pragma unroll
                        for (int j = 0; j < 4; ++j) { v0[j] = sigmoid_f(v0[j]); v1[j] = sigmoid_f(v1[j]); } }
                    store8(rowp + bj * 128, v0, v1); }
            }
    }
};
struct EpiRes {
    static constexpr bool PERM = true;
    float* H; bf16_t* HB; float* SS;
    DI void operator()(const f32x4 (&acc)[2][2][4][2], const pg8::Unit& u, int wr, int wc, int fr, int fq) const {
        const int row0 = u.pm * 256 + wr * 64 + fr, col0 = u.pn * 256 + wc * 32 + 8 * fq;
#pragma unroll
        for (int ai = 0; ai < 2; ++ai)
#pragma unroll
            for (int m = 0; m < 4; ++m) {
                const int row = row0 + ai * 128 + m * 16;
                float* hp = H + (size_t)row * DM + col0; bf16_t* bp = HB + (size_t)row * DM + col0; float ssum = 0.f;
#pragma unroll
                for (int bj = 0; bj < 2; ++bj) {
                    f32x4 h0 = *(const f32x4*)(hp + bj * 128), h1 = *(const f32x4*)(hp + bj * 128 + 4);
                    h0 = h0 + acc[ai][bj][m][0]; h1 = h1 + acc[ai][bj][m][1];
                    *(f32x4*)(hp + bj * 128) = h0; *(f32x4*)(hp + bj * 128 + 4) = h1;
                    store8(bp + bj * 128, h0, h1);
                    ssum += (h0[0] * h0[0] + h0[1] * h0[1]) + (h0[2] * h0[2] + h0[3] * h0[3]) + (h1[0] * h1[0] + h1[1] * h1[1]) + (h1[2] * h1[2] + h1[3] * h1[3]);
                }
                ssum = sum_xor16_32(ssum);
                if (fq == 0) SS[(size_t)row * 16 + u.pn * 4 + wc] = ssum;
            }
    }
};
struct EpiSwiGLU {
    static constexpr bool PERM = true;
    bf16_t* ACT; const float* SS;
    DI void operator()(const f32x4 (&acc)[2][2][4][2], const pg8::Unit& u, int wr, int wc, int fr, int fq) const {
        const int row0 = u.pm * 256 + wr * 64 + fr, col0 = u.pn * 128 + wc * 32 + 8 * fq;
#pragma unroll
        for (int ai = 0; ai < 2; ++ai)
#pragma unroll
            for (int m = 0; m < 4; ++m) {
                const int row = row0 + ai * 128 + m * 16;
                const float rs = row_rstd(SS, row, fq);
                const f32x4 g0 = acc[ai][0][m][0] * rs, g1 = acc[ai][0][m][1] * rs, u0 = acc[ai][1][m][0] * rs, u1 = acc[ai][1][m][1] * rs; f32x4 v0, v1;
#pragma unroll
                for (int j = 0; j < 4; ++j) { v0[j] = silu_f(g0[j]) * u0[j]; v1[j] = silu_f(g1[j]) * u1[j]; }
                store8(ACT + (size_t)row * DFF + col0, v0, v1);
            }
    }
};

template <class Map>
DI void cvt_item(const float* src, int ld, const float* gain, bf16_t* WT, int K, int n0, int k0, const Map& mp, LAS float* scr, int lane) {
    const int nn = lane & 31; const int sc = mp.col(n0 + nn); const float scale = mp.scale(n0 + nn);
#pragma unroll 8
    for (int i = 0; i < 32; ++i) { const int kk = 2 * i + (lane >> 5); const float gk = gain ? gain[k0 + kk] : 1.0f; scr[kk * 33 + nn] = src[(size_t)(k0 + kk) * ld + sc] * (gk * scale); }
    asm volatile("s_waitcnt lgkmcnt(0)" ::: "memory");
    const int c = lane & 7;
#pragma unroll
    for (int j = 0; j < 4; ++j) { const int n = (lane >> 3) + 8 * j; const LAS float* s = scr + (8 * c) * 33 + n;
        u32x4 o; o.x = pk2(s[0 * 33], s[1 * 33]); o.y = pk2(s[2 * 33], s[3 * 33]); o.z = pk2(s[4 * 33], s[5 * 33]); o.w = pk2(s[6 * 33], s[7 * 33]);
        *(u32x4*)(WT + (size_t)(n0 + n) * K + k0 + 8 * c) = o; }
    asm volatile("s_waitcnt lgkmcnt(0)" ::: "memory");
}
struct MapId { DI int col(int n) const { return n; } DI float scale(int) const { return 1.0f; } };
struct MapInA { DI int col(int n) const { if (n >= 1024) return n; const int p = n & 127; return (n & ~127) + (p >> 1) + 64 * (p & 1); } DI float scale(int n) const { return (n >= 512 && n < 1024) ? 0.08838834764831845f : 1.0f; } };
struct MapInC { DI int col(int n) const { return n; } DI float scale(int n) const { return (n >= 512 && n < 1024) ? 0.08838834764831845f : 1.0f; } };
struct MapUp  { DI int col(int n) const { return 128 * (n >> 8) + (n & 127); } DI float scale(int) const { return 1.0f; } };

DI void p0_prologue(Frame& F) {
    LAS float* scr = (LAS float*)(F.lds + F.wave * 16384);
    const int gw = blockIdx.x * 8 + F.wave, NGW = F.G * 8;
    constexpr int I_IN = 16 * 96, I_OUT = 16 * 32, I_UP = 16 * 176, I_DOWN = 44 * 32, I_LAYER = I_IN + I_OUT + I_UP + I_DOWN;
    for (int it = gw; it < DEPTH * I_LAYER; it += NGW) {
        const int L = it / I_LAYER; int r = it % I_LAYER; const int j = L >> 1;
        if (r < I_IN) { const int kb = r / 96, nb = r % 96;
            if (L & 1) cvt_item(F.in[11] + (size_t)j * DM * CIN, CIN, F.in[1] + L * DM, W_in(F, L), DM, 32 * nb, 64 * kb, MapInC(), scr, F.lane);
            else       cvt_item(F.in[4] + (size_t)j * DM * NIN, NIN, F.in[1] + L * DM, W_in(F, L), DM, 32 * nb, 64 * kb, MapInA(), scr, F.lane);
            continue; }
        r -= I_IN;
        if (r < I_OUT) { const int kb = r / 32, nb = r % 32;
            cvt_item(((L & 1) ? F.in[12] : F.in[5]) + (size_t)j * DM * DM, DM, nullptr, W_out(F, L), DM, 32 * nb, 64 * kb, MapId(), scr, F.lane); continue; }
        r -= I_OUT;
        if (r < I_UP) { const int kb = r / 176, nb = r % 176; const int n0 = 32 * nb; const bool up = (n0 >> 7) & 1;
            cvt_item((up ? F.in[17] : F.in[16]) + (size_t)L * DM * DFF, DFF, F.in[2] + L * DM, W_up(F, L), DM, n0, 64 * kb, MapUp(), scr, F.lane); continue; }
        r -= I_UP;
        { const int kb = r / 32, nb = r % 32;
          cvt_item(F.in[18] + (size_t)L * DFF * DM, DM, nullptr, W_down(F, L), DFF, 32 * nb, 64 * kb, MapId(), scr, F.lane); }
    }
    float* SS = (float*)(F.ws + WS_SS); bf16_t* HB = (bf16_t*)(F.ws + WS_HB);
    for (int m = gw; m < MROWS; m += NGW) {
        const f32x4* xr = (const f32x4*)(F.in[0] + (size_t)m * DM) + F.lane; f32x4* hr = (f32x4*)(F.H + (size_t)m * DM) + F.lane; u32x2* br = (u32x2*)(HB + (size_t)m * DM) + F.lane;
        f32x4 v[4]; float s = 0.f;
#pragma unroll
        for (int q = 0; q < 4; ++q) { v[q] = xr[64 * q]; s += (v[q].x * v[q].x + v[q].y * v[q].y) + (v[q].z * v[q].z + v[q].w * v[q].w); }
        s = wave_sum(s);
#pragma unroll
        for (int q = 0; q < 4; ++q) { hr[64 * q] = v[q]; u32x2 o; o.x = pk2(v[q].x, v[q].y); o.y = pk2(v[q].z, v[q].w); br[64 * q] = o; }
        if (F.lane < 16) SS[(size_t)m * 16 + F.lane] = (F.lane == 0) ? s : 0.f;
    }
    const int gt = blockIdx.x * 512 + F.tid, NGT = F.G * 512;
    float* COS = (float*)(F.ws + WS_COS); float* SIN = (float*)(F.ws + WS_SIN);
    for (int e = gt; e < SEQ * 64; e += NGT) {
        const int pos = e >> 6, i = e & 63;
        const float inv = exp2f(-(float)i * (13.287712379549449f / 64.0f));
        const float ang = (float)pos * inv;
        const double a = (double)ang; const double n = rint(a * 0.15915494309189535); const float rr = (float)(a - n * 6.283185307179586);
        COS[e] = cosf(rr); SIN[e] = sinf(rr);
    }
    float* WG = (float*)(F.ws + WS_WG);
    for (int e = gt; e < 2 * 8 * DM; e += NGT) { const int j = e >> 13, c = (e >> 10) & 7, k = e & 1023;
        WG[e] = F.in[11][(size_t)j * DM * CIN + (size_t)k * CIN + 3072 + c] * F.in[1][(2 * j + 1) * DM + k]; }
    bf16_t* WM = (bf16_t*)(F.ws + WS_WM);
    for (int e = gt; e < 2 * 4 * 128 * 128; e += NGT) { const int p = (e >> 7) & 127, q = e & 127; const float w = ((q >> 6) <= (p >> 6)) ? F.in[9][e] : 0.f; WM[e] = (bf16_t)(pk2(w, 0.f) & 0xffffu); }
}

DI void gate_step(Frame& F, int L) {
    const int j = L >> 1; const int gw = blockIdx.x * 8 + F.wave, NGW = F.G * 8;
    const float* SS = (const float*)(F.ws + WS_SS); const bf16_t* HB = (const bf16_t*)(F.ws + WS_HB); const float* WG = (const float*)(F.ws + WS_WG) + j * 8 * DM;
    float* GLI = (float*)(F.ws + WS_GLI); float* GLF = (float*)(F.ws + WS_GLF);
    for (int m = gw; m < MROWS; m += NGW) {
        const u32x4 a0 = *((const u32x4*)(HB + (size_t)m * DM) + F.lane), a1 = *((const u32x4*)(HB + (size_t)m * DM + 512) + F.lane);
        float x[16];
        x[0] = bflo(a0.x); x[1] = bfhi(a0.x); x[2] = bflo(a0.y); x[3] = bfhi(a0.y); x[4] = bflo(a0.z); x[5] = bfhi(a0.z); x[6] = bflo(a0.w); x[7] = bfhi(a0.w);
        x[8] = bflo(a1.x); x[9] = bfhi(a1.x); x[10] = bflo(a1.y); x[11] = bfhi(a1.y); x[12] = bflo(a1.z); x[13] = bfhi(a1.z); x[14] = bflo(a1.w); x[15] = bfhi(a1.w);
        float ssp = (F.lane < 16) ? SS[(size_t)m * 16 + F.lane] : 0.f; ssp = wave_sum(ssp);
        const float rs = 1.0f / sqrtf(ssp * (1.0f / DM) + EPS);
        float myv = 0.f;
#pragma unroll
        for (int c = 0; c < 8; ++c) {
            const f32x4* w0 = (const f32x4*)(WG + c * DM + 8 * F.lane); const f32x4* w1 = (const f32x4*)(WG + c * DM + 512 + 8 * F.lane);
            const f32x4 wa = w0[0], wb = w0[1], wc2 = w1[0], wd = w1[1];
            float d = x[0] * wa.x + x[1] * wa.y + x[2] * wa.z + x[3] * wa.w + x[4] * wb.x + x[5] * wb.y + x[6] * wb.z + x[7] * wb.w
                    + x[8] * wc2.x + x[9] * wc2.y + x[10] * wc2.z + x[11] * wc2.w + x[12] * wd.x + x[13] * wd.y + x[14] * wd.z + x[15] * wd.w;
            d = wave_sum(d);
            if (F.lane == c) myv = d * rs;
        }
        if (F.lane < 8) {
            const int hh = F.lane & 3; const int b = m >> 12, t = m & (SEQ - 1); const size_t idx = (size_t)(b * 4 + hh) * SEQ + t;
            if (F.lane < 4) GLI[idx] = myv + F.in[13][j * 4 + hh];
            else { const float xx = myv + F.in[14][j * 4 + hh]; GLF[idx] = (xx >= 0.f) ? -log1pf(expf(-xx)) : (xx - log1pf(expf(xx))); }
        }
    }
}

DI void final_norm(Frame& F) {
    const int gw = blockIdx.x * 8 + F.wave, NGW = F.G * 8; const float* SS = (const float*)(F.ws + WS_SS); const f32x4* gv = (const f32x4*)F.in[3] + F.lane;
    for (int m = gw; m < MROWS; m += NGW) {
        f32x4* hr = (f32x4*)(F.H + (size_t)m * DM) + F.lane;
        float ssp = (F.lane < 16) ? SS[(size_t)m * 16 + F.lane] : 0.f; ssp = wave_sum(ssp);
        const float rs = 1.0f / sqrtf(ssp * (1.0f / DM) + EPS);
#pragma unroll
        for (int q = 0; q < 4; ++q) { const f32x4 v = hr[64 * q], g = gv[64 * q]; hr[64 * q] = v * rs * g; }
    }
}

DI int opaque(int x) { asm volatile("" : "+v"(x)); return x; }
DI int crow(int i, int h) { return (i & 3) + 8 * (i >> 2) + 4 * h; }
constexpr int QLD = 136, PLD = 72;
constexpr int QS_OFF = 0, KS_OFF = 17408, KW_OFF = 34816, VS_OFF = 52224, PS_OFF = 86016;
constexpr int SA_OFF = 95232, SCM_OFF = SA_OFF + 2048, SMT_OFF = SCM_OFF + 2048, SMISC_OFF = SMT_OFF + 2048;
constexpr int STAT_OFF = SMISC_OFF + 256, NV_OFF = STAT_OFF + 4096, LA_END = NV_OFF + 512;
static_assert(LA_END <= RING_BYTES, "mixer LDS");

DI bf16x8 gather_col(const LAS bf16_t* base, int ld, int col, int s0) {
    bf16x8 r;
#pragma unroll
    for (int j = 0; j < 8; ++j) r[j] = (short)base[(s0 + j) * ld + col];
    return r;
}
DI bf16x8 pack_acc(const f32x16& x, int s) {
    u32x4 p; p.x = pk2(x[8 * s + 0], x[8 * s + 1]); p.y = pk2(x[8 * s + 2], x[8 * s + 3]); p.z = pk2(x[8 * s + 4], x[8 * s + 5]); p.w = pk2(x[8 * s + 6], x[8 * s + 7]);
    return __builtin_bit_cast(bf16x8, p);
}
#define MFMA32(a, b, c) __builtin_amdgcn_mfma_f32_32x32x16_bf16((a), (b), (c), 0, 0, 0)
#define MFMA16(a, b, c) __builtin_amdgcn_mfma_f32_16x16x32_bf16((a), (b), (c), 0, 0, 0)

DI void mlstm_scan(Frame& F, int b, int h, int g) {
    LAS float* SA = (LAS float*)(F.lds + SA_OFF); LAS float* SCM = (LAS float*)(F.lds + SCM_OFF); LAS float* SMT = (LAS float*)(F.lds + SMT_OFF); LAS float* SM = (LAS float*)(F.lds + SMISC_OFF);
    const float* GLI = (const float*)(F.ws + WS_GLI) + (size_t)(b * 4 + h) * SEQ; const float* GLF = (const float*)(F.ws + WS_GLF) + (size_t)(b * 4 + h) * SEQ;
    float mprev = 0.f, Lc = 0.f; const int lane = F.lane;
    for (int gg = 0; gg <= g; ++gg) {
        float li[8], lf[8]; const int lo = opaque(lane);
        const float* gli = GLI + gg * 512 + lo; const float* glf = GLF + gg * 512 + lo;
#pragma unroll
        for (int c = 0; c < 8; ++c) { li[c] = gli[c * 64]; lf[c] = glf[c * 64]; }
        if (lane == 0) SM[16 + gg] = Lc;
#pragma unroll
        for (int c = 0; c < 8; ++c) {
            const float bs = wave_scan<false>(lf[c]);
            const float a = li[c] - bs; const float cmx = wave_scan<true>(a);
            const float cm = fmaxf(mprev, cmx);
            const float cm63 = lane63(cm), b63 = lane63(bs);
            if (gg == g) { (SA + lo)[c * 64] = a; (SCM + lo)[c * 64] = cm; (SMT + lo)[c * 64] = bs + cm; if (lane == 0) SM[c] = mprev; }
            Lc += mprev - cm63; mprev = b63 + cm63;
        }
    }
}

template <int MODE, bool PASS2>
DI void la_stage(Frame& F, const bf16_t* PROJ, int R0, int h, int c, float lg2) {
    constexpr int DV = MODE ? 256 : 128, VLD = DV + 8;
    LAS bf16_t* Qs = (LAS bf16_t*)(F.lds + QS_OFF); LAS bf16_t* Ks = (LAS bf16_t*)(F.lds + KS_OFF); LAS bf16_t* Kw = (LAS bf16_t*)(F.lds + KW_OFF); LAS bf16_t* Vs = (LAS bf16_t*)(F.lds + VS_OFF);
    const LAS float* SA = (const LAS float*)(F.lds + SA_OFF); const LAS float* SCM = (const LAS float*)(F.lds + SCM_OFF);
    const int qcol = 128 * h, kcol = 512 + 128 * h, vcol = 1024 + DV * h; const int tid_o = opaque(F.tid);
#pragma unroll
    for (int i = 0; i < 2; ++i) { const int p = tid_o + 512 * i, t = p >> 4, cp = (p & 15) * 8;
        const u32x4 kv = *(const u32x4*)(PROJ + (size_t)(R0 + t) * NIN + kcol + cp);
        float ck;
        if (MODE) ck = fexp(SA[c * 64 + t] - SCM[c * 64 + 63]); else ck = __builtin_amdgcn_exp2f(lg2 * (float)(63 - t));
        u32x4 kw; kw.x = pk2(bflo(kv.x) * ck, bfhi(kv.x) * ck); kw.y = pk2(bflo(kv.y) * ck, bfhi(kv.y) * ck); kw.z = pk2(bflo(kv.z) * ck, bfhi(kv.z) * ck); kw.w = pk2(bflo(kv.w) * ck, bfhi(kv.w) * ck);
        *(LAS u32x4*)(Kw + t * QLD + cp) = kw;
        if (PASS2) { *(LAS u32x4*)(Ks + t * QLD + cp) = kv;
            const u32x4 qv = *(const u32x4*)(PROJ + (size_t)(R0 + t) * NIN + qcol + cp); *(LAS u32x4*)(Qs + t * QLD + cp) = qv; }
    }
#pragma unroll
    for (int i = 0; i < DV / 64; ++i) { const int p = tid_o + 512 * i, t = p / (DV / 8), cp = (p % (DV / 8)) * 8;
        const u32x4 vv = *(const u32x4*)(PROJ + (size_t)(R0 + t) * NIN + vcol + cp); *(LAS u32x4*)(Vs + t * VLD + cp) = vv; }
}

template <int MODE>
DI void la_pass1(Frame& F, int unit) {
    constexpr int DV = MODE ? 256 : 128, VLD = DV + 8, ND = MODE ? 4 : 2;
    const int b = unit >> 5, h = (unit >> 3) & 3, g = unit & 7, row0 = b * SEQ + g * 512;
    const int w = F.wave; int lane = F.lane, r = lane & 31, hh = lane >> 5;
    const int eb = MODE ? w : (w & 3), dt0 = MODE ? 0 : 2 * (w >> 2), e0 = 32 * eb;
    const bf16_t* PROJ = (const bf16_t*)(F.ws + WS_PROJ);
    LAS bf16_t* Kw = (LAS bf16_t*)(F.lds + KW_OFF); LAS bf16_t* Vs = (LAS bf16_t*)(F.lds + VS_OFF);
    const LAS float* SCM = (const LAS float*)(F.lds + SCM_OFF); const LAS float* SM = (const LAS float*)(F.lds + SMISC_OFF); LAS float* NV = (LAS float*)(F.lds + NV_OFF);
    const float lg2 = log2f(1.0f - exp2f(-5.0f - (float)h));
    if (MODE) { if (w == 0) mlstm_scan(F, b, h, g); if (F.tid < 128) NV[F.tid] = 0.f; }
    __syncthreads();
    f32x16 C[ND];
#pragma unroll
    for (int d = 0; d < ND; ++d)
#pragma unroll
        for (int i = 0; i < 16; ++i) C[d][i] = 0.f;
    for (int c = 0; c < 8; ++c) {
        lane = opaque(F.lane); r = lane & 31; hh = lane >> 5;
        la_stage<MODE, false>(F, PROJ, row0 + 64 * c, h, c, lg2);
        __syncthreads();
        const float alpha = MODE ? fexp(SM[c] - SCM[c * 64 + 63]) : __builtin_amdgcn_exp2f(lg2 * 64.0f);
        bf16x8 vf[4];
#pragma unroll
        for (int ks = 0; ks < 4; ++ks) vf[ks] = gather_col(Vs, VLD, e0 + r, 16 * ks + 8 * hh);
#pragma unroll
        for (int d = 0; d < ND; ++d) {
#pragma unroll
            for (int i = 0; i < 16; ++i) C[d][i] *= alpha;
#pragma unroll
            for (int ks = 0; ks < 4; ++ks) { const bf16x8 ka = gather_col(Kw, QLD, 32 * (dt0 + d) + r, 16 * ks + 8 * hh); C[d] = MFMA32(ka, vf[ks], C[d]); }
            asm volatile("" ::: "memory");
        }
        if (MODE) {
            const int dd = 16 * w + (lane & 15), sq = lane >> 4; float s = 0.f;
#pragma unroll
            for (int q = 0; q < 16; ++q) s += bf2f(Kw[(16 * sq + q) * QLD + dd]);
            s = sum_xor16_32(s);
            if (lane < 16) NV[dd] = alpha * NV[dd] + s;
        }
        __syncthreads();
    }
    float* T = (float*)(F.ws + WS_TST) + (size_t)unit * DV * 128;
#pragma unroll
    for (int d = 0; d < ND; ++d)
#pragma unroll
        for (int q = 0; q < 4; ++q) { const f32x4 v = {C[d][4 * q], C[d][4 * q + 1], C[d][4 * q + 2], C[d][4 * q + 3]};
            *(f32x4*)(T + (size_t)(e0 + r) * 128 + 32 * (dt0 + d) + 8 * q + 4 * hh) = v; }
    if (MODE && F.tid < 128) ((float*)(F.ws + WS_NST))[unit * 128 + F.tid] = NV[F.tid];
    __syncthreads();
}

template <int MODE>
DI void la_pass2(Frame& F, int unit, int j) {
    constexpr int DV = MODE ? 256 : 128, VLD = DV + 8, NT = MODE ? 2 : 1;
    const int b = unit >> 5, h = (unit >> 3) & 3, g = unit & 7, row0 = b * SEQ + g * 512;
    const int w = F.wave; int lane = F.lane, r = lane & 31, hh = lane >> 5, r16 = lane & 15, q4 = lane >> 4;
    const int eb = MODE ? w : (w & 3), tb0 = MODE ? 0 : (w >> 2), e0 = 32 * eb;
    const int gcol = MODE ? (2048 + 256 * h) : (1536 + 128 * h), ocol = DV * h;
    const bf16_t* PROJ = (const bf16_t*)(F.ws + WS_PROJ); bf16_t* MIX = (bf16_t*)(F.ws + WS_MIX);
    const float* gain = MODE ? (F.in[15] + (j * 4 + h) * 256) : (F.in[6] + (j * 4 + h) * 128);
    LAS bf16_t* Qs = (LAS bf16_t*)(F.lds + QS_OFF); LAS bf16_t* Ks = (LAS bf16_t*)(F.lds + KS_OFF); LAS bf16_t* Kw = (LAS bf16_t*)(F.lds + KW_OFF); LAS bf16_t* Vs = (LAS bf16_t*)(F.lds + VS_OFF); LAS bf16_t* Ps = (LAS bf16_t*)(F.lds + PS_OFF);
    const LAS float* SA = (const LAS float*)(F.lds + SA_OFF); const LAS float* SCM = (const LAS float*)(F.lds + SCM_OFF); const LAS float* SMT = (const LAS float*)(F.lds + SMT_OFF); const LAS float* SM = (const LAS float*)(F.lds + SMISC_OFF);
    LAS float* STAT = (LAS float*)(F.lds + STAT_OFF); LAS float* NV = (LAS float*)(F.lds + NV_OFF);
    const float lg2 = log2f(1.0f - exp2f(-5.0f - (float)h));
    if (MODE) { if (w == 0) mlstm_scan(F, b, h, g); }
    __syncthreads();
    f32x16 C[4];
#pragma unroll
    for (int d = 0; d < 4; ++d)
#pragma unroll
        for (int i = 0; i < 16; ++i) C[d][i] = 0.f;
    float nacc = 0.f;
    for (int gp = 0; gp < g; ++gp) {
        const float coef = MODE ? fexp(SM[16 + g] - SM[16 + gp + 1]) : __builtin_amdgcn_exp2f(lg2 * (float)(512 * (g - 1 - gp)));
        const float* T = (const float*)(F.ws + WS_TST) + (size_t)(unit - g + gp) * DV * 128 + (size_t)(e0 + r) * 128 + 4 * hh;
#pragma unroll
        for (int d = 0; d < 4; ++d)
#pragma unroll
            for (int q = 0; q < 4; ++q) { const f32x4 v = *(const f32x4*)(T + 32 * d + 8 * q);
                C[d][4 * q] += coef * v.x; C[d][4 * q + 1] += coef * v.y; C[d][4 * q + 2] += coef * v.z; C[d][4 * q + 3] += coef * v.w; }
        if (MODE && F.tid < 128) nacc += coef * ((const float*)(F.ws + WS_NST))[(unit - g + gp) * 128 + F.tid];
    }
    if (MODE && F.tid < 128) NV[F.tid] = nacc;
    for (int c = 0; c < 8; ++c) {
        const int R0 = row0 + 64 * c;
        lane = opaque(F.lane); r = lane & 31; hh = lane >> 5; r16 = lane & 15; q4 = lane >> 4;
        la_stage<MODE, true>(F, PROJ, R0, h, c, lg2);
        __syncthreads();
#pragma unroll
        for (int i = 0; i < 2; ++i) {
            const int tt = 2 * w + i, si = tt >> 2, ti = tt & 3;
            f32x4 x = {0.f, 0.f, 0.f, 0.f};
#pragma unroll
            for (int kk = 0; kk < 4; ++kk) { const bf16x8 ka = *(const LAS bf16x8*)(Ks + (16 * si + r16) * QLD + 32 * kk + 8 * q4); const bf16x8 qb = *(const LAS bf16x8*)(Qs + (16 * ti + r16) * QLD + 32 * kk + 8 * q4); x = MFMA16(ka, qb, x); }
            const int t = 16 * ti + r16; float p[4];
#pragma unroll
            for (int q = 0; q < 4; ++q) { const int s = 16 * si + 4 * q4 + q; float wgt;
                if (MODE) wgt = (s <= t) ? fexp(SA[c * 64 + s] - SCM[c * 64 + t]) : 0.f;
                else { const int dlt = t > s ? t - s : s - t; wgt = __builtin_amdgcn_exp2f(lg2 * (float)dlt); }
                p[q] = x[q] * wgt; }
            u32x2 pw; pw.x = pk2(p[0], p[1]); pw.y = pk2(p[2], p[3]);
            *(LAS u32x2*)(Ps + t * PLD + 16 * si + 4 * q4) = pw;
        }
        __syncthreads();
        bf16x8 vf[4];
#pragma unroll
        for (int ks = 0; ks < 4; ++ks) vf[ks] = gather_col(Vs, VLD, e0 + r, 16 * ks + 8 * hh);
        __builtin_amdgcn_sched_barrier(0);
        float cqv[NT], rinvv[NT];
#pragma unroll
        for (int tt = 0; tt < NT; ++tt) {
            const int t = 32 * (tb0 + tt) + r;
            if (MODE) {
                const float cq = fexp(SM[c] - SCM[c * 64 + t]);
                float ps = 0.f, qn = 0.f;
#pragma unroll
                for (int q = 0; q < 4; ++q) { const u32x4 pv = *(const LAS u32x4*)(Ps + t * PLD + 32 * hh + 8 * q);
                    ps += (bflo(pv.x) + bfhi(pv.x)) + (bflo(pv.y) + bfhi(pv.y)) + (bflo(pv.z) + bfhi(pv.z)) + (bflo(pv.w) + bfhi(pv.w)); }
#pragma unroll
                for (int q = 0; q < 8; ++q) { const u32x4 qv = *(const LAS u32x4*)(Qs + t * QLD + 64 * hh + 8 * q); const f32x4 n0 = *(const LAS f32x4*)(NV + 64 * hh + 8 * q), n1 = *(const LAS f32x4*)(NV + 64 * hh + 8 * q + 4);
                    qn += bflo(qv.x) * n0.x + bfhi(qv.x) * n0.y + bflo(qv.y) * n0.z + bfhi(qv.y) * n0.w + bflo(qv.z) * n1.x + bfhi(qv.z) * n1.y + bflo(qv.w) * n1.z + bfhi(qv.w) * n1.w;
                    if (q & 1) asm volatile("" ::: "memory"); }
                float den = sum_xor32(ps + cq * qn);
                cqv[tt] = cq; rinvv[tt] = 1.0f / fmaxf(fabsf(den), fexp(-SMT[c * 64 + t]));
            } else { cqv[tt] = __builtin_amdgcn_exp2f(lg2 * (float)(t + 1)); rinvv[tt] = 1.f; }
        }
        __builtin_amdgcn_sched_barrier(0);
        f32x16 o2[NT], val[NT];
#pragma unroll
        for (int tt = 0; tt < NT; ++tt)
#pragma unroll
            for (int i = 0; i < 16; ++i) { o2[tt][i] = 0.f; val[tt][i] = 0.f; }
#pragma unroll
        for (int d = 0; d < 4; ++d) {
#pragma unroll
            for (int s2 = 0; s2 < 2; ++s2) { const bf16x8 ca = pack_acc(C[d], s2);
#pragma unroll
                for (int tt = 0; tt < NT; ++tt) { const int t = 32 * (tb0 + tt) + r;
                    const bf16x4 qlo = *(const LAS bf16x4*)(Qs + t * QLD + 32 * d + 16 * s2 + 4 * hh), qhi = *(const LAS bf16x4*)(Qs + t * QLD + 32 * d + 16 * s2 + 4 * hh + 8);
                    const bf16x8 qb = __builtin_shufflevector(qlo, qhi, 0, 1, 2, 3, 4, 5, 6, 7);
                    o2[tt] = MFMA32(ca, qb, o2[tt]); } }
            __builtin_amdgcn_sched_barrier(0);
        }
#pragma unroll
        for (int tt = 0; tt < NT; ++tt) { const int t = 32 * (tb0 + tt) + r;
#pragma unroll
            for (int ks = 0; ks < 4; ++ks) { const bf16x8 pb = *(const LAS bf16x8*)(Ps + t * PLD + 16 * ks + 8 * hh); val[tt] = MFMA32(vf[ks], pb, val[tt]); } }
#pragma unroll
        for (int tt = 0; tt < NT; ++tt) { const int t = 32 * (tb0 + tt) + r;
            float s1 = 0.f, s2s = 0.f;
#pragma unroll
            for (int i = 0; i < 16; ++i) { const float v = (val[tt][i] + cqv[tt] * o2[tt][i]) * rinvv[tt]; val[tt][i] = v; s1 += v; s2s += v * v; }
            s1 = sum_xor32(s1); s2s = sum_xor32(s2s);
            if (hh == 0) { STAT[(w * 64 + t) * 2] = s1; STAT[(w * 64 + t) * 2 + 1] = s2s; }
        }
        __syncthreads();
#pragma unroll
        for (int tt = 0; tt < NT; ++tt) {
            const int t = 32 * (tb0 + tt) + r; float S1 = 0.f, S2 = 0.f;
#pragma unroll
            for (int ww = 0; ww < (MODE ? 8 : 4); ++ww) { const int wi = MODE ? ww : (4 * tb0 + ww); S1 += STAT[(wi * 64 + t) * 2]; S2 += STAT[(wi * 64 + t) * 2 + 1]; }
            const float mean = S1 * (1.0f / DV); const float var = fmaxf(S2 * (1.0f / DV) - mean * mean, 0.f); const float rs = 1.0f / sqrtf(var + EPS);
            const size_t rowoff = (size_t)(R0 + t);
#pragma unroll
            for (int q = 0; q < 4; ++q) { const int e = e0 + 8 * q + 4 * hh;
                const f32x4 gn = *(const f32x4*)(gain + e); const u32x2 gt = *(const u32x2*)(PROJ + rowoff * NIN + gcol + e);
                const float y0 = (val[tt][4 * q] - mean) * rs * gn.x * bflo(gt.x), y1 = (val[tt][4 * q + 1] - mean) * rs * gn.y * bfhi(gt.x);
                const float y2 = (val[tt][4 * q + 2] - mean) * rs * gn.z * bflo(gt.y), y3 = (val[tt][4 * q + 3] - mean) * rs * gn.w * bfhi(gt.y);
                u32x2 o; o.x = pk2(y0, y1); o.y = pk2(y2, y3); *(u32x2*)(MIX + rowoff * DM + ocol + e) = o; asm volatile("" ::: "memory"); }
        }
        __builtin_amdgcn_sched_barrier(0);
        const float alpha = MODE ? fexp(SM[c] - SCM[c * 64 + 63]) : __builtin_amdgcn_exp2f(lg2 * 64.0f);
#pragma unroll
        for (int d = 0; d < 4; ++d) {
#pragma unroll
            for (int i = 0; i < 16; ++i) C[d][i] *= alpha;
#pragma unroll
            for (int ks = 0; ks < 4; ++ks) { const bf16x8 ka = gather_col(Kw, QLD, 32 * d + r, 16 * ks + 8 * hh); C[d] = MFMA32(ka, vf[ks], C[d]); }
            __builtin_amdgcn_sched_barrier(0);
        }
        if (MODE) {
            const int dd = 16 * w + (lane & 15), sq = lane >> 4; float s = 0.f;
#pragma unroll
            for (int q = 0; q < 16; ++q) s += bf2f(Kw[(16 * sq + q) * QLD + dd]);
            s = sum_xor16_32(s);
            if (lane < 16) NV[dd] = alpha * NV[dd] + s;
        }
        __syncthreads();
    }
}

constexpr int VN_OFF = 0, SGST_OFF = 34816;
DI void sgu_unit(Frame& F, int unit, int j) {
    const int row0 = unit * 128; const int w = F.wave; int lane = F.lane, r = lane & 31, hh = lane >> 5;
    const bf16_t* PROJ = (const bf16_t*)(F.ws + WS_PROJ); bf16_t* MIX = (bf16_t*)(F.ws + WS_MIX);
    LAS bf16_t* Vn = (LAS bf16_t*)(F.lds + VN_OFF); LAS float* ST = (LAS float*)(F.lds + SGST_OFF);
    const float* lng = F.in[7] + j * 512; const float* lnb = F.in[8] + j * 512;
    for (int i = 0; i < 16; ++i) { const int p = 16 * w + i;
        const u32x4 v = *((const u32x4*)(PROJ + (size_t)(row0 + p) * NIN + 2560) + lane);
        const float x0 = bflo(v.x), x1 = bfhi(v.x), x2 = bflo(v.y), x3 = bfhi(v.y), x4 = bflo(v.z), x5 = bfhi(v.z), x6 = bflo(v.w), x7 = bfhi(v.w);
        float s = ((x0 + x1) + (x2 + x3)) + ((x4 + x5) + (x6 + x7)); s = wave_sum(s); const float mean = s * (1.0f / 512.0f);
        const float d0 = x0 - mean, d1 = x1 - mean, d2 = x2 - mean, d3 = x3 - mean, d4 = x4 - mean, d5 = x5 - mean, d6 = x6 - mean, d7 = x7 - mean;
        float q = ((d0 * d0 + d1 * d1) + (d2 * d2 + d3 * d3)) + ((d4 * d4 + d5 * d5) + (d6 * d6 + d7 * d7)); q = wave_sum(q);
        if (lane == 0) { ST[2 * p] = mean; ST[2 * p + 1] = 1.0f / sqrtf(q * (1.0f / 512.0f) + EPS); } }
    __syncthreads();
    const int dtl = w & 3, pt0 = 2 * (w >> 2);
    for (int gq = 0; gq < 4; ++gq) {
        lane = opaque(F.lane); r = lane & 31; hh = lane >> 5; const int tid_o = opaque(F.tid);
#pragma unroll
        for (int i = 0; i < 4; ++i) { const int pc = tid_o + 512 * i, q = pc >> 4, cp = (pc & 15) * 8; const int col = 128 * gq + cp;
            const u32x4 v = *(const u32x4*)(PROJ + (size_t)(row0 + q) * NIN + 2560 + col); const float mean = ST[2 * q], rs = ST[2 * q + 1];
            const f32x4 g0 = *(const f32x4*)(lng + col), g1 = *(const f32x4*)(lng + col + 4), b0 = *(const f32x4*)(lnb + col), b1 = *(const f32x4*)(lnb + col + 4);
            u32x4 o; o.x = pk2((bflo(v.x) - mean) * rs * g0.x + b0.x, (bfhi(v.x) - mean) * rs * g0.y + b0.y); o.y = pk2((bflo(v.y) - mean) * rs * g0.z + b0.z, (bfhi(v.y) - mean) * rs * g0.w + b0.w);
            o.z = pk2((bflo(v.z) - mean) * rs * g1.x + b1.x, (bfhi(v.z) - mean) * rs * g1.y + b1.y); o.w = pk2((bflo(v.w) - mean) * rs * g1.z + b1.z, (bfhi(v.w) - mean) * rs * g1.w + b1.w);
            *(LAS u32x4*)(Vn + q * QLD + cp) = o; }
        __syncthreads();
        const bf16_t* WM = (const bf16_t*)(F.ws + WS_WM) + (size_t)(j * 4 + gq) * 128 * 128;
        f32x16 acc[2];
#pragma unroll
        for (int i = 0; i < 16; ++i) { acc[0][i] = 0.f; acc[1][i] = 0.f; }
#pragma unroll
        for (int ks = 0; ks < 8; ++ks) { const bf16x8 vb = gather_col(Vn, QLD, 32 * dtl + r, 16 * ks + 8 * hh);
#pragma unroll
            for (int pt = 0; pt < 2; ++pt) { const bf16x8 wa = *(const bf16x8*)(WM + (size_t)(32 * (pt0 + pt) + r) * 128 + 16 * ks + 8 * hh); acc[pt] = MFMA32(wa, vb, acc[pt]); } }
        const float* bs = F.in[10] + (j * 4 + gq) * 128;
#pragma unroll
        for (int pt = 0; pt < 2; ++pt)
#pragma unroll
            for (int i = 0; i < 16; ++i) { const int p = 32 * (pt0 + pt) + crow(i, hh); const int col = 128 * gq + 32 * dtl + r;
                const float uu = bf2f(PROJ[(size_t)(row0 + p) * NIN + 2048 + col]);
                MIX[(size_t)(row0 + p) * DM + 512 + col] = (bf16_t)(pk2(uu * (acc[pt][i] + bs[p]), 0.f) & 0xffffu); if ((i & 3) == 3) asm volatile("" ::: "memory"); }
        __syncthreads();
    }
}

struct Args { const float* in[19]; float* out; unsigned char* ws; int ph_lo, ph_hi; };
__global__ void __launch_bounds__(512, 2) fwd(Args args) {
    extern __shared__ __attribute__((aligned(16))) unsigned char lds_raw[];
    Frame F;
    F.lds = (LAS unsigned char*)lds_raw;
    const int wave_s = __builtin_amdgcn_readfirstlane(threadIdx.x >> 6);
    F.tid = threadIdx.x; F.lane = F.tid & 63; F.wave = wave_s; F.G = gridDim.x;
    F.in = (const float* const __attribute__((address_space(4)))*)__builtin_amdgcn_kernarg_segment_ptr();
    F.H = args.out; F.ws = args.ws;
    volatile LAS unsigned* MISC = (volatile LAS unsigned*)(F.lds + LDSCTL_OFF);
    if (F.tid < 64) MISC[F.tid] = 0u;
    __syncthreads();
    if (ONE_LAUNCH) (void)xcd_barrier_post((unsigned*)(F.ws + WS_CTL), MISC + 8, F.tid);
    const int lo = ONE_LAUNCH ? 0 : args.ph_lo, hi = ONE_LAUNCH ? NPHASE : args.ph_hi;
#define IN(k) (lo <= (k) && (k) < hi)
#define REFRESH() do { F.lane = opaque((int)__builtin_amdgcn_mbcnt_hi(~0u, __builtin_amdgcn_mbcnt_lo(~0u, 0u))); F.wave = wave_s; F.tid = wave_s * 64 + F.lane; } while (0)
#define SEAM(k) do { if (ONE_LAUNCH && IN((k) + 1)) { REFRESH(); XcdBarrier bb_; bb_.bar = (unsigned*)(F.ws + WS_CTL); bb_.x = xb_xcc_id(); bb_.st = (volatile LAS unsigned*)(F.lds + LDSCTL_OFF) + 8; xcd_barrier(bb_, F.tid); } } while (0)
    const float* SS = (const float*)(F.ws + WS_SS); bf16_t* HB = (bf16_t*)(F.ws + WS_HB); bf16_t* MIX = (bf16_t*)(F.ws + WS_MIX); bf16_t* PROJ = (bf16_t*)(F.ws + WS_PROJ);

    if ((PH_MASK & 1) && IN(0)) { REFRESH(); p0_prologue(F); SEAM(0); }
    for (int L = 0; L < DEPTH; ++L) {
        const int pb = 1 + 6 * L, j = L >> 1;
        if (IN(pb)) {
            REFRESH();
            pg8::Gemm g{HB, W_in(F, L), MROWS, NIN, DM}; pg8::StaticOrder S; S.init(MROWS, NIN, F.G, (int)blockIdx.x);
            if (L & 1) { if (PH_MASK & 2) { EpiInC E{PROJ, SS}; pg8::gemm_phase<EpiInC, pg8::StaticOrder, true, true>(F.lds, g, S, E, F.tid); } if (PH_MASK & 4) gate_step(F, L); }
            else if (PH_MASK & 8) { EpiInA E{PROJ, SS, (const float*)(F.ws + WS_COS), (const float*)(F.ws + WS_SIN)}; pg8::gemm_phase<EpiInA, pg8::StaticOrder, true, true>(F.lds, g, S, E, F.tid); }
            SEAM(pb);
        }
        if (IN(pb + 1)) {
            REFRESH();
            for (int u = blockIdx.x; u < 256; u += F.G) { if (L & 1) { if (PH_MASK & 16) la_pass1<1>(F, u); } else { if (PH_MASK & 32) la_pass1<0>(F, u); if (PH_MASK & 64) sgu_unit(F, u, j); } }
            SEAM(pb + 1);
        }
        if (IN(pb + 2)) {
            REFRESH();
            for (int u = blockIdx.x; u < 256; u += F.G) { if (L & 1) { if (PH_MASK & 128) la_pass2<1>(F, u, j); } else { if (PH_MASK & 256) la_pass2<0>(F, u, j); } }
            SEAM(pb + 2);
        }
        if (IN(pb + 3)) {
            REFRESH();
            pg8::Gemm g{MIX, W_out(F, L), MROWS, DM, DM}; pg8::StaticOrder S; S.init(MROWS, DM, F.G, (int)blockIdx.x);
            if (PH_MASK & 512) { EpiRes E{F.H, HB, (float*)(F.ws + WS_SS)}; pg8::gemm_phase<EpiRes, pg8::StaticOrder, true, true>(F.lds, g, S, E, F.tid); }
            SEAM(pb + 3);
        }
        if (IN(pb + 4)) {
            REFRESH();
            pg8::Gemm g{HB, W_up(F, L), MROWS, NUP, DM}; pg8::StaticOrder S; S.init(MROWS, NUP, F.G, (int)blockIdx.x);
            if (PH_MASK & 1024) { EpiSwiGLU E{PROJ, SS}; pg8::gemm_phase<EpiSwiGLU, pg8::StaticOrder, true, true>(F.lds, g, S, E, F.tid); }
            SEAM(pb + 4);
        }
        if (IN(pb + 5)) {
            REFRESH();
            pg8::Gemm g{PROJ, W_down(F, L), MROWS, DM, DFF}; pg8::StaticOrder S; S.init(MROWS, DM, F.G, (int)blockIdx.x);
            if (PH_MASK & 2048) { EpiRes E{F.H, HB, (float*)(F.ws + WS_SS)}; pg8::gemm_phase<EpiRes, pg8::StaticOrder, true, true>(F.lds, g, S, E, F.tid); }
            SEAM(pb + 5);
        }
    }
    if ((PH_MASK & 4096) && IN(NPHASE - 1)) { REFRESH(); final_norm(F); }
#undef IN
#undef SEAM
#undef REFRESH
}

extern "C" void kernel_launch(void* const* d_in, const int* in_sizes, int n_in, void* d_out, int out_size, void* d_ws, size_t ws_size, hipStream_t stream) {
    static int grid = 0;
    if (grid == 0) {
        if (n_in != 19 || out_size != MROWS * DM || ws_size < WS_END) { fprintf(stderr, "kernel_launch: unexpected problem shape (n_in %d, out %d, ws %zu)\n", n_in, out_size, ws_size); grid = -1; return; }
        int dev = 0, cus = 0, per_cu = 0;
        if (hipGetDevice(&dev) != hipSuccess || hipDeviceGetAttribute(&cus, hipDeviceAttributeMultiprocessorCount, dev) != hipSuccess) { grid = -1; return; }
        if (hipFuncSetAttribute((const void*)fwd, hipFuncAttributeMaxDynamicSharedMemorySize, LDS_BYTES) != hipSuccess) { fprintf(stderr, "kernel_launch: hipFuncSetAttribute failed\n"); grid = -1; return; }
        if (hipOccupancyMaxActiveBlocksPerMultiprocessor(&per_cu, (const void*)fwd, 512, LDS_BYTES) != hipSuccess || per_cu < 1) { fprintf(stderr, "kernel_launch: occupancy query says %d\n", per_cu); (void)hipGetLastError(); grid = -1; return; }
        grid = cus;
    }
    if (grid < 0) return;
    (void)hipMemsetAsync((char*)d_ws + WS_CTL, 0, CTL_ZERO_BYTES, stream);
    Args a{};
    for (int i = 0; i < 19; ++i) a.in[i] = (const float*)d_in[i];
    a.out = (float*)d_out; a.ws = (unsigned char*)d_ws;
    if (ONE_LAUNCH) { a.ph_lo = 0; a.ph_hi = NPHASE; hipLaunchKernelGGL(fwd, dim3(grid), dim3(512), LDS_BYTES, stream, a); }
    else for (int p = 0; p < NPHASE; ++p) { a.ph_lo = p; a.ph_hi = p + 1; hipLaunchKernelGGL(fwd, dim3(grid), dim3(512), LDS_BYTES, stream, a); }
}
```

```cpp
#include <hip/hip_runtime.h>
#include <cstdio>
#include <cstdint>

#ifndef PH_MASK
#define PH_MASK 8191
#endif
#ifndef DUP_MASK
#define DUP_MASK 0
#endif
#define REPS(bit) for (int rep_ = 0; rep_ < ((DUP_MASK & (bit)) ? 2 : 1); ++rep_)
#ifndef ONE_LAUNCH
#define ONE_LAUNCH 1
#endif

namespace pg8 {
#define PG8_LAS __attribute__((address_space(3)))
typedef unsigned short bf16_t;
typedef short bf16x8 __attribute__((ext_vector_type(8)));
typedef float f32x4 __attribute__((ext_vector_type(4)));
typedef unsigned u32x4 __attribute__((ext_vector_type(4)));
constexpr int BM = 256, BK = 64, HALF = 128, HTB = HALF * BK * 2  , STAGE_BYTES = 8 * HTB, NXCD = 8, WGM = 8;

__host__ __device__ __forceinline__ int lds_byte(int r, int c) { const int st = (r >> 4) * 2 + (c >> 5), rr = r & 15, cc = c & 31, ob = rr * 64 + cc * 2; return st * 1024 + (ob ^ (((ob >> 9) & 1) << 5)); }
__host__ __device__ __forceinline__ void stage_rc(int b, int& R, int& C) { const int st = b / 1024, sb = b % 1024, swz = sb ^ (((sb >> 9) & 1) << 5); R = (st >> 1) * 16 + swz / 64; C = (st & 1) * 32 + (swz % 64) / 2; }
__host__ __device__ __forceinline__ int perm32(int rho) { const int n = rho >> 4, i = rho & 15; return 8 * (i >> 2) + 4 * n + (i & 3); }

struct Unit { int pm, pn; };
struct Gemm { const bf16_t* A; const bf16_t* Bt; int M, N, K; };

struct StaticOrder {
    int nM, nN, nwg, G, c;
    __host__ __device__ void init(int M, int N, int G_, int c_) { nM = M / BM; nN = N / BM; nwg = nM * nN; G = G_; c = c_; }
    __host__ __device__ bool next(int i, Unit& u) const {
        const long L = (long)i * G + c; if (L >= nwg) return false;
        int wgid = (int)L; { const int q = nwg / NXCD, r = nwg % NXCD, xcd = wgid % NXCD, off = wgid / NXCD; wgid = (xcd < r ? xcd * (q + 1) : r * (q + 1) + (xcd - r) * q) + off; }
        const int nig = WGM * nN, gid = wgid / nig, fm = gid * WGM, gsz = (nM - fm) < WGM ? (nM - fm) : WGM;
        u.pm = fm + ((wgid % nig) % gsz); u.pn = (wgid % nig) / gsz; return true;
    }
    __device__ __forceinline__ void a_ready(const Unit&) const {}
    __device__ __forceinline__ void done(const Unit&) const {}
};

template <class Epi, class Sched, bool ALIGN_EPI = false, bool SP2 = false>
__device__ __forceinline__ void gemm_phase(PG8_LAS unsigned char* lds, const Gemm g, const Sched& S, const Epi& E, int tid_) {
    asm volatile("" : "+v"(tid_));
    const int tid = tid_, wid = __builtin_amdgcn_readfirstlane(tid >> 6), lane = tid & 63, wr = wid >> 2, wc = wid & 3, fr = lane & 15, fq = lane >> 4;
    const int K = g.K, nt = K / BK;
    unsigned voffA[2], voffB[2];
#pragma unroll
    for (int i = 0; i < 2; ++i) { int R, C; stage_rc(tid * 16 + i * 8192, R, C); const int Rb = Epi::PERM ? ((R & ~31) + perm32(R & 31)) : R;
        voffA[i] = (unsigned)(R * K + C) * 2u; voffB[i] = (unsigned)(Rb * K + C) * 2u; }
    const size_t kstep = (size_t)(BK * 2);
    const size_t hstep = (size_t)HALF * K * 2;
    const size_t tstep = 2 * hstep;
    const unsigned ldsw = (unsigned)wid * 1024u;
    const int aoff = lds_byte(wr * 64 + fr, fq * 8), boff = lds_byte(wc * 32 + fr, fq * 8);
#define PG8_SA(b, h) (((b) * 2 + (h)) * HTB)
#define PG8_SB(b, h) ((4 + (b) * 2 + (h)) * HTB)
#define PG8_STAGE(bufoff, gbase, voff) do { _Pragma("unroll") for (int _i = 0; _i < 2; ++_i) \
        __builtin_amdgcn_global_load_lds((const unsigned*)((const char*)(gbase) + (voff)[_i]), (PG8_LAS unsigned*)(lds + (bufoff) + ldsw + _i * 8192), 16, 0, 0); } while (0)
#define PG8_LDA(dst, b, h) do { _Pragma("unroll") for (int m = 0; m < 4; ++m) _Pragma("unroll") for (int k = 0; k < 2; ++k) dst[m][k] = *(const PG8_LAS bf16x8*)(lds + PG8_SA(b, h) + aoff + m * 2048 + k * 1024); } while (0)
#define PG8_LDB(dst, b, h) do { _Pragma("unroll") for (int n = 0; n < 2; ++n) _Pragma("unroll") for (int k = 0; k < 2; ++k) dst[n][k] = *(const PG8_LAS bf16x8*)(lds + PG8_SB(b, h) + boff + n * 2048 + k * 1024); } while (0)
#define PG8_MMA(ai, bj, At, Bt) do { __builtin_amdgcn_s_setprio(1); _Pragma("unroll") for (int m = 0; m < 4; ++m) _Pragma("unroll") for (int n = 0; n < 2; ++n) _Pragma("unroll") for (int k = 0; k < 2; ++k) \
        acc[ai][bj][m][n] = __builtin_amdgcn_mfma_f32_16x16x32_bf16(Bt[n][k], At[m][k], acc[ai][bj][m][n], 0, 0, 0); __builtin_amdgcn_s_setprio(0); } while (0)
#define PG8_WAIT_V(n) asm volatile("s_waitcnt vmcnt(" #n ")" ::: "memory")
#define PG8_WAIT_L(n) asm volatile("s_waitcnt lgkmcnt(" #n ")" ::: "memory")
#define PG8_BAR __builtin_amdgcn_s_barrier()
#define PG8_SCHED __builtin_amdgcn_sched_barrier(0)
    Unit cur, nxt; int ui = 0;
    if (!S.next(0, cur)) return;
    f32x4 acc[2][2][4][2];
#pragma unroll
    for (int a = 0; a < 2; ++a)
#pragma unroll
        for (int b = 0; b < 2; ++b)
#pragma unroll
            for (int m = 0; m < 4; ++m)
#pragma unroll
                for (int n = 0; n < 2; ++n) acc[a][b][m][n] = (f32x4){0.f, 0.f, 0.f, 0.f};
    bf16x8 At[4][2], B0[2][2], B1[2][2];
    const char* cA = (const char*)g.A + (size_t)cur.pm * tstep; const char* cB = (const char*)g.Bt + (size_t)cur.pn * tstep;
    S.a_ready(cur);
    if constexpr (SP2) {
        PG8_STAGE(PG8_SB(0, 0), cB, voffB); PG8_STAGE(PG8_SB(0, 1), cB + hstep, voffB); PG8_STAGE(PG8_SA(0, 0), cA, voffA); PG8_STAGE(PG8_SA(0, 1), cA + hstep, voffA);
        if (wr == 1) PG8_BAR;
        PG8_WAIT_V(2); PG8_BAR;
        PG8_STAGE(PG8_SB(1, 0), cB + kstep, voffB); PG8_STAGE(PG8_SA(1, 0), cA + kstep, voffA); PG8_STAGE(PG8_SB(1, 1), cB + hstep + kstep, voffB);
        PG8_WAIT_V(6); PG8_BAR;
    } else {
        PG8_STAGE(PG8_SB(0, 0), cB, voffB); PG8_STAGE(PG8_SA(0, 0), cA, voffA); PG8_STAGE(PG8_SB(0, 1), cB + hstep, voffB); PG8_STAGE(PG8_SA(0, 1), cA + hstep, voffA);
        if (wr == 1) PG8_BAR;
        PG8_WAIT_V(4); PG8_BAR;
        PG8_STAGE(PG8_SB(1, 0), cB + kstep, voffB); PG8_STAGE(PG8_SA(1, 0), cA + kstep, voffA); PG8_STAGE(PG8_SB(1, 1), cB + hstep + kstep, voffB);
        PG8_WAIT_V(6); PG8_BAR;
    }
    for (;;) {
        const bool has_next = S.next(ui + 1, nxt);
        const char* nA = has_next ? (const char*)g.A + (size_t)nxt.pm * tstep : cA; const char* nB = has_next ? (const char*)g.Bt + (size_t)nxt.pn * tstep : cB;
        for (int t = 0; t < nt; t += 2) {
            const bool last = (t == nt - 2);
            const char* a1 = cA + (size_t)(t + 1) * kstep;
            const char* a2 = last ? nA : cA + (size_t)(t + 2) * kstep; const char* b2 = last ? nB : cB + (size_t)(t + 2) * kstep;
            const char* a3 = a2 + kstep; const char* b3 = b2 + kstep;
            if (last && has_next) S.a_ready(nxt);
            if constexpr (SP2) {
            PG8_LDB(B0, 0, 0); PG8_LDB(B1, 0, 1); PG8_SCHED; PG8_LDA(At, 0, 0); PG8_STAGE(PG8_SA(1, 1), a1 + hstep, voffA);
            PG8_WAIT_V(8); PG8_WAIT_L(0); PG8_BAR; PG8_MMA(0, 0, At, B0); PG8_MMA(0, 1, At, B1); PG8_BAR; PG8_SCHED;
            PG8_LDA(At, 0, 1); PG8_STAGE(PG8_SB(0, 0), b2, voffB); PG8_STAGE(PG8_SB(0, 1), b2 + hstep, voffB); PG8_STAGE(PG8_SA(0, 0), a2, voffA);
            PG8_WAIT_V(8); PG8_WAIT_L(0); PG8_BAR; PG8_MMA(1, 0, At, B0); PG8_MMA(1, 1, At, B1); PG8_BAR; PG8_SCHED;
            PG8_LDB(B0, 1, 0); PG8_LDB(B1, 1, 1); PG8_SCHED; PG8_LDA(At, 1, 0); PG8_STAGE(PG8_SA(0, 1), a2 + hstep, voffA);
            PG8_WAIT_V(8); PG8_WAIT_L(0); PG8_BAR; PG8_MMA(0, 0, At, B0); PG8_MMA(0, 1, At, B1); PG8_BAR; PG8_SCHED;
            PG8_LDA(At, 1, 1); PG8_STAGE(PG8_SB(1, 0), b3, voffB); PG8_STAGE(PG8_SB(1, 1), b3 + hstep, voffB); PG8_STAGE(PG8_SA(1, 0), a3, voffA);
            PG8_WAIT_V(8); PG8_WAIT_L(0); PG8_BAR; PG8_MMA(1, 0, At, B0); PG8_MMA(1, 1, At, B1); PG8_BAR; PG8_SCHED;
            } else {
            PG8_LDB(B0, 0, 0); PG8_SCHED; PG8_LDA(At, 0, 0); PG8_STAGE(PG8_SA(1, 1), a1 + hstep, voffA);
            PG8_WAIT_L(8); PG8_BAR; PG8_WAIT_L(0); PG8_MMA(0, 0, At, B0); PG8_BAR; PG8_SCHED;
            PG8_LDB(B1, 0, 1); PG8_STAGE(PG8_SB(0, 0), b2, voffB);
            PG8_BAR; PG8_WAIT_L(0); PG8_MMA(0, 1, At, B1); PG8_BAR;
            PG8_LDA(At, 0, 1); PG8_STAGE(PG8_SA(0, 0), a2, voffA);
            PG8_BAR; PG8_WAIT_L(0); PG8_MMA(1, 0, At, B0); PG8_BAR; PG8_SCHED;
            PG8_STAGE(PG8_SB(0, 1), b2 + hstep, voffB);
            PG8_WAIT_V(6); PG8_BAR; PG8_MMA(1, 1, At, B1); PG8_BAR;
            PG8_LDB(B0, 1, 0); PG8_SCHED; PG8_LDA(At, 1, 0); PG8_STAGE(PG8_SA(0, 1), a2 + hstep, voffA);
            PG8_WAIT_L(8); PG8_BAR; PG8_WAIT_L(0); PG8_MMA(0, 0, At, B0); PG8_BAR; PG8_SCHED;
            PG8_LDB(B1, 1, 1); PG8_STAGE(PG8_SB(1, 0), b3, voffB);
            PG8_BAR; PG8_WAIT_L(0); PG8_MMA(0, 1, At, B1); PG8_BAR;
            PG8_LDA(At, 1, 1); PG8_STAGE(PG8_SA(1, 0), a3, voffA);
            PG8_BAR; PG8_WAIT_L(0); PG8_MMA(1, 0, At, B0); PG8_BAR; PG8_SCHED;
            PG8_STAGE(PG8_SB(1, 1), b3 + hstep, voffB);
            PG8_WAIT_V(6); PG8_BAR; PG8_MMA(1, 1, At, B1); PG8_BAR;
            }
        }
        if constexpr (ALIGN_EPI) { if (wr == 0) PG8_BAR; }
        E(acc, cur, wr, wc, fr, fq); S.done(cur);
        if (!has_next) break;
#pragma unroll
        for (int a = 0; a < 2; ++a)
#pragma unroll
            for (int b = 0; b < 2; ++b)
#pragma unroll
                for (int m = 0; m < 4; ++m)
#pragma unroll
                    for (int n = 0; n < 2; ++n) acc[a][b][m][n] = (f32x4){0.f, 0.f, 0.f, 0.f};
        cur = nxt; cA = nA; cB = nB; ++ui;
        if constexpr (ALIGN_EPI) { if (wr == 1) PG8_BAR; }
    }
    PG8_WAIT_V(0);
    if constexpr (!ALIGN_EPI) { if (wr == 0) PG8_BAR; }
    PG8_BAR;
#undef PG8_SA
#undef PG8_SB
#undef PG8_STAGE
#undef PG8_LDA
#undef PG8_LDB
#undef PG8_MMA
#undef PG8_WAIT_V
#undef PG8_WAIT_L
#undef PG8_BAR
#undef PG8_SCHED
}
}

constexpr int BATCH = 8, SEQ = 4096, DM = 1024, MROWS = BATCH * SEQ, DEPTH = 4;
constexpr int NIN = 3072, CIN = 3080, DFF = 2816, NUP = 2 * DFF;
constexpr float EPS = 1e-6f;
constexpr int NPHASE = 2 + 6 * DEPTH;

constexpr size_t MiB = 1u << 20;
constexpr size_t WS_CTL = 0, CTL_ZERO_BYTES = 64 * 1024;
constexpr size_t WS_COS = 1 * MiB, WS_SIN = 2 * MiB;
constexpr size_t WS_SS = 3 * MiB;
constexpr size_t WS_GLI = 5 * MiB, WS_GLF = 5 * MiB + 512 * 1024;
constexpr size_t WS_WG = 6 * MiB;
constexpr size_t WS_WM = 6 * MiB + 256 * 1024;
constexpr size_t WS_NST = 7 * MiB;
constexpr size_t WS_W = 8 * MiB;
constexpr size_t W_IN_OFF = 0, W_OUT_OFF = (size_t)NIN * DM * 2, W_UP_OFF = W_OUT_OFF + (size_t)DM * DM * 2, W_DOWN_OFF = W_UP_OFF + (size_t)NUP * DM * 2, W_LAYER = W_DOWN_OFF + (size_t)DM * DFF * 2;
constexpr size_t WS_HB = 106 * MiB;
constexpr size_t WS_MIX = 170 * MiB;
constexpr size_t WS_PROJ = 234 * MiB;
constexpr size_t WS_TST = 426 * MiB;
constexpr size_t WS_END = 460 * MiB;
static_assert(WS_W + 4 * W_LAYER <= WS_HB && WS_TST + (size_t)256 * 256 * 128 * 4 <= WS_END, "ws map");

constexpr int RING_BYTES = 131072;
constexpr int LDSCTL_OFF = RING_BYTES;
constexpr int LDS_BYTES = 147456;

#define GAS __attribute__((address_space(1)))
#define LAS __attribute__((address_space(3)))
#define DI __device__ __forceinline__
typedef unsigned short bf16_t;
typedef short bf16x8 __attribute__((ext_vector_type(8)));
typedef short bf16x4 __attribute__((ext_vector_type(4)));
typedef float f32x4 __attribute__((ext_vector_type(4)));
typedef float f32x16 __attribute__((ext_vector_type(16)));
typedef unsigned u32x4 __attribute__((ext_vector_type(4)));
typedef unsigned u32x2 __attribute__((ext_vector_type(2)));

DI unsigned pk2(float lo, float hi) { typedef __bf16 b2 __attribute__((ext_vector_type(2))); b2 v; v.x = (__bf16)lo; v.y = (__bf16)hi; return __builtin_bit_cast(unsigned, v); }
DI float bf2f(unsigned short x) { return __uint_as_float(((unsigned)x) << 16); }
DI float bflo(unsigned w) { return __uint_as_float(w << 16); }
DI float bfhi(unsigned w) { return __uint_as_float(w & 0xffff0000u); }
DI float fexp(float x) { return __builtin_amdgcn_exp2f(x * 1.4426950408889634f); }
DI float frcp(float x) { return __builtin_amdgcn_rcpf(x); }
DI float sigmoid_f(float x) { return frcp(1.f + fexp(-x)); }
DI float silu_f(float x) { return x * sigmoid_f(x); }
DI float gelu_tanh_f(float x) { return x * sigmoid_f(1.5957691216057308f * (x + 0.044715f * x * x * x)); }
template <int CTRL> DI float dpp_f(float v) { return __int_as_float(__builtin_amdgcn_mov_dpp(__float_as_int(v), CTRL, 0xF, 0xF, true)); }
DI float xor16_f(float v) { return __int_as_float(__builtin_amdgcn_ds_swizzle(__float_as_int(v), 0x401F)); }
DI float sum_xor32(float v) { const auto r = __builtin_amdgcn_permlane32_swap(__float_as_uint(v), __float_as_uint(v), false, false); return __uint_as_float(r[0]) + __uint_as_float(r[1]); }
DI float sum_xor16_32(float v) { v += xor16_f(v); return sum_xor32(v); }
DI float wave_sum(float v) {
    v += dpp_f<0xB1>(v); v += dpp_f<0x4E>(v); v += dpp_f<0x141>(v); v += dpp_f<0x140>(v);
    return sum_xor16_32(v);
}
template <int CTRL, int ROWMASK, bool IS_MAX> DI float scan_step(float v, const float ident) {
    const float t = __int_as_float(__builtin_amdgcn_update_dpp(__float_as_int(ident), __float_as_int(v), CTRL, ROWMASK, 0xF, false));
    return IS_MAX ? fmaxf(v, t) : v + t;
}
template <bool IS_MAX> DI float wave_scan(float v) {
    const float id = IS_MAX ? -3.0e38f : 0.f;
    v = scan_step<0x111, 0xF, IS_MAX>(v, id); v = scan_step<0x112, 0xF, IS_MAX>(v, id); v = scan_step<0x114, 0xF, IS_MAX>(v, id); v = scan_step<0x118, 0xF, IS_MAX>(v, id);
    v = scan_step<0x142, 0xA, IS_MAX>(v, id);
    v = scan_step<0x143, 0xC, IS_MAX>(v, id);
    return v;
}
DI float lane63(float v) { return __int_as_float(__builtin_amdgcn_readlane(__float_as_int(v), 63)); }

#define XB_TMO      128
#define XB_XCNT(j)  (256  + 64 * (j))
#define XB_XSUB(j)  (1280 + 64 * (j))
#define XB_XGEN(j)  (2304 + 64 * (j))
#define XB_TOP      3328
#define XB_TOPGEN   3392
#define XCD_BAR_WORDS 3456
#define XB_SPIN_CAP (1u << 18)

__device__ __forceinline__ unsigned xb_ld(unsigned* p)              { return __hip_atomic_load(p, __ATOMIC_RELAXED, __HIP_MEMORY_SCOPE_AGENT); }
__device__ __forceinline__ unsigned xb_add(unsigned* p, unsigned v) { return __hip_atomic_fetch_add(p, v, __ATOMIC_RELAXED, __HIP_MEMORY_SCOPE_AGENT); }
__device__ __forceinline__ unsigned xb_xcc_id() { return (unsigned)__builtin_amdgcn_s_getreg((3 << 11) | 20) & 0xFu; }
#define XB_SPIN(cond, bar) do { unsigned _sp = 0; while (cond) { __builtin_amdgcn_s_sleep(1); \
    if ((++_sp & 255u) == 0u) { if (xb_ld(&(bar)[XB_TMO])) break; if (_sp > XB_SPIN_CAP) { atomicAdd(&(bar)[XB_TMO], 1u); break; } } } } while (0)

struct XcdBarrier { unsigned* bar; unsigned x; volatile LAS unsigned* st; };

__device__ __forceinline__ XcdBarrier xcd_barrier_post(unsigned* bar, volatile LAS unsigned* st, int tid) {
    XcdBarrier b; b.bar = bar; b.x = xb_xcc_id(); b.st = st;
    if (tid == 0) (void)xb_add(&bar[XB_XCNT(b.x)], 1u);
    return b;
}
__device__ __forceinline__ void xcd_barrier_complete(unsigned* bar, unsigned x, unsigned& nloc, unsigned& nx) {
    const unsigned G = gridDim.x * gridDim.y * gridDim.z;
    unsigned sum, cnt, mine, sp = 0u;
    for (;;) {
        sum = 0u; cnt = 0u; mine = 0u;
#pragma unroll
        for (unsigned j = 0; j < 16; ++j) { const unsigned c = xb_ld(&bar[XB_XCNT(j)]); sum += c; cnt += (c > 0u) ? 1u : 0u; mine = (j == x) ? c : mine; }
        if (sum == G) break;
        __builtin_amdgcn_s_sleep(1);
        if ((++sp & 255u) == 0u) { if (xb_ld(&bar[XB_TMO])) break; if (sp > XB_SPIN_CAP) { atomicAdd(&bar[XB_TMO], 1u); break; } }
    }
    nloc = mine > 0u ? mine : 1u; nx = cnt > 0u ? cnt : 1u;
}
__device__ __forceinline__ void xcd_barrier(const XcdBarrier& b, int tid) {
    asm volatile("s_waitcnt vmcnt(0)" ::: "memory");
    __syncthreads();
    if (tid == 0) {
        unsigned* bar = b.bar;
        __builtin_amdgcn_s_waitcnt(0);
        unsigned nloc = b.st[0], nx = b.st[1];
        if (nloc == 0u) { xcd_barrier_complete(bar, b.x, nloc, nx); b.st[0] = nloc; b.st[1] = nx; }
        const unsigned old = xb_add(&bar[XB_XSUB(b.x)], 1u);
        const unsigned gen = old / nloc;
        if (old + 1u == (gen + 1u) * nloc) {
            __builtin_amdgcn_fence(__ATOMIC_RELEASE, "agent");
            asm volatile("s_waitcnt vmcnt(0)" ::: "memory");
            const unsigned og = xb_add(&bar[XB_TOP], 1u);
            const unsigned tg = og / nx;
            if (og + 1u == (tg + 1u) * nx) xb_add(&bar[XB_TOPGEN], 1u);
            else XB_SPIN(xb_ld(&bar[XB_TOPGEN]) == tg, bar);
            __builtin_amdgcn_fence(__ATOMIC_ACQUIRE, "agent");
            xb_add(&bar[XB_XGEN(b.x)], 1u);
            asm volatile("s_waitcnt vmcnt(0)" ::: "memory");
        } else {
            XB_SPIN(xb_ld(&bar[XB_XGEN(b.x)]) == gen, bar);
            __builtin_amdgcn_fence(__ATOMIC_ACQUIRE, "agent");
            asm volatile("s_waitcnt vmcnt(0)" ::: "memory");
        }
    }
    __syncthreads();
}

struct Frame {
    LAS unsigned char* lds;
    int tid, lane, wave, G;
    const float* const __attribute__((address_space(4)))* in;
    float* H;
    unsigned char* ws;
};
DI bf16_t* W_in(const Frame& F, int L)   { return (bf16_t*)(F.ws + WS_W + (size_t)L * W_LAYER + W_IN_OFF); }
DI bf16_t* W_out(const Frame& F, int L)  { return (bf16_t*)(F.ws + WS_W + (size_t)L * W_LAYER + W_OUT_OFF); }
DI bf16_t* W_up(const Frame& F, int L)   { return (bf16_t*)(F.ws + WS_W + (size_t)L * W_LAYER + W_UP_OFF); }
DI bf16_t* W_down(const Frame& F, int L) { return (bf16_t*)(F.ws + WS_W + (size_t)L * W_LAYER + W_DOWN_OFF); }

DI void row_rstd8(const float* __restrict__ SS, int row0, int fq, float (&rs)[2][4]) {
    f32x4 sp[2][4];
#pragma unroll
    for (int ai = 0; ai < 2; ++ai)
#pragma unroll
        for (int m = 0; m < 4; ++m) sp[ai][m] = *(const f32x4*)(SS + (size_t)(row0 + ai * 128 + m * 16) * 16 + 4 * fq);
#pragma unroll
    for (int ai = 0; ai < 2; ++ai)
#pragma unroll
        for (int m = 0; m < 4; ++m) { float s = (sp[ai][m].x + sp[ai][m].y) + (sp[ai][m].z + sp[ai][m].w); s = sum_xor16_32(s); rs[ai][m] = 1.0f / sqrtf(s * (1.0f / DM) + EPS); }
}
DI void store8(bf16_t* p, const f32x4& v0, const f32x4& v1) { u32x4 w; w.x = pk2(v0[0], v0[1]); w.y = pk2(v0[2], v0[3]); w.z = pk2(v1[0], v1[1]); w.w = pk2(v1[2], v1[3]); *(u32x4*)p = w; }

struct EpiInA {
    static constexpr bool PERM = true;
    bf16_t* P; const float* SS; const float* COS; const float* SIN;
    DI void operator()(const f32x4 (&acc)[2][2][4][2], const pg8::Unit& u, int wr, int wc, int fr, int fq) const {
        const int row0 = u.pm * 256 + wr * 64 + fr, colw = wc * 32 + 8 * fq, typ = u.pn >> 1;
        float rsv[2][4]; row_rstd8(SS, row0, fq, rsv);
#pragma unroll
        for (int ai = 0; ai < 2; ++ai) {
            f32x4 cc[4], sn[4];
            if (typ < 2) {
#pragma unroll
                for (int m = 0; m < 4; ++m) { const int pos = (row0 + ai * 128 + m * 16) & (SEQ - 1); cc[m] = *(const f32x4*)(COS + pos * 64 + (colw >> 1)); sn[m] = *(const f32x4*)(SIN + pos * 64 + (colw >> 1)); } }
#pragma unroll
            for (int m = 0; m < 4; ++m) {
                const int row = row0 + ai * 128 + m * 16;
                const float rs = rsv[ai][m];
                bf16_t* rowp = P + (size_t)row * NIN + u.pn * 256 + colw;
                if (typ < 2) {
                    const f32x4 c4 = cc[m], s4 = sn[m];
#pragma unroll
                    for (int bj = 0; bj < 2; ++bj) { const f32x4 a0 = acc[ai][bj][m][0] * rs, a1 = acc[ai][bj][m][1] * rs; f32x4 v0, v1;
                        v0[0] = a0[0] * c4[0] - a0[1] * s4[0]; v0[1] = a0[0] * s4[0] + a0[1] * c4[0];
                        v0[2] = a0[2] * c4[1] - a0[3] * s4[1]; v0[3] = a0[2] * s4[1] + a0[3] * c4[1];
                        v1[0] = a1[0] * c4[2] - a1[1] * s4[2]; v1[1] = a1[0] * s4[2] + a1[1] * c4[2];
                        v1[2] = a1[2] * c4[3] - a1[3] * s4[3]; v1[3] = a1[2] * s4[3] + a1[3] * c4[3];
                        store8(rowp + bj * 128, v0, v1); }
                } else {
#pragma unroll
                    for (int bj = 0; bj < 2; ++bj) { f32x4 v0 = acc[ai][bj][m][0] * rs, v1 = acc[ai][bj][m][1] * rs;
                        if (typ == 3) {
#pragma unroll
                            for (int j = 0; j < 4; ++j) { v0[j] = silu_f(v0[j]); v1[j] = silu_f(v1[j]); } }
                        else if (typ >= 4) {
#pragma unroll
                            for (int j = 0; j < 4; ++j) { v0[j] = gelu_tanh_f(v0[j]); v1[j] = gelu_tanh_f(v1[j]); } }
                        store8(rowp + bj * 128, v0, v1); }
                }
            }
        }
    }
};
struct EpiInC {
    static constexpr bool PERM = true;
    bf16_t* P; const float* SS;
    DI void operator()(const f32x4 (&acc)[2][2][4][2], const pg8::Unit& u, int wr, int wc, int fr, int fq) const {
        const int row0 = u.pm * 256 + wr * 64 + fr, colw = wc * 32 + 8 * fq; const bool sg = u.pn >= 8;
        float rsv[2][4]; row_rstd8(SS, row0, fq, rsv);
#pragma unroll
        for (int ai = 0; ai < 2; ++ai)
#pragma unroll
            for (int m = 0; m < 4; ++m) {
                const int row = row0 + ai * 128 + m * 16;
                const float rs = rsv[ai][m];
                bf16_t* rowp = P + (size_t)row * NIN + u.pn * 256 + colw;
#pragma unroll
                for (int bj = 0; bj < 2; ++bj) { f32x4 v0 = acc[ai][bj][m][0] * rs, v1 = acc[ai][bj][m][1] * rs;
                    if (sg) {
#pragma unroll
                        for (int j = 0; j < 4; ++j) { v0[j] = sigmoid_f(v0[j]); v1[j] = sigmoid_f(v1[j]); } }
                    store8(rowp + bj * 128, v0, v1); }
            }
    }
};
struct EpiRes {
    static constexpr bool PERM = true;
    bf16_t* HB; float* SS; float sgn;
    DI void operator()(const f32x4 (&acc)[2][2][4][2], const pg8::Unit& u, int wr, int wc, int fr, int fq) const {
        const int row0 = u.pm * 256 + wr * 64 + fr, col0 = u.pn * 256 + wc * 32 + 8 * fq;
#pragma unroll
        for (int ai = 0; ai < 2; ++ai) {
            u32x4 hv[4][2];
#pragma unroll
            for (int m = 0; m < 4; ++m) { const bf16_t* bp = HB + (size_t)(row0 + ai * 128 + m * 16) * DM + col0;
#pragma unroll
                for (int bj = 0; bj < 2; ++bj) hv[m][bj] = *(const u32x4*)(bp + bj * 128); }
#pragma unroll
            for (int m = 0; m < 4; ++m) {
                const int row = row0 + ai * 128 + m * 16;
                bf16_t* bp = HB + (size_t)row * DM + col0; float ssum = 0.f;
#pragma unroll
                for (int bj = 0; bj < 2; ++bj) {
                    const u32x4 w = hv[m][bj];
                    const f32x4 b0 = {bflo(w.x), bfhi(w.x), bflo(w.y), bfhi(w.y)}, b1 = {bflo(w.z), bfhi(w.z), bflo(w.w), bfhi(w.w)};
                    const f32x4 h0 = b0 + acc[ai][bj][m][0] * sgn, h1 = b1 + acc[ai][bj][m][1] * sgn;
                    store8(bp + bj * 128, h0, h1);
                    ssum += (h0[0] * h0[0] + h0[1] * h0[1]) + (h0[2] * h0[2] + h0[3] * h0[3]) + (h1[0] * h1[0] + h1[1] * h1[1]) + (h1[2] * h1[2] + h1[3] * h1[3]);
                }
                ssum = sum_xor16_32(ssum);
                if (fq == 0) SS[(size_t)row * 16 + u.pn * 4 + wc] = ssum;
            }
        }
    }
};
struct EpiSwiGLU {
    static constexpr bool PERM = true;
    bf16_t* ACT; const float* SS;
    DI void operator()(const f32x4 (&acc)[2][2][4][2], const pg8::Unit& u, int wr, int wc, int fr, int fq) const {
        const int row0 = u.pm * 256 + wr * 64 + fr, col0 = u.pn * 128 + wc * 32 + 8 * fq;
        float rsv[2][4]; row_rstd8(SS, row0, fq, rsv);
#pragma unroll
        for (int ai = 0; ai < 2; ++ai)
#pragma unroll
            for (int m = 0; m < 4; ++m) {
                const int row = row0 + ai * 128 + m * 16;
                const float rs = rsv[ai][m];
                const f32x4 g0 = acc[ai][0][m][0] * rs, g1 = acc[ai][0][m][1] * rs, u0 = acc[ai][1][m][0] * rs, u1 = acc[ai][1][m][1] * rs; f32x4 v0, v1;
#pragma unroll
                for (int j = 0; j < 4; ++j) { v0[j] = silu_f(g0[j]) * u0[j]; v1[j] = silu_f(g1[j]) * u1[j]; }
                store8(ACT + (size_t)row * DFF + col0, v0, v1);
            }
    }
};

template <class Map>
DI void cvt_item(const float* src, int ld, const float* gain, bf16_t* WT, int K, int n0, int k0, const Map& mp, LAS float* scr, int lane) {
    const int nn = lane & 31; const int sc = mp.col(n0 + nn); const float scale = mp.scale(n0 + nn);
#pragma unroll 8
    for (int i = 0; i < 32; ++i) { const int kk = 2 * i + (lane >> 5); const float gk = gain ? gain[k0 + kk] : 1.0f; scr[kk * 33 + nn] = src[(size_t)(k0 + kk) * ld + sc] * (gk * scale); }
    asm volatile("s_waitcnt lgkmcnt(0)" ::: "memory");
    const int c = lane & 7;
#pragma unroll
    for (int j = 0; j < 4; ++j) { const int n = (lane >> 3) + 8 * j; const LAS float* s = scr + (8 * c) * 33 + n;
        u32x4 o; o.x = pk2(s[0 * 33], s[1 * 33]); o.y = pk2(s[2 * 33], s[3 * 33]); o.z = pk2(s[4 * 33], s[5 * 33]); o.w = pk2(s[6 * 33], s[7 * 33]);
        *(u32x4*)(WT + (size_t)(n0 + n) * K + k0 + 8 * c) = o; }
    asm volatile("s_waitcnt lgkmcnt(0)" ::: "memory");
}
struct MapId { DI int col(int n) const { return n; } DI float scale(int) const { return 1.0f; } };
struct MapInA { DI int col(int n) const { if (n >= 1024) return n; const int p = n & 127; return (n & ~127) + (p >> 1) + 64 * (p & 1); } DI float scale(int n) const { return (n >= 512 && n < 1024) ? 0.08838834764831845f : 1.0f; } };
struct MapInC { DI int col(int n) const { return n; } DI float scale(int n) const { return (n >= 512 && n < 1024) ? 0.08838834764831845f : 1.0f; } };
struct MapUp  { DI int col(int n) const { return 128 * (n >> 8) + (n & 127); } DI float scale(int) const { return 1.0f; } };

DI void p0_prologue(Frame& F) {
    LAS float* scr = (LAS float*)(F.lds + F.wave * 16384);
    const int gw = blockIdx.x * 8 + F.wave, NGW = F.G * 8;
    constexpr int I_IN = 16 * 96, I_OUT = 16 * 32, I_UP = 16 * 176, I_DOWN = 44 * 32, I_LAYER = I_IN + I_OUT + I_UP + I_DOWN;
    for (int it = gw; it < DEPTH * I_LAYER; it += NGW) {
        const int L = it / I_LAYER; int r = it % I_LAYER; const int j = L >> 1;
        if (r < I_IN) { const int kb = r / 96, nb = r % 96;
            if (L & 1) cvt_item(F.in[11] + (size_t)j * DM * CIN, CIN, F.in[1] + L * DM, W_in(F, L), DM, 32 * nb, 64 * kb, MapInC(), scr, F.lane);
            else       cvt_item(F.in[4] + (size_t)j * DM * NIN, NIN, F.in[1] + L * DM, W_in(F, L), DM, 32 * nb, 64 * kb, MapInA(), scr, F.lane);
            continue; }
        r -= I_IN;
        if (r < I_OUT) { const int kb = r / 32, nb = r % 32;
            cvt_item(((L & 1) ? F.in[12] : F.in[5]) + (size_t)j * DM * DM, DM, nullptr, W_out(F, L), DM, 32 * nb, 64 * kb, MapId(), scr, F.lane); continue; }
        r -= I_OUT;
        if (r < I_UP) { const int kb = r / 176, nb = r % 176; const int n0 = 32 * nb; const bool up = (n0 >> 7) & 1;
            cvt_item((up ? F.in[17] : F.in[16]) + (size_t)L * DM * DFF, DFF, F.in[2] + L * DM, W_up(F, L), DM, n0, 64 * kb, MapUp(), scr, F.lane); continue; }
        r -= I_UP;
        { const int kb = r / 32, nb = r % 32;
          cvt_item(F.in[18] + (size_t)L * DFF * DM, DM, nullptr, W_down(F, L), DFF, 32 * nb, 64 * kb, MapId(), scr, F.lane); }
    }
    float* SS = (float*)(F.ws + WS_SS); bf16_t* HB = (bf16_t*)(F.ws + WS_HB);
    for (int m = gw; m < MROWS; m += NGW) {
        const f32x4* xr = (const f32x4*)(F.in[0] + (size_t)m * DM) + F.lane; u32x2* br = (u32x2*)(HB + (size_t)m * DM) + F.lane;
        f32x4 v[4]; float s = 0.f;
#pragma unroll
        for (int q = 0; q < 4; ++q) { v[q] = xr[64 * q]; s += (v[q].x * v[q].x + v[q].y * v[q].y) + (v[q].z * v[q].z + v[q].w * v[q].w); }
        s = wave_sum(s);
#pragma unroll
        for (int q = 0; q < 4; ++q) { u32x2 o; o.x = pk2(v[q].x, v[q].y); o.y = pk2(v[q].z, v[q].w); br[64 * q] = o; }
        if (F.lane < 16) SS[(size_t)m * 16 + F.lane] = (F.lane == 0) ? s : 0.f;
    }
    const int gt = blockIdx.x * 512 + F.tid, NGT = F.G * 512;
    float* COS = (float*)(F.ws + WS_COS); float* SIN = (float*)(F.ws + WS_SIN);
    for (int e = gt; e < SEQ * 64; e += NGT) {
        const int pos = e >> 6, i = e & 63;
        const float inv = exp2f(-(float)i * (13.287712379549449f / 64.0f));
        const float ang = (float)pos * inv;
        const double a = (double)ang; const double n = rint(a * 0.15915494309189535); const float rr = (float)(a - n * 6.283185307179586);
        COS[e] = cosf(rr); SIN[e] = sinf(rr);
    }
    float* WG = (float*)(F.ws + WS_WG);
    for (int e = gt; e < 2 * 8 * DM; e += NGT) { const int j = e >> 13, c = (e >> 10) & 7, k = e & 1023;
        WG[e] = F.in[11][(size_t)j * DM * CIN + (size_t)k * CIN + 3072 + c] * F.in[1][(2 * j + 1) * DM + k]; }
    bf16_t* WM = (bf16_t*)(F.ws + WS_WM);
    for (int e = gt; e < 2 * 4 * 128 * 128; e += NGT) { const int p = (e >> 7) & 127, q = e & 127; const float w = ((q >> 6) <= (p >> 6)) ? F.in[9][e] : 0.f; WM[e] = (bf16_t)(pk2(w, 0.f) & 0xffffu); }
}

DI void gate_step(Frame& F, int L) {
    const int j = L >> 1; const int gw = blockIdx.x * 8 + F.wave, NGW = F.G * 8;
    const float* SS = (const float*)(F.ws + WS_SS); const bf16_t* HB = (const bf16_t*)(F.ws + WS_HB); const float* WG = (const float*)(F.ws + WS_WG) + j * 8 * DM;
    float* GLI = (float*)(F.ws + WS_GLI); float* GLF = (float*)(F.ws + WS_GLF);
    for (int m = gw; m < MROWS; m += NGW) {
        const u32x4 a0 = *((const u32x4*)(HB + (size_t)m * DM) + F.lane), a1 = *((const u32x4*)(HB + (size_t)m * DM + 512) + F.lane);
        float x[16];
        x[0] = bflo(a0.x); x[1] = bfhi(a0.x); x[2] = bflo(a0.y); x[3] = bfhi(a0.y); x[4] = bflo(a0.z); x[5] = bfhi(a0.z); x[6] = bflo(a0.w); x[7] = bfhi(a0.w);
        x[8] = bflo(a1.x); x[9] = bfhi(a1.x); x[10] = bflo(a1.y); x[11] = bfhi(a1.y); x[12] = bflo(a1.z); x[13] = bfhi(a1.z); x[14] = bflo(a1.w); x[15] = bfhi(a1.w);
        float ssp = (F.lane < 16) ? SS[(size_t)m * 16 + F.lane] : 0.f; ssp = wave_sum(ssp);
        const float rs = 1.0f / sqrtf(ssp * (1.0f / DM) + EPS);
        float myv = 0.f;
#pragma unroll
        for (int c = 0; c < 8; ++c) {
            const f32x4* w0 = (const f32x4*)(WG + c * DM + 8 * F.lane); const f32x4* w1 = (const f32x4*)(WG + c * DM + 512 + 8 * F.lane);
            const f32x4 wa = w0[0], wb = w0[1], wc2 = w1[0], wd = w1[1];
            float d = x[0] * wa.x + x[1] * wa.y + x[2] * wa.z + x[3] * wa.w + x[4] * wb.x + x[5] * wb.y + x[6] * wb.z + x[7] * wb.w
                    + x[8] * wc2.x + x[9] * wc2.y + x[10] * wc2.z + x[11] * wc2.w + x[12] * wd.x + x[13] * wd.y + x[14] * wd.z + x[15] * wd.w;
            d = wave_sum(d);
            if (F.lane == c) myv = d * rs;
        }
        if (F.lane < 8) {
            const int hh = F.lane & 3; const int b = m >> 12, t = m & (SEQ - 1); const size_t idx = (size_t)(b * 4 + hh) * SEQ + t;
            if (F.lane < 4) GLI[idx] = myv + F.in[13][j * 4 + hh];
            else { const float xx = myv + F.in[14][j * 4 + hh]; GLF[idx] = (xx >= 0.f) ? -log1pf(expf(-xx)) : (xx - log1pf(expf(xx))); }
        }
    }
}

DI void final_norm(Frame& F) {
    const int gw = blockIdx.x * 8 + F.wave, NGW = F.G * 8; const float* SS = (const float*)(F.ws + WS_SS); const bf16_t* HB = (const bf16_t*)(F.ws + WS_HB); const f32x4* gv = (const f32x4*)F.in[3] + F.lane;
    for (int m = gw; m < MROWS; m += NGW) {
        f32x4* hr = (f32x4*)(F.H + (size_t)m * DM) + F.lane; const u32x2* br = (const u32x2*)(HB + (size_t)m * DM) + F.lane;
        float ssp = (F.lane < 16) ? SS[(size_t)m * 16 + F.lane] : 0.f; ssp = wave_sum(ssp);
        const float rs = 1.0f / sqrtf(ssp * (1.0f / DM) + EPS);
#pragma unroll
        for (int q = 0; q < 4; ++q) { const u32x2 w = br[64 * q]; const f32x4 v = {bflo(w.x), bfhi(w.x), bflo(w.y), bfhi(w.y)}, g = gv[64 * q]; hr[64 * q] = v * rs * g; }
    }
}

DI int opaque(int x) { asm volatile("" : "+v"(x)); return x; }
DI int crow(int i, int h) { return (i & 3) + 8 * (i >> 2) + 4 * h; }
constexpr int QLD = 136, PLD = 72;
constexpr int QS_OFF = 0, KS_OFF = 17408, KW_OFF = 34816, VS_OFF = 52224, PS_OFF = 86016;
constexpr int SA_OFF = 95232, SCM_OFF = SA_OFF + 2048, SMT_OFF = SCM_OFF + 2048, SMISC_OFF = SMT_OFF + 2048;
constexpr int STAT_OFF = SMISC_OFF + 256, NV_OFF = STAT_OFF + 4096, LA_END = NV_OFF + 512;
static_assert(LA_END <= RING_BYTES, "mixer LDS");

DI bf16x8 gather_col(const LAS bf16_t* base, int ld, int col, int s0) {
    bf16x8 r;
#pragma unroll
    for (int j = 0; j < 8; ++j) r[j] = (short)base[(s0 + j) * ld + col];
    return r;
}
DI bf16x8 pack_acc(const f32x16& x, int s) {
    u32x4 p; p.x = pk2(x[8 * s + 0], x[8 * s + 1]); p.y = pk2(x[8 * s + 2], x[8 * s + 3]); p.z = pk2(x[8 * s + 4], x[8 * s + 5]); p.w = pk2(x[8 * s + 6], x[8 * s + 7]);
    return __builtin_bit_cast(bf16x8, p);
}
#define MFMA32(a, b, c) __builtin_amdgcn_mfma_f32_32x32x16_bf16((a), (b), (c), 0, 0, 0)
#define MFMA16(a, b, c) __builtin_amdgcn_mfma_f32_16x16x32_bf16((a), (b), (c), 0, 0, 0)

DI void mlstm_scan(Frame& F, int b, int h, int g) {
    LAS float* SA = (LAS float*)(F.lds + SA_OFF); LAS float* SCM = (LAS float*)(F.lds + SCM_OFF); LAS float* SMT = (LAS float*)(F.lds + SMT_OFF); LAS float* SM = (LAS float*)(F.lds + SMISC_OFF);
    const float* GLI = (const float*)(F.ws + WS_GLI) + (size_t)(b * 4 + h) * SEQ; const float* GLF = (const float*)(F.ws + WS_GLF) + (size_t)(b * 4 + h) * SEQ;
    float mprev = 0.f, Lc = 0.f; const int lane = F.lane;
    for (int gg = 0; gg <= g; ++gg) {
        float li[8], lf[8]; const int lo = opaque(lane);
        const float* gli = GLI + gg * 512 + lo; const float* glf = GLF + gg * 512 + lo;
#pragma unroll
        for (int c = 0; c < 8; ++c) { li[c] = gli[c * 64]; lf[c] = glf[c * 64]; }
        if (lane == 0) SM[16 + gg] = Lc;
#pragma unroll
        for (int c = 0; c < 8; ++c) {
            const float bs = wave_scan<false>(lf[c]);
            const float a = li[c] - bs; const float cmx = wave_scan<true>(a);
            const float cm = fmaxf(mprev, cmx);
            const float cm63 = lane63(cm), b63 = lane63(bs);
            if (gg == g) { (SA + lo)[c * 64] = a; (SCM + lo)[c * 64] = cm; (SMT + lo)[c * 64] = bs + cm; if (lane == 0) SM[c] = mprev; }
            Lc += mprev - cm63; mprev = b63 + cm63;
        }
    }
}

template <int MODE, bool PASS2>
DI void la_stage(Frame& F, const bf16_t* PROJ, int R0, int h, int c, float lg2) {
    constexpr int DV = MODE ? 256 : 128, VLD = DV + 8;
    LAS bf16_t* Qs = (LAS bf16_t*)(F.lds + QS_OFF); LAS bf16_t* Ks = (LAS bf16_t*)(F.lds + KS_OFF); LAS bf16_t* Kw = (LAS bf16_t*)(F.lds + KW_OFF); LAS bf16_t* Vs = (LAS bf16_t*)(F.lds + VS_OFF);
    const LAS float* SA = (const LAS float*)(F.lds + SA_OFF); const LAS float* SCM = (const LAS float*)(F.lds + SCM_OFF);
    const int qcol = 128 * h, kcol = 512 + 128 * h, vcol = 1024 + DV * h; const int tid_o = opaque(F.tid);
#pragma unroll
    for (int i = 0; i < 2; ++i) { const int p = tid_o + 512 * i, t = p >> 4, cp = (p & 15) * 8;
        const u32x4 kv = *(const u32x4*)(PROJ + (size_t)(R0 + t) * NIN + kcol + cp);
        float ck;
        if (MODE) ck = fexp(SA[c * 64 + t] - SCM[c * 64 + 63]); else ck = __builtin_amdgcn_exp2f(lg2 * (float)(63 - t));
        u32x4 kw; kw.x = pk2(bflo(kv.x) * ck, bfhi(kv.x) * ck); kw.y = pk2(bflo(kv.y) * ck, bfhi(kv.y) * ck); kw.z = pk2(bflo(kv.z) * ck, bfhi(kv.z) * ck); kw.w = pk2(bflo(kv.w) * ck, bfhi(kv.w) * ck);
        *(LAS u32x4*)(Kw + t * QLD + cp) = kw;
        if (PASS2) { *(LAS u32x4*)(Ks + t * QLD + cp) = kv;
            const u32x4 qv = *(const u32x4*)(PROJ + (size_t)(R0 + t) * NIN + qcol + cp); *(LAS u32x4*)(Qs + t * QLD + cp) = qv; }
    }
#pragma unroll
    for (int i = 0; i < DV / 64; ++i) { const int p = tid_o + 512 * i, t = p / (DV / 8), cp = (p % (DV / 8)) * 8;
        const u32x4 vv = *(const u32x4*)(PROJ + (size_t)(R0 + t) * NIN + vcol + cp); *(LAS u32x4*)(Vs + t * VLD + cp) = vv; }
}

template <int MODE>
DI void la_pass1(Frame& F, int unit) {
    constexpr int DV = MODE ? 256 : 128, VLD = DV + 8, ND = MODE ? 4 : 2;
    const int b = unit >> 5, h = (unit >> 3) & 3, g = unit & 7, row0 = b * SEQ + g * 512;
    const int w = F.wave; int lane = F.lane, r = lane & 31, hh = lane >> 5;
    const int eb = MODE ? w : (w & 3), dt0 = MODE ? 0 : 2 * (w >> 2), e0 = 32 * eb;
    const bf16_t* PROJ = (const bf16_t*)(F.ws + WS_PROJ);
    LAS bf16_t* Kw = (LAS bf16_t*)(F.lds + KW_OFF); LAS bf16_t* Vs = (LAS bf16_t*)(F.lds + VS_OFF);
    const LAS float* SCM = (const LAS float*)(F.lds + SCM_OFF); const LAS float* SM = (const LAS float*)(F.lds + SMISC_OFF); LAS float* NV = (LAS float*)(F.lds + NV_OFF);
    const float lg2 = log2f(1.0f - exp2f(-5.0f - (float)h));
    if (MODE) { if (w == 0) mlstm_scan(F, b, h, g); if (F.tid < 128) NV[F.tid] = 0.f; }
    __syncthreads();
    f32x16 C[ND];
#pragma unroll
    for (int d = 0; d < ND; ++d)
#pragma unroll
        for (int i = 0; i < 16; ++i) C[d][i] = 0.f;
    for (int c = 0; c < 8; ++c) {
        lane = opaque(F.lane); r = lane & 31; hh = lane >> 5;
        la_stage<MODE, false>(F, PROJ, row0 + 64 * c, h, c, lg2);
        __syncthreads();
        const float alpha = MODE ? fexp(SM[c] - SCM[c * 64 + 63]) : __builtin_amdgcn_exp2f(lg2 * 64.0f);
        bf16x8 vf[4];
#pragma unroll
        for (int ks = 0; ks < 4; ++ks) vf[ks] = gather_col(Vs, VLD, e0 + r, 16 * ks + 8 * hh);
#pragma unroll
        for (int d = 0; d < ND; ++d) {
#pragma unroll
            for (int i = 0; i < 16; ++i) C[d][i] *= alpha;
#pragma unroll
            for (int ks = 0; ks < 4; ++ks) { const bf16x8 ka = gather_col(Kw, QLD, 32 * (dt0 + d) + r, 16 * ks + 8 * hh); C[d] = MFMA32(ka, vf[ks], C[d]); }
            asm volatile("" ::: "memory");
        }
        if (MODE) {
            const int dd = 16 * w + (lane & 15), sq = lane >> 4; float s = 0.f;
#pragma unroll
            for (int q = 0; q < 16; ++q) s += bf2f(Kw[(16 * sq + q) * QLD + dd]);
            s = sum_xor16_32(s);
            if (lane < 16) NV[dd] = alpha * NV[dd] + s;
        }
        __syncthreads();
    }
    float* T = (float*)(F.ws + WS_TST) + (size_t)unit * DV * 128;
#pragma unroll
    for (int d = 0; d < ND; ++d)
#pragma unroll
        for (int q = 0; q < 4; ++q) { const f32x4 v = {C[d][4 * q], C[d][4 * q + 1], C[d][4 * q + 2], C[d][4 * q + 3]};
            *(f32x4*)(T + (size_t)(e0 + r) * 128 + 32 * (dt0 + d) + 8 * q + 4 * hh) = v; }
    if (MODE && F.tid < 128) ((float*)(F.ws + WS_NST))[unit * 128 + F.tid] = NV[F.tid];
    __syncthreads();
}

template <int MODE>
DI void la_pass2(Frame& F, int unit, int j) {
    constexpr int DV = MODE ? 256 : 128, VLD = DV + 8, NT = MODE ? 2 : 1;
    const int b = unit >> 5, h = (unit >> 3) & 3, g = unit & 7, row0 = b * SEQ + g * 512;
    const int w = F.wave; int lane = F.lane, r = lane & 31, hh = lane >> 5, r16 = lane & 15, q4 = lane >> 4;
    const int eb = MODE ? w : (w & 3), tb0 = MODE ? 0 : (w >> 2), e0 = 32 * eb;
    const int gcol = MODE ? (2048 + 256 * h) : (1536 + 128 * h), ocol = DV * h;
    const bf16_t* PROJ = (const bf16_t*)(F.ws + WS_PROJ); bf16_t* MIX = (bf16_t*)(F.ws + WS_MIX);
    const float* gain = MODE ? (F.in[15] + (j * 4 + h) * 256) : (F.in[6] + (j * 4 + h) * 128);
    LAS bf16_t* Qs = (LAS bf16_t*)(F.lds + QS_OFF); LAS bf16_t* Ks = (LAS bf16_t*)(F.lds + KS_OFF); LAS bf16_t* Kw = (LAS bf16_t*)(F.lds + KW_OFF); LAS bf16_t* Vs = (LAS bf16_t*)(F.lds + VS_OFF); LAS bf16_t* Ps = (LAS bf16_t*)(F.lds + PS_OFF);
    const LAS float* SA = (const LAS float*)(F.lds + SA_OFF); const LAS float* SCM = (const LAS float*)(F.lds + SCM_OFF); const LAS float* SMT = (const LAS float*)(F.lds + SMT_OFF); const LAS float* SM = (const LAS float*)(F.lds + SMISC_OFF);
    LAS float* STAT = (LAS float*)(F.lds + STAT_OFF); LAS float* NV = (LAS float*)(F.lds + NV_OFF);
    const float lg2 = log2f(1.0f - exp2f(-5.0f - (float)h));
    if (MODE) { if (w == 0) mlstm_scan(F, b, h, g); }
    __syncthreads();
    f32x16 C[4];
#pragma unroll
    for (int d = 0; d < 4; ++d)
#pragma unroll
        for (int i = 0; i < 16; ++i) C[d][i] = 0.f;
    float nacc = 0.f;
    for (int gp = 0; gp < g; ++gp) {
        const float coef = MODE ? fexp(SM[16 + g] - SM[16 + gp + 1]) : __builtin_amdgcn_exp2f(lg2 * (float)(512 * (g - 1 - gp)));
        const float* T = (const float*)(F.ws + WS_TST) + (size_t)(unit - g + gp) * DV * 128 + (size_t)(e0 + r) * 128 + 4 * hh;
#pragma unroll
        for (int d = 0; d < 4; ++d)
#pragma unroll
            for (int q = 0; q < 4; ++q) { const f32x4 v = *(const f32x4*)(T + 32 * d + 8 * q);
                C[d][4 * q] += coef * v.x; C[d][4 * q + 1] += coef * v.y; C[d][4 * q + 2] += coef * v.z; C[d][4 * q + 3] += coef * v.w; }
        if (MODE && F.tid < 128) nacc += coef * ((const float*)(F.ws + WS_NST))[(unit - g + gp) * 128 + F.tid];
    }
    if (MODE && F.tid < 128) NV[F.tid] = nacc;
    for (int c = 0; c < 8; ++c) {
        const int R0 = row0 + 64 * c;
        lane = opaque(F.lane); r = lane & 31; hh = lane >> 5; r16 = lane & 15; q4 = lane >> 4;
        la_stage<MODE, true>(F, PROJ, R0, h, c, lg2);
        __syncthreads();
#pragma unroll
        for (int i = 0; i < 2; ++i) {
            const int tt = 2 * w + i, si = tt >> 2, ti = tt & 3;
            f32x4 x = {0.f, 0.f, 0.f, 0.f};
#pragma unroll
            for (int kk = 0; kk < 4; ++kk) { const bf16x8 ka = *(const LAS bf16x8*)(Ks + (16 * si + r16) * QLD + 32 * kk + 8 * q4); const bf16x8 qb = *(const LAS bf16x8*)(Qs + (16 * ti + r16) * QLD + 32 * kk + 8 * q4); x = MFMA16(ka, qb, x); }
            const int t = 16 * ti + r16; float p[4];
#pragma unroll
            for (int q = 0; q < 4; ++q) { const int s = 16 * si + 4 * q4 + q; float wgt;
                if (MODE) wgt = (s <= t) ? fexp(SA[c * 64 + s] - SCM[c * 64 + t]) : 0.f;
                else { const int dlt = t > s ? t - s : s - t; wgt = __builtin_amdgcn_exp2f(lg2 * (float)dlt); }
                p[q] = x[q] * wgt; }
            u32x2 pw; pw.x = pk2(p[0], p[1]); pw.y = pk2(p[2], p[3]);
            *(LAS u32x2*)(Ps + t * PLD + 16 * si + 4 * q4) = pw;
        }
        __syncthreads();
        bf16x8 vf[4];
#pragma unroll
        for (int ks = 0; ks < 4; ++ks) vf[ks] = gather_col(Vs, VLD, e0 + r, 16 * ks + 8 * hh);
        __builtin_amdgcn_sched_barrier(0);
        float cqv[NT], rinvv[NT];
#pragma unroll
        for (int tt = 0; tt < NT; ++tt) {
            const int t = 32 * (tb0 + tt) + r;
            if (MODE) {
                const float cq = fexp(SM[c] - SCM[c * 64 + t]);
                float ps = 0.f, qn = 0.f;
#pragma unroll
                for (int q = 0; q < 4; ++q) { const u32x4 pv = *(const LAS u32x4*)(Ps + t * PLD + 32 * hh + 8 * q);
                    ps += (bflo(pv.x) + bfhi(pv.x)) + (bflo(pv.y) + bfhi(pv.y)) + (bflo(pv.z) + bfhi(pv.z)) + (bflo(pv.w) + bfhi(pv.w)); }
#pragma unroll
                for (int q = 0; q < 8; ++q) { const u32x4 qv = *(const LAS u32x4*)(Qs + t * QLD + 64 * hh + 8 * q); const f32x4 n0 = *(const LAS f32x4*)(NV + 64 * hh + 8 * q), n1 = *(const LAS f32x4*)(NV + 64 * hh + 8 * q + 4);
                    qn += bflo(qv.x) * n0.x + bfhi(qv.x) * n0.y + bflo(qv.y) * n0.z + bfhi(qv.y) * n0.w + bflo(qv.z) * n1.x + bfhi(qv.z) * n1.y + bflo(qv.w) * n1.z + bfhi(qv.w) * n1.w;
                    if (q & 1) asm volatile("" ::: "memory"); }
                float den = sum_xor32(ps + cq * qn);
                cqv[tt] = cq; rinvv[tt] = 1.0f / fmaxf(fabsf(den), fexp(-SMT[c * 64 + t]));
            } else { cqv[tt] = __builtin_amdgcn_exp2f(lg2 * (float)(t + 1)); rinvv[tt] = 1.f; }
        }
        __builtin_amdgcn_sched_barrier(0);
        f32x16 o2[NT], val[NT];
#pragma unroll
        for (int tt = 0; tt < NT; ++tt)
#pragma unroll
            for (int i = 0; i < 16; ++i) { o2[tt][i] = 0.f; val[tt][i] = 0.f; }
#pragma unroll
        for (int d = 0; d < 4; ++d) {
#pragma unroll
            for (int s2 = 0; s2 < 2; ++s2) { const bf16x8 ca = pack_acc(C[d], s2);
#pragma unroll
                for (int tt = 0; tt < NT; ++tt) { const int t = 32 * (tb0 + tt) + r;
                    const bf16x4 qlo = *(const LAS bf16x4*)(Qs + t * QLD + 32 * d + 16 * s2 + 4 * hh), qhi = *(const LAS bf16x4*)(Qs + t * QLD + 32 * d + 16 * s2 + 4 * hh + 8);
                    const bf16x8 qb = __builtin_shufflevector(qlo, qhi, 0, 1, 2, 3, 4, 5, 6, 7);
                    o2[tt] = MFMA32(ca, qb, o2[tt]); } }
            __builtin_amdgcn_sched_barrier(0);
        }
#pragma unroll
        for (int tt = 0; tt < NT; ++tt) { const int t = 32 * (tb0 + tt) + r;
#pragma unroll
            for (int ks = 0; ks < 4; ++ks) { const bf16x8 pb = *(const LAS bf16x8*)(Ps + t * PLD + 16 * ks + 8 * hh); val[tt] = MFMA32(vf[ks], pb, val[tt]); } }
#pragma unroll
        for (int tt = 0; tt < NT; ++tt) { const int t = 32 * (tb0 + tt) + r;
            float s1 = 0.f, s2s = 0.f;
#pragma unroll
            for (int i = 0; i < 16; ++i) { const float v = (val[tt][i] + cqv[tt] * o2[tt][i]) * rinvv[tt]; val[tt][i] = v; s1 += v; s2s += v * v; }
            s1 = sum_xor32(s1); s2s = sum_xor32(s2s);
            if (hh == 0) { STAT[(w * 64 + t) * 2] = s1; STAT[(w * 64 + t) * 2 + 1] = s2s; }
        }
        __syncthreads();
#pragma unroll
        for (int tt = 0; tt < NT; ++tt) {
            const int t = 32 * (tb0 + tt) + r; float S1 = 0.f, S2 = 0.f;
#pragma unroll
            for (int ww = 0; ww < (MODE ? 8 : 4); ++ww) { const int wi = MODE ? ww : (4 * tb0 + ww); S1 += STAT[(wi * 64 + t) * 2]; S2 += STAT[(wi * 64 + t) * 2 + 1]; }
            const float mean = S1 * (1.0f / DV); const float var = fmaxf(S2 * (1.0f / DV) - mean * mean, 0.f); const float rs = 1.0f / sqrtf(var + EPS);
            const size_t rowoff = (size_t)(R0 + t);
#pragma unroll
            for (int q = 0; q < 4; ++q) { const int e = e0 + 8 * q + 4 * hh;
                const f32x4 gn = *(const f32x4*)(gain + e); const u32x2 gt = *(const u32x2*)(PROJ + rowoff * NIN + gcol + e);
                const float y0 = (val[tt][4 * q] - mean) * rs * gn.x * bflo(gt.x), y1 = (val[tt][4 * q + 1] - mean) * rs * gn.y * bfhi(gt.x);
                const float y2 = (val[tt][4 * q + 2] - mean) * rs * gn.z * bflo(gt.y), y3 = (val[tt][4 * q + 3] - mean) * rs * gn.w * bfhi(gt.y);
                u32x2 o; o.x = pk2(y0, y1); o.y = pk2(y2, y3); *(u32x2*)(MIX + rowoff * DM + ocol + e) = o; asm volatile("" ::: "memory"); }
        }
        __builtin_amdgcn_sched_barrier(0);
        const float alpha = MODE ? fexp(SM[c] - SCM[c * 64 + 63]) : __builtin_amdgcn_exp2f(lg2 * 64.0f);
#pragma unroll
        for (int d = 0; d < 4; ++d) {
#pragma unroll
            for (int i = 0; i < 16; ++i) C[d][i] *= alpha;
#pragma unroll
            for (int ks = 0; ks < 4; ++ks) { const bf16x8 ka = gather_col(Kw, QLD, 32 * d + r, 16 * ks + 8 * hh); C[d] = MFMA32(ka, vf[ks], C[d]); }
            __builtin_amdgcn_sched_barrier(0);
        }
        if (MODE) {
            const int dd = 16 * w + (lane & 15), sq = lane >> 4; float s = 0.f;
#pragma unroll
            for (int q = 0; q < 16; ++q) s += bf2f(Kw[(16 * sq + q) * QLD + dd]);
            s = sum_xor16_32(s);
            if (lane < 16) NV[dd] = alpha * NV[dd] + s;
        }
        __syncthreads();
    }
}

constexpr int VN_OFF = 0, SGST_OFF = 34816;
DI void sgu_unit(Frame& F, int unit, int j) {
    const int row0 = unit * 128; const int w = F.wave; int lane = F.lane, r = lane & 31, hh = lane >> 5;
    const bf16_t* PROJ = (const bf16_t*)(F.ws + WS_PROJ); bf16_t* MIX = (bf16_t*)(F.ws + WS_MIX);
    LAS bf16_t* Vn = (LAS bf16_t*)(F.lds + VN_OFF); LAS float* ST = (LAS float*)(F.lds + SGST_OFF);
    const float* lng = F.in[7] + j * 512; const float* lnb = F.in[8] + j * 512;
    for (int i = 0; i < 16; ++i) { const int p = 16 * w + i;
        const u32x4 v = *((const u32x4*)(PROJ + (size_t)(row0 + p) * NIN + 2560) + lane);
        const float x0 = bflo(v.x), x1 = bfhi(v.x), x2 = bflo(v.y), x3 = bfhi(v.y), x4 = bflo(v.z), x5 = bfhi(v.z), x6 = bflo(v.w), x7 = bfhi(v.w);
        float s = ((x0 + x1) + (x2 + x3)) + ((x4 + x5) + (x6 + x7)); s = wave_sum(s); const float mean = s * (1.0f / 512.0f);
        const float d0 = x0 - mean, d1 = x1 - mean, d2 = x2 - mean, d3 = x3 - mean, d4 = x4 - mean, d5 = x5 - mean, d6 = x6 - mean, d7 = x7 - mean;
        float q = ((d0 * d0 + d1 * d1) + (d2 * d2 + d3 * d3)) + ((d4 * d4 + d5 * d5) + (d6 * d6 + d7 * d7)); q = wave_sum(q);
        if (lane == 0) { ST[2 * p] = mean; ST[2 * p + 1] = 1.0f / sqrtf(q * (1.0f / 512.0f) + EPS); } }
    __syncthreads();
    const int dtl = w & 3, pt0 = 2 * (w >> 2);
    for (int gq = 0; gq < 4; ++gq) {
        lane = opaque(F.lane); r = lane & 31; hh = lane >> 5; const int tid_o = opaque(F.tid);
#pragma unroll
        for (int i = 0; i < 4; ++i) { const int pc = tid_o + 512 * i, q = pc >> 4, cp = (pc & 15) * 8; const int col = 128 * gq + cp;
            const u32x4 v = *(const u32x4*)(PROJ + (size_t)(row0 + q) * NIN + 2560 + col); const float mean = ST[2 * q], rs = ST[2 * q + 1];
            const f32x4 g0 = *(const f32x4*)(lng + col), g1 = *(const f32x4*)(lng + col + 4), b0 = *(const f32x4*)(lnb + col), b1 = *(const f32x4*)(lnb + col + 4);
            u32x4 o; o.x = pk2((bflo(v.x) - mean) * rs * g0.x + b0.x, (bfhi(v.x) - mean) * rs * g0.y + b0.y); o.y = pk2((bflo(v.y) - mean) * rs * g0.z + b0.z, (bfhi(v.y) - mean) * rs * g0.w + b0.w);
            o.z = pk2((bflo(v.z) - mean) * rs * g1.x + b1.x, (bfhi(v.z) - mean) * rs * g1.y + b1.y); o.w = pk2((bflo(v.w) - mean) * rs * g1.z + b1.z, (bfhi(v.w) - mean) * rs * g1.w + b1.w);
            *(LAS u32x4*)(Vn + q * QLD + cp) = o; }
        __syncthreads();
        const bf16_t* WM = (const bf16_t*)(F.ws + WS_WM) + (size_t)(j * 4 + gq) * 128 * 128;
        f32x16 acc[2];
#pragma unroll
        for (int i = 0; i < 16; ++i) { acc[0][i] = 0.f; acc[1][i] = 0.f; }
#pragma unroll
        for (int ks = 0; ks < 8; ++ks) { const bf16x8 vb = gather_col(Vn, QLD, 32 * dtl + r, 16 * ks + 8 * hh);
#pragma unroll
            for (int pt = 0; pt < 2; ++pt) { const bf16x8 wa = *(const bf16x8*)(WM + (size_t)(32 * (pt0 + pt) + r) * 128 + 16 * ks + 8 * hh); acc[pt] = MFMA32(wa, vb, acc[pt]); } }
        const float* bs = F.in[10] + (j * 4 + gq) * 128;
#pragma unroll
        for (int pt = 0; pt < 2; ++pt)
#pragma unroll
            for (int i = 0; i < 16; ++i) { const int p = 32 * (pt0 + pt) + crow(i, hh); const int col = 128 * gq + 32 * dtl + r;
                const float uu = bf2f(PROJ[(size_t)(row0 + p) * NIN + 2048 + col]);
                MIX[(size_t)(row0 + p) * DM + 512 + col] = (bf16_t)(pk2(uu * (acc[pt][i] + bs[p]), 0.f) & 0xffffu); if ((i & 3) == 3) asm volatile("" ::: "memory"); }
        __syncthreads();
    }
}

struct Args { const float* in[19]; float* out; unsigned char* ws; int ph_lo, ph_hi; };
__global__ void __launch_bounds__(512, 2) fwd(Args args) {
    extern __shared__ __attribute__((aligned(16))) unsigned char lds_raw[];
    Frame F;
    F.lds = (LAS unsigned char*)lds_raw;
    const int wave_s = __builtin_amdgcn_readfirstlane(threadIdx.x >> 6);
    F.tid = threadIdx.x; F.lane = F.tid & 63; F.wave = wave_s; F.G = gridDim.x;
    F.in = (const float* const __attribute__((address_space(4)))*)__builtin_amdgcn_kernarg_segment_ptr();
    F.H = args.out; F.ws = args.ws;
    volatile LAS unsigned* MISC = (volatile LAS unsigned*)(F.lds + LDSCTL_OFF);
    if (F.tid < 64) MISC[F.tid] = 0u;
    __syncthreads();
    if (ONE_LAUNCH) (void)xcd_barrier_post((unsigned*)(F.ws + WS_CTL), MISC + 8, F.tid);
    const int lo = ONE_LAUNCH ? 0 : args.ph_lo, hi = ONE_LAUNCH ? NPHASE : args.ph_hi;
#define IN(k) (lo <= (k) && (k) < hi)
#define REFRESH() do { F.lane = opaque((int)__builtin_amdgcn_mbcnt_hi(~0u, __builtin_amdgcn_mbcnt_lo(~0u, 0u))); F.wave = wave_s; F.tid = wave_s * 64 + F.lane; \
        { unsigned long long p_ = (unsigned long long)args.ws; asm volatile("" : "+s"(p_)); F.ws = (unsigned char*)p_; } } while (0)
#define SEAM(k) do { if (ONE_LAUNCH && IN((k) + 1)) { REFRESH(); XcdBarrier bb_; bb_.bar = (unsigned*)(F.ws + WS_CTL); bb_.x = xb_xcc_id(); bb_.st = (volatile LAS unsigned*)(F.lds + LDSCTL_OFF) + 8; xcd_barrier(bb_, F.tid); if (DUP_MASK & 4096) xcd_barrier(bb_, F.tid); } } while (0)
#define SS ((const float*)(F.ws + WS_SS))
#define HB ((bf16_t*)(F.ws + WS_HB))
#define MIX ((bf16_t*)(F.ws + WS_MIX))
#define PROJ ((bf16_t*)(F.ws + WS_PROJ))

    if ((PH_MASK & 1) && IN(0)) { REPS(1) { REFRESH(); p0_prologue(F); } SEAM(0); }
    for (int L = 0; L < DEPTH; ++L) {
        const int pb = 1 + 6 * L, j = L >> 1;
        if (IN(pb)) {
            REFRESH();
            pg8::Gemm g{HB, W_in(F, L), MROWS, NIN, DM}; pg8::StaticOrder S; S.init(MROWS, NIN, F.G, (int)blockIdx.x);
            if (L & 1) { if (PH_MASK & 2) REPS(2) { EpiInC E{PROJ, SS}; pg8::gemm_phase<EpiInC, pg8::StaticOrder, true, true>(F.lds, g, S, E, F.tid); } if (PH_MASK & 4) gate_step(F, L); }
            else if (PH_MASK & 8) REPS(8) { EpiInA E{PROJ, SS, (const float*)(F.ws + WS_COS), (const float*)(F.ws + WS_SIN)}; pg8::gemm_phase<EpiInA, pg8::StaticOrder, true, true>(F.lds, g, S, E, F.tid); }
            SEAM(pb);
        }
        if (IN(pb + 1)) {
            REFRESH();
            for (int u = blockIdx.x; u < 256; u += F.G) { if (L & 1) { if (PH_MASK & 16) REPS(16) la_pass1<1>(F, u); } else { if (PH_MASK & 32) REPS(32) la_pass1<0>(F, u); if (PH_MASK & 64) REPS(64) sgu_unit(F, u, j); } }
            SEAM(pb + 1);
        }
        if (IN(pb + 2)) {
            REFRESH();
            for (int u = blockIdx.x; u < 256; u += F.G) { if (L & 1) { if (PH_MASK & 128) REPS(128) la_pass2<1>(F, u, j); } else { if (PH_MASK & 256) REPS(256) la_pass2<0>(F, u, j); } }
            SEAM(pb + 2);
        }
        if (IN(pb + 3)) {
            REFRESH();
            pg8::Gemm g{MIX, W_out(F, L), MROWS, DM, DM}; pg8::StaticOrder S; S.init(MROWS, DM, F.G, (int)blockIdx.x);
            if (PH_MASK & 512) for (int rep_ = 0; rep_ < ((DUP_MASK & 512) ? 3 : 1); ++rep_) { EpiRes E{HB, (float*)(F.ws + WS_SS), (rep_ == 1) ? -1.f : 1.f}; pg8::gemm_phase<EpiRes, pg8::StaticOrder, true, true>(F.lds, g, S, E, F.tid); if (ONE_LAUNCH && rep_ + 1 < ((DUP_MASK & 512) ? 3 : 1)) { REFRESH(); XcdBarrier bb_; bb_.bar = (unsigned*)(F.ws + WS_CTL); bb_.x = xb_xcc_id(); bb_.st = (volatile LAS unsigned*)(F.lds + LDSCTL_OFF) + 8; xcd_barrier(bb_, F.tid); } }
            SEAM(pb + 3);
        }
        if (IN(pb + 4)) {
            REFRESH();
            pg8::Gemm g{HB, W_up(F, L), MROWS, NUP, DM}; pg8::StaticOrder S; S.init(MROWS, NUP, F.G, (int)blockIdx.x);
            if (PH_MASK & 1024) REPS(1024) { EpiSwiGLU E{PROJ, SS}; pg8::gemm_phase<EpiSwiGLU, pg8::StaticOrder, true, true>(F.lds, g, S, E, F.tid); }
            SEAM(pb + 4);
        }
        if (IN(pb + 5)) {
            REFRESH();
            pg8::Gemm g{PROJ, W_down(F, L), MROWS, DM, DFF}; pg8::StaticOrder S; S.init(MROWS, DM, F.G, (int)blockIdx.x);
            if (PH_MASK & 2048) for (int rep_ = 0; rep_ < ((DUP_MASK & 2048) ? 3 : 1); ++rep_) { EpiRes E{HB, (float*)(F.ws + WS_SS), (rep_ == 1) ? -1.f : 1.f}; pg8::gemm_phase<EpiRes, pg8::StaticOrder, true, true>(F.lds, g, S, E, F.tid); if (ONE_LAUNCH && rep_ + 1 < ((DUP_MASK & 2048) ? 3 : 1)) { REFRESH(); XcdBarrier bb_; bb_.bar = (unsigned*)(F.ws + WS_CTL); bb_.x = xb_xcc_id(); bb_.st = (volatile LAS unsigned*)(F.lds + LDSCTL_OFF) + 8; xcd_barrier(bb_, F.tid); } }
            SEAM(pb + 5);
        }
    }
    if ((PH_MASK & 4096) && IN(NPHASE - 1)) { REFRESH(); final_norm(F); }
#undef IN
#undef SEAM
#undef REFRESH
#undef SS
#undef HB
#undef MIX
#undef PROJ
}

extern "C" void kernel_launch(void* const* d_in, const int* in_sizes, int n_in, void* d_out, int out_size, void* d_ws, size_t ws_size, hipStream_t stream) {
    static int grid = 0;
    if (grid == 0) {
        if (n_in != 19 || out_size != MROWS * DM || ws_size < WS_END) { fprintf(stderr, "kernel_launch: unexpected problem shape (n_in %d, out %d, ws %zu)\n", n_in, out_size, ws_size); grid = -1; return; }
        int dev = 0, cus = 0, per_cu = 0;
        if (hipGetDevice(&dev) != hipSuccess || hipDeviceGetAttribute(&cus, hipDeviceAttributeMultiprocessorCount, dev) != hipSuccess) { grid = -1; return; }
        if (hipFuncSetAttribute((const void*)fwd, hipFuncAttributeMaxDynamicSharedMemorySize, LDS_BYTES) != hipSuccess) { fprintf(stderr, "kernel_launch: hipFuncSetAttribute failed\n"); grid = -1; return; }
        if (hipOccupancyMaxActiveBlocksPerMultiprocessor(&per_cu, (const void*)fwd, 512, LDS_BYTES) != hipSuccess || per_cu < 1) { fprintf(stderr, "kernel_launch: occupancy query says %d\n", per_cu); (void)hipGetLastError(); grid = -1; return; }
        grid = cus;
    }
    if (grid < 0) return;
    (void)hipMemsetAsync((char*)d_ws + WS_CTL, 0, CTL_ZERO_BYTES, stream);
    Args a{};
    for (int i = 0; i < 19; ++i) a.in[i] = (const float*)d_in[i];
    a.out = (float*)d_out; a.ws = (unsigned char*)d_ws;
    if (ONE_LAUNCH) { a.ph_lo = 0; a.ph_hi = NPHASE; hipLaunchKernelGGL(fwd, dim3(grid), dim3(512), LDS_BYTES, stream, a); }
    else for (int p = 0; p < NPHASE; ++p) { a.ph_lo = p; a.ph_hi = p + 1; hipLaunchKernelGGL(fwd, dim3(grid), dim3(512), LDS_BYTES, stream, a); }
}
```

```cpp
#include <hip/hip_runtime.h>
#include <cstdio>
#include <cstdint>

#ifndef PH_MASK
#define PH_MASK 8191
#endif
#ifndef DUP_MASK
#define DUP_MASK 0
#endif
#ifndef SDUP
#define SDUP 0
#endif
#define REPS(bit) for (int rep_ = 0; rep_ < ((DUP_MASK & (bit)) ? 2 : 1); ++rep_)
#ifndef ONE_LAUNCH
#define ONE_LAUNCH 1
#endif

namespace pg8 {
#define PG8_LAS __attribute__((address_space(3)))
typedef unsigned short bf16_t;
typedef short bf16x8 __attribute__((ext_vector_type(8)));
typedef float f32x4 __attribute__((ext_vector_type(4)));
typedef unsigned u32x4 __attribute__((ext_vector_type(4)));
constexpr int BM = 256, BK = 64, HALF = 128, HTB = HALF * BK * 2  , STAGE_BYTES = 8 * HTB, NXCD = 8, WGM = 8;

__host__ __device__ __forceinline__ int lds_byte(int r, int c) { const int st = (r >> 4) * 2 + (c >> 5), rr = r & 15, cc = c & 31, ob = rr * 64 + cc * 2; return st * 1024 + (ob ^ (((ob >> 9) & 1) << 5)); }
__host__ __device__ __forceinline__ void stage_rc(int b, int& R, int& C) { const int st = b / 1024, sb = b % 1024, swz = sb ^ (((sb >> 9) & 1) << 5); R = (st >> 1) * 16 + swz / 64; C = (st & 1) * 32 + (swz % 64) / 2; }
__host__ __device__ __forceinline__ int perm32(int rho) { const int n = rho >> 4, i = rho & 15; return 8 * (i >> 2) + 4 * n + (i & 3); }

struct Unit { int pm, pn; };
struct Gemm { const bf16_t* A; const bf16_t* Bt; int M, N, K; };

struct StaticOrder {
    int nM, nN, nwg, G, c;
    __host__ __device__ void init(int M, int N, int G_, int c_) { nM = M / BM; nN = N / BM; nwg = nM * nN; G = G_; c = c_; }
    __host__ __device__ bool next(int i, Unit& u) const {
        const long L = (long)i * G + c; if (L >= nwg) return false;
        int wgid = (int)L; { const int q = nwg / NXCD, r = nwg % NXCD, xcd = wgid % NXCD, off = wgid / NXCD; wgid = (xcd < r ? xcd * (q + 1) : r * (q + 1) + (xcd - r) * q) + off; }
        const int nig = WGM * nN, gid = wgid / nig, fm = gid * WGM, gsz = (nM - fm) < WGM ? (nM - fm) : WGM;
        u.pm = fm + ((wgid % nig) % gsz); u.pn = (wgid % nig) / gsz; return true;
    }
    __device__ __forceinline__ void a_ready(const Unit&) const {}
    __device__ __forceinline__ void done(const Unit&) const {}
};

template <class Epi, class Sched, bool ALIGN_EPI = false, bool SP2 = false>
__device__ __forceinline__ void gemm_phase(PG8_LAS unsigned char* lds, const Gemm g, const Sched& S, const Epi& E, int tid_) {
    asm volatile("" : "+v"(tid_));
    const int tid = tid_, wid = __builtin_amdgcn_readfirstlane(tid >> 6), lane = tid & 63, wr = wid >> 2, wc = wid & 3, fr = lane & 15, fq = lane >> 4;
    const int K = g.K, nt = K / BK;
    unsigned voffA[2], voffB[2];
#pragma unroll
    for (int i = 0; i < 2; ++i) { int R, C; stage_rc(tid * 16 + i * 8192, R, C); const int Rb = Epi::PERM ? ((R & ~31) + perm32(R & 31)) : R;
        voffA[i] = (unsigned)(R * K + C) * 2u; voffB[i] = (unsigned)(Rb * K + C) * 2u; }
    const size_t kstep = (size_t)(BK * 2);
    const size_t hstep = (size_t)HALF * K * 2;
    const size_t tstep = 2 * hstep;
    const unsigned ldsw = (unsigned)wid * 1024u;
    const int aoff = lds_byte(wr * 64 + fr, fq * 8), boff = lds_byte(wc * 32 + fr, fq * 8);
#define PG8_SA(b, h) (((b) * 2 + (h)) * HTB)
#define PG8_SB(b, h) ((4 + (b) * 2 + (h)) * HTB)
#define PG8_STAGE(bufoff, gbase, voff) do { _Pragma("unroll") for (int _i = 0; _i < 2; ++_i) \
        __builtin_amdgcn_global_load_lds((const unsigned*)((const char*)(gbase) + (voff)[_i]), (PG8_LAS unsigned*)(lds + (bufoff) + ldsw + _i * 8192), 16, 0, 0); } while (0)
#define PG8_LDA(dst, b, h) do { _Pragma("unroll") for (int m = 0; m < 4; ++m) _Pragma("unroll") for (int k = 0; k < 2; ++k) dst[m][k] = *(const PG8_LAS bf16x8*)(lds + PG8_SA(b, h) + aoff + m * 2048 + k * 1024); } while (0)
#define PG8_LDB(dst, b, h) do { _Pragma("unroll") for (int n = 0; n < 2; ++n) _Pragma("unroll") for (int k = 0; k < 2; ++k) dst[n][k] = *(const PG8_LAS bf16x8*)(lds + PG8_SB(b, h) + boff + n * 2048 + k * 1024); } while (0)
#define PG8_MMA(ai, bj, At, Bt) do { __builtin_amdgcn_s_setprio(1); _Pragma("unroll") for (int m = 0; m < 4; ++m) _Pragma("unroll") for (int n = 0; n < 2; ++n) _Pragma("unroll") for (int k = 0; k < 2; ++k) \
        acc[ai][bj][m][n] = __builtin_amdgcn_mfma_f32_16x16x32_bf16(Bt[n][k], At[m][k], acc[ai][bj][m][n], 0, 0, 0); __builtin_amdgcn_s_setprio(0); } while (0)
#define PG8_WAIT_V(n) asm volatile("s_waitcnt vmcnt(" #n ")" ::: "memory")
#define PG8_WAIT_L(n) asm volatile("s_waitcnt lgkmcnt(" #n ")" ::: "memory")
#define PG8_BAR __builtin_amdgcn_s_barrier()
#define PG8_SCHED __builtin_amdgcn_sched_barrier(0)
    Unit cur, nxt; int ui = 0;
    if (!S.next(0, cur)) return;
    f32x4 acc[2][2][4][2];
#pragma unroll
    for (int a = 0; a < 2; ++a)
#pragma unroll
        for (int b = 0; b < 2; ++b)
#pragma unroll
            for (int m = 0; m < 4; ++m)
#pragma unroll
                for (int n = 0; n < 2; ++n) acc[a][b][m][n] = (f32x4){0.f, 0.f, 0.f, 0.f};
    bf16x8 At[4][2], B0[2][2], B1[2][2];
    const char* cA = (const char*)g.A + (size_t)cur.pm * tstep; const char* cB = (const char*)g.Bt + (size_t)cur.pn * tstep;
    S.a_ready(cur);
    if constexpr (SP2) {
        PG8_STAGE(PG8_SB(0, 0), cB, voffB); PG8_STAGE(PG8_SB(0, 1), cB + hstep, voffB); PG8_STAGE(PG8_SA(0, 0), cA, voffA); PG8_STAGE(PG8_SA(0, 1), cA + hstep, voffA);
        if (wr == 1) PG8_BAR;
        PG8_WAIT_V(2); PG8_BAR;
        PG8_STAGE(PG8_SB(1, 0), cB + kstep, voffB); PG8_STAGE(PG8_SA(1, 0), cA + kstep, voffA); PG8_STAGE(PG8_SB(1, 1), cB + hstep + kstep, voffB);
        PG8_WAIT_V(6); PG8_BAR;
    } else {
        PG8_STAGE(PG8_SB(0, 0), cB, voffB); PG8_STAGE(PG8_SA(0, 0), cA, voffA); PG8_STAGE(PG8_SB(0, 1), cB + hstep, voffB); PG8_STAGE(PG8_SA(0, 1), cA + hstep, voffA);
        if (wr == 1) PG8_BAR;
        PG8_WAIT_V(4); PG8_BAR;
        PG8_STAGE(PG8_SB(1, 0), cB + kstep, voffB); PG8_STAGE(PG8_SA(1, 0), cA + kstep, voffA); PG8_STAGE(PG8_SB(1, 1), cB + hstep + kstep, voffB);
        PG8_WAIT_V(6); PG8_BAR;
    }
    for (;;) {
        const bool has_next = S.next(ui + 1, nxt);
        const char* nA = has_next ? (const char*)g.A + (size_t)nxt.pm * tstep : cA; const char* nB = has_next ? (const char*)g.Bt + (size_t)nxt.pn * tstep : cB;
        for (int t = 0; t < nt; t += 2) {
            const bool last = (t == nt - 2);
            const char* a1 = cA + (size_t)(t + 1) * kstep;
            const char* a2 = last ? nA : cA + (size_t)(t + 2) * kstep; const char* b2 = last ? nB : cB + (size_t)(t + 2) * kstep;
            const char* a3 = a2 + kstep; const char* b3 = b2 + kstep;
            if (last && has_next) S.a_ready(nxt);
            if constexpr (SP2) {
            PG8_LDB(B0, 0, 0); PG8_LDB(B1, 0, 1); PG8_SCHED; PG8_LDA(At, 0, 0); PG8_STAGE(PG8_SA(1, 1), a1 + hstep, voffA);
            PG8_WAIT_V(8); PG8_WAIT_L(0); PG8_BAR; PG8_MMA(0, 0, At, B0); PG8_MMA(0, 1, At, B1); PG8_BAR; PG8_SCHED;
            PG8_LDA(At, 0, 1); PG8_STAGE(PG8_SB(0, 0), b2, voffB); PG8_STAGE(PG8_SB(0, 1), b2 + hstep, voffB); PG8_STAGE(PG8_SA(0, 0), a2, voffA);
            PG8_WAIT_V(8); PG8_WAIT_L(0); PG8_BAR; PG8_MMA(1, 0, At, B0); PG8_MMA(1, 1, At, B1); PG8_BAR; PG8_SCHED;
            PG8_LDB(B0, 1, 0); PG8_LDB(B1, 1, 1); PG8_SCHED; PG8_LDA(At, 1, 0); PG8_STAGE(PG8_SA(0, 1), a2 + hstep, voffA);
            PG8_WAIT_V(8); PG8_WAIT_L(0); PG8_BAR; PG8_MMA(0, 0, At, B0); PG8_MMA(0, 1, At, B1); PG8_BAR; PG8_SCHED;
            PG8_LDA(At, 1, 1); PG8_STAGE(PG8_SB(1, 0), b3, voffB); PG8_STAGE(PG8_SB(1, 1), b3 + hstep, voffB); PG8_STAGE(PG8_SA(1, 0), a3, voffA);
            PG8_WAIT_V(8); PG8_WAIT_L(0); PG8_BAR; PG8_MMA(1, 0, At, B0); PG8_MMA(1, 1, At, B1); PG8_BAR; PG8_SCHED;
            } else {
            PG8_LDB(B0, 0, 0); PG8_SCHED; PG8_LDA(At, 0, 0); PG8_STAGE(PG8_SA(1, 1), a1 + hstep, voffA);
            PG8_WAIT_L(8); PG8_BAR; PG8_WAIT_L(0); PG8_MMA(0, 0, At, B0); PG8_BAR; PG8_SCHED;
            PG8_LDB(B1, 0, 1); PG8_STAGE(PG8_SB(0, 0), b2, voffB);
            PG8_BAR; PG8_WAIT_L(0); PG8_MMA(0, 1, At, B1); PG8_BAR;
            PG8_LDA(At, 0, 1); PG8_STAGE(PG8_SA(0, 0), a2, voffA);
            PG8_BAR; PG8_WAIT_L(0); PG8_MMA(1, 0, At, B0); PG8_BAR; PG8_SCHED;
            PG8_STAGE(PG8_SB(0, 1), b2 + hstep, voffB);
            PG8_WAIT_V(6); PG8_BAR; PG8_MMA(1, 1, At, B1); PG8_BAR;
            PG8_LDB(B0, 1, 0); PG8_SCHED; PG8_LDA(At, 1, 0); PG8_STAGE(PG8_SA(0, 1), a2 + hstep, voffA);
            PG8_WAIT_L(8); PG8_BAR; PG8_WAIT_L(0); PG8_MMA(0, 0, At, B0); PG8_BAR; PG8_SCHED;
            PG8_LDB(B1, 1, 1); PG8_STAGE(PG8_SB(1, 0), b3, voffB);
            PG8_BAR; PG8_WAIT_L(0); PG8_MMA(0, 1, At, B1); PG8_BAR;
            PG8_LDA(At, 1, 1); PG8_STAGE(PG8_SA(1, 0), a3, voffA);
            PG8_BAR; PG8_WAIT_L(0); PG8_MMA(1, 0, At, B0); PG8_BAR; PG8_SCHED;
            PG8_STAGE(PG8_SB(1, 1), b3 + hstep, voffB);
            PG8_WAIT_V(6); PG8_BAR; PG8_MMA(1, 1, At, B1); PG8_BAR;
            }
        }
        if constexpr (ALIGN_EPI) { if (wr == 0) PG8_BAR; }
        E(acc, cur, wr, wc, fr, fq); S.done(cur);
        if (!has_next) break;
#pragma unroll
        for (int a = 0; a < 2; ++a)
#pragma unroll
            for (int b = 0; b < 2; ++b)
#pragma unroll
                for (int m = 0; m < 4; ++m)
#pragma unroll
                    for (int n = 0; n < 2; ++n) acc[a][b][m][n] = (f32x4){0.f, 0.f, 0.f, 0.f};
        cur = nxt; cA = nA; cB = nB; ++ui;
        if constexpr (ALIGN_EPI) { if (wr == 1) PG8_BAR; }
    }
    PG8_WAIT_V(0);
    if constexpr (!ALIGN_EPI) { if (wr == 0) PG8_BAR; }
    PG8_BAR;
#undef PG8_SA
#undef PG8_SB
#undef PG8_STAGE
#undef PG8_LDA
#undef PG8_LDB
#undef PG8_MMA
#undef PG8_WAIT_V
#undef PG8_WAIT_L
#undef PG8_BAR
#undef PG8_SCHED
}
}

constexpr int BATCH = 8, SEQ = 4096, DM = 1024, MROWS = BATCH * SEQ, DEPTH = 4;
constexpr int NIN = 3072, CIN = 3080, DFF = 2816, NUP = 2 * DFF;
constexpr float EPS = 1e-6f;
constexpr int NPHASE = 2 + 6 * DEPTH;

constexpr size_t MiB = 1u << 20;
constexpr size_t WS_CTL = 0, CTL_ZERO_BYTES = 64 * 1024;
constexpr size_t WS_COS = 1 * MiB, WS_SIN = 2 * MiB;
constexpr size_t WS_SS = 3 * MiB;
constexpr size_t WS_GLI = 5 * MiB, WS_GLF = 5 * MiB + 512 * 1024;
constexpr size_t WS_WG = 6 * MiB;
constexpr size_t WS_WM = 6 * MiB + 256 * 1024;
constexpr size_t WS_NST = 7 * MiB;
constexpr size_t WS_W = 8 * MiB;
constexpr size_t W_IN_OFF = 0, W_OUT_OFF = (size_t)NIN * DM * 2, W_UP_OFF = W_OUT_OFF + (size_t)DM * DM * 2, W_DOWN_OFF = W_UP_OFF + (size_t)NUP * DM * 2, W_LAYER = W_DOWN_OFF + (size_t)DM * DFF * 2;
constexpr size_t WS_HB = 106 * MiB;
constexpr size_t WS_MIX = 170 * MiB;
constexpr size_t WS_PROJ = 234 * MiB;
constexpr size_t WS_TST = 426 * MiB;
constexpr size_t WS_END = 460 * MiB;
static_assert(WS_W + 4 * W_LAYER <= WS_HB && WS_TST + (size_t)256 * 256 * 128 * 4 <= WS_END, "ws map");

constexpr int RING_BYTES = 131072;
constexpr int LDSCTL_OFF = RING_BYTES;
constexpr int LDS_BYTES = 147456;

#define GAS __attribute__((address_space(1)))
#define LAS __attribute__((address_space(3)))
#define DI __device__ __forceinline__
typedef unsigned short bf16_t;
typedef short bf16x8 __attribute__((ext_vector_type(8)));
typedef short bf16x4 __attribute__((ext_vector_type(4)));
typedef float f32x4 __attribute__((ext_vector_type(4)));
typedef float f32x16 __attribute__((ext_vector_type(16)));
typedef unsigned u32x4 __attribute__((ext_vector_type(4)));
typedef unsigned u32x2 __attribute__((ext_vector_type(2)));

DI unsigned pk2(float lo, float hi) { typedef __bf16 b2 __attribute__((ext_vector_type(2))); b2 v; v.x = (__bf16)lo; v.y = (__bf16)hi; return __builtin_bit_cast(unsigned, v); }
DI float bf2f(unsigned short x) { return __uint_as_float(((unsigned)x) << 16); }
DI float bflo(unsigned w) { return __uint_as_float(w << 16); }
DI float bfhi(unsigned w) { return __uint_as_float(w & 0xffff0000u); }
DI float fexp(float x) { return __builtin_amdgcn_exp2f(x * 1.4426950408889634f); }
DI float frcp(float x) { return __builtin_amdgcn_rcpf(x); }
DI float sigmoid_f(float x) { return frcp(1.f + fexp(-x)); }
DI float silu_f(float x) { return x * sigmoid_f(x); }
DI float gelu_tanh_f(float x) { return x * sigmoid_f(1.5957691216057308f * (x + 0.044715f * x * x * x)); }
template <int CTRL> DI float dpp_f(float v) { return __int_as_float(__builtin_amdgcn_mov_dpp(__float_as_int(v), CTRL, 0xF, 0xF, true)); }
DI float xor16_f(float v) { return __int_as_float(__builtin_amdgcn_ds_swizzle(__float_as_int(v), 0x401F)); }
DI float sum_xor32(float v) { const auto r = __builtin_amdgcn_permlane32_swap(__float_as_uint(v), __float_as_uint(v), false, false); return __uint_as_float(r[0]) + __uint_as_float(r[1]); }
DI float sum_xor16_32(float v) { v += xor16_f(v); return sum_xor32(v); }
DI float wave_sum(float v) {
    v += dpp_f<0xB1>(v); v += dpp_f<0x4E>(v); v += dpp_f<0x141>(v); v += dpp_f<0x140>(v);
    return sum_xor16_32(v);
}
template <int CTRL, int ROWMASK, bool IS_MAX> DI float scan_step(float v, const float ident) {
    const float t = __int_as_float(__builtin_amdgcn_update_dpp(__float_as_int(ident), __float_as_int(v), CTRL, ROWMASK, 0xF, false));
    return IS_MAX ? fmaxf(v, t) : v + t;
}
template <bool IS_MAX> DI float wave_scan(float v) {
    const float id = IS_MAX ? -3.0e38f : 0.f;
    v = scan_step<0x111, 0xF, IS_MAX>(v, id); v = scan_step<0x112, 0xF, IS_MAX>(v, id); v = scan_step<0x114, 0xF, IS_MAX>(v, id); v = scan_step<0x118, 0xF, IS_MAX>(v, id);
    v = scan_step<0x142, 0xA, IS_MAX>(v, id);
    v = scan_step<0x143, 0xC, IS_MAX>(v, id);
    return v;
}
DI float lane63(float v) { return __int_as_float(__builtin_amdgcn_readlane(__float_as_int(v), 63)); }

#define XB_TMO      128
#define XB_XCNT(j)  (256  + 64 * (j))
#define XB_XSUB(j)  (1280 + 64 * (j))
#define XB_XGEN(j)  (2304 + 64 * (j))
#define XB_TOP      3328
#define XB_TOPGEN   3392
#define XCD_BAR_WORDS 3456
#define XB_SPIN_CAP (1u << 18)

__device__ __forceinline__ unsigned xb_ld(unsigned* p)              { return __hip_atomic_load(p, __ATOMIC_RELAXED, __HIP_MEMORY_SCOPE_AGENT); }
__device__ __forceinline__ unsigned xb_add(unsigned* p, unsigned v) { return __hip_atomic_fetch_add(p, v, __ATOMIC_RELAXED, __HIP_MEMORY_SCOPE_AGENT); }
__device__ __forceinline__ unsigned xb_xcc_id() { return (unsigned)__builtin_amdgcn_s_getreg((3 << 11) | 20) & 0xFu; }
#define XB_SPIN(cond, bar) do { unsigned _sp = 0; while (cond) { __builtin_amdgcn_s_sleep(1); \
    if ((++_sp & 255u) == 0u) { if (xb_ld(&(bar)[XB_TMO])) break; if (_sp > XB_SPIN_CAP) { atomicAdd(&(bar)[XB_TMO], 1u); break; } } } } while (0)

struct XcdBarrier { unsigned* bar; unsigned x; volatile LAS unsigned* st; };

__device__ __forceinline__ XcdBarrier xcd_barrier_post(unsigned* bar, volatile LAS unsigned* st, int tid) {
    XcdBarrier b; b.bar = bar; b.x = xb_xcc_id(); b.st = st;
    if (tid == 0) (void)xb_add(&bar[XB_XCNT(b.x)], 1u);
    return b;
}
__device__ __forceinline__ void xcd_barrier_complete(unsigned* bar, unsigned x, unsigned& nloc, unsigned& nx) {
    const unsigned G = gridDim.x * gridDim.y * gridDim.z;
    unsigned sum, cnt, mine, sp = 0u;
    for (;;) {
        sum = 0u; cnt = 0u; mine = 0u;
#pragma unroll
        for (unsigned j = 0; j < 16; ++j) { const unsigned c = xb_ld(&bar[XB_XCNT(j)]); sum += c; cnt += (c > 0u) ? 1u : 0u; mine = (j == x) ? c : mine; }
        if (sum == G) break;
        __builtin_amdgcn_s_sleep(1);
        if ((++sp & 255u) == 0u) { if (xb_ld(&bar[XB_TMO])) break; if (sp > XB_SPIN_CAP) { atomicAdd(&bar[XB_TMO], 1u); break; } }
    }
    nloc = mine > 0u ? mine : 1u; nx = cnt > 0u ? cnt : 1u;
}
__device__ __forceinline__ void xcd_barrier(const XcdBarrier& b, int tid) {
    asm volatile("s_waitcnt vmcnt(0)" ::: "memory");
    __syncthreads();
    if (tid == 0) {
        unsigned* bar = b.bar;
        __builtin_amdgcn_s_waitcnt(0);
        unsigned nloc = b.st[0], nx = b.st[1];
        if (nloc == 0u) { xcd_barrier_complete(bar, b.x, nloc, nx); b.st[0] = nloc; b.st[1] = nx; }
        const unsigned old = xb_add(&bar[XB_XSUB(b.x)], 1u);
        const unsigned gen = old / nloc;
        if (old + 1u == (gen + 1u) * nloc) {
            __builtin_amdgcn_fence(__ATOMIC_RELEASE, "agent");
            asm volatile("s_waitcnt vmcnt(0)" ::: "memory");
            const unsigned og = xb_add(&bar[XB_TOP], 1u);
            const unsigned tg = og / nx;
            if (og + 1u == (tg + 1u) * nx) xb_add(&bar[XB_TOPGEN], 1u);
            else XB_SPIN(xb_ld(&bar[XB_TOPGEN]) == tg, bar);
            __builtin_amdgcn_fence(__ATOMIC_ACQUIRE, "agent");
            xb_add(&bar[XB_XGEN(b.x)], 1u);
            asm volatile("s_waitcnt vmcnt(0)" ::: "memory");
        } else {
            XB_SPIN(xb_ld(&bar[XB_XGEN(b.x)]) == gen, bar);
            __builtin_amdgcn_fence(__ATOMIC_ACQUIRE, "agent");
            asm volatile("s_waitcnt vmcnt(0)" ::: "memory");
        }
    }
    __syncthreads();
}

struct Frame {
    LAS unsigned char* lds;
    int tid, lane, wave, G;
    const float* const __attribute__((address_space(4)))* in;
    float* H;
    unsigned char* ws;
};
DI bf16_t* W_in(const Frame& F, int L)   { return (bf16_t*)(F.ws + WS_W + (size_t)L * W_LAYER + W_IN_OFF); }
DI bf16_t* W_out(const Frame& F, int L)  { return (bf16_t*)(F.ws + WS_W + (size_t)L * W_LAYER + W_OUT_OFF); }
DI bf16_t* W_up(const Frame& F, int L)   { return (bf16_t*)(F.ws + WS_W + (size_t)L * W_LAYER + W_UP_OFF); }
DI bf16_t* W_down(const Frame& F, int L) { return (bf16_t*)(F.ws + WS_W + (size_t)L * W_LAYER + W_DOWN_OFF); }

DI void row_rstd8(const float* __restrict__ SS, int row0, int fq, float (&rs)[2][4]) {
    f32x4 sp[2][4];
#pragma unroll
    for (int ai = 0; ai < 2; ++ai)
#pragma unroll
        for (int m = 0; m < 4; ++m) sp[ai][m] = *(const f32x4*)(SS + (size_t)(row0 + ai * 128 + m * 16) * 16 + 4 * fq);
#pragma unroll
    for (int ai = 0; ai < 2; ++ai)
#pragma unroll
        for (int m = 0; m < 4; ++m) { float s = (sp[ai][m].x + sp[ai][m].y) + (sp[ai][m].z + sp[ai][m].w); s = sum_xor16_32(s); rs[ai][m] = 1.0f / sqrtf(s * (1.0f / DM) + EPS); }
}
DI void store8(bf16_t* p, const f32x4& v0, const f32x4& v1) { u32x4 w; w.x = pk2(v0[0], v0[1]); w.y = pk2(v0[2], v0[3]); w.z = pk2(v1[0], v1[1]); w.w = pk2(v1[2], v1[3]); *(u32x4*)p = w; }

struct EpiInA {
    static constexpr bool PERM = true;
    bf16_t* P; const float* SS; const float* COS; const float* SIN;
    DI void operator()(const f32x4 (&acc)[2][2][4][2], const pg8::Unit& u, int wr, int wc, int fr, int fq) const {
        const int row0 = u.pm * 256 + wr * 64 + fr, colw = wc * 32 + 8 * fq, typ = u.pn >> 1;
        float rsv[2][4]; row_rstd8(SS, row0, fq, rsv);
#pragma unroll
        for (int ai = 0; ai < 2; ++ai) {
            f32x4 cc[4], sn[4];
            if (typ < 2) {
#pragma unroll
                for (int m = 0; m < 4; ++m) { const int pos = (row0 + ai * 128 + m * 16) & (SEQ - 1); cc[m] = *(const f32x4*)(COS + pos * 64 + (colw >> 1)); sn[m] = *(const f32x4*)(SIN + pos * 64 + (colw >> 1)); } }
#pragma unroll
            for (int m = 0; m < 4; ++m) {
                const int row = row0 + ai * 128 + m * 16;
                const float rs = rsv[ai][m];
                bf16_t* rowp = P + (size_t)row * NIN + u.pn * 256 + colw;
                if (typ < 2) {
                    const f32x4 c4 = cc[m], s4 = sn[m];
#pragma unroll
                    for (int bj = 0; bj < 2; ++bj) { const f32x4 a0 = acc[ai][bj][m][0] * rs, a1 = acc[ai][bj][m][1] * rs; f32x4 v0, v1;
                        v0[0] = a0[0] * c4[0] - a0[1] * s4[0]; v0[1] = a0[0] * s4[0] + a0[1] * c4[0];
                        v0[2] = a0[2] * c4[1] - a0[3] * s4[1]; v0[3] = a0[2] * s4[1] + a0[3] * c4[1];
                        v1[0] = a1[0] * c4[2] - a1[1] * s4[2]; v1[1] = a1[0] * s4[2] + a1[1] * c4[2];
                        v1[2] = a1[2] * c4[3] - a1[3] * s4[3]; v1[3] = a1[2] * s4[3] + a1[3] * c4[3];
                        store8(rowp + bj * 128, v0, v1); }
                } else {
#pragma unroll
                    for (int bj = 0; bj < 2; ++bj) { f32x4 v0 = acc[ai][bj][m][0] * rs, v1 = acc[ai][bj][m][1] * rs;
                        if (typ == 3) {
#pragma unroll
                            for (int j = 0; j < 4; ++j) { v0[j] = silu_f(v0[j]); v1[j] = silu_f(v1[j]); } }
                        else if (typ >= 4) {
#pragma unroll
                            for (int j = 0; j < 4; ++j) { v0[j] = gelu_tanh_f(v0[j]); v1[j] = gelu_tanh_f(v1[j]); } }
                        store8(rowp + bj * 128, v0, v1); }
                }
            }
        }
    }
};
struct EpiInC {
    static constexpr bool PERM = true;
    bf16_t* P; const float* SS;
    DI void operator()(const f32x4 (&acc)[2][2][4][2], const pg8::Unit& u, int wr, int wc, int fr, int fq) const {
        const int row0 = u.pm * 256 + wr * 64 + fr, colw = wc * 32 + 8 * fq; const bool sg = u.pn >= 8;
        float rsv[2][4]; row_rstd8(SS, row0, fq, rsv);
#pragma unroll
        for (int ai = 0; ai < 2; ++ai)
#pragma unroll
            for (int m = 0; m < 4; ++m) {
                const int row = row0 + ai * 128 + m * 16;
                const float rs = rsv[ai][m];
                bf16_t* rowp = P + (size_t)row * NIN + u.pn * 256 + colw;
#pragma unroll
                for (int bj = 0; bj < 2; ++bj) { f32x4 v0 = acc[ai][bj][m][0] * rs, v1 = acc[ai][bj][m][1] * rs;
                    if (sg) {
#pragma unroll
                        for (int j = 0; j < 4; ++j) { v0[j] = sigmoid_f(v0[j]); v1[j] = sigmoid_f(v1[j]); } }
                    store8(rowp + bj * 128, v0, v1); }
            }
    }
};
struct EpiRes {
    static constexpr bool PERM = true;
    bf16_t* HB; float* SS; float sgn;
    DI void operator()(const f32x4 (&acc)[2][2][4][2], const pg8::Unit& u, int wr, int wc, int fr, int fq) const {
        const int row0 = u.pm * 256 + wr * 64 + fr, col0 = u.pn * 256 + wc * 32 + 8 * fq;
#pragma unroll
        for (int ai = 0; ai < 2; ++ai) {
            u32x4 hv[4][2];
#pragma unroll
            for (int m = 0; m < 4; ++m) { const bf16_t* bp = HB + (size_t)(row0 + ai * 128 + m * 16) * DM + col0;
#pragma unroll
                for (int bj = 0; bj < 2; ++bj) hv[m][bj] = *(const u32x4*)(bp + bj * 128); }
#pragma unroll
            for (int m = 0; m < 4; ++m) {
                const int row = row0 + ai * 128 + m * 16;
                bf16_t* bp = HB + (size_t)row * DM + col0; float ssum = 0.f;
#pragma unroll
                for (int bj = 0; bj < 2; ++bj) {
                    const u32x4 w = hv[m][bj];
                    const f32x4 b0 = {bflo(w.x), bfhi(w.x), bflo(w.y), bfhi(w.y)}, b1 = {bflo(w.z), bfhi(w.z), bflo(w.w), bfhi(w.w)};
                    const f32x4 h0 = b0 + acc[ai][bj][m][0] * sgn, h1 = b1 + acc[ai][bj][m][1] * sgn;
                    store8(bp + bj * 128, h0, h1);
                    ssum += (h0[0] * h0[0] + h0[1] * h0[1]) + (h0[2] * h0[2] + h0[3] * h0[3]) + (h1[0] * h1[0] + h1[1] * h1[1]) + (h1[2] * h1[2] + h1[3] * h1[3]);
                }
                ssum = sum_xor16_32(ssum);
                if (fq == 0) SS[(size_t)row * 16 + u.pn * 4 + wc] = ssum;
            }
        }
    }
};
struct EpiSwiGLU {
    static constexpr bool PERM = true;
    bf16_t* ACT; const float* SS;
    DI void operator()(const f32x4 (&acc)[2][2][4][2], const pg8::Unit& u, int wr, int wc, int fr, int fq) const {
        const int row0 = u.pm * 256 + wr * 64 + fr, col0 = u.pn * 128 + wc * 32 + 8 * fq;
        float rsv[2][4]; row_rstd8(SS, row0, fq, rsv);
#pragma unroll
        for (int ai = 0; ai < 2; ++ai)
#pragma unroll
            for (int m = 0; m < 4; ++m) {
                const int row = row0 + ai * 128 + m * 16;
                const float rs = rsv[ai][m];
                const f32x4 g0 = acc[ai][0][m][0] * rs, g1 = acc[ai][0][m][1] * rs, u0 = acc[ai][1][m][0] * rs, u1 = acc[ai][1][m][1] * rs; f32x4 v0, v1;
#pragma unroll
                for (int j = 0; j < 4; ++j) { v0[j] = silu_f(g0[j]) * u0[j]; v1[j] = silu_f(g1[j]) * u1[j]; }
                store8(ACT + (size_t)row * DFF + col0, v0, v1);
            }
    }
};

template <class Map>
DI void cvt_item(const float* src, int ld, const float* gain, bf16_t* WT, int K, int n0, int k0, const Map& mp, LAS float* scr, int lane) {
    const int nn = lane & 31; const int sc = mp.col(n0 + nn); const float scale = mp.scale(n0 + nn);
    float wv[32], gv[32];
    const float* sp = src + (size_t)(k0 + (lane >> 5)) * ld + sc;
#pragma unroll
    for (int i = 0; i < 32; ++i) { wv[i] = sp[(size_t)(2 * i) * ld]; gv[i] = gain ? gain[k0 + 2 * i + (lane >> 5)] : 1.0f; }
#pragma unroll
    for (int i = 0; i < 32; ++i) { const int kk = 2 * i + (lane >> 5); scr[kk * 33 + nn] = wv[i] * (gv[i] * scale); }
    asm volatile("s_waitcnt lgkmcnt(0)" ::: "memory");
    const int c = lane & 7;
#pragma unroll
    for (int j = 0; j < 4; ++j) { const int n = (lane >> 3) + 8 * j; const LAS float* s = scr + (8 * c) * 33 + n;
        u32x4 o; o.x = pk2(s[0 * 33], s[1 * 33]); o.y = pk2(s[2 * 33], s[3 * 33]); o.z = pk2(s[4 * 33], s[5 * 33]); o.w = pk2(s[6 * 33], s[7 * 33]);
        *(u32x4*)(WT + (size_t)(n0 + n) * K + k0 + 8 * c) = o; }
    asm volatile("s_waitcnt lgkmcnt(0)" ::: "memory");
}
struct MapId { DI int col(int n) const { return n; } DI float scale(int) const { return 1.0f; } };
struct MapInA { DI int col(int n) const { if (n >= 1024) return n; const int p = n & 127; return (n & ~127) + (p >> 1) + 64 * (p & 1); } DI float scale(int n) const { return (n >= 512 && n < 1024) ? 0.08838834764831845f : 1.0f; } };
struct MapInC { DI int col(int n) const { return n; } DI float scale(int n) const { return (n >= 512 && n < 1024) ? 0.08838834764831845f : 1.0f; } };
struct MapUp  { DI int col(int n) const { return 128 * (n >> 8) + (n & 127); } DI float scale(int) const { return 1.0f; } };

DI void p0_prologue(Frame& F) {
    LAS float* scr = (LAS float*)(F.lds + F.wave * 16384);
    const int gw = blockIdx.x * 8 + F.wave, NGW = F.G * 8;
    constexpr int I_IN = 16 * 96, I_OUT = 16 * 32, I_UP = 16 * 176, I_DOWN = 44 * 32, I_LAYER = I_IN + I_OUT + I_UP + I_DOWN;
    for (int it = gw; it < DEPTH * I_LAYER; it += NGW) {
        const int L = it / I_LAYER; int r = it % I_LAYER; const int j = L >> 1;
        if (r < I_IN) { const int kb = r / 96, nb = r % 96;
            if (L & 1) cvt_item(F.in[11] + (size_t)j * DM * CIN, CIN, F.in[1] + L * DM, W_in(F, L), DM, 32 * nb, 64 * kb, MapInC(), scr, F.lane);
            else       cvt_item(F.in[4] + (size_t)j * DM * NIN, NIN, F.in[1] + L * DM, W_in(F, L), DM, 32 * nb, 64 * kb, MapInA(), scr, F.lane);
            continue; }
        r -= I_IN;
        if (r < I_OUT) { const int kb = r / 32, nb = r % 32;
            cvt_item(((L & 1) ? F.in[12] : F.in[5]) + (size_t)j * DM * DM, DM, nullptr, W_out(F, L), DM, 32 * nb, 64 * kb, MapId(), scr, F.lane); continue; }
        r -= I_OUT;
        if (r < I_UP) { const int kb = r / 176, nb = r % 176; const int n0 = 32 * nb; const bool up = (n0 >> 7) & 1;
            cvt_item((up ? F.in[17] : F.in[16]) + (size_t)L * DM * DFF, DFF, F.in[2] + L * DM, W_up(F, L), DM, n0, 64 * kb, MapUp(), scr, F.lane); continue; }
        r -= I_UP;
        { const int kb = r / 32, nb = r % 32;
          cvt_item(F.in[18] + (size_t)L * DFF * DM, DM, nullptr, W_down(F, L), DFF, 32 * nb, 64 * kb, MapId(), scr, F.lane); }
    }
    float* SS = (float*)(F.ws + WS_SS); bf16_t* HB = (bf16_t*)(F.ws + WS_HB);
    for (int m2 = gw; m2 < MROWS / 2; m2 += NGW) {
        f32x4 v[2][4];
#pragma unroll
        for (int rr = 0; rr < 2; ++rr) { const f32x4* xr = (const f32x4*)(F.in[0] + (size_t)(2 * m2 + rr) * DM) + F.lane;
#pragma unroll
            for (int q = 0; q < 4; ++q) v[rr][q] = xr[64 * q]; }
#pragma unroll
        for (int rr = 0; rr < 2; ++rr) { const int m = 2 * m2 + rr; u32x2* br = (u32x2*)(HB + (size_t)m * DM) + F.lane; float s = 0.f;
#pragma unroll
            for (int q = 0; q < 4; ++q) { const f32x4 x = v[rr][q]; s += (x.x * x.x + x.y * x.y) + (x.z * x.z + x.w * x.w); u32x2 o; o.x = pk2(x.x, x.y); o.y = pk2(x.z, x.w); br[64 * q] = o; }
            s = wave_sum(s);
            if (F.lane < 16) SS[(size_t)m * 16 + F.lane] = (F.lane == 0) ? s : 0.f; }
    }
    const int gt = blockIdx.x * 512 + F.tid, NGT = F.G * 512;
    float* COS = (float*)(F.ws + WS_COS); float* SIN = (float*)(F.ws + WS_SIN);
    for (int e = gt; e < SEQ * 64; e += NGT) {
        const int pos = e >> 6, i = e & 63;
        const float inv = exp2f(-(float)i * (13.287712379549449f / 64.0f));
        const float ang = (float)pos * inv;
        const double a = (double)ang; const double n = rint(a * 0.15915494309189535); const float rr = (float)(a - n * 6.283185307179586);
        COS[e] = cosf(rr); SIN[e] = sinf(rr);
    }
    float* WG = (float*)(F.ws + WS_WG);
    for (int e = gt; e < 2 * 8 * DM; e += NGT) { const int j = e >> 13, c = (e >> 10) & 7, k = e & 1023;
        WG[e] = F.in[11][(size_t)j * DM * CIN + (size_t)k * CIN + 3072 + c] * F.in[1][(2 * j + 1) * DM + k]; }
    bf16_t* WM = (bf16_t*)(F.ws + WS_WM);
    for (int e = gt; e < 2 * 4 * 128 * 128; e += NGT) { const int p = (e >> 7) & 127, q = e & 127; const float w = ((q >> 6) <= (p >> 6)) ? F.in[9][e] : 0.f; WM[e] = (bf16_t)(pk2(w, 0.f) & 0xffffu); }
}

DI void gate_step(Frame& F, int L) {
    const int j = L >> 1; const int gw = blockIdx.x * 8 + F.wave, NGW = F.G * 8;
    const float* SS = (const float*)(F.ws + WS_SS); const bf16_t* HB = (const bf16_t*)(F.ws + WS_HB); const float* WG = (const float*)(F.ws + WS_WG) + j * 8 * DM;
    float* GLI = (float*)(F.ws + WS_GLI); float* GLF = (float*)(F.ws + WS_GLF);
    for (int m = gw; m < MROWS; m += NGW) {
        const u32x4 a0 = *((const u32x4*)(HB + (size_t)m * DM) + F.lane), a1 = *((const u32x4*)(HB + (size_t)m * DM + 512) + F.lane);
        float x[16];
        x[0] = bflo(a0.x); x[1] = bfhi(a0.x); x[2] = bflo(a0.y); x[3] = bfhi(a0.y); x[4] = bflo(a0.z); x[5] = bfhi(a0.z); x[6] = bflo(a0.w); x[7] = bfhi(a0.w);
        x[8] = bflo(a1.x); x[9] = bfhi(a1.x); x[10] = bflo(a1.y); x[11] = bfhi(a1.y); x[12] = bflo(a1.z); x[13] = bfhi(a1.z); x[14] = bflo(a1.w); x[15] = bfhi(a1.w);
        float ssp = (F.lane < 16) ? SS[(size_t)m * 16 + F.lane] : 0.f; ssp = wave_sum(ssp);
        const float rs = 1.0f / sqrtf(ssp * (1.0f / DM) + EPS);
        float myv = 0.f;
#pragma unroll
        for (int c = 0; c < 8; ++c) {
            const f32x4* w0 = (const f32x4*)(WG + c * DM + 8 * F.lane); const f32x4* w1 = (const f32x4*)(WG + c * DM + 512 + 8 * F.lane);
            const f32x4 wa = w0[0], wb = w0[1], wc2 = w1[0], wd = w1[1];
            float d = x[0] * wa.x + x[1] * wa.y + x[2] * wa.z + x[3] * wa.w + x[4] * wb.x + x[5] * wb.y + x[6] * wb.z + x[7] * wb.w
                    + x[8] * wc2.x + x[9] * wc2.y + x[10] * wc2.z + x[11] * wc2.w + x[12] * wd.x + x[13] * wd.y + x[14] * wd.z + x[15] * wd.w;
            d = wave_sum(d);
            if (F.lane == c) myv = d * rs;
        }
        if (F.lane < 8) {
            const int hh = F.lane & 3; const int b = m >> 12, t = m & (SEQ - 1); const size_t idx = (size_t)(b * 4 + hh) * SEQ + t;
            if (F.lane < 4) GLI[idx] = myv + F.in[13][j * 4 + hh];
            else { const float xx = myv + F.in[14][j * 4 + hh]; GLF[idx] = (xx >= 0.f) ? -log1pf(expf(-xx)) : (xx - log1pf(expf(xx))); }
        }
    }
}

DI void final_norm(Frame& F) {
    const int gw = blockIdx.x * 8 + F.wave, NGW = F.G * 8; const float* SS = (const float*)(F.ws + WS_SS); const bf16_t* HB = (const bf16_t*)(F.ws + WS_HB); const f32x4* gv = (const f32x4*)F.in[3] + F.lane;
    for (int m = gw; m < MROWS; m += NGW) {
        f32x4* hr = (f32x4*)(F.H + (size_t)m * DM) + F.lane; const u32x2* br = (const u32x2*)(HB + (size_t)m * DM) + F.lane;
        float ssp = (F.lane < 16) ? SS[(size_t)m * 16 + F.lane] : 0.f; ssp = wave_sum(ssp);
        const float rs = 1.0f / sqrtf(ssp * (1.0f / DM) + EPS);
#pragma unroll
        for (int q = 0; q < 4; ++q) { const u32x2 w = br[64 * q]; const f32x4 v = {bflo(w.x), bfhi(w.x), bflo(w.y), bfhi(w.y)}, g = gv[64 * q]; hr[64 * q] = v * rs * g; }
    }
}

DI int opaque(int x) { asm volatile("" : "+v"(x)); return x; }
DI int crow(int i, int h) { return (i & 3) + 8 * (i >> 2) + 4 * h; }
constexpr int QLD = 136, PLD = 72, KWLD = 160;
constexpr int QS_OFF = 0, KS_OFF = 17408, KW_OFF = 34816, VS_OFF = 55296, PS_OFF = 92160;
constexpr int SA_OFF = 101376, SCM_OFF = SA_OFF + 2048, SMT_OFF = SCM_OFF + 2048, SMISC_OFF = SMT_OFF + 2048;
constexpr int PQ_OFF = SMISC_OFF + 256, MS_OFF = PQ_OFF + 512, LS_OFF = MS_OFF + 320;
constexpr int STAT_OFF = LS_OFF + 320, NV_OFF = STAT_OFF + 4096, PSUM_OFF = NV_OFF + 512, QN_OFF = PSUM_OFF + 1024, LA_END = QN_OFF + 256;
static_assert(LA_END <= RING_BYTES, "mixer LDS");

DI bf16x8 gather_col(const LAS bf16_t* base, int ld, int col, int s0) {
    bf16x8 r;
#pragma unroll
    for (int j = 0; j < 8; ++j) r[j] = (short)base[(s0 + j) * ld + col];
    return r;
}
DI bf16x8 tr_frag(const LAS bf16_t* tile, int ld, int col0, int s0, int lane) {
    const int i16 = lane & 15, q = i16 >> 2, p = i16 & 3, blk = (lane >> 4) & 1, hh = lane >> 5;
    const LAS bf16_t* a = tile + (s0 + 8 * hh + q) * ld + col0 + 16 * blk + 4 * p;
    const bf16x4 lo = __builtin_amdgcn_ds_read_tr16_b64_v4i16((LAS bf16x4*)a), hi = __builtin_amdgcn_ds_read_tr16_b64_v4i16((LAS bf16x4*)(a + 4 * ld));
    return __builtin_shufflevector(lo, hi, 0, 1, 2, 3, 4, 5, 6, 7);
}
DI bf16x8 pack_acc(const f32x16& x, int s) {
    u32x4 p; p.x = pk2(x[8 * s + 0], x[8 * s + 1]); p.y = pk2(x[8 * s + 2], x[8 * s + 3]); p.z = pk2(x[8 * s + 4], x[8 * s + 5]); p.w = pk2(x[8 * s + 6], x[8 * s + 7]);
    return __builtin_bit_cast(bf16x8, p);
}
#define MFMA32(a, b, c) __builtin_amdgcn_mfma_f32_32x32x16_bf16((a), (b), (c), 0, 0, 0)
#define MFMA16(a, b, c) __builtin_amdgcn_mfma_f32_16x16x32_bf16((a), (b), (c), 0, 0, 0)

DI void mlstm_scan(Frame& F, int b, int h, int g) {
    LAS float* SA = (LAS float*)(F.lds + SA_OFF); LAS float* SCM = (LAS float*)(F.lds + SCM_OFF); LAS float* SMT = (LAS float*)(F.lds + SMT_OFF); LAS float* SM = (LAS float*)(F.lds + SMISC_OFF);
    LAS float* PQ = (LAS float*)(F.lds + PQ_OFF); LAS float* MS = (LAS float*)(F.lds + MS_OFF); LAS float* LS = (LAS float*)(F.lds + LS_OFF);
    const float* GLI = (const float*)(F.ws + WS_GLI) + (size_t)(b * 4 + h) * SEQ; const float* GLF = (const float*)(F.ws + WS_GLF) + (size_t)(b * 4 + h) * SEQ;
    const int lane = opaque(F.lane), w = F.wave;
    if (w <= g) {
        float li[8], lf[8]; const float* gli = GLI + w * 512 + lane; const float* glf = GLF + w * 512 + lane;
#pragma unroll
        for (int c = 0; c < 8; ++c) { li[c] = gli[c * 64]; lf[c] = glf[c * 64]; }
#pragma unroll
        for (int c = 0; c < 8; ++c) {
            const float bs = wave_scan<false>(lf[c]); const float a = li[c] - bs; const float cmx = wave_scan<true>(a);
            const float amax = lane63(cmx), b63 = lane63(bs);
            if (lane == 0) { PQ[(8 * w + c) * 2] = b63; PQ[(8 * w + c) * 2 + 1] = amax; }
            if (w == g) { (SA + lane)[c * 64] = a; (SCM + lane)[c * 64] = cmx; (SMT + lane)[c * 64] = bs; }
        }
    }
    __syncthreads();
    if (w == 0) {
        const bool live = lane < 8 * (g + 1);
        float P = live ? PQ[lane * 2] : 0.f; const float am = live ? PQ[lane * 2 + 1] : -3.0e38f; float Q = live ? am + P : -3.0e38f;
#define SCAN_PQ(CTRL, RM) { const float tP = __int_as_float(__builtin_amdgcn_update_dpp(0, __float_as_int(P), CTRL, RM, 0xF, false)); \
                            const float tQ = __int_as_float(__builtin_amdgcn_update_dpp(__float_as_int(-3.0e38f), __float_as_int(Q), CTRL, RM, 0xF, false)); Q = fmaxf(tQ + P, Q); P = tP + P; }
        SCAN_PQ(0x111, 0xF) SCAN_PQ(0x112, 0xF) SCAN_PQ(0x114, 0xF) SCAN_PQ(0x118, 0xF) SCAN_PQ(0x142, 0xA) SCAN_PQ(0x143, 0xC)
#undef SCAN_PQ
        const float mnext = fmaxf(P, Q);
        MS[lane + 1] = mnext; if (lane == 0) MS[0] = 0.f;
        const float mprev = MS[lane];
        const float la = live ? (mprev - fmaxf(mprev, am)) : 0.f;
        const float Linc = wave_scan<false>(la);
        LS[lane + 1] = Linc; if (lane == 0) LS[0] = 0.f;
    }
    __syncthreads();
    {
        const int i = F.tid, c = i >> 6; const float mprev = MS[8 * g + c]; const float cm = fmaxf(mprev, SCM[i]); SCM[i] = cm; SMT[i] = SMT[i] + cm;
        if (i < 8) SM[i] = MS[8 * g + i];
        if (i >= 16 && i < 25) SM[i] = LS[8 * (i - 16)];
    }
}

template <int MODE, bool PASS2> struct ChunkRegs { u32x4 k[2]; u32x4 q[PASS2 ? 2 : 1]; u32x4 v[(MODE ? 256 : 128) / 64]; };
template <int MODE, bool PASS2>
DI void la_load(ChunkRegs<MODE, PASS2>& R, const bf16_t* PROJ, int R0, int h, int tid) {
    constexpr int DV = MODE ? 256 : 128;
    const int qcol = 128 * h, kcol = 512 + 128 * h, vcol = 1024 + DV * h;
#pragma unroll
    for (int i = 0; i < 2; ++i) { const int p = tid + 512 * i, t = p >> 4, cp = (p & 15) * 8;
        R.k[i] = *(const u32x4*)(PROJ + (size_t)(R0 + t) * NIN + kcol + cp);
        if (PASS2) R.q[i] = *(const u32x4*)(PROJ + (size_t)(R0 + t) * NIN + qcol + cp); }
#pragma unroll
    for (int i = 0; i < DV / 64; ++i) { const int p = tid + 512 * i, t = p / (DV / 8), cp = (p % (DV / 8)) * 8;
        R.v[i] = *(const u32x4*)(PROJ + (size_t)(R0 + t) * NIN + vcol + cp); }
}
template <int MODE, bool PASS2>
DI void la_write(Frame& F, const ChunkRegs<MODE, PASS2>& R, int c, float lg2, int tid) {
    constexpr int DV = MODE ? 256 : 128, VLD = DV + 32;
    LAS bf16_t* Qs = (LAS bf16_t*)(F.lds + QS_OFF); LAS bf16_t* Ks = (LAS bf16_t*)(F.lds + KS_OFF); LAS bf16_t* Kw = (LAS bf16_t*)(F.lds + KW_OFF); LAS bf16_t* Vs = (LAS bf16_t*)(F.lds + VS_OFF);
    const LAS float* SA = (const LAS float*)(F.lds + SA_OFF); const LAS float* SCM = (const LAS float*)(F.lds + SCM_OFF);
#pragma unroll
    for (int i = 0; i < 2; ++i) { const int p = tid + 512 * i, t = p >> 4, cp = (p & 15) * 8; const u32x4 kv = R.k[i];
        float ck;
        if (MODE) ck = fexp(SA[c * 64 + t] - SCM[c * 64 + 63]); else ck = __builtin_amdgcn_exp2f(lg2 * (float)(63 - t));
        u32x4 kw; kw.x = pk2(bflo(kv.x) * ck, bfhi(kv.x) * ck); kw.y = pk2(bflo(kv.y) * ck, bfhi(kv.y) * ck); kw.z = pk2(bflo(kv.z) * ck, bfhi(kv.z) * ck); kw.w = pk2(bflo(kv.w) * ck, bfhi(kv.w) * ck);
        *(LAS u32x4*)(Kw + t * KWLD + cp) = kw;
        if (PASS2) { *(LAS u32x4*)(Ks + t * QLD + cp) = kv; *(LAS u32x4*)(Qs + t * QLD + cp) = R.q[i]; }
    }
#pragma unroll
    for (int i = 0; i < DV / 64; ++i) { const int p = tid + 512 * i, t = p / (DV / 8), cp = (p % (DV / 8)) * 8; *(LAS u32x4*)(Vs + t * VLD + cp) = R.v[i]; }
}

template <int MODE>
DI void la_pass1(Frame& F, int unit) {
    constexpr int DV = MODE ? 256 : 128, VLD = DV + 32, ND = MODE ? 4 : 2;
    const int b = unit >> 5, h = (unit >> 3) & 3, g = unit & 7, row0 = b * SEQ + g * 512;
    const int w = F.wave; int lane = F.lane, r = lane & 31, hh = lane >> 5;
    const int eb = MODE ? w : (w & 3), dt0 = MODE ? 0 : 2 * (w >> 2), e0 = 32 * eb;
    const bf16_t* PROJ = (const bf16_t*)(F.ws + WS_PROJ);
    LAS bf16_t* Kw = (LAS bf16_t*)(F.lds + KW_OFF); LAS bf16_t* Vs = (LAS bf16_t*)(F.lds + VS_OFF);
    const LAS float* SCM = (const LAS float*)(F.lds + SCM_OFF); const LAS float* SM = (const LAS float*)(F.lds + SMISC_OFF); LAS float* NV = (LAS float*)(F.lds + NV_OFF);
    const float lg2 = log2f(1.0f - exp2f(-5.0f - (float)h));
    ChunkRegs<MODE, false> R; la_load<MODE, false>(R, PROJ, row0, h, opaque(F.tid));
    if (MODE) { mlstm_scan(F, b, h, g); if (F.tid < 128) NV[F.tid] = 0.f; }
    __syncthreads();
    f32x16 C[ND];
#pragma unroll
    for (int d = 0; d < ND; ++d)
#pragma unroll
        for (int i = 0; i < 16; ++i) C[d][i] = 0.f;
    for (int c = 0; c < 8; ++c) {
        lane = opaque(F.lane); r = lane & 31; hh = lane >> 5; const int tid_o = opaque(F.tid);
        la_write<MODE, false>(F, R, c, lg2, tid_o);
        __syncthreads();
        if (c < 7) la_load<MODE, false>(R, PROJ, row0 + 64 * (c + 1), h, tid_o);
        const float alpha = MODE ? fexp(SM[c] - SCM[c * 64 + 63]) : __builtin_amdgcn_exp2f(lg2 * 64.0f);
        bf16x8 vf[4];
#pragma unroll
        for (int ks = 0; ks < 4; ++ks) vf[ks] = tr_frag(Vs, VLD, e0, 16 * ks, lane);
#pragma unroll
        for (int d = 0; d < ND; ++d) {
#pragma unroll
            for (int i = 0; i < 16; ++i) C[d][i] *= alpha;
#pragma unroll
            for (int ks = 0; ks < 4; ++ks) { const bf16x8 ka = tr_frag(Kw, KWLD, 32 * (dt0 + d), 16 * ks, lane); C[d] = MFMA32(ka, vf[ks], C[d]); }
        }
        if (MODE) {
            const int dd = 16 * w + (lane & 15), sq = lane >> 4; float s = 0.f;
#pragma unroll
            for (int q = 0; q < 16; ++q) s += bf2f(Kw[(16 * sq + q) * KWLD + dd]);
            s = sum_xor16_32(s);
            if (lane < 16) NV[dd] = alpha * NV[dd] + s;
        }
        __syncthreads();
    }
    float* T = (float*)(F.ws + WS_TST) + (size_t)unit * DV * 128;
#pragma unroll
    for (int d = 0; d < ND; ++d)
#pragma unroll
        for (int q = 0; q < 4; ++q) { const f32x4 v = {C[d][4 * q], C[d][4 * q + 1], C[d][4 * q + 2], C[d][4 * q + 3]};
            *(f32x4*)(T + (size_t)(e0 + r) * 128 + 32 * (dt0 + d) + 8 * q + 4 * hh) = v; }
    if (MODE && F.tid < 128) ((float*)(F.ws + WS_NST))[unit * 128 + F.tid] = NV[F.tid];
    __syncthreads();
}

template <int MODE>
DI void la_pass2(Frame& F, int unit, int j) {
    constexpr int DV = MODE ? 256 : 128, VLD = DV + 32, NT = MODE ? 2 : 1;
    const int b = unit >> 5, h = (unit >> 3) & 3, g = unit & 7, row0 = b * SEQ + g * 512;
    const int w = F.wave; int lane = F.lane, r = lane & 31, hh = lane >> 5, r16 = lane & 15, q4 = lane >> 4;
    const int eb = MODE ? w : (w & 3), tb0 = MODE ? 0 : (w >> 2), e0 = 32 * eb;
    const int gcol = MODE ? (2048 + 256 * h) : (1536 + 128 * h), ocol = DV * h;
    const bf16_t* PROJ = (const bf16_t*)(F.ws + WS_PROJ); bf16_t* MIX = (bf16_t*)(F.ws + WS_MIX);
    const float* gain = MODE ? (F.in[15] + (j * 4 + h) * 256) : (F.in[6] + (j * 4 + h) * 128);
    LAS bf16_t* Qs = (LAS bf16_t*)(F.lds + QS_OFF); LAS bf16_t* Ks = (LAS bf16_t*)(F.lds + KS_OFF); LAS bf16_t* Kw = (LAS bf16_t*)(F.lds + KW_OFF); LAS bf16_t* Vs = (LAS bf16_t*)(F.lds + VS_OFF); LAS bf16_t* Ps = (LAS bf16_t*)(F.lds + PS_OFF);
    const LAS float* SA = (const LAS float*)(F.lds + SA_OFF); const LAS float* SCM = (const LAS float*)(F.lds + SCM_OFF); const LAS float* SMT = (const LAS float*)(F.lds + SMT_OFF); const LAS float* SM = (const LAS float*)(F.lds + SMISC_OFF);
    LAS float* STAT = (LAS float*)(F.lds + STAT_OFF); LAS float* NV = (LAS float*)(F.lds + NV_OFF); LAS float* PSUM = (LAS float*)(F.lds + PSUM_OFF); LAS float* QN = (LAS float*)(F.lds + QN_OFF);
    const float lg2 = log2f(1.0f - exp2f(-5.0f - (float)h));
    ChunkRegs<MODE, true> R; la_load<MODE, true>(R, PROJ, row0, h, opaque(F.tid));
    if (MODE) mlstm_scan(F, b, h, g);
    __syncthreads();
    f32x16 C[4];
#pragma unroll
    for (int d = 0; d < 4; ++d)
#pragma unroll
        for (int i = 0; i < 16; ++i) C[d][i] = 0.f;
    float nacc = 0.f;
    for (int gp = 0; gp < g; ++gp) {
        const float coef = MODE ? fexp(SM[16 + g] - SM[16 + gp + 1]) : __builtin_amdgcn_exp2f(lg2 * (float)(512 * (g - 1 - gp)));
        const float* T = (const float*)(F.ws + WS_TST) + (size_t)(unit - g + gp) * DV * 128 + (size_t)(e0 + r) * 128 + 4 * hh;
#pragma unroll
        for (int d = 0; d < 4; ++d)
#pragma unroll
            for (int q = 0; q < 4; ++q) { const f32x4 v = *(const f32x4*)(T + 32 * d + 8 * q);
                C[d][4 * q] += coef * v.x; C[d][4 * q + 1] += coef * v.y; C[d][4 * q + 2] += coef * v.z; C[d][4 * q + 3] += coef * v.w; }
        if (MODE && F.tid < 128) nacc += coef * ((const float*)(F.ws + WS_NST))[(unit - g + gp) * 128 + F.tid];
    }
    if (MODE && F.tid < 128) NV[F.tid] = nacc;
    for (int c = 0; c < 8; ++c) {
        const int R0 = row0 + 64 * c;
        lane = opaque(F.lane); r = lane & 31; hh = lane >> 5; r16 = lane & 15; q4 = lane >> 4; const int tid_o = opaque(F.tid);
        la_write<MODE, true>(F, R, c, lg2, tid_o);
        if (SDUP & 1) { asm volatile("" ::: "memory"); la_write<MODE, true>(F, R, c, lg2, tid_o); }
        __syncthreads();
        if (SDUP & 16) __syncthreads();
        if (c < 7) la_load<MODE, true>(R, PROJ, R0 + 64, h, tid_o);
        u32x2 gt[NT][4];
#pragma unroll
        for (int tt = 0; tt < NT; ++tt)
#pragma unroll
            for (int q = 0; q < 4; ++q) gt[tt][q] = *(const u32x2*)(PROJ + (size_t)(R0 + 32 * (tb0 + tt) + r) * NIN + gcol + e0 + 8 * q + 4 * hh);
        for (int srep = 0; srep < ((SDUP & 2) ? 2 : 1); ++srep) {
        if (srep) asm volatile("" ::: "memory");
#pragma unroll
        for (int i = 0; i < 2; ++i) {
            const int tt = 2 * w + i, si = tt >> 2, ti = tt & 3;
            f32x4 x = {0.f, 0.f, 0.f, 0.f};
#pragma unroll
            for (int kk = 0; kk < 4; ++kk) { const bf16x8 ka = *(const LAS bf16x8*)(Ks + (16 * si + r16) * QLD + 32 * kk + 8 * q4); const bf16x8 qb = *(const LAS bf16x8*)(Qs + (16 * ti + r16) * QLD + 32 * kk + 8 * q4); x = MFMA16(ka, qb, x); }
            const int t = 16 * ti + r16; float p[4];
#pragma unroll
            for (int q = 0; q < 4; ++q) { const int s = 16 * si + 4 * q4 + q; float wgt;
                if (MODE) wgt = (s <= t) ? fexp(SA[c * 64 + s] - SCM[c * 64 + t]) : 0.f;
                else { const int dlt = t > s ? t - s : s - t; wgt = __builtin_amdgcn_exp2f(lg2 * (float)dlt); }
                p[q] = x[q] * wgt; }
            u32x2 pw; pw.x = pk2(p[0], p[1]); pw.y = pk2(p[2], p[3]);
            *(LAS u32x2*)(Ps + t * PLD + 16 * si + 4 * q4) = pw;
            if (MODE) { float cs = (bflo(pw.x) + bfhi(pw.x)) + (bflo(pw.y) + bfhi(pw.y)); cs = sum_xor16_32(cs); if (q4 == 0) PSUM[si * 64 + t] = cs; }
        }
        if (MODE) {
            const int t = 8 * w + (lane >> 3), part = lane & 7;
            const u32x4 qa = *(const LAS u32x4*)(Qs + t * QLD + 16 * part), qb2 = *(const LAS u32x4*)(Qs + t * QLD + 16 * part + 8);
            const f32x4 n0 = *(const LAS f32x4*)(NV + 16 * part), n1 = *(const LAS f32x4*)(NV + 16 * part + 4), n2 = *(const LAS f32x4*)(NV + 16 * part + 8), n3 = *(const LAS f32x4*)(NV + 16 * part + 12);
            float qn = bflo(qa.x) * n0.x + bfhi(qa.x) * n0.y + bflo(qa.y) * n0.z + bfhi(qa.y) * n0.w + bflo(qa.z) * n1.x + bfhi(qa.z) * n1.y + bflo(qa.w) * n1.z + bfhi(qa.w) * n1.w
                     + bflo(qb2.x) * n2.x + bfhi(qb2.x) * n2.y + bflo(qb2.y) * n2.z + bfhi(qb2.y) * n2.w + bflo(qb2.z) * n3.x + bfhi(qb2.z) * n3.y + bflo(qb2.w) * n3.z + bfhi(qb2.w) * n3.w;
            qn += dpp_f<0xB1>(qn); qn += dpp_f<0x4E>(qn); qn += dpp_f<0x141>(qn);
            if (part == 0) QN[t] = qn;
        }
        }
        __syncthreads();
        if (SDUP & 16) __syncthreads();
        bf16x8 vf[4];
#pragma unroll
        for (int ks = 0; ks < 4; ++ks) vf[ks] = tr_frag(Vs, VLD, e0, 16 * ks, lane);
        float cqv[NT], rinvv[NT];
#pragma unroll
        for (int tt = 0; tt < NT; ++tt) {
            const int t = 32 * (tb0 + tt) + r;
            if (MODE) {
                const float cq = fexp(SM[c] - SCM[c * 64 + t]);
                const float den = ((PSUM[t] + PSUM[64 + t]) + (PSUM[128 + t] + PSUM[192 + t])) + cq * QN[t];
                cqv[tt] = cq; rinvv[tt] = 1.0f / fmaxf(fabsf(den), fexp(-SMT[c * 64 + t]));
            } else { cqv[tt] = __builtin_amdgcn_exp2f(lg2 * (float)(t + 1)); rinvv[tt] = 1.f; }
        }
        f32x16 o2[NT], val[NT];
        for (int orep = 0; orep < ((SDUP & 4) ? 2 : 1); ++orep) {
        if (orep) asm volatile("" ::: "memory");
#pragma unroll
        for (int tt = 0; tt < NT; ++tt)
#pragma unroll
            for (int i = 0; i < 16; ++i) { o2[tt][i] = 0.f; val[tt][i] = 0.f; }
#pragma unroll
        for (int d = 0; d < 4; ++d) {
#pragma unroll
            for (int s2 = 0; s2 < 2; ++s2) { const bf16x8 ca = pack_acc(C[d], s2);
#pragma unroll
                for (int tt = 0; tt < NT; ++tt) { const int t = 32 * (tb0 + tt) + r;
                    const bf16x4 qlo = *(const LAS bf16x4*)(Qs + t * QLD + 32 * d + 16 * s2 + 4 * hh), qhi = *(const LAS bf16x4*)(Qs + t * QLD + 32 * d + 16 * s2 + 4 * hh + 8);
                    const bf16x8 qb = __builtin_shufflevector(qlo, qhi, 0, 1, 2, 3, 4, 5, 6, 7);
                    o2[tt] = MFMA32(ca, qb, o2[tt]); } }
            __builtin_amdgcn_sched_barrier(0);
        }
#pragma unroll
        for (int tt = 0; tt < NT; ++tt) { const int t = 32 * (tb0 + tt) + r;
#pragma unroll
            for (int ks = 0; ks < 4; ++ks) { const bf16x8 pb = *(const LAS bf16x8*)(Ps + t * PLD + 16 * ks + 8 * hh); val[tt] = MFMA32(vf[ks], pb, val[tt]); } }
#pragma unroll
        for (int tt = 0; tt < NT; ++tt) { const int t = 32 * (tb0 + tt) + r;
            float s1 = 0.f, s2s = 0.f;
#pragma unroll
            for (int i = 0; i < 16; ++i) { const float v = (val[tt][i] + cqv[tt] * o2[tt][i]) * rinvv[tt]; val[tt][i] = v; s1 += v; s2s += v * v; }
            s1 = sum_xor32(s1); s2s = sum_xor32(s2s);
            if (hh == 0) { STAT[(w * 64 + t) * 2] = s1; STAT[(w * 64 + t) * 2 + 1] = s2s; }
        }
        }
        __syncthreads();
        if (SDUP & 16) __syncthreads();
        for (int frep = 0; frep < ((SDUP & 8) ? 2 : 1); ++frep) {
        if (frep) asm volatile("" ::: "memory");
#pragma unroll
        for (int tt = 0; tt < NT; ++tt) {
            const int t = 32 * (tb0 + tt) + r; float S1 = 0.f, S2 = 0.f;
#pragma unroll
            for (int ww = 0; ww < (MODE ? 8 : 4); ++ww) { const int wi = MODE ? ww : (4 * tb0 + ww); S1 += STAT[(wi * 64 + t) * 2]; S2 += STAT[(wi * 64 + t) * 2 + 1]; }
            const float mean = S1 * (1.0f / DV); const float var = fmaxf(S2 * (1.0f / DV) - mean * mean, 0.f); const float rs = 1.0f / sqrtf(var + EPS);
            const size_t rowoff = (size_t)(R0 + t);
#pragma unroll
            for (int q = 0; q < 4; ++q) { const int e = e0 + 8 * q + 4 * hh;
                const f32x4 gn = *(const f32x4*)(gain + e); const u32x2 gtv = gt[tt][q];
                const float y0 = (val[tt][4 * q] - mean) * rs * gn.x * bflo(gtv.x), y1 = (val[tt][4 * q + 1] - mean) * rs * gn.y * bfhi(gtv.x);
                const float y2 = (val[tt][4 * q + 2] - mean) * rs * gn.z * bflo(gtv.y), y3 = (val[tt][4 * q + 3] - mean) * rs * gn.w * bfhi(gtv.y);
                u32x2 o; o.x = pk2(y0, y1); o.y = pk2(y2, y3); *(u32x2*)(MIX + rowoff * DM + ocol + e) = o; }
        }
        }
        __builtin_amdgcn_sched_barrier(0);
        const float alpha = MODE ? fexp(SM[c] - SCM[c * 64 + 63]) : __builtin_amdgcn_exp2f(lg2 * 64.0f);
#pragma unroll
        for (int d = 0; d < 4; ++d) {
#pragma unroll
            for (int i = 0; i < 16; ++i) C[d][i] *= alpha;
#pragma unroll
            for (int ks = 0; ks < 4; ++ks) { const bf16x8 ka = tr_frag(Kw, KWLD, 32 * d, 16 * ks, lane); C[d] = MFMA32(ka, vf[ks], C[d]); }
        }
        if (MODE) {
            const int dd = 16 * w + (lane & 15), sq = lane >> 4; float s = 0.f;
#pragma unroll
            for (int q = 0; q < 16; ++q) s += bf2f(Kw[(16 * sq + q) * KWLD + dd]);
            s = sum_xor16_32(s);
            if (lane < 16) NV[dd] = alpha * NV[dd] + s;
        }
        __syncthreads();
        if (SDUP & 16) __syncthreads();
    }
}

constexpr int VN_OFF = 0, SGST_OFF = 34816;
DI void sgu_unit(Frame& F, int unit, int j) {
    const int row0 = unit * 128; const int w = F.wave; int lane = F.lane, r = lane & 31, hh = lane >> 5;
    const bf16_t* PROJ = (const bf16_t*)(F.ws + WS_PROJ); bf16_t* MIX = (bf16_t*)(F.ws + WS_MIX);
    LAS bf16_t* Vn = (LAS bf16_t*)(F.lds + VN_OFF); LAS float* ST = (LAS float*)(F.lds + SGST_OFF);
    const float* lng = F.in[7] + j * 512; const float* lnb = F.in[8] + j * 512;
    for (int i = 0; i < 16; ++i) { const int p = 16 * w + i;
        const u32x4 v = *((const u32x4*)(PROJ + (size_t)(row0 + p) * NIN + 2560) + lane);
        const float x0 = bflo(v.x), x1 = bfhi(v.x), x2 = bflo(v.y), x3 = bfhi(v.y), x4 = bflo(v.z), x5 = bfhi(v.z), x6 = bflo(v.w), x7 = bfhi(v.w);
        float s = ((x0 + x1) + (x2 + x3)) + ((x4 + x5) + (x6 + x7)); s = wave_sum(s); const float mean = s * (1.0f / 512.0f);
        const float d0 = x0 - mean, d1 = x1 - mean, d2 = x2 - mean, d3 = x3 - mean, d4 = x4 - mean, d5 = x5 - mean, d6 = x6 - mean, d7 = x7 - mean;
        float q = ((d0 * d0 + d1 * d1) + (d2 * d2 + d3 * d3)) + ((d4 * d4 + d5 * d5) + (d6 * d6 + d7 * d7)); q = wave_sum(q);
        if (lane == 0) { ST[2 * p] = mean; ST[2 * p + 1] = 1.0f / sqrtf(q * (1.0f / 512.0f) + EPS); } }
    __syncthreads();
    const int dtl = w & 3, pt0 = 2 * (w >> 2);
    for (int gq = 0; gq < 4; ++gq) {
        lane = opaque(F.lane); r = lane & 31; hh = lane >> 5; const int tid_o = opaque(F.tid);
#pragma unroll
        for (int i = 0; i < 4; ++i) { const int pc = tid_o + 512 * i, q = pc >> 4, cp = (pc & 15) * 8; const int col = 128 * gq + cp;
            const u32x4 v = *(const u32x4*)(PROJ + (size_t)(row0 + q) * NIN + 2560 + col); const float mean = ST[2 * q], rs = ST[2 * q + 1];
            const f32x4 g0 = *(const f32x4*)(lng + col), g1 = *(const f32x4*)(lng + col + 4), b0 = *(const f32x4*)(lnb + col), b1 = *(const f32x4*)(lnb + col + 4);
            u32x4 o; o.x = pk2((bflo(v.x) - mean) * rs * g0.x + b0.x, (bfhi(v.x) - mean) * rs * g0.y + b0.y); o.y = pk2((bflo(v.y) - mean) * rs * g0.z + b0.z, (bfhi(v.y) - mean) * rs * g0.w + b0.w);
            o.z = pk2((bflo(v.z) - mean) * rs * g1.x + b1.x, (bfhi(v.z) - mean) * rs * g1.y + b1.y); o.w = pk2((bflo(v.w) - mean) * rs * g1.z + b1.z, (bfhi(v.w) - mean) * rs * g1.w + b1.w);
            *(LAS u32x4*)(Vn + q * QLD + cp) = o; }
        __syncthreads();
        const bf16_t* WM = (const bf16_t*)(F.ws + WS_WM) + (size_t)(j * 4 + gq) * 128 * 128;
        f32x16 acc[2];
#pragma unroll
        for (int i = 0; i < 16; ++i) { acc[0][i] = 0.f; acc[1][i] = 0.f; }
#pragma unroll
        for (int ks = 0; ks < 8; ++ks) { const bf16x8 vb = gather_col(Vn, QLD, 32 * dtl + r, 16 * ks + 8 * hh);
#pragma unroll
            for (int pt = 0; pt < 2; ++pt) { const bf16x8 wa = *(const bf16x8*)(WM + (size_t)(32 * (pt0 + pt) + r) * 128 + 16 * ks + 8 * hh); acc[pt] = MFMA32(wa, vb, acc[pt]); } }
        const float* bs = F.in[10] + (j * 4 + gq) * 128;
#pragma unroll
        for (int pt = 0; pt < 2; ++pt)
#pragma unroll
            for (int i = 0; i < 16; ++i) { const int p = 32 * (pt0 + pt) + crow(i, hh); const int col = 128 * gq + 32 * dtl + r;
                const float uu = bf2f(PROJ[(size_t)(row0 + p) * NIN + 2048 + col]);
                MIX[(size_t)(row0 + p) * DM + 512 + col] = (bf16_t)(pk2(uu * (acc[pt][i] + bs[p]), 0.f) & 0xffffu); if ((i & 3) == 3) asm volatile("" ::: "memory"); }
        __syncthreads();
    }
}

struct Args { const float* in[19]; float* out; unsigned char* ws; int ph_lo, ph_hi; };
__global__ void __launch_bounds__(512, 2) fwd(Args args) {
    extern __shared__ __attribute__((aligned(16))) unsigned char lds_raw[];
    Frame F;
    F.lds = (LAS unsigned char*)lds_raw;
    const int wave_s = __builtin_amdgcn_readfirstlane(threadIdx.x >> 6);
    F.tid = threadIdx.x; F.lane = F.tid & 63; F.wave = wave_s; F.G = gridDim.x;
    F.in = (const float* const __attribute__((address_space(4)))*)__builtin_amdgcn_kernarg_segment_ptr();
    F.H = args.out; F.ws = args.ws;
    volatile LAS unsigned* MISC = (volatile LAS unsigned*)(F.lds + LDSCTL_OFF);
    if (F.tid < 64) MISC[F.tid] = 0u;
    __syncthreads();
    if (ONE_LAUNCH) (void)xcd_barrier_post((unsigned*)(F.ws + WS_CTL), MISC + 8, F.tid);
    const int lo = ONE_LAUNCH ? 0 : args.ph_lo, hi = ONE_LAUNCH ? NPHASE : args.ph_hi;
#define IN(k) (lo <= (k) && (k) < hi)
#define REFRESH() do { F.lane = opaque((int)__builtin_amdgcn_mbcnt_hi(~0u, __builtin_amdgcn_mbcnt_lo(~0u, 0u))); F.wave = wave_s; F.tid = wave_s * 64 + F.lane; \
        { unsigned long long z_ = 0ull; asm volatile("" : "+s"(z_)); F.ws = args.ws + z_; } } while (0)
#define SEAM(k) do { if (ONE_LAUNCH && IN((k) + 1)) { REFRESH(); XcdBarrier bb_; bb_.bar = (unsigned*)(F.ws + WS_CTL); bb_.x = xb_xcc_id(); bb_.st = (volatile LAS unsigned*)(F.lds + LDSCTL_OFF) + 8; xcd_barrier(bb_, F.tid); if (DUP_MASK & 4096) xcd_barrier(bb_, F.tid); } } while (0)
#define SS ((const float*)(F.ws + WS_SS))
#define HB ((bf16_t*)(F.ws + WS_HB))
#define MIX ((bf16_t*)(F.ws + WS_MIX))
#define PROJ ((bf16_t*)(F.ws + WS_PROJ))

    if ((PH_MASK & 1) && IN(0)) { REPS(1) { REFRESH(); p0_prologue(F); } SEAM(0); }
    for (int L = 0; L < DEPTH; ++L) {
        const int pb = 1 + 6 * L, j = L >> 1;
        if (IN(pb)) {
            REFRESH();
            pg8::Gemm g{HB, W_in(F, L), MROWS, NIN, DM}; pg8::StaticOrder S; S.init(MROWS, NIN, F.G, (int)blockIdx.x);
            if (L & 1) { if (PH_MASK & 2) REPS(2) { EpiInC E{PROJ, SS}; pg8::gemm_phase<EpiInC, pg8::StaticOrder, true, true>(F.lds, g, S, E, F.tid); } if (PH_MASK & 4) gate_step(F, L); }
            else if (PH_MASK & 8) REPS(8) { EpiInA E{PROJ, SS, (const float*)(F.ws + WS_COS), (const float*)(F.ws + WS_SIN)}; pg8::gemm_phase<EpiInA, pg8::StaticOrder, true, true>(F.lds, g, S, E, F.tid); }
            SEAM(pb);
        }
        if (IN(pb + 1)) {
            REFRESH();
            for (int u = blockIdx.x; u < 256; u += F.G) { if (L & 1) { if (PH_MASK & 16) REPS(16) la_pass1<1>(F, u); } else { if (PH_MASK & 32) REPS(32) la_pass1<0>(F, u); if (PH_MASK & 64) REPS(64) sgu_unit(F, u, j); } }
            SEAM(pb + 1);
        }
        if (IN(pb + 2)) {
            REFRESH();
            for (int u = blockIdx.x; u < 256; u += F.G) { if (L & 1) { if (PH_MASK & 128) REPS(128) la_pass2<1>(F, u, j); } else { if (PH_MASK & 256) REPS(256) la_pass2<0>(F, u, j); } }
            SEAM(pb + 2);
        }
        if (IN(pb + 3)) {
            REFRESH();
            pg8::Gemm g{MIX, W_out(F, L), MROWS, DM, DM}; pg8::StaticOrder S; S.init(MROWS, DM, F.G, (int)blockIdx.x);
            if (PH_MASK & 512) for (int rep_ = 0; rep_ < ((DUP_MASK & 512) ? 3 : 1); ++rep_) { EpiRes E{HB, (float*)(F.ws + WS_SS), (rep_ == 1) ? -1.f : 1.f}; pg8::gemm_phase<EpiRes, pg8::StaticOrder, true, true>(F.lds, g, S, E, F.tid); if (ONE_LAUNCH && rep_ + 1 < ((DUP_MASK & 512) ? 3 : 1)) { REFRESH(); XcdBarrier bb_; bb_.bar = (unsigned*)(F.ws + WS_CTL); bb_.x = xb_xcc_id(); bb_.st = (volatile LAS unsigned*)(F.lds + LDSCTL_OFF) + 8; xcd_barrier(bb_, F.tid); } }
            SEAM(pb + 3);
        }
        if (IN(pb + 4)) {
            REFRESH();
            pg8::Gemm g{HB, W_up(F, L), MROWS, NUP, DM}; pg8::StaticOrder S; S.init(MROWS, NUP, F.G, (int)blockIdx.x);
            if (PH_MASK & 1024) REPS(1024) { EpiSwiGLU E{PROJ, SS}; pg8::gemm_phase<EpiSwiGLU, pg8::StaticOrder, true, true>(F.lds, g, S, E, F.tid); }
            SEAM(pb + 4);
        }
        if (IN(pb + 5)) {
            REFRESH();
            pg8::Gemm g{PROJ, W_down(F, L), MROWS, DM, DFF}; pg8::StaticOrder S; S.init(MROWS, DM, F.G, (int)blockIdx.x);
            if (PH_MASK & 2048) for (int rep_ = 0; rep_ < ((DUP_MASK & 2048) ? 3 : 1); ++rep_) { EpiRes E{HB, (float*)(F.ws + WS_SS), (rep_ == 1) ? -1.f : 1.f}; pg8::gemm_phase<EpiRes, pg8::StaticOrder, true, true>(F.lds, g, S, E, F.tid); if (ONE_LAUNCH && rep_ + 1 < ((DUP_MASK & 2048) ? 3 : 1)) { REFRESH(); XcdBarrier bb_; bb_.bar = (unsigned*)(F.ws + WS_CTL); bb_.x = xb_xcc_id(); bb_.st = (volatile LAS unsigned*)(F.lds + LDSCTL_OFF) + 8; xcd_barrier(bb_, F.tid); } }
            SEAM(pb + 5);
        }
    }
    if ((PH_MASK & 4096) && IN(NPHASE - 1)) { REFRESH(); final_norm(F); }
#undef IN
#undef SEAM
#undef REFRESH
#undef SS
#undef HB
#undef MIX
#undef PROJ
}

extern "C" void kernel_launch(void* const* d_in, const int* in_sizes, int n_in, void* d_out, int out_size, void* d_ws, size_t ws_size, hipStream_t stream) {
    static int grid = 0;
    if (grid == 0) {
        if (n_in != 19 || out_size != MROWS * DM || ws_size < WS_END) { fprintf(stderr, "kernel_launch: unexpected problem shape (n_in %d, out %d, ws %zu)\n", n_in, out_size, ws_size); grid = -1; return; }
        int dev = 0, cus = 0, per_cu = 0;
        if (hipGetDevice(&dev) != hipSuccess || hipDeviceGetAttribute(&cus, hipDeviceAttributeMultiprocessorCount, dev) != hipSuccess) { grid = -1; return; }
        if (hipFuncSetAttribute((const void*)fwd, hipFuncAttributeMaxDynamicSharedMemorySize, LDS_BYTES) != hipSuccess) { fprintf(stderr, "kernel_launch: hipFuncSetAttribute failed\n"); grid = -1; return; }
        if (hipOccupancyMaxActiveBlocksPerMultiprocessor(&per_cu, (const void*)fwd, 512, LDS_BYTES) != hipSuccess || per_cu < 1) { fprintf(stderr, "kernel_launch: occupancy query says %d\n", per_cu); (void)hipGetLastError(); grid = -1; return; }
        grid = cus;
    }
    if (grid < 0) return;
    (void)hipMemsetAsync((char*)d_ws + WS_CTL, 0, CTL_ZERO_BYTES, stream);
    Args a{};
    for (int i = 0; i < 19; ++i) a.in[i] = (const float*)d_in[i];
    a.out = (float*)d_out; a.ws = (unsigned char*)d_ws;
    if (ONE_LAUNCH) { a.ph_lo = 0; a.ph_hi = NPHASE; hipLaunchKernelGGL(fwd, dim3(grid), dim3(512), LDS_BYTES, stream, a); }
    else for (int p = 0; p < NPHASE; ++p) { a.ph_lo = p; a.ph_hi = p + 1; hipLaunchKernelGGL(fwd, dim3(grid), dim3(512), LDS_BYTES, stream, a); }
}
```

```cpp
#include <hip/hip_runtime.h>
#include <cstdio>
#include <cstdint>

#ifndef PH_MASK
#define PH_MASK 8191
#endif
#ifndef DUP_MASK
#define DUP_MASK 0
#endif
#define REPS(bit) for (int rep_ = 0; rep_ < ((DUP_MASK & (bit)) ? 2 : 1); ++rep_)
#ifndef GEMM_ALIGN
#define GEMM_ALIGN true
#endif
#ifndef GEMM_SP2
#define GEMM_SP2 true
#endif
#ifndef ONE_LAUNCH
#define ONE_LAUNCH 1
#endif

#ifndef SDUP
#define SDUP 0
#endif
namespace pg8 {
#define PG8_LAS __attribute__((address_space(3)))
typedef unsigned short bf16_t;
typedef short bf16x8 __attribute__((ext_vector_type(8)));
typedef float f32x4 __attribute__((ext_vector_type(4)));
typedef unsigned u32x4 __attribute__((ext_vector_type(4)));
constexpr int BM = 256, BK = 64, HALF = 128, HTB = HALF * BK * 2  , STAGE_BYTES = 8 * HTB, NXCD = 8, WGM = 8;

__host__ __device__ __forceinline__ int lds_byte(int r, int c) { const int st = (r >> 4) * 2 + (c >> 5), rr = r & 15, cc = c & 31, ob = rr * 64 + cc * 2; return st * 1024 + (ob ^ (((ob >> 9) & 1) << 5)); }
__host__ __device__ __forceinline__ void stage_rc(int b, int& R, int& C) { const int st = b / 1024, sb = b % 1024, swz = sb ^ (((sb >> 9) & 1) << 5); R = (st >> 1) * 16 + swz / 64; C = (st & 1) * 32 + (swz % 64) / 2; }
__host__ __device__ __forceinline__ int perm32(int rho) { const int n = rho >> 4, i = rho & 15; return 8 * (i >> 2) + 4 * n + (i & 3); }

struct Unit { int pm, pn, ui; };
struct Gemm { const bf16_t* A; const bf16_t* Bt; int M, N, K; };

struct StaticOrder {
    int nM, nN, nwg, G, c;
    __host__ __device__ void init(int M, int N, int G_, int c_) { nM = M / BM; nN = N / BM; nwg = nM * nN; G = G_; c = c_; }
    __host__ __device__ bool next(int i, Unit& u) const {
        const long L = (long)i * G + c; if (L >= nwg) return false;
        int wgid = (int)L; { const int q = nwg / NXCD, r = nwg % NXCD, xcd = wgid % NXCD, off = wgid / NXCD; wgid = (xcd < r ? xcd * (q + 1) : r * (q + 1) + (xcd - r) * q) + off; }
        const int nig = WGM * nN, gid = wgid / nig, fm = gid * WGM, gsz = (nM - fm) < WGM ? (nM - fm) : WGM;
        u.pm = fm + ((wgid % nig) % gsz); u.pn = (wgid % nig) / gsz; u.ui = i; return true;
    }
    __device__ __forceinline__ void a_ready(const Unit&) const {}
    __device__ __forceinline__ void done(const Unit&) const {}
};

template <class Epi, class Sched, bool ALIGN_EPI = false, bool SP2 = false>
__device__ __forceinline__ void gemm_phase(PG8_LAS unsigned char* lds, const Gemm g, const Sched& S, const Epi& E, int tid_) {
    asm volatile("" : "+v"(tid_));
    const int tid = tid_, wid = __builtin_amdgcn_readfirstlane(tid >> 6), lane = tid & 63, wr = wid >> 2, wc = wid & 3, fr = lane & 15, fq = lane >> 4;
    const int K = g.K, nt = K / BK;
    unsigned voffA[2], voffB[2];
#pragma unroll
    for (int i = 0; i < 2; ++i) { int R, C; stage_rc(tid * 16 + i * 8192, R, C); const int Rb = Epi::PERM ? ((R & ~31) + perm32(R & 31)) : R;
        voffA[i] = (unsigned)(R * K + C) * 2u; voffB[i] = (unsigned)(Rb * K + C) * 2u; }
    const size_t kstep = (size_t)(BK * 2);
    const size_t hstep = (size_t)HALF * K * 2;
    const size_t tstep = 2 * hstep;
    const unsigned ldsw = (unsigned)wid * 1024u;
    const int aoff = lds_byte(wr * 64 + fr, fq * 8), boff = lds_byte(wc * 32 + fr, fq * 8);
#define PG8_SA(b, h) (((b) * 2 + (h)) * HTB)
#define PG8_SB(b, h) ((4 + (b) * 2 + (h)) * HTB)
#define PG8_STAGE(bufoff, gbase, voff) do { _Pragma("unroll") for (int _i = 0; _i < 2; ++_i) \
        __builtin_amdgcn_global_load_lds((const unsigned*)((const char*)(gbase) + (voff)[_i]), (PG8_LAS unsigned*)(lds + (bufoff) + ldsw + _i * 8192), 16, 0, 0); } while (0)
#define PG8_LDA(dst, b, h) do { _Pragma("unroll") for (int m = 0; m < 4; ++m) _Pragma("unroll") for (int k = 0; k < 2; ++k) dst[m][k] = *(const PG8_LAS bf16x8*)(lds + PG8_SA(b, h) + aoff + m * 2048 + k * 1024); } while (0)
#define PG8_LDB(dst, b, h) do { _Pragma("unroll") for (int n = 0; n < 2; ++n) _Pragma("unroll") for (int k = 0; k < 2; ++k) dst[n][k] = *(const PG8_LAS bf16x8*)(lds + PG8_SB(b, h) + boff + n * 2048 + k * 1024); } while (0)
#define PG8_MMA(ai, bj, At, Bt) do { __builtin_amdgcn_s_setprio(1); _Pragma("unroll") for (int m = 0; m < 4; ++m) _Pragma("unroll") for (int n = 0; n < 2; ++n) _Pragma("unroll") for (int k = 0; k < 2; ++k) \
        acc[ai][bj][m][n] = __builtin_amdgcn_mfma_f32_16x16x32_bf16(Bt[n][k], At[m][k], acc[ai][bj][m][n], 0, 0, 0); __builtin_amdgcn_s_setprio(0); } while (0)
#define PG8_WAIT_V(n) asm volatile("s_waitcnt vmcnt(" #n ")" ::: "memory")
#define PG8_WAIT_L(n) asm volatile("s_waitcnt lgkmcnt(" #n ")" ::: "memory")
#define PG8_BAR __builtin_amdgcn_s_barrier()
#define PG8_SCHED __builtin_amdgcn_sched_barrier(0)
    Unit cur, nxt; int ui = 0;
    if (!S.next(0, cur)) return;
    f32x4 acc[2][2][4][2];
#pragma unroll
    for (int a = 0; a < 2; ++a)
#pragma unroll
        for (int b = 0; b < 2; ++b)
#pragma unroll
            for (int m = 0; m < 4; ++m)
#pragma unroll
                for (int n = 0; n < 2; ++n) acc[a][b][m][n] = (f32x4){0.f, 0.f, 0.f, 0.f};
    bf16x8 At[4][2], B0[2][2], B1[2][2];
    const char* cA = (const char*)g.A + (size_t)cur.pm * tstep; const char* cB = (const char*)g.Bt + (size_t)cur.pn * tstep;
    S.a_ready(cur);
    if constexpr (SP2) {
        PG8_STAGE(PG8_SB(0, 0), cB, voffB); PG8_STAGE(PG8_SB(0, 1), cB + hstep, voffB); PG8_STAGE(PG8_SA(0, 0), cA, voffA); PG8_STAGE(PG8_SA(0, 1), cA + hstep, voffA);
        if (wr == 1) PG8_BAR;
        PG8_WAIT_V(2); PG8_BAR;
        PG8_STAGE(PG8_SB(1, 0), cB + kstep, voffB); PG8_STAGE(PG8_SA(1, 0), cA + kstep, voffA); PG8_STAGE(PG8_SB(1, 1), cB + hstep + kstep, voffB);
        PG8_WAIT_V(6); PG8_BAR;
    } else {
        PG8_STAGE(PG8_SB(0, 0), cB, voffB); PG8_STAGE(PG8_SA(0, 0), cA, voffA); PG8_STAGE(PG8_SB(0, 1), cB + hstep, voffB); PG8_STAGE(PG8_SA(0, 1), cA + hstep, voffA);
        if (wr == 1) PG8_BAR;
        PG8_WAIT_V(4); PG8_BAR;
        PG8_STAGE(PG8_SB(1, 0), cB + kstep, voffB); PG8_STAGE(PG8_SA(1, 0), cA + kstep, voffA); PG8_STAGE(PG8_SB(1, 1), cB + hstep + kstep, voffB);
        PG8_WAIT_V(6); PG8_BAR;
    }
    for (;;) {
        const bool has_next = S.next(ui + 1, nxt);
        const char* nA = has_next ? (const char*)g.A + (size_t)nxt.pm * tstep : cA; const char* nB = has_next ? (const char*)g.Bt + (size_t)nxt.pn * tstep : cB;
        for (int t = 0; t < nt; t += 2) {
            const bool last = (t == nt - 2);
            const char* a1 = cA + (size_t)(t + 1) * kstep;
            const char* a2 = last ? nA : cA + (size_t)(t + 2) * kstep; const char* b2 = last ? nB : cB + (size_t)(t + 2) * kstep;
            const char* a3 = a2 + kstep; const char* b3 = b2 + kstep;
            if (last && has_next) S.a_ready(nxt);
            if constexpr (SP2) {
            PG8_LDB(B0, 0, 0); PG8_LDB(B1, 0, 1); PG8_SCHED; PG8_LDA(At, 0, 0); PG8_STAGE(PG8_SA(1, 1), a1 + hstep, voffA);
            PG8_WAIT_V(8); PG8_WAIT_L(0); PG8_BAR; PG8_MMA(0, 0, At, B0); PG8_MMA(0, 1, At, B1); PG8_BAR; PG8_SCHED;
            PG8_LDA(At, 0, 1); PG8_STAGE(PG8_SB(0, 0), b2, voffB); PG8_STAGE(PG8_SB(0, 1), b2 + hstep, voffB); PG8_STAGE(PG8_SA(0, 0), a2, voffA);
            PG8_WAIT_V(8); PG8_WAIT_L(0); PG8_BAR; PG8_MMA(1, 0, At, B0); PG8_MMA(1, 1, At, B1); PG8_BAR; PG8_SCHED;
            PG8_LDB(B0, 1, 0); PG8_LDB(B1, 1, 1); PG8_SCHED; PG8_LDA(At, 1, 0); PG8_STAGE(PG8_SA(0, 1), a2 + hstep, voffA);
            PG8_WAIT_V(8); PG8_WAIT_L(0); PG8_BAR; PG8_MMA(0, 0, At, B0); PG8_MMA(0, 1, At, B1); PG8_BAR; PG8_SCHED;
            PG8_LDA(At, 1, 1); PG8_STAGE(PG8_SB(1, 0), b3, voffB); PG8_STAGE(PG8_SB(1, 1), b3 + hstep, voffB); PG8_STAGE(PG8_SA(1, 0), a3, voffA);
            PG8_WAIT_V(8); PG8_WAIT_L(0); PG8_BAR; PG8_MMA(1, 0, At, B0); PG8_MMA(1, 1, At, B1); PG8_BAR; PG8_SCHED;
            } else {
            PG8_LDB(B0, 0, 0); PG8_SCHED; PG8_LDA(At, 0, 0); PG8_STAGE(PG8_SA(1, 1), a1 + hstep, voffA);
            PG8_WAIT_L(8); PG8_BAR; PG8_WAIT_L(0); PG8_MMA(0, 0, At, B0); PG8_BAR; PG8_SCHED;
            PG8_LDB(B1, 0, 1); PG8_STAGE(PG8_SB(0, 0), b2, voffB);
            PG8_BAR; PG8_WAIT_L(0); PG8_MMA(0, 1, At, B1); PG8_BAR;
            PG8_LDA(At, 0, 1); PG8_STAGE(PG8_SA(0, 0), a2, voffA);
            PG8_BAR; PG8_WAIT_L(0); PG8_MMA(1, 0, At, B0); PG8_BAR; PG8_SCHED;
            PG8_STAGE(PG8_SB(0, 1), b2 + hstep, voffB);
            PG8_WAIT_V(6); PG8_BAR; PG8_MMA(1, 1, At, B1); PG8_BAR;
            PG8_LDB(B0, 1, 0); PG8_SCHED; PG8_LDA(At, 1, 0); PG8_STAGE(PG8_SA(0, 1), a2 + hstep, voffA);
            PG8_WAIT_L(8); PG8_BAR; PG8_WAIT_L(0); PG8_MMA(0, 0, At, B0); PG8_BAR; PG8_SCHED;
            PG8_LDB(B1, 1, 1); PG8_STAGE(PG8_SB(1, 0), b3, voffB);
            PG8_BAR; PG8_WAIT_L(0); PG8_MMA(0, 1, At, B1); PG8_BAR;
            PG8_LDA(At, 1, 1); PG8_STAGE(PG8_SA(1, 0), a3, voffA);
            PG8_BAR; PG8_WAIT_L(0); PG8_MMA(1, 0, At, B0); PG8_BAR; PG8_SCHED;
            PG8_STAGE(PG8_SB(1, 1), b3 + hstep, voffB);
            PG8_WAIT_V(6); PG8_BAR; PG8_MMA(1, 1, At, B1); PG8_BAR;
            }
        }
        if constexpr (ALIGN_EPI) { if (wr == 0) PG8_BAR; }
        E(acc, cur, wr, wc, fr, fq); if (SDUP & 32) { asm volatile("" ::: "memory"); E(acc, cur, wr, wc, fr, fq); } S.done(cur);
        if (!has_next) break;
#pragma unroll
        for (int a = 0; a < 2; ++a)
#pragma unroll
            for (int b = 0; b < 2; ++b)
#pragma unroll
                for (int m = 0; m < 4; ++m)
#pragma unroll
                    for (int n = 0; n < 2; ++n) acc[a][b][m][n] = (f32x4){0.f, 0.f, 0.f, 0.f};
        cur = nxt; cA = nA; cB = nB; ++ui;
        if constexpr (ALIGN_EPI) { if (wr == 1) PG8_BAR; }
    }
    PG8_WAIT_V(0);
    if constexpr (!ALIGN_EPI) { if (wr == 0) PG8_BAR; }
    PG8_BAR;
#undef PG8_SA
#undef PG8_SB
#undef PG8_STAGE
#undef PG8_LDA
#undef PG8_LDB
#undef PG8_MMA
#undef PG8_WAIT_V
#undef PG8_WAIT_L
#undef PG8_BAR
#undef PG8_SCHED
}
}

constexpr int BATCH = 8, SEQ = 4096, DM = 1024, MROWS = BATCH * SEQ, DEPTH = 4;
constexpr int NIN = 3072, CIN = 3080, DFF = 2816, NUP = 2 * DFF;
constexpr float EPS = 1e-6f;
constexpr size_t M512 = (size_t)MROWS * 512;
constexpr int NPHASE = 2 + 6 * DEPTH;

constexpr size_t MiB = 1u << 20;
constexpr size_t WS_CTL = 0, CTL_ZERO_BYTES = 64 * 1024;
constexpr size_t WS_COS = 1 * MiB, WS_SIN = 2 * MiB;
constexpr size_t WS_SS = 3 * MiB;
constexpr size_t WS_GLI = 5 * MiB, WS_GLF = 5 * MiB + 512 * 1024;
constexpr size_t WS_WG = 6 * MiB;
constexpr size_t WS_WM = 6 * MiB + 256 * 1024;
constexpr size_t WS_NST = 7 * MiB;
constexpr size_t WS_W = 8 * MiB;
constexpr size_t W_IN_OFF = 0, W_OUT_OFF = (size_t)NIN * DM * 2, W_UP_OFF = W_OUT_OFF + (size_t)DM * DM * 2, W_DOWN_OFF = W_UP_OFF + (size_t)NUP * DM * 2, W_LAYER = W_DOWN_OFF + (size_t)DM * DFF * 2;
constexpr size_t WS_HB = 106 * MiB;
constexpr size_t WS_MIX = 170 * MiB;
constexpr size_t WS_PROJ = 234 * MiB;
constexpr size_t WS_TST = 426 * MiB;
constexpr size_t WS_END = 460 * MiB;
static_assert(WS_W + 4 * W_LAYER <= WS_HB && WS_TST + (size_t)256 * 256 * 128 * 4 <= WS_END, "ws map");

constexpr int RING_BYTES = 131072;
constexpr int LDSCTL_OFF = RING_BYTES;
constexpr int RSTD_OFF = LDSCTL_OFF + 256;
constexpr int LDS_BYTES = 147456;

#define GAS __attribute__((address_space(1)))
#define LAS __attribute__((address_space(3)))
#define DI __device__ __forceinline__
typedef unsigned short bf16_t;
typedef short bf16x8 __attribute__((ext_vector_type(8)));
typedef short bf16x4 __attribute__((ext_vector_type(4)));
typedef float f32x4 __attribute__((ext_vector_type(4)));
typedef float f32x16 __attribute__((ext_vector_type(16)));
typedef unsigned u32x4 __attribute__((ext_vector_type(4)));
typedef unsigned u32x2 __attribute__((ext_vector_type(2)));

DI unsigned pk2(float lo, float hi) { typedef __bf16 b2 __attribute__((ext_vector_type(2))); b2 v; v.x = (__bf16)lo; v.y = (__bf16)hi; return __builtin_bit_cast(unsigned, v); }
DI float bf2f(unsigned short x) { return __uint_as_float(((unsigned)x) << 16); }
DI float bflo(unsigned w) { return __uint_as_float(w << 16); }
DI float bfhi(unsigned w) { return __uint_as_float(w & 0xffff0000u); }
DI float fexp(float x) { return __builtin_amdgcn_exp2f(x * 1.4426950408889634f); }
DI float frcp(float x) { return __builtin_amdgcn_rcpf(x); }
DI float sigmoid_f(float x) { return frcp(1.f + fexp(-x)); }
DI float silu_f(float x) { return x * sigmoid_f(x); }
DI float gelu_tanh_f(float x) { return x * sigmoid_f(1.5957691216057308f * (x + 0.044715f * x * x * x)); }
template <int CTRL> DI float dpp_f(float v) { return __int_as_float(__builtin_amdgcn_mov_dpp(__float_as_int(v), CTRL, 0xF, 0xF, true)); }
DI float xor16_f(float v) { return __int_as_float(__builtin_amdgcn_ds_swizzle(__float_as_int(v), 0x401F)); }
DI float sum_xor32(float v) { const auto r = __builtin_amdgcn_permlane32_swap(__float_as_uint(v), __float_as_uint(v), false, false); return __uint_as_float(r[0]) + __uint_as_float(r[1]); }
DI float sum_xor16_32(float v) { v += xor16_f(v); return sum_xor32(v); }
DI float wave_sum(float v) {
    v += dpp_f<0xB1>(v); v += dpp_f<0x4E>(v); v += dpp_f<0x141>(v); v += dpp_f<0x140>(v);
    return sum_xor16_32(v);
}
template <int CTRL, int ROWMASK, bool IS_MAX> DI float scan_step(float v, const float ident) {
    const float t = __int_as_float(__builtin_amdgcn_update_dpp(__float_as_int(ident), __float_as_int(v), CTRL, ROWMASK, 0xF, false));
    return IS_MAX ? fmaxf(v, t) : v + t;
}
template <bool IS_MAX> DI float wave_scan(float v) {
    const float id = IS_MAX ? -3.0e38f : 0.f;
    v = scan_step<0x111, 0xF, IS_MAX>(v, id); v = scan_step<0x112, 0xF, IS_MAX>(v, id); v = scan_step<0x114, 0xF, IS_MAX>(v, id); v = scan_step<0x118, 0xF, IS_MAX>(v, id);
    v = scan_step<0x142, 0xA, IS_MAX>(v, id);
    v = scan_step<0x143, 0xC, IS_MAX>(v, id);
    return v;
}
DI float lane63(float v) { return __int_as_float(__builtin_amdgcn_readlane(__float_as_int(v), 63)); }

#define XB_TMO      128
#define XB_XCNT(j)  (256  + 64 * (j))
#define XB_XSUB(j)  (1280 + 64 * (j))
#define XB_XGEN(j)  (2304 + 64 * (j))
#define XB_TOP      3328
#define XB_TOPGEN   3392
#define XCD_BAR_WORDS 3456
#define XB_SPIN_CAP (1u << 18)

__device__ __forceinline__ unsigned xb_ld(unsigned* p)              { return __hip_atomic_load(p, __ATOMIC_RELAXED, __HIP_MEMORY_SCOPE_AGENT); }
__device__ __forceinline__ unsigned xb_add(unsigned* p, unsigned v) { return __hip_atomic_fetch_add(p, v, __ATOMIC_RELAXED, __HIP_MEMORY_SCOPE_AGENT); }
__device__ __forceinline__ unsigned xb_xcc_id() { return (unsigned)__builtin_amdgcn_s_getreg((3 << 11) | 20) & 0xFu; }
#define XB_SPIN(cond, bar) do { unsigned _sp = 0; while (cond) { __builtin_amdgcn_s_sleep(1); \
    if ((++_sp & 255u) == 0u) { if (xb_ld(&(bar)[XB_TMO])) break; if (_sp > XB_SPIN_CAP) { atomicAdd(&(bar)[XB_TMO], 1u); break; } } } } while (0)

struct XcdBarrier { unsigned* bar; unsigned x; volatile LAS unsigned* st; };

__device__ __forceinline__ XcdBarrier xcd_barrier_post(unsigned* bar, volatile LAS unsigned* st, int tid) {
    XcdBarrier b; b.bar = bar; b.x = xb_xcc_id(); b.st = st;
    if (tid == 0) (void)xb_add(&bar[XB_XCNT(b.x)], 1u);
    return b;
}
__device__ __forceinline__ void xcd_barrier_complete(unsigned* bar, unsigned x, unsigned& nloc, unsigned& nx) {
    const unsigned G = gridDim.x * gridDim.y * gridDim.z;
    unsigned sum, cnt, mine, sp = 0u;
    for (;;) {
        sum = 0u; cnt = 0u; mine = 0u;
#pragma unroll
        for (unsigned j = 0; j < 16; ++j) { const unsigned c = xb_ld(&bar[XB_XCNT(j)]); sum += c; cnt += (c > 0u) ? 1u : 0u; mine = (j == x) ? c : mine; }
        if (sum == G) break;
        __builtin_amdgcn_s_sleep(1);
        if ((++sp & 255u) == 0u) { if (xb_ld(&bar[XB_TMO])) break; if (sp > XB_SPIN_CAP) { atomicAdd(&bar[XB_TMO], 1u); break; } }
    }
    nloc = mine > 0u ? mine : 1u; nx = cnt > 0u ? cnt : 1u;
}
__device__ __forceinline__ void xcd_barrier(const XcdBarrier& b, int tid) {
    asm volatile("s_waitcnt vmcnt(0)" ::: "memory");
    __syncthreads();
    if (tid == 0) {
        unsigned* bar = b.bar;
        __builtin_amdgcn_s_waitcnt(0);
        unsigned nloc = b.st[0], nx = b.st[1];
        if (nloc == 0u) { xcd_barrier_complete(bar, b.x, nloc, nx); b.st[0] = nloc; b.st[1] = nx; }
        const unsigned old = xb_add(&bar[XB_XSUB(b.x)], 1u);
        const unsigned gen = old / nloc;
        if (old + 1u == (gen + 1u) * nloc) {
            __builtin_amdgcn_fence(__ATOMIC_RELEASE, "agent");
            asm volatile("s_waitcnt vmcnt(0)" ::: "memory");
            const unsigned og = xb_add(&bar[XB_TOP], 1u);
            const unsigned tg = og / nx;
            if (og + 1u == (tg + 1u) * nx) xb_add(&bar[XB_TOPGEN], 1u);
            else XB_SPIN(xb_ld(&bar[XB_TOPGEN]) == tg, bar);
            __builtin_amdgcn_fence(__ATOMIC_ACQUIRE, "agent");
            xb_add(&bar[XB_XGEN(b.x)], 1u);
            asm volatile("s_waitcnt vmcnt(0)" ::: "memory");
        } else {
            XB_SPIN(xb_ld(&bar[XB_XGEN(b.x)]) == gen, bar);
            __builtin_amdgcn_fence(__ATOMIC_ACQUIRE, "agent");
            asm volatile("s_waitcnt vmcnt(0)" ::: "memory");
        }
    }
    __syncthreads();
}

struct Frame {
    LAS unsigned char* lds;
    int tid, lane, wave, G;
    const float* const __attribute__((address_space(4)))* in;
    float* H;
    unsigned char* ws;
};
DI bf16_t* W_in(const Frame& F, int L)   { return (bf16_t*)(F.ws + WS_W + (size_t)L * W_LAYER + W_IN_OFF); }
DI bf16_t* W_out(const Frame& F, int L)  { return (bf16_t*)(F.ws + WS_W + (size_t)L * W_LAYER + W_OUT_OFF); }
DI bf16_t* W_up(const Frame& F, int L)   { return (bf16_t*)(F.ws + WS_W + (size_t)L * W_LAYER + W_UP_OFF); }
DI bf16_t* W_down(const Frame& F, int L) { return (bf16_t*)(F.ws + WS_W + (size_t)L * W_LAYER + W_DOWN_OFF); }

template <class Sched>
DI void rstd_table(Frame& F, const Sched& S, const float* __restrict__ SS) {
    LAS float* T = (LAS float*)(F.lds + RSTD_OFF); pg8::Unit u;
    for (int i0 = 0; S.next(i0, u); i0 += 4) {
        f32x4 sp[2][4]; bool ok[2];
#pragma unroll
        for (int k = 0; k < 2; ++k) { const int i = i0 + 2 * k + (F.tid >> 8); ok[k] = S.next(i, u);
            if (ok[k]) { const float* p = SS + (size_t)(256 * u.pm + (F.tid & 255)) * 16;
#pragma unroll
                for (int q = 0; q < 4; ++q) sp[k][q] = *(const f32x4*)(p + 4 * q); } }
#pragma unroll
        for (int k = 0; k < 2; ++k) if (ok[k]) { const int i = i0 + 2 * k + (F.tid >> 8); float s = 0.f;
#pragma unroll
            for (int q = 0; q < 4; ++q) s += (sp[k][q].x + sp[k][q].y) + (sp[k][q].z + sp[k][q].w);
            T[i * 256 + (F.tid & 255)] = 1.0f / sqrtf(s * (1.0f / DM) + EPS); }
    }
    __syncthreads();
}
DI void row_rstd8(const LAS float* T, int ui, int wr, int fr, float (&rs)[2][4]) {
#pragma unroll
    for (int ai = 0; ai < 2; ++ai)
#pragma unroll
        for (int m = 0; m < 4; ++m) rs[ai][m] = T[ui * 256 + ai * 128 + wr * 64 + m * 16 + fr];
}
DI void store8(bf16_t* p, const f32x4& v0, const f32x4& v1) { u32x4 w; w.x = pk2(v0[0], v0[1]); w.y = pk2(v0[2], v0[3]); w.z = pk2(v1[0], v1[1]); w.w = pk2(v1[2], v1[3]); *(u32x4*)p = w; }

struct EpiInA {
    static constexpr bool PERM = true;
    bf16_t* P; const LAS float* RT; const float* COS; const float* SIN;
    DI void operator()(const f32x4 (&acc)[2][2][4][2], const pg8::Unit& u, int wr, int wc, int fr, int fq) const {
        const int row0 = u.pm * 256 + wr * 64 + fr, colw = wc * 32 + 8 * fq, typ = u.pn >> 1;
        float rsv[2][4]; row_rstd8(RT, u.ui, wr, fr, rsv);
#pragma unroll
        for (int ai = 0; ai < 2; ++ai) {
            f32x4 cc[4], sn[4];
            if (typ < 2) {
#pragma unroll
                for (int m = 0; m < 4; ++m) { const int pos = (row0 + ai * 128 + m * 16) & (SEQ - 1); cc[m] = *(const f32x4*)(COS + pos * 64 + (colw >> 1)); sn[m] = *(const f32x4*)(SIN + pos * 64 + (colw >> 1)); } }
#pragma unroll
            for (int m = 0; m < 4; ++m) {
                const int row = row0 + ai * 128 + m * 16;
                const float rs = rsv[ai][m];
                const int bb = row >> 12, tq = row & (SEQ - 1);
                bf16_t* rowp = (typ < 4) ? P + (size_t)typ * M512 + ((size_t)((bb * 4 + 2 * (u.pn & 1)) * SEQ + tq)) * 128 + colw
                                         : P + (size_t)typ * M512 + (size_t)row * 512 + (u.pn & 1) * 256 + colw;
                const size_t bjs = (typ < 4) ? (size_t)SEQ * 128 : 128;
                if (typ < 2) {
                    const f32x4 c4 = cc[m], s4 = sn[m];
#pragma unroll
                    for (int bj = 0; bj < 2; ++bj) { const f32x4 a0 = acc[ai][bj][m][0] * rs, a1 = acc[ai][bj][m][1] * rs; f32x4 v0, v1;
                        v0[0] = a0[0] * c4[0] - a0[1] * s4[0]; v0[1] = a0[0] * s4[0] + a0[1] * c4[0];
                        v0[2] = a0[2] * c4[1] - a0[3] * s4[1]; v0[3] = a0[2] * s4[1] + a0[3] * c4[1];
                        v1[0] = a1[0] * c4[2] - a1[1] * s4[2]; v1[1] = a1[0] * s4[2] + a1[1] * c4[2];
                        v1[2] = a1[2] * c4[3] - a1[3] * s4[3]; v1[3] = a1[2] * s4[3] + a1[3] * c4[3];
                        store8(rowp + bj * bjs, v0, v1); }
                } else {
#pragma unroll
                    for (int bj = 0; bj < 2; ++bj) { f32x4 v0 = acc[ai][bj][m][0] * rs, v1 = acc[ai][bj][m][1] * rs;
                        if (typ == 3) {
#pragma unroll
                            for (int j = 0; j < 4; ++j) { v0[j] = silu_f(v0[j]); v1[j] = silu_f(v1[j]); } }
                        else if (typ >= 4) {
#pragma unroll
                            for (int j = 0; j < 4; ++j) { v0[j] = gelu_tanh_f(v0[j]); v1[j] = gelu_tanh_f(v1[j]); } }
                        store8(rowp + bj * bjs, v0, v1); }
                }
            }
        }
    }
};
struct EpiInC {
    static constexpr bool PERM = true;
    bf16_t* P; const LAS float* RT;
    DI void operator()(const f32x4 (&acc)[2][2][4][2], const pg8::Unit& u, int wr, int wc, int fr, int fq) const {
        const int row0 = u.pm * 256 + wr * 64 + fr, colw = wc * 32 + 8 * fq; const bool sg = u.pn >= 8;
        float rsv[2][4]; row_rstd8(RT, u.ui, wr, fr, rsv);
#pragma unroll
        for (int ai = 0; ai < 2; ++ai)
#pragma unroll
            for (int m = 0; m < 4; ++m) {
                const int row = row0 + ai * 128 + m * 16;
                const float rs = rsv[ai][m];
                const int bb = row >> 12, tq = row & (SEQ - 1);
                bf16_t* rowp; size_t bjs;
                if (u.pn < 4) { rowp = P + (size_t)(u.pn >> 1) * M512 + ((size_t)((bb * 4 + 2 * (u.pn & 1)) * SEQ + tq)) * 128 + colw; bjs = (size_t)SEQ * 128; }
                else { rowp = P + (size_t)(u.pn < 8 ? 2 : 4) * M512 + ((size_t)((bb * 4 + (u.pn & 3)) * SEQ + tq)) * 256 + colw; bjs = 128; }
#pragma unroll
                for (int bj = 0; bj < 2; ++bj) { f32x4 v0 = acc[ai][bj][m][0] * rs, v1 = acc[ai][bj][m][1] * rs;
                    if (sg) {
#pragma unroll
                        for (int j = 0; j < 4; ++j) { v0[j] = sigmoid_f(v0[j]); v1[j] = sigmoid_f(v1[j]); } }
                    store8(rowp + bj * bjs, v0, v1); }
            }
    }
};
struct EpiRes {
    static constexpr bool PERM = true;
    bf16_t* HB; float* SS; float sgn;
    DI void operator()(const f32x4 (&acc)[2][2][4][2], const pg8::Unit& u, int wr, int wc, int fr, int fq) const {
        const int row0 = u.pm * 256 + wr * 64 + fr, col0 = u.pn * 256 + wc * 32 + 8 * fq;
#pragma unroll
        for (int ai = 0; ai < 2; ++ai) {
            u32x4 hv[4][2];
#pragma unroll
            for (int m = 0; m < 4; ++m) { const bf16_t* bp = HB + (size_t)(row0 + ai * 128 + m * 16) * DM + col0;
#pragma unroll
                for (int bj = 0; bj < 2; ++bj) hv[m][bj] = *(const u32x4*)(bp + bj * 128); }
#pragma unroll
            for (int m = 0; m < 4; ++m) {
                const int row = row0 + ai * 128 + m * 16;
                bf16_t* bp = HB + (size_t)row * DM + col0; float ssum = 0.f;
#pragma unroll
                for (int bj = 0; bj < 2; ++bj) {
                    const u32x4 w = hv[m][bj];
                    const f32x4 b0 = {bflo(w.x), bfhi(w.x), bflo(w.y), bfhi(w.y)}, b1 = {bflo(w.z), bfhi(w.z), bflo(w.w), bfhi(w.w)};
                    const f32x4 h0 = b0 + acc[ai][bj][m][0] * sgn, h1 = b1 + acc[ai][bj][m][1] * sgn;
                    store8(bp + bj * 128, h0, h1);
                    ssum += (h0[0] * h0[0] + h0[1] * h0[1]) + (h0[2] * h0[2] + h0[3] * h0[3]) + (h1[0] * h1[0] + h1[1] * h1[1]) + (h1[2] * h1[2] + h1[3] * h1[3]);
                }
                ssum = sum_xor16_32(ssum);
                if (fq == 0) SS[(size_t)row * 16 + u.pn * 4 + wc] = ssum;
            }
        }
    }
};
struct EpiSwiGLU {
    static constexpr bool PERM = true;
    bf16_t* ACT; const LAS float* RT;
    DI void operator()(const f32x4 (&acc)[2][2][4][2], const pg8::Unit& u, int wr, int wc, int fr, int fq) const {
        const int row0 = u.pm * 256 + wr * 64 + fr, col0 = u.pn * 128 + wc * 32 + 8 * fq;
        float rsv[2][4]; row_rstd8(RT, u.ui, wr, fr, rsv);
#pragma unroll
        for (int ai = 0; ai < 2; ++ai)
#pragma unroll
            for (int m = 0; m < 4; ++m) {
                const int row = row0 + ai * 128 + m * 16;
                const float rs = rsv[ai][m];
                const f32x4 g0 = acc[ai][0][m][0] * rs, g1 = acc[ai][0][m][1] * rs, u0 = acc[ai][1][m][0] * rs, u1 = acc[ai][1][m][1] * rs; f32x4 v0, v1;
#pragma unroll
                for (int j = 0; j < 4; ++j) { v0[j] = silu_f(g0[j]) * u0[j]; v1[j] = silu_f(g1[j]) * u1[j]; }
                store8(ACT + (size_t)row * DFF + col0, v0, v1);
            }
    }
};

template <class Map>
DI void cvt_item(const float* src, int ld, const float* gain, bf16_t* WT, int K, int n0, int k0, const Map& mp, LAS float* scr, int lane) {
    const int nn = lane & 31; const int sc = mp.col(n0 + nn); const float scale = mp.scale(n0 + nn);
    float wv[32], gv[32];
    const float* sp = src + (size_t)(k0 + (lane >> 5)) * ld + sc;
#pragma unroll
    for (int i = 0; i < 32; ++i) { wv[i] = sp[(size_t)(2 * i) * ld]; gv[i] = gain ? gain[k0 + 2 * i + (lane >> 5)] : 1.0f; }
#pragma unroll
    for (int i = 0; i < 32; ++i) { const int kk = 2 * i + (lane >> 5); scr[kk * 33 + nn] = wv[i] * (gv[i] * scale); }
    asm volatile("s_waitcnt lgkmcnt(0)" ::: "memory");
    const int c = lane & 7;
#pragma unroll
    for (int j = 0; j < 4; ++j) { const int n = (lane >> 3) + 8 * j; const LAS float* s = scr + (8 * c) * 33 + n;
        u32x4 o; o.x = pk2(s[0 * 33], s[1 * 33]); o.y = pk2(s[2 * 33], s[3 * 33]); o.z = pk2(s[4 * 33], s[5 * 33]); o.w = pk2(s[6 * 33], s[7 * 33]);
        *(u32x4*)(WT + (size_t)(n0 + n) * K + k0 + 8 * c) = o; }
    asm volatile("s_waitcnt lgkmcnt(0)" ::: "memory");
}
struct MapId { DI int col(int n) const { return n; } DI float scale(int) const { return 1.0f; } };
struct MapInA { DI int col(int n) const { if (n >= 1024) return n; const int p = n & 127; return (n & ~127) + (p >> 1) + 64 * (p & 1); } DI float scale(int n) const { return (n >= 512 && n < 1024) ? 0.08838834764831845f : 1.0f; } };
struct MapInC { DI int col(int n) const { return n; } DI float scale(int n) const { return (n >= 512 && n < 1024) ? 0.08838834764831845f : 1.0f; } };
struct MapUp  { DI int col(int n) const { return 128 * (n >> 8) + (n & 127); } DI float scale(int) const { return 1.0f; } };

DI void p0_prologue(Frame& F) {
    LAS float* scr = (LAS float*)(F.lds + F.wave * 16384);
    const int gw = blockIdx.x * 8 + F.wave, NGW = F.G * 8;
    constexpr int I_IN = 16 * 96, I_OUT = 16 * 32, I_UP = 16 * 176, I_DOWN = 44 * 32, I_LAYER = I_IN + I_OUT + I_UP + I_DOWN;
    for (int it = gw; it < DEPTH * I_LAYER; it += NGW) {
        const int L = it / I_LAYER; int r = it % I_LAYER; const int j = L >> 1;
        if (r < I_IN) { const int kb = r / 96, nb = r % 96;
            if (L & 1) cvt_item(F.in[11] + (size_t)j * DM * CIN, CIN, F.in[1] + L * DM, W_in(F, L), DM, 32 * nb, 64 * kb, MapInC(), scr, F.lane);
            else       cvt_item(F.in[4] + (size_t)j * DM * NIN, NIN, F.in[1] + L * DM, W_in(F, L), DM, 32 * nb, 64 * kb, MapInA(), scr, F.lane);
            continue; }
        r -= I_IN;
        if (r < I_OUT) { const int kb = r / 32, nb = r % 32;
            cvt_item(((L & 1) ? F.in[12] : F.in[5]) + (size_t)j * DM * DM, DM, nullptr, W_out(F, L), DM, 32 * nb, 64 * kb, MapId(), scr, F.lane); continue; }
        r -= I_OUT;
        if (r < I_UP) { const int kb = r / 176, nb = r % 176; const int n0 = 32 * nb; const bool up = (n0 >> 7) & 1;
            cvt_item((up ? F.in[17] : F.in[16]) + (size_t)L * DM * DFF, DFF, F.in[2] + L * DM, W_up(F, L), DM, n0, 64 * kb, MapUp(), scr, F.lane); continue; }
        r -= I_UP;
        { const int kb = r / 32, nb = r % 32;
          cvt_item(F.in[18] + (size_t)L * DFF * DM, DM, nullptr, W_down(F, L), DFF, 32 * nb, 64 * kb, MapId(), scr, F.lane); }
    }
    float* SS = (float*)(F.ws + WS_SS); bf16_t* HB = (bf16_t*)(F.ws + WS_HB);
    for (int m2 = gw; m2 < MROWS / 2; m2 += NGW) {
        f32x4 v[2][4];
#pragma unroll
        for (int rr = 0; rr < 2; ++rr) { const f32x4* xr = (const f32x4*)(F.in[0] + (size_t)(2 * m2 + rr) * DM) + F.lane;
#pragma unroll
            for (int q = 0; q < 4; ++q) v[rr][q] = xr[64 * q]; }
#pragma unroll
        for (int rr = 0; rr < 2; ++rr) { const int m = 2 * m2 + rr; u32x2* br = (u32x2*)(HB + (size_t)m * DM) + F.lane; float s = 0.f;
#pragma unroll
            for (int q = 0; q < 4; ++q) { const f32x4 x = v[rr][q]; s += (x.x * x.x + x.y * x.y) + (x.z * x.z + x.w * x.w); u32x2 o; o.x = pk2(x.x, x.y); o.y = pk2(x.z, x.w); br[64 * q] = o; }
            s = wave_sum(s);
            if (F.lane < 16) SS[(size_t)m * 16 + F.lane] = (F.lane == 0) ? s : 0.f; }
    }
    const int gt = blockIdx.x * 512 + F.tid, NGT = F.G * 512;
    float* COS = (float*)(F.ws + WS_COS); float* SIN = (float*)(F.ws + WS_SIN);
    for (int e = gt; e < SEQ * 64; e += NGT) {
        const int pos = e >> 6, i = e & 63;
        const float inv = exp2f(-(float)i * (13.287712379549449f / 64.0f));
        const float ang = (float)pos * inv;
        const double a = (double)ang; const double n = rint(a * 0.15915494309189535); const float rr = (float)(a - n * 6.283185307179586);
        COS[e] = cosf(rr); SIN[e] = sinf(rr);
    }
    float* WG = (float*)(F.ws + WS_WG);
    for (int e = gt; e < 2 * 8 * DM; e += NGT) { const int j = e >> 13, c = (e >> 10) & 7, k = e & 1023;
        WG[e] = F.in[11][(size_t)j * DM * CIN + (size_t)k * CIN + 3072 + c] * F.in[1][(2 * j + 1) * DM + k]; }
    bf16_t* WM = (bf16_t*)(F.ws + WS_WM);
    for (int e = gt; e < 2 * 4 * 128 * 128; e += NGT) { const int p = (e >> 7) & 127, q = e & 127; const float w = ((q >> 6) <= (p >> 6)) ? F.in[9][e] : 0.f; WM[e] = (bf16_t)(pk2(w, 0.f) & 0xffffu); }
}

DI void gate_step(Frame& F, int L) {
    const int j = L >> 1; const int gw = blockIdx.x * 8 + F.wave, NGW = F.G * 8;
    const float* SS = (const float*)(F.ws + WS_SS); const bf16_t* HB = (const bf16_t*)(F.ws + WS_HB); const float* WG = (const float*)(F.ws + WS_WG) + j * 8 * DM;
    float* GLI = (float*)(F.ws + WS_GLI); float* GLF = (float*)(F.ws + WS_GLF);
    for (int m4 = gw; m4 < MROWS / 4; m4 += NGW) {
        u32x4 a0[4], a1[4]; float ssv[4];
#pragma unroll
        for (int rr = 0; rr < 4; ++rr) { const int m = 4 * m4 + rr; a0[rr] = *((const u32x4*)(HB + (size_t)m * DM) + F.lane); a1[rr] = *((const u32x4*)(HB + (size_t)m * DM + 512) + F.lane);
            ssv[rr] = (F.lane < 16) ? SS[(size_t)m * 16 + F.lane] : 0.f; }
#pragma unroll
        for (int rr = 0; rr < 4; ++rr) {
            const int m = 4 * m4 + rr; float x[16];
            x[0] = bflo(a0[rr].x); x[1] = bfhi(a0[rr].x); x[2] = bflo(a0[rr].y); x[3] = bfhi(a0[rr].y); x[4] = bflo(a0[rr].z); x[5] = bfhi(a0[rr].z); x[6] = bflo(a0[rr].w); x[7] = bfhi(a0[rr].w);
            x[8] = bflo(a1[rr].x); x[9] = bfhi(a1[rr].x); x[10] = bflo(a1[rr].y); x[11] = bfhi(a1[rr].y); x[12] = bflo(a1[rr].z); x[13] = bfhi(a1[rr].z); x[14] = bflo(a1[rr].w); x[15] = bfhi(a1[rr].w);
            const float ssp = wave_sum(ssv[rr]);
            const float rs = 1.0f / sqrtf(ssp * (1.0f / DM) + EPS);
            float myv = 0.f;
#pragma unroll
            for (int c = 0; c < 8; ++c) {
                const f32x4* w0 = (const f32x4*)(WG + c * DM + 8 * F.lane); const f32x4* w1 = (const f32x4*)(WG + c * DM + 512 + 8 * F.lane);
                const f32x4 wa = w0[0], wb = w0[1], wc2 = w1[0], wd = w1[1];
                float d = x[0] * wa.x + x[1] * wa.y + x[2] * wa.z + x[3] * wa.w + x[4] * wb.x + x[5] * wb.y + x[6] * wb.z + x[7] * wb.w
                        + x[8] * wc2.x + x[9] * wc2.y + x[10] * wc2.z + x[11] * wc2.w + x[12] * wd.x + x[13] * wd.y + x[14] * wd.z + x[15] * wd.w;
                d = wave_sum(d);
                if (F.lane == c) myv = d * rs;
            }
            if (F.lane < 8) {
                const int hh = F.lane & 3; const int b = m >> 12, t = m & (SEQ - 1); const size_t idx = (size_t)(b * 4 + hh) * SEQ + t;
                if (F.lane < 4) GLI[idx] = myv + F.in[13][j * 4 + hh];
                else { const float xx = myv + F.in[14][j * 4 + hh]; GLF[idx] = (xx >= 0.f) ? -log1pf(expf(-xx)) : (xx - log1pf(expf(xx))); }
            }
        }
    }
}

DI void final_norm(Frame& F) {
    const int gw = blockIdx.x * 8 + F.wave, NGW = F.G * 8; const float* SS = (const float*)(F.ws + WS_SS); const bf16_t* HB = (const bf16_t*)(F.ws + WS_HB); const f32x4* gv = (const f32x4*)F.in[3] + F.lane;
    f32x4 g[4];
#pragma unroll
    for (int q = 0; q < 4; ++q) g[q] = gv[64 * q];
    for (int m4 = gw; m4 < MROWS / 4; m4 += NGW) {
        u32x2 w[4][4]; float ssv[4];
#pragma unroll
        for (int rr = 0; rr < 4; ++rr) { const int m = 4 * m4 + rr; const u32x2* br = (const u32x2*)(HB + (size_t)m * DM) + F.lane;
#pragma unroll
            for (int q = 0; q < 4; ++q) w[rr][q] = br[64 * q];
            ssv[rr] = (F.lane < 16) ? SS[(size_t)m * 16 + F.lane] : 0.f; }
#pragma unroll
        for (int rr = 0; rr < 4; ++rr) { const int m = 4 * m4 + rr; f32x4* hr = (f32x4*)(F.H + (size_t)m * DM) + F.lane;
            const float rs = 1.0f / sqrtf(wave_sum(ssv[rr]) * (1.0f / DM) + EPS);
#pragma unroll
            for (int q = 0; q < 4; ++q) { const f32x4 v = {bflo(w[rr][q].x), bfhi(w[rr][q].x), bflo(w[rr][q].y), bfhi(w[rr][q].y)}; hr[64 * q] = v * rs * g[q]; } }
    }
}

DI int opaque(int x) { asm volatile("" : "+v"(x)); return x; }
DI int crow(int i, int h) { return (i & 3) + 8 * (i >> 2) + 4 * h; }
constexpr int QLD = 136, PLD = 72, KWLD = 160;
constexpr int QS_OFF = 0, KS_OFF = 17408, KW_OFF = 34816, VS_OFF = 55296, PS_OFF = 92160;
constexpr int SA_OFF = 101376, SCM_OFF = SA_OFF + 2048, SMT_OFF = SCM_OFF + 2048, SMISC_OFF = SMT_OFF + 2048;
constexpr int PQ_OFF = SMISC_OFF + 256, MS_OFF = PQ_OFF + 512, LS_OFF = MS_OFF + 320;
constexpr int STAT_OFF = LS_OFF + 320, NV_OFF = STAT_OFF + 4096, PSUM_OFF = NV_OFF + 512, QN_OFF = PSUM_OFF + 1024, GAIN_OFF = QN_OFF + 256, LA_END = GAIN_OFF + 1024;
static_assert(LA_END <= RING_BYTES, "mixer LDS");

DI bf16x8 gather_col(const LAS bf16_t* base, int ld, int col, int s0) {
    bf16x8 r;
#pragma unroll
    for (int j = 0; j < 8; ++j) r[j] = (short)base[(s0 + j) * ld + col];
    return r;
}
DI bf16x8 tr_frag(const LAS bf16_t* tile, int ld, int col0, int s0, int lane) {
    const int i16 = lane & 15, q = i16 >> 2, p = i16 & 3, blk = (lane >> 4) & 1, hh = lane >> 5;
    const LAS bf16_t* a = tile + (s0 + 8 * hh + q) * ld + col0 + 16 * blk + 4 * p;
    const bf16x4 lo = __builtin_amdgcn_ds_read_tr16_b64_v4i16((LAS bf16x4*)a), hi = __builtin_amdgcn_ds_read_tr16_b64_v4i16((LAS bf16x4*)(a + 4 * ld));
    return __builtin_shufflevector(lo, hi, 0, 1, 2, 3, 4, 5, 6, 7);
}
DI bf16x8 pack_acc(const f32x16& x, int s) {
    u32x4 p; p.x = pk2(x[8 * s + 0], x[8 * s + 1]); p.y = pk2(x[8 * s + 2], x[8 * s + 3]); p.z = pk2(x[8 * s + 4], x[8 * s + 5]); p.w = pk2(x[8 * s + 6], x[8 * s + 7]);
    return __builtin_bit_cast(bf16x8, p);
}
#define MFMA32(a, b, c) __builtin_amdgcn_mfma_f32_32x32x16_bf16((a), (b), (c), 0, 0, 0)
#define MFMA16(a, b, c) __builtin_amdgcn_mfma_f32_16x16x32_bf16((a), (b), (c), 0, 0, 0)

DI void mlstm_scan(Frame& F, int b, int h, int g) {
    LAS float* SA = (LAS float*)(F.lds + SA_OFF); LAS float* SCM = (LAS float*)(F.lds + SCM_OFF); LAS float* SMT = (LAS float*)(F.lds + SMT_OFF); LAS float* SM = (LAS float*)(F.lds + SMISC_OFF);
    LAS float* PQ = (LAS float*)(F.lds + PQ_OFF); LAS float* MS = (LAS float*)(F.lds + MS_OFF); LAS float* LS = (LAS float*)(F.lds + LS_OFF);
    const float* GLI = (const float*)(F.ws + WS_GLI) + (size_t)(b * 4 + h) * SEQ; const float* GLF = (const float*)(F.ws + WS_GLF) + (size_t)(b * 4 + h) * SEQ;
    const int lane = opaque(F.lane), w = F.wave;
    if (w <= g) {
        float li[8], lf[8]; const float* gli = GLI + w * 512 + lane; const float* glf = GLF + w * 512 + lane;
#pragma unroll
        for (int c = 0; c < 8; ++c) { li[c] = gli[c * 64]; lf[c] = glf[c * 64]; }
#pragma unroll
        for (int c = 0; c < 8; ++c) {
            const float bs = wave_scan<false>(lf[c]); const float a = li[c] - bs; const float cmx = wave_scan<true>(a);
            const float amax = lane63(cmx), b63 = lane63(bs);
            if (lane == 0) { PQ[(8 * w + c) * 2] = b63; PQ[(8 * w + c) * 2 + 1] = amax; }
            if (w == g) { (SA + lane)[c * 64] = a; (SCM + lane)[c * 64] = cmx; (SMT + lane)[c * 64] = bs; }
        }
    }
    __syncthreads();
    if (w == 0) {
        const bool live = lane < 8 * (g + 1);
        float P = live ? PQ[lane * 2] : 0.f; const float am = live ? PQ[lane * 2 + 1] : -3.0e38f; float Q = live ? am + P : -3.0e38f;
#define SCAN_PQ(CTRL, RM) { const float tP = __int_as_float(__builtin_amdgcn_update_dpp(0, __float_as_int(P), CTRL, RM, 0xF, false)); \
                            const float tQ = __int_as_float(__builtin_amdgcn_update_dpp(__float_as_int(-3.0e38f), __float_as_int(Q), CTRL, RM, 0xF, false)); Q = fmaxf(tQ + P, Q); P = tP + P; }
        SCAN_PQ(0x111, 0xF) SCAN_PQ(0x112, 0xF) SCAN_PQ(0x114, 0xF) SCAN_PQ(0x118, 0xF) SCAN_PQ(0x142, 0xA) SCAN_PQ(0x143, 0xC)
#undef SCAN_PQ
        const float mnext = fmaxf(P, Q);
        MS[lane + 1] = mnext; if (lane == 0) MS[0] = 0.f;
        const float mprev = MS[lane];
        const float la = live ? (mprev - fmaxf(mprev, am)) : 0.f;
        const float Linc = wave_scan<false>(la);
        LS[lane + 1] = Linc; if (lane == 0) LS[0] = 0.f;
    }
    __syncthreads();
    {
        const int i = F.tid, c = i >> 6; const float mprev = MS[8 * g + c]; const float cm = fmaxf(mprev, SCM[i]); SCM[i] = cm; SMT[i] = SMT[i] + cm;
        if (i < 8) SM[i] = MS[8 * g + i];
        if (i >= 16 && i < 25) SM[i] = LS[8 * (i - 16)];
    }
}

template <int MODE, bool PASS2> struct ChunkRegs { u32x4 k[2]; u32x4 q[PASS2 ? 2 : 1]; u32x4 v[(MODE ? 256 : 128) / 64]; };
template <int MODE, bool PASS2>
DI void la_load(ChunkRegs<MODE, PASS2>& R, const bf16_t* PROJ, int bh, int T0, int tid) {
    constexpr int DV = MODE ? 256 : 128;
    const bf16_t* Q = PROJ + ((size_t)bh * SEQ + T0) * 128; const bf16_t* K = Q + M512; const bf16_t* V = PROJ + 2 * M512 + ((size_t)bh * SEQ + T0) * DV;
#pragma unroll
    for (int i = 0; i < 2; ++i) { const int p = tid + 512 * i;
        R.k[i] = *(const u32x4*)(K + p * 8);
        if (PASS2) R.q[i] = *(const u32x4*)(Q + p * 8); }
#pragma unroll
    for (int i = 0; i < DV / 64; ++i) { const int p = tid + 512 * i; R.v[i] = *(const u32x4*)(V + p * 8); }
}
template <int MODE, bool PASS2>
DI void la_write(Frame& F, const ChunkRegs<MODE, PASS2>& R, int c, float lg2, int tid) {
    constexpr int DV = MODE ? 256 : 128, VLD = DV + 32;
    LAS bf16_t* Qs = (LAS bf16_t*)(F.lds + QS_OFF); LAS bf16_t* Ks = (LAS bf16_t*)(F.lds + KS_OFF); LAS bf16_t* Kw = (LAS bf16_t*)(F.lds + KW_OFF); LAS bf16_t* Vs = (LAS bf16_t*)(F.lds + VS_OFF);
    const LAS float* SA = (const LAS float*)(F.lds + SA_OFF); const LAS float* SCM = (const LAS float*)(F.lds + SCM_OFF);
#pragma unroll
    for (int i = 0; i < 2; ++i) { const int p = tid + 512 * i, t = p >> 4, cp = (p & 15) * 8; const u32x4 kv = R.k[i];
        float ck;
        if (MODE) ck = fexp(SA[c * 64 + t] - SCM[c * 64 + 63]); else ck = __builtin_amdgcn_exp2f(lg2 * (float)(63 - t));
        u32x4 kw; kw.x = pk2(bflo(kv.x) * ck, bfhi(kv.x) * ck); kw.y = pk2(bflo(kv.y) * ck, bfhi(kv.y) * ck); kw.z = pk2(bflo(kv.z) * ck, bfhi(kv.z) * ck); kw.w = pk2(bflo(kv.w) * ck, bfhi(kv.w) * ck);
        *(LAS u32x4*)(Kw + t * KWLD + cp) = kw;
        if (PASS2) { *(LAS u32x4*)(Ks + t * QLD + cp) = kv; *(LAS u32x4*)(Qs + t * QLD + cp) = R.q[i]; }
    }
#pragma unroll
    for (int i = 0; i < DV / 64; ++i) { const int p = tid + 512 * i, t = p / (DV / 8), cp = (p % (DV / 8)) * 8; *(LAS u32x4*)(Vs + t * VLD + cp) = R.v[i]; }
}

template <int MODE>
DI void la_pass1(Frame& F, int unit) {
    constexpr int DV = MODE ? 256 : 128, VLD = DV + 32, ND = MODE ? 4 : 2;
    const int b = unit >> 5, h = (unit >> 3) & 3, g = unit & 7, row0 = b * SEQ + g * 512;
    const int w = F.wave; int lane = F.lane, r = lane & 31, hh = lane >> 5;
    const int eb = MODE ? w : (w & 3), dt0 = MODE ? 0 : 2 * (w >> 2), e0 = 32 * eb;
    const bf16_t* PROJ = (const bf16_t*)(F.ws + WS_PROJ);
    LAS bf16_t* Kw = (LAS bf16_t*)(F.lds + KW_OFF); LAS bf16_t* Vs = (LAS bf16_t*)(F.lds + VS_OFF);
    const LAS float* SCM = (const LAS float*)(F.lds + SCM_OFF); const LAS float* SM = (const LAS float*)(F.lds + SMISC_OFF); LAS float* NV = (LAS float*)(F.lds + NV_OFF);
    const float lg2 = log2f(1.0f - exp2f(-5.0f - (float)h));
    ChunkRegs<MODE, false> R; la_load<MODE, false>(R, PROJ, b * 4 + h, g * 512, opaque(F.tid));
    if (MODE) { mlstm_scan(F, b, h, g); if (F.tid < 128) NV[F.tid] = 0.f; }
    __syncthreads();
    f32x16 C[ND];
#pragma unroll
    for (int d = 0; d < ND; ++d)
#pragma unroll
        for (int i = 0; i < 16; ++i) C[d][i] = 0.f;
    for (int c = 0; c < 8; ++c) {
        lane = opaque(F.lane); r = lane & 31; hh = lane >> 5; const int tid_o = opaque(F.tid);
        la_write<MODE, false>(F, R, c, lg2, tid_o);
        __syncthreads();
        if (c < 7) la_load<MODE, false>(R, PROJ, b * 4 + h, g * 512 + 64 * (c + 1), tid_o);
        const float alpha = MODE ? fexp(SM[c] - SCM[c * 64 + 63]) : __builtin_amdgcn_exp2f(lg2 * 64.0f);
        bf16x8 vf[4];
#pragma unroll
        for (int ks = 0; ks < 4; ++ks) vf[ks] = tr_frag(Vs, VLD, e0, 16 * ks, lane);
#pragma unroll
        for (int d = 0; d < ND; ++d) {
#pragma unroll
            for (int i = 0; i < 16; ++i) C[d][i] *= alpha;
#pragma unroll
            for (int ks = 0; ks < 4; ++ks) { const bf16x8 ka = tr_frag(Kw, KWLD, 32 * (dt0 + d), 16 * ks, lane); C[d] = MFMA32(ka, vf[ks], C[d]); }
        }
        if (MODE) {
            const int dd = 16 * w + (lane & 15), sq = lane >> 4; float s = 0.f;
#pragma unroll
            for (int q = 0; q < 16; ++q) s += bf2f(Kw[(16 * sq + q) * KWLD + dd]);
            s = sum_xor16_32(s);
            if (lane < 16) NV[dd] = alpha * NV[dd] + s;
        }
        __syncthreads();
    }
    bf16_t* T = (bf16_t*)(F.ws + WS_TST) + (size_t)unit * DV * 128;
#pragma unroll
    for (int d = 0; d < ND; ++d)
#pragma unroll
        for (int q = 0; q < 4; ++q) { u32x2 v; v.x = pk2(C[d][4 * q], C[d][4 * q + 1]); v.y = pk2(C[d][4 * q + 2], C[d][4 * q + 3]);
            *(u32x2*)(T + (size_t)(e0 + r) * 128 + 32 * (dt0 + d) + 8 * q + 4 * hh) = v; }
    if (MODE && F.tid < 128) ((float*)(F.ws + WS_NST))[unit * 128 + F.tid] = NV[F.tid];
    __syncthreads();
}

template <int MODE>
DI void la_pass2(Frame& F, int unit, int j) {
    constexpr int DV = MODE ? 256 : 128, VLD = DV + 32, NT = MODE ? 2 : 1;
    const int b = unit >> 5, h = (unit >> 3) & 3, g = unit & 7, row0 = b * SEQ + g * 512;
    const int w = F.wave; int lane = F.lane, r = lane & 31, hh = lane >> 5, r16 = lane & 15, q4 = lane >> 4;
    const int eb = MODE ? w : (w & 3), tb0 = MODE ? 0 : (w >> 2), e0 = 32 * eb;
    const int ocol = DV * h;
    const bf16_t* PROJ = (const bf16_t*)(F.ws + WS_PROJ); bf16_t* MIX = (bf16_t*)(F.ws + WS_MIX);
    const bf16_t* GATE = PROJ + (MODE ? 4 : 3) * M512 + (size_t)(b * 4 + h) * SEQ * DV;
    const float* gain = MODE ? (F.in[15] + (j * 4 + h) * 256) : (F.in[6] + (j * 4 + h) * 128);
    LAS bf16_t* Qs = (LAS bf16_t*)(F.lds + QS_OFF); LAS bf16_t* Ks = (LAS bf16_t*)(F.lds + KS_OFF); LAS bf16_t* Kw = (LAS bf16_t*)(F.lds + KW_OFF); LAS bf16_t* Vs = (LAS bf16_t*)(F.lds + VS_OFF); LAS bf16_t* Ps = (LAS bf16_t*)(F.lds + PS_OFF);
    const LAS float* SA = (const LAS float*)(F.lds + SA_OFF); const LAS float* SCM = (const LAS float*)(F.lds + SCM_OFF); const LAS float* SMT = (const LAS float*)(F.lds + SMT_OFF); const LAS float* SM = (const LAS float*)(F.lds + SMISC_OFF);
    LAS float* STAT = (LAS float*)(F.lds + STAT_OFF); LAS float* NV = (LAS float*)(F.lds + NV_OFF); LAS float* PSUM = (LAS float*)(F.lds + PSUM_OFF); LAS float* QN = (LAS float*)(F.lds + QN_OFF);
    const float lg2 = log2f(1.0f - exp2f(-5.0f - (float)h));
    ChunkRegs<MODE, true> R; la_load<MODE, true>(R, PROJ, b * 4 + h, g * 512, opaque(F.tid));
    LAS float* GAIN = (LAS float*)(F.lds + GAIN_OFF); if (F.tid < DV) GAIN[F.tid] = gain[F.tid];
    if (MODE) mlstm_scan(F, b, h, g);
    __syncthreads();
    f32x16 C[4];
#pragma unroll
    for (int d = 0; d < 4; ++d)
#pragma unroll
        for (int i = 0; i < 16; ++i) C[d][i] = 0.f;
    float nacc = 0.f;
    for (int gp = 0; gp < g; ++gp) {
        const float coef = MODE ? fexp(SM[16 + g] - SM[16 + gp + 1]) : __builtin_amdgcn_exp2f(lg2 * (float)(512 * (g - 1 - gp)));
        const bf16_t* T = (const bf16_t*)(F.ws + WS_TST) + (size_t)(unit - g + gp) * DV * 128 + (size_t)(e0 + r) * 128 + 4 * hh;
        u32x2 tv[4][4];
#pragma unroll
        for (int d = 0; d < 4; ++d)
#pragma unroll
            for (int q = 0; q < 4; ++q) tv[d][q] = *(const u32x2*)(T + 32 * d + 8 * q);
#pragma unroll
        for (int d = 0; d < 4; ++d)
#pragma unroll
            for (int q = 0; q < 4; ++q) { const u32x2 v = tv[d][q];
                C[d][4 * q] += coef * bflo(v.x); C[d][4 * q + 1] += coef * bfhi(v.x); C[d][4 * q + 2] += coef * bflo(v.y); C[d][4 * q + 3] += coef * bfhi(v.y); }
        if (MODE && F.tid < 128) nacc += coef * ((const float*)(F.ws + WS_NST))[(unit - g + gp) * 128 + F.tid];
    }
    if (MODE && F.tid < 128) NV[F.tid] = nacc;
    for (int c = 0; c < 8; ++c) {
        const int R0 = row0 + 64 * c;
        lane = opaque(F.lane); r = lane & 31; hh = lane >> 5; r16 = lane & 15; q4 = lane >> 4; const int tid_o = opaque(F.tid);
        la_write<MODE, true>(F, R, c, lg2, tid_o);
        if (SDUP & 1) { asm volatile("" ::: "memory"); la_write<MODE, true>(F, R, c, lg2, tid_o); }
        __syncthreads();
        if (SDUP & 16) __syncthreads();
        if (c < 7) la_load<MODE, true>(R, PROJ, b * 4 + h, g * 512 + 64 * (c + 1), tid_o);
        u32x2 gt[NT][4];
#pragma unroll
        for (int tt = 0; tt < NT; ++tt)
#pragma unroll
            for (int q = 0; q < 4; ++q) gt[tt][q] = *(const u32x2*)(GATE + (size_t)(g * 512 + 64 * c + 32 * (tb0 + tt) + r) * DV + e0 + 8 * q + 4 * hh);
        for (int srep = 0; srep < ((SDUP & 2) ? 2 : 1); ++srep) {
        if (srep) asm volatile("" ::: "memory");
#pragma unroll
        for (int i = 0; i < 2; ++i) {
            const int tt = 2 * w + i, si = tt >> 2, ti = tt & 3;
            f32x4 x = {0.f, 0.f, 0.f, 0.f};
#pragma unroll
            for (int kk = 0; kk < 4; ++kk) { const bf16x8 ka = *(const LAS bf16x8*)(Ks + (16 * si + r16) * QLD + 32 * kk + 8 * q4); const bf16x8 qb = *(const LAS bf16x8*)(Qs + (16 * ti + r16) * QLD + 32 * kk + 8 * q4); x = MFMA16(ka, qb, x); }
            const int t = 16 * ti + r16; float p[4];
#pragma unroll
            for (int q = 0; q < 4; ++q) { const int s = 16 * si + 4 * q4 + q; float wgt;
                if (MODE) wgt = (s <= t) ? fexp(SA[c * 64 + s] - SCM[c * 64 + t]) : 0.f;
                else { const int dlt = t > s ? t - s : s - t; wgt = __builtin_amdgcn_exp2f(lg2 * (float)dlt); }
                p[q] = x[q] * wgt; }
            u32x2 pw; pw.x = pk2(p[0], p[1]); pw.y = pk2(p[2], p[3]);
            *(LAS u32x2*)(Ps + t * PLD + 16 * si + 4 * q4) = pw;
            if (MODE) { float cs = (bflo(pw.x) + bfhi(pw.x)) + (bflo(pw.y) + bfhi(pw.y)); cs = sum_xor16_32(cs); if (q4 == 0) PSUM[si * 64 + t] = cs; }
        }
        if (MODE) {
            const int t = 8 * w + (lane >> 3), part = lane & 7;
            const u32x4 qa = *(const LAS u32x4*)(Qs + t * QLD + 16 * part), qb2 = *(const LAS u32x4*)(Qs + t * QLD + 16 * part + 8);
            const f32x4 n0 = *(const LAS f32x4*)(NV + 16 * part), n1 = *(const LAS f32x4*)(NV + 16 * part + 4), n2 = *(const LAS f32x4*)(NV + 16 * part + 8), n3 = *(const LAS f32x4*)(NV + 16 * part + 12);
            float qn = bflo(qa.x) * n0.x + bfhi(qa.x) * n0.y + bflo(qa.y) * n0.z + bfhi(qa.y) * n0.w + bflo(qa.z) * n1.x + bfhi(qa.z) * n1.y + bflo(qa.w) * n1.z + bfhi(qa.w) * n1.w
                     + bflo(qb2.x) * n2.x + bfhi(qb2.x) * n2.y + bflo(qb2.y) * n2.z + bfhi(qb2.y) * n2.w + bflo(qb2.z) * n3.x + bfhi(qb2.z) * n3.y + bflo(qb2.w) * n3.z + bfhi(qb2.w) * n3.w;
            qn += dpp_f<0xB1>(qn); qn += dpp_f<0x4E>(qn); qn += dpp_f<0x141>(qn);
            if (part == 0) QN[t] = qn;
        }
        }
        __syncthreads();
        if (SDUP & 16) __syncthreads();
        bf16x8 vf[4];
#pragma unroll
        for (int ks = 0; ks < 4; ++ks) vf[ks] = tr_frag(Vs, VLD, e0, 16 * ks, lane);
        float cqv[NT], rinvv[NT];
#pragma unroll
        for (int tt = 0; tt < NT; ++tt) {
            const int t = 32 * (tb0 + tt) + r;
            if (MODE) {
                const float cq = fexp(SM[c] - SCM[c * 64 + t]);
                const float den = ((PSUM[t] + PSUM[64 + t]) + (PSUM[128 + t] + PSUM[192 + t])) + cq * QN[t];
                cqv[tt] = cq; rinvv[tt] = 1.0f / fmaxf(fabsf(den), fexp(-SMT[c * 64 + t]));
            } else { cqv[tt] = __builtin_amdgcn_exp2f(lg2 * (float)(t + 1)); rinvv[tt] = 1.f; }
        }
        f32x16 o2[NT], val[NT];
        for (int orep = 0; orep < ((SDUP & 4) ? 2 : 1); ++orep) {
        if (orep) asm volatile("" ::: "memory");
#pragma unroll
        for (int tt = 0; tt < NT; ++tt)
#pragma unroll
            for (int i = 0; i < 16; ++i) { o2[tt][i] = 0.f; val[tt][i] = 0.f; }
#pragma unroll
        for (int d = 0; d < 4; ++d) {
#pragma unroll
            for (int s2 = 0; s2 < 2; ++s2) { const bf16x8 ca = pack_acc(C[d], s2);
#pragma unroll
                for (int tt = 0; tt < NT; ++tt) { const int t = 32 * (tb0 + tt) + r;
                    const bf16x4 qlo = *(const LAS bf16x4*)(Qs + t * QLD + 32 * d + 16 * s2 + 4 * hh), qhi = *(const LAS bf16x4*)(Qs + t * QLD + 32 * d + 16 * s2 + 4 * hh + 8);
                    const bf16x8 qb = __builtin_shufflevector(qlo, qhi, 0, 1, 2, 3, 4, 5, 6, 7);
                    o2[tt] = MFMA32(ca, qb, o2[tt]); } }
            __builtin_amdgcn_sched_barrier(0);
        }
#pragma unroll
        for (int tt = 0; tt < NT; ++tt) { const int t = 32 * (tb0 + tt) + r;
#pragma unroll
            for (int ks = 0; ks < 4; ++ks) { const bf16x8 pb = *(const LAS bf16x8*)(Ps + t * PLD + 16 * ks + 8 * hh); val[tt] = MFMA32(vf[ks], pb, val[tt]); } }
#pragma unroll
        for (int tt = 0; tt < NT; ++tt) { const int t = 32 * (tb0 + tt) + r;
            float s1 = 0.f, s2s = 0.f;
#pragma unroll
            for (int i = 0; i < 16; ++i) { const float v = (val[tt][i] + cqv[tt] * o2[tt][i]) * rinvv[tt]; val[tt][i] = v; s1 += v; s2s += v * v; }
            s1 = sum_xor32(s1); s2s = sum_xor32(s2s);
            if (hh == 0) { STAT[(w * 64 + t) * 2] = s1; STAT[(w * 64 + t) * 2 + 1] = s2s; }
        }
        }
        __syncthreads();
        if (SDUP & 16) __syncthreads();
        for (int frep = 0; frep < ((SDUP & 8) ? 2 : 1); ++frep) {
        if (frep) asm volatile("" ::: "memory");
#pragma unroll
        for (int tt = 0; tt < NT; ++tt) {
            const int t = 32 * (tb0 + tt) + r; float S1 = 0.f, S2 = 0.f;
#pragma unroll
            for (int ww = 0; ww < (MODE ? 8 : 4); ++ww) { const int wi = MODE ? ww : (4 * tb0 + ww); S1 += STAT[(wi * 64 + t) * 2]; S2 += STAT[(wi * 64 + t) * 2 + 1]; }
            const float mean = S1 * (1.0f / DV); const float var = fmaxf(S2 * (1.0f / DV) - mean * mean, 0.f); const float rs = 1.0f / sqrtf(var + EPS);
            const size_t rowoff = (size_t)(R0 + t);
#pragma unroll
            for (int q = 0; q < 4; ++q) { const int e = e0 + 8 * q + 4 * hh;
                const f32x4 gn = *(const LAS f32x4*)(GAIN + e); const u32x2 gtv = gt[tt][q];
                const float y0 = (val[tt][4 * q] - mean) * rs * gn.x * bflo(gtv.x), y1 = (val[tt][4 * q + 1] - mean) * rs * gn.y * bfhi(gtv.x);
                const float y2 = (val[tt][4 * q + 2] - mean) * rs * gn.z * bflo(gtv.y), y3 = (val[tt][4 * q + 3] - mean) * rs * gn.w * bfhi(gtv.y);
                u32x2 o; o.x = pk2(y0, y1); o.y = pk2(y2, y3); *(u32x2*)(MIX + rowoff * DM + ocol + e) = o; }
        }
        }
        __builtin_amdgcn_sched_barrier(0);
        const float alpha = MODE ? fexp(SM[c] - SCM[c * 64 + 63]) : __builtin_amdgcn_exp2f(lg2 * 64.0f);
#pragma unroll
        for (int d = 0; d < 4; ++d) {
#pragma unroll
            for (int i = 0; i < 16; ++i) C[d][i] *= alpha;
#pragma unroll
            for (int ks = 0; ks < 4; ++ks) { const bf16x8 ka = tr_frag(Kw, KWLD, 32 * d, 16 * ks, lane); C[d] = MFMA32(ka, vf[ks], C[d]); }
        }
        if (SDUP & 64) {
            f32x16 dm;
#pragma unroll
            for (int i = 0; i < 16; ++i) dm[i] = 0.f;
            asm volatile("" ::: "memory");
#pragma unroll
            for (int d = 0; d < 4; ++d)
#pragma unroll
                for (int ks = 0; ks < 4; ++ks) { const bf16x8 ka = tr_frag(Kw, KWLD, 32 * d, 16 * ks, lane); dm = MFMA32(ka, vf[ks], dm); }
            asm volatile("" :: "v"(dm));
        }
        if (SDUP & 128) {
            f32x16 dm;
#pragma unroll
            for (int i = 0; i < 16; ++i) dm[i] = 0.f;
            asm volatile("" ::: "memory");
#pragma unroll
            for (int d = 0; d < 4; ++d)
#pragma unroll
                for (int s2 = 0; s2 < 2; ++s2) { const bf16x8 ca = pack_acc(C[d], s2);
#pragma unroll
                    for (int tt = 0; tt < NT; ++tt) { const int t = 32 * (tb0 + tt) + r;
                        const bf16x4 qlo = *(const LAS bf16x4*)(Qs + t * QLD + 32 * d + 16 * s2 + 4 * hh), qhi = *(const LAS bf16x4*)(Qs + t * QLD + 32 * d + 16 * s2 + 4 * hh + 8);
                        const bf16x8 qb = __builtin_shufflevector(qlo, qhi, 0, 1, 2, 3, 4, 5, 6, 7);
                        dm = MFMA32(ca, qb, dm); } }
            asm volatile("" :: "v"(dm));
        }
        if (MODE) {
            const int dd = 16 * w + (lane & 15), sq = lane >> 4; float s = 0.f;
#pragma unroll
            for (int q = 0; q < 16; ++q) s += bf2f(Kw[(16 * sq + q) * KWLD + dd]);
            s = sum_xor16_32(s);
            if (lane < 16) NV[dd] = alpha * NV[dd] + s;
        }
        __syncthreads();
        if (SDUP & 16) __syncthreads();
    }
}

constexpr int VN_OFF = 0, SGST_OFF = 34816;
DI void sgu_unit(Frame& F, int unit, int j) {
    const int row0 = unit * 128; const int w = F.wave; int lane = F.lane, r = lane & 31, hh = lane >> 5;
    const bf16_t* PROJ = (const bf16_t*)(F.ws + WS_PROJ); bf16_t* MIX = (bf16_t*)(F.ws + WS_MIX);
    LAS bf16_t* Vn = (LAS bf16_t*)(F.lds + VN_OFF); LAS float* ST = (LAS float*)(F.lds + SGST_OFF);
    const float* lng = F.in[7] + j * 512; const float* lnb = F.in[8] + j * 512;
    {
        u32x4 vv[16];
#pragma unroll
        for (int i = 0; i < 16; ++i) vv[i] = *((const u32x4*)(PROJ + 5 * M512 + (size_t)(row0 + 16 * w + i) * 512) + lane);
#pragma unroll
        for (int i = 0; i < 16; ++i) { const int p = 16 * w + i; const u32x4 v = vv[i];
            const float x0 = bflo(v.x), x1 = bfhi(v.x), x2 = bflo(v.y), x3 = bfhi(v.y), x4 = bflo(v.z), x5 = bfhi(v.z), x6 = bflo(v.w), x7 = bfhi(v.w);
            float s = ((x0 + x1) + (x2 + x3)) + ((x4 + x5) + (x6 + x7)); s = wave_sum(s); const float mean = s * (1.0f / 512.0f);
            const float d0 = x0 - mean, d1 = x1 - mean, d2 = x2 - mean, d3 = x3 - mean, d4 = x4 - mean, d5 = x5 - mean, d6 = x6 - mean, d7 = x7 - mean;
            float q = ((d0 * d0 + d1 * d1) + (d2 * d2 + d3 * d3)) + ((d4 * d4 + d5 * d5) + (d6 * d6 + d7 * d7)); q = wave_sum(q);
            if (lane == 0) { ST[2 * p] = mean; ST[2 * p + 1] = 1.0f / sqrtf(q * (1.0f / 512.0f) + EPS); } }
    }
    __syncthreads();
    const int dtl = w & 3, pt0 = 2 * (w >> 2);
    for (int gq = 0; gq < 4; ++gq) {
        lane = opaque(F.lane); r = lane & 31; hh = lane >> 5; const int tid_o = opaque(F.tid);
#pragma unroll
        for (int i = 0; i < 4; ++i) { const int pc = tid_o + 512 * i, q = pc >> 4, cp = (pc & 15) * 8; const int col = 128 * gq + cp;
            const u32x4 v = *(const u32x4*)(PROJ + 5 * M512 + (size_t)(row0 + q) * 512 + col); const float mean = ST[2 * q], rs = ST[2 * q + 1];
            const f32x4 g0 = *(const f32x4*)(lng + col), g1 = *(const f32x4*)(lng + col + 4), b0 = *(const f32x4*)(lnb + col), b1 = *(const f32x4*)(lnb + col + 4);
            u32x4 o; o.x = pk2((bflo(v.x) - mean) * rs * g0.x + b0.x, (bfhi(v.x) - mean) * rs * g0.y + b0.y); o.y = pk2((bflo(v.y) - mean) * rs * g0.z + b0.z, (bfhi(v.y) - mean) * rs * g0.w + b0.w);
            o.z = pk2((bflo(v.z) - mean) * rs * g1.x + b1.x, (bfhi(v.z) - mean) * rs * g1.y + b1.y); o.w = pk2((bflo(v.w) - mean) * rs * g1.z + b1.z, (bfhi(v.w) - mean) * rs * g1.w + b1.w);
            *(LAS u32x4*)(Vn + q * QLD + cp) = o; }
        __syncthreads();
        const bf16_t* WM = (const bf16_t*)(F.ws + WS_WM) + (size_t)(j * 4 + gq) * 128 * 128;
        unsigned short uv[2][16];
#pragma unroll
        for (int pt = 0; pt < 2; ++pt)
#pragma unroll
            for (int i = 0; i < 16; ++i) uv[pt][i] = PROJ[4 * M512 + (size_t)(row0 + 32 * (pt0 + pt) + crow(i, hh)) * 512 + 128 * gq + 32 * dtl + r];
        f32x16 acc[2];
#pragma unroll
        for (int i = 0; i < 16; ++i) { acc[0][i] = 0.f; acc[1][i] = 0.f; }
#pragma unroll
        for (int ks = 0; ks < 8; ++ks) { const bf16x8 vb = gather_col(Vn, QLD, 32 * dtl + r, 16 * ks + 8 * hh);
#pragma unroll
            for (int pt = 0; pt < 2; ++pt) { const bf16x8 wa = *(const bf16x8*)(WM + (size_t)(32 * (pt0 + pt) + r) * 128 + 16 * ks + 8 * hh); acc[pt] = MFMA32(wa, vb, acc[pt]); } }
        const float* bs = F.in[10] + (j * 4 + gq) * 128;
#pragma unroll
        for (int pt = 0; pt < 2; ++pt)
#pragma unroll
            for (int i = 0; i < 16; ++i) { const int p = 32 * (pt0 + pt) + crow(i, hh); const int col = 128 * gq + 32 * dtl + r;
                MIX[(size_t)(row0 + p) * DM + 512 + col] = (bf16_t)(pk2(bf2f(uv[pt][i]) * (acc[pt][i] + bs[p]), 0.f) & 0xffffu); if ((i & 3) == 3) asm volatile("" ::: "memory"); }
        __syncthreads();
    }
}

struct Args { const float* in[19]; float* out; unsigned char* ws; int ph_lo, ph_hi; };
__global__ void __launch_bounds__(512, 2) fwd(Args args) {
    extern __shared__ __attribute__((aligned(16))) unsigned char lds_raw[];
    Frame F;
    F.lds = (LAS unsigned char*)lds_raw;
    const int wave_s = __builtin_amdgcn_readfirstlane(threadIdx.x >> 6);
    F.tid = threadIdx.x; F.lane = F.tid & 63; F.wave = wave_s; F.G = gridDim.x;
    F.in = (const float* const __attribute__((address_space(4)))*)__builtin_amdgcn_kernarg_segment_ptr();
    F.H = args.out; F.ws = args.ws;
    volatile LAS unsigned* MISC = (volatile LAS unsigned*)(F.lds + LDSCTL_OFF);
    if (F.tid < 64) MISC[F.tid] = 0u;
    __syncthreads();
    if (ONE_LAUNCH) (void)xcd_barrier_post((unsigned*)(F.ws + WS_CTL), MISC + 8, F.tid);
    const int lo = ONE_LAUNCH ? 0 : args.ph_lo, hi = ONE_LAUNCH ? NPHASE : args.ph_hi;
#define IN(k) (lo <= (k) && (k) < hi)
#define REFRESH() do { F.lane = opaque((int)__builtin_amdgcn_mbcnt_hi(~0u, __builtin_amdgcn_mbcnt_lo(~0u, 0u))); F.wave = wave_s; F.tid = wave_s * 64 + F.lane; \
        { unsigned long long z_ = 0ull; asm volatile("" : "+s"(z_)); F.ws = args.ws + z_; } } while (0)
#define SEAM(k) do { if (ONE_LAUNCH && IN((k) + 1)) { REFRESH(); XcdBarrier bb_; bb_.bar = (unsigned*)(F.ws + WS_CTL); bb_.x = xb_xcc_id(); bb_.st = (volatile LAS unsigned*)(F.lds + LDSCTL_OFF) + 8; xcd_barrier(bb_, F.tid); if (DUP_MASK & 4096) xcd_barrier(bb_, F.tid); } } while (0)
#define SS ((const float*)(F.ws + WS_SS))
#define HB ((bf16_t*)(F.ws + WS_HB))
#define MIX ((bf16_t*)(F.ws + WS_MIX))
#define PROJ ((bf16_t*)(F.ws + WS_PROJ))

    if ((PH_MASK & 1) && IN(0)) { REPS(1) { REFRESH(); p0_prologue(F); } SEAM(0); }
    for (int L = 0; L < DEPTH; ++L) {
        const int pb = 1 + 6 * L, j = L >> 1;
        if (IN(pb)) {
            REFRESH();
            pg8::Gemm g{HB, W_in(F, L), MROWS, NIN, DM}; pg8::StaticOrder S; S.init(MROWS, NIN, F.G, (int)blockIdx.x);
            if (L & 1) { if (PH_MASK & 2) REPS(2) { rstd_table(F, S, SS); EpiInC E{PROJ, (const LAS float*)(F.lds + RSTD_OFF)}; pg8::gemm_phase<EpiInC, pg8::StaticOrder, GEMM_ALIGN, GEMM_SP2>(F.lds, g, S, E, F.tid); } if (PH_MASK & 4) gate_step(F, L); }
            else if (PH_MASK & 8) REPS(8) { rstd_table(F, S, SS); EpiInA E{PROJ, (const LAS float*)(F.lds + RSTD_OFF), (const float*)(F.ws + WS_COS), (const float*)(F.ws + WS_SIN)}; pg8::gemm_phase<EpiInA, pg8::StaticOrder, GEMM_ALIGN, GEMM_SP2>(F.lds, g, S, E, F.tid); }
            SEAM(pb);
        }
        if (IN(pb + 1)) {
            REFRESH();
            for (int u = blockIdx.x; u < 256; u += F.G) { if (L & 1) { if (PH_MASK & 16) REPS(16) la_pass1<1>(F, u); } else { if (PH_MASK & 32) REPS(32) la_pass1<0>(F, u); if (PH_MASK & 64) REPS(64) sgu_unit(F, u, j); } }
            SEAM(pb + 1);
        }
        if (IN(pb + 2)) {
            REFRESH();
            for (int u = blockIdx.x; u < 256; u += F.G) { if (L & 1) { if (PH_MASK & 128) REPS(128) la_pass2<1>(F, u, j); } else { if (PH_MASK & 256) REPS(256) la_pass2<0>(F, u, j); } }
            SEAM(pb + 2);
        }
        if (IN(pb + 3)) {
            REFRESH();
            pg8::Gemm g{MIX, W_out(F, L), MROWS, DM, DM}; pg8::StaticOrder S; S.init(MROWS, DM, F.G, (int)blockIdx.x);
            if (PH_MASK & 512) for (int rep_ = 0; rep_ < ((DUP_MASK & 512) ? 3 : 1); ++rep_) { EpiRes E{HB, (float*)(F.ws + WS_SS), (rep_ == 1) ? -1.f : 1.f}; pg8::gemm_phase<EpiRes, pg8::StaticOrder, GEMM_ALIGN, GEMM_SP2>(F.lds, g, S, E, F.tid); if (ONE_LAUNCH && rep_ + 1 < ((DUP_MASK & 512) ? 3 : 1)) { REFRESH(); XcdBarrier bb_; bb_.bar = (unsigned*)(F.ws + WS_CTL); bb_.x = xb_xcc_id(); bb_.st = (volatile LAS unsigned*)(F.lds + LDSCTL_OFF) + 8; xcd_barrier(bb_, F.tid); } }
            SEAM(pb + 3);
        }
        if (IN(pb + 4)) {
            REFRESH();
            pg8::Gemm g{HB, W_up(F, L), MROWS, NUP, DM}; pg8::StaticOrder S; S.init(MROWS, NUP, F.G, (int)blockIdx.x);
            if (PH_MASK & 1024) REPS(1024) { rstd_table(F, S, SS); EpiSwiGLU E{PROJ, (const LAS float*)(F.lds + RSTD_OFF)}; pg8::gemm_phase<EpiSwiGLU, pg8::StaticOrder, GEMM_ALIGN, GEMM_SP2>(F.lds, g, S, E, F.tid); }
            SEAM(pb + 4);
        }
        if (IN(pb + 5)) {
            REFRESH();
            pg8::Gemm g{PROJ, W_down(F, L), MROWS, DM, DFF}; pg8::StaticOrder S; S.init(MROWS, DM, F.G, (int)blockIdx.x);
            if (PH_MASK & 2048) for (int rep_ = 0; rep_ < ((DUP_MASK & 2048) ? 3 : 1); ++rep_) { EpiRes E{HB, (float*)(F.ws + WS_SS), (rep_ == 1) ? -1.f : 1.f}; pg8::gemm_phase<EpiRes, pg8::StaticOrder, GEMM_ALIGN, GEMM_SP2>(F.lds, g, S, E, F.tid); if (ONE_LAUNCH && rep_ + 1 < ((DUP_MASK & 2048) ? 3 : 1)) { REFRESH(); XcdBarrier bb_; bb_.bar = (unsigned*)(F.ws + WS_CTL); bb_.x = xb_xcc_id(); bb_.st = (volatile LAS unsigned*)(F.lds + LDSCTL_OFF) + 8; xcd_barrier(bb_, F.tid); } }
            SEAM(pb + 5);
        }
    }
    if ((PH_MASK & 4096) && IN(NPHASE - 1)) { REFRESH(); final_norm(F); }
#undef IN
#undef SEAM
#undef REFRESH
#undef SS
#undef HB
#undef MIX
#undef PROJ
}

extern "C" void kernel_launch(void* const* d_in, const int* in_sizes, int n_in, void* d_out, int out_size, void* d_ws, size_t ws_size, hipStream_t stream) {
    static int grid = 0;
    if (grid == 0) {
        if (n_in != 19 || out_size != MROWS * DM || ws_size < WS_END) { fprintf(stderr, "kernel_launch: unexpected problem shape (n_in %d, out %d, ws %zu)\n", n_in, out_size, ws_size); grid = -1; return; }
        int dev = 0, cus = 0, per_cu = 0;
        if (hipGetDevice(&dev) != hipSuccess || hipDeviceGetAttribute(&cus, hipDeviceAttributeMultiprocessorCount, dev) != hipSuccess) { grid = -1; return; }
        if (hipFuncSetAttribute((const void*)fwd, hipFuncAttributeMaxDynamicSharedMemorySize, LDS_BYTES) != hipSuccess) { fprintf(stderr, "kernel_launch: hipFuncSetAttribute failed\n"); grid = -1; return; }
        if (hipOccupancyMaxActiveBlocksPerMultiprocessor(&per_cu, (const void*)fwd, 512, LDS_BYTES) != hipSuccess || per_cu < 1) { fprintf(stderr, "kernel_launch: occupancy query says %d\n", per_cu); (void)hipGetLastError(); grid = -1; return; }
        grid = cus;
    }
    if (grid < 0) return;
    (void)hipMemsetAsync((char*)d_ws + WS_CTL, 0, CTL_ZERO_BYTES, stream);
    Args a{};
    for (int i = 0; i < 19; ++i) a.in[i] = (const float*)d_in[i];
    a.out = (float*)d_out; a.ws = (unsigned char*)d_ws;
    if (ONE_LAUNCH) { a.ph_lo = 0; a.ph_hi = NPHASE; hipLaunchKernelGGL(fwd, dim3(grid), dim3(512), LDS_BYTES, stream, a); }
    else for (int p = 0; p < NPHASE; ++p) { a.ph_lo = p; a.ph_hi = p + 1; hipLaunchKernelGGL(fwd, dim3(grid), dim3(512), LDS_BYTES, stream, a); }
}
```

```cpp
#include <hip/hip_runtime.h>
#include <cstdio>
#include <cstdint>

#ifndef PH_MASK
#define PH_MASK 8191
#endif
#ifndef DUP_MASK
#define DUP_MASK 0
#endif
#define REPS(bit) for (int rep_ = 0; rep_ < ((DUP_MASK & (bit)) ? 2 : 1); ++rep_)
#ifndef DEFER_WEIGHTS
#define DEFER_WEIGHTS 1
#endif
#ifndef GEMM_ALIGN
#define GEMM_ALIGN true
#endif
#ifndef GEMM_SP2
#define GEMM_SP2 true
#endif
#ifndef ONE_LAUNCH
#define ONE_LAUNCH 1
#endif

#ifndef SDUP
#define SDUP 0
#endif
namespace pg8 {
#define PG8_LAS __attribute__((address_space(3)))
typedef unsigned short bf16_t;
typedef short bf16x8 __attribute__((ext_vector_type(8)));
typedef float f32x4 __attribute__((ext_vector_type(4)));
typedef unsigned u32x4 __attribute__((ext_vector_type(4)));
constexpr int BM = 256, BK = 64, HALF = 128, HTB = HALF * BK * 2  , STAGE_BYTES = 8 * HTB, NXCD = 8, WGM = 8;

__host__ __device__ __forceinline__ int lds_byte(int r, int c) { const int st = (r >> 4) * 2 + (c >> 5), rr = r & 15, cc = c & 31, ob = rr * 64 + cc * 2; return st * 1024 + (ob ^ (((ob >> 9) & 1) << 5)); }
__host__ __device__ __forceinline__ void stage_rc(int b, int& R, int& C) { const int st = b / 1024, sb = b % 1024, swz = sb ^ (((sb >> 9) & 1) << 5); R = (st >> 1) * 16 + swz / 64; C = (st & 1) * 32 + (swz % 64) / 2; }
__host__ __device__ __forceinline__ int perm32(int rho) { const int n = rho >> 4, i = rho & 15; return 8 * (i >> 2) + 4 * n + (i & 3); }

struct Unit { int pm, pn, ui; };
struct Gemm { const bf16_t* A; const bf16_t* Bt; int M, N, K; };

struct StaticOrder {
    int nM, nN, nwg, G, c;
    __host__ __device__ void init(int M, int N, int G_, int c_) { nM = M / BM; nN = N / BM; nwg = nM * nN; G = G_; c = c_; }
    __host__ __device__ bool next(int i, Unit& u) const {
        const long L = (long)i * G + c; if (L >= nwg) return false;
        int wgid = (int)L; { const int q = nwg / NXCD, r = nwg % NXCD, xcd = wgid % NXCD, off = wgid / NXCD; wgid = (xcd < r ? xcd * (q + 1) : r * (q + 1) + (xcd - r) * q) + off; }
        const int nig = WGM * nN, gid = wgid / nig, fm = gid * WGM, gsz = (nM - fm) < WGM ? (nM - fm) : WGM;
        u.pm = fm + ((wgid % nig) % gsz); u.pn = (wgid % nig) / gsz; u.ui = i; return true;
    }
    __device__ __forceinline__ void a_ready(const Unit&) const {}
    __device__ __forceinline__ void done(const Unit&) const {}
};

template <class Epi, class Sched, bool ALIGN_EPI = false, bool SP2 = false>
__device__ __forceinline__ void gemm_phase(PG8_LAS unsigned char* lds, const Gemm g, const Sched& S, const Epi& E, int tid_) {
    asm volatile("" : "+v"(tid_));
    const int tid = tid_, wid = __builtin_amdgcn_readfirstlane(tid >> 6), lane = tid & 63, wr = wid >> 2, wc = wid & 3, fr = lane & 15, fq = lane >> 4;
    const int K = g.K, nt = K / BK;
    unsigned voffA[2], voffB[2];
#pragma unroll
    for (int i = 0; i < 2; ++i) { int R, C; stage_rc(tid * 16 + i * 8192, R, C); const int Rb = Epi::PERM ? ((R & ~31) + perm32(R & 31)) : R;
        voffA[i] = (unsigned)(R * K + C) * 2u; voffB[i] = (unsigned)(Rb * K + C) * 2u; }
    const size_t kstep = (size_t)(BK * 2);
    const size_t hstep = (size_t)HALF * K * 2;
    const size_t tstep = 2 * hstep;
    const unsigned ldsw = (unsigned)wid * 1024u;
    const int aoff = lds_byte(wr * 64 + fr, fq * 8), boff = lds_byte(wc * 32 + fr, fq * 8);
#define PG8_SA(b, h) (((b) * 2 + (h)) * HTB)
#define PG8_SB(b, h) ((4 + (b) * 2 + (h)) * HTB)
#define PG8_STAGE(bufoff, gbase, voff) do { _Pragma("unroll") for (int _i = 0; _i < 2; ++_i) \
        __builtin_amdgcn_global_load_lds((const unsigned*)((const char*)(gbase) + (voff)[_i]), (PG8_LAS unsigned*)(lds + (bufoff) + ldsw + _i * 8192), 16, 0, 0); } while (0)
#define PG8_LDA(dst, b, h) do { _Pragma("unroll") for (int m = 0; m < 4; ++m) _Pragma("unroll") for (int k = 0; k < 2; ++k) dst[m][k] = *(const PG8_LAS bf16x8*)(lds + PG8_SA(b, h) + aoff + m * 2048 + k * 1024); } while (0)
#define PG8_LDB(dst, b, h) do { _Pragma("unroll") for (int n = 0; n < 2; ++n) _Pragma("unroll") for (int k = 0; k < 2; ++k) dst[n][k] = *(const PG8_LAS bf16x8*)(lds + PG8_SB(b, h) + boff + n * 2048 + k * 1024); } while (0)
#define PG8_MMA(ai, bj, At, Bt) do { __builtin_amdgcn_s_setprio(1); _Pragma("unroll") for (int m = 0; m < 4; ++m) _Pragma("unroll") for (int n = 0; n < 2; ++n) _Pragma("unroll") for (int k = 0; k < 2; ++k) \
        acc[ai][bj][m][n] = __builtin_amdgcn_mfma_f32_16x16x32_bf16(Bt[n][k], At[m][k], acc[ai][bj][m][n], 0, 0, 0); __builtin_amdgcn_s_setprio(0); } while (0)
#define PG8_WAIT_V(n) asm volatile("s_waitcnt vmcnt(" #n ")" ::: "memory")
#define PG8_WAIT_L(n) asm volatile("s_waitcnt lgkmcnt(" #n ")" ::: "memory")
#define PG8_BAR __builtin_amdgcn_s_barrier()
#define PG8_SCHED __builtin_amdgcn_sched_barrier(0)
    Unit cur, nxt; int ui = 0;
    if (!S.next(0, cur)) return;
    f32x4 acc[2][2][4][2];
#pragma unroll
    for (int a = 0; a < 2; ++a)
#pragma unroll
        for (int b = 0; b < 2; ++b)
#pragma unroll
            for (int m = 0; m < 4; ++m)
#pragma unroll
                for (int n = 0; n < 2; ++n) acc[a][b][m][n] = (f32x4){0.f, 0.f, 0.f, 0.f};
    bf16x8 At[4][2], B0[2][2], B1[2][2];
    const char* cA = (const char*)g.A + (size_t)cur.pm * tstep; const char* cB = (const char*)g.Bt + (size_t)cur.pn * tstep;
    S.a_ready(cur);
    if constexpr (SP2) {
        PG8_STAGE(PG8_SB(0, 0), cB, voffB); PG8_STAGE(PG8_SB(0, 1), cB + hstep, voffB); PG8_STAGE(PG8_SA(0, 0), cA, voffA); PG8_STAGE(PG8_SA(0, 1), cA + hstep, voffA);
        if (wr == 1) PG8_BAR;
        PG8_WAIT_V(2); PG8_BAR;
        PG8_STAGE(PG8_SB(1, 0), cB + kstep, voffB); PG8_STAGE(PG8_SA(1, 0), cA + kstep, voffA); PG8_STAGE(PG8_SB(1, 1), cB + hstep + kstep, voffB);
        PG8_WAIT_V(6); PG8_BAR;
    } else {
        PG8_STAGE(PG8_SB(0, 0), cB, voffB); PG8_STAGE(PG8_SA(0, 0), cA, voffA); PG8_STAGE(PG8_SB(0, 1), cB + hstep, voffB); PG8_STAGE(PG8_SA(0, 1), cA + hstep, voffA);
        if (wr == 1) PG8_BAR;
        PG8_WAIT_V(4); PG8_BAR;
        PG8_STAGE(PG8_SB(1, 0), cB + kstep, voffB); PG8_STAGE(PG8_SA(1, 0), cA + kstep, voffA); PG8_STAGE(PG8_SB(1, 1), cB + hstep + kstep, voffB);
        PG8_WAIT_V(6); PG8_BAR;
    }
    for (;;) {
        const bool has_next = S.next(ui + 1, nxt);
        const char* nA = has_next ? (const char*)g.A + (size_t)nxt.pm * tstep : cA; const char* nB = has_next ? (const char*)g.Bt + (size_t)nxt.pn * tstep : cB;
        for (int t = 0; t < nt; t += 2) {
            const bool last = (t == nt - 2);
            const char* a1 = cA + (size_t)(t + 1) * kstep;
            const char* a2 = last ? nA : cA + (size_t)(t + 2) * kstep; const char* b2 = last ? nB : cB + (size_t)(t + 2) * kstep;
            const char* a3 = a2 + kstep; const char* b3 = b2 + kstep;
            if (last && has_next) S.a_ready(nxt);
            if constexpr (SP2) {
            PG8_LDB(B0, 0, 0); PG8_LDB(B1, 0, 1); PG8_SCHED; PG8_LDA(At, 0, 0); PG8_STAGE(PG8_SA(1, 1), a1 + hstep, voffA);
            PG8_WAIT_V(8); PG8_WAIT_L(0); PG8_BAR; PG8_MMA(0, 0, At, B0); PG8_MMA(0, 1, At, B1); PG8_BAR; PG8_SCHED;
            PG8_LDA(At, 0, 1); PG8_STAGE(PG8_SB(0, 0), b2, voffB); PG8_STAGE(PG8_SB(0, 1), b2 + hstep, voffB); PG8_STAGE(PG8_SA(0, 0), a2, voffA);
            PG8_WAIT_V(8); PG8_WAIT_L(0); PG8_BAR; PG8_MMA(1, 0, At, B0); PG8_MMA(1, 1, At, B1); PG8_BAR; PG8_SCHED;
            PG8_LDB(B0, 1, 0); PG8_LDB(B1, 1, 1); PG8_SCHED; PG8_LDA(At, 1, 0); PG8_STAGE(PG8_SA(0, 1), a2 + hstep, voffA);
            PG8_WAIT_V(8); PG8_WAIT_L(0); PG8_BAR; PG8_MMA(0, 0, At, B0); PG8_MMA(0, 1, At, B1); PG8_BAR; PG8_SCHED;
            PG8_LDA(At, 1, 1); PG8_STAGE(PG8_SB(1, 0), b3, voffB); PG8_STAGE(PG8_SB(1, 1), b3 + hstep, voffB); PG8_STAGE(PG8_SA(1, 0), a3, voffA);
            PG8_WAIT_V(8); PG8_WAIT_L(0); PG8_BAR; PG8_MMA(1, 0, At, B0); PG8_MMA(1, 1, At, B1); PG8_BAR; PG8_SCHED;
            } else {
            PG8_LDB(B0, 0, 0); PG8_SCHED; PG8_LDA(At, 0, 0); PG8_STAGE(PG8_SA(1, 1), a1 + hstep, voffA);
            PG8_WAIT_L(8); PG8_BAR; PG8_WAIT_L(0); PG8_MMA(0, 0, At, B0); PG8_BAR; PG8_SCHED;
            PG8_LDB(B1, 0, 1); PG8_STAGE(PG8_SB(0, 0), b2, voffB);
            PG8_BAR; PG8_WAIT_L(0); PG8_MMA(0, 1, At, B1); PG8_BAR;
            PG8_LDA(At, 0, 1); PG8_STAGE(PG8_SA(0, 0), a2, voffA);
            PG8_BAR; PG8_WAIT_L(0); PG8_MMA(1, 0, At, B0); PG8_BAR; PG8_SCHED;
            PG8_STAGE(PG8_SB(0, 1), b2 + hstep, voffB);
            PG8_WAIT_V(6); PG8_BAR; PG8_MMA(1, 1, At, B1); PG8_BAR;
            PG8_LDB(B0, 1, 0); PG8_SCHED; PG8_LDA(At, 1, 0); PG8_STAGE(PG8_SA(0, 1), a2 + hstep, voffA);
            PG8_WAIT_L(8); PG8_BAR; PG8_WAIT_L(0); PG8_MMA(0, 0, At, B0); PG8_BAR; PG8_SCHED;
            PG8_LDB(B1, 1, 1); PG8_STAGE(PG8_SB(1, 0), b3, voffB);
            PG8_BAR; PG8_WAIT_L(0); PG8_MMA(0, 1, At, B1); PG8_BAR;
            PG8_LDA(At, 1, 1); PG8_STAGE(PG8_SA(1, 0), a3, voffA);
            PG8_BAR; PG8_WAIT_L(0); PG8_MMA(1, 0, At, B0); PG8_BAR; PG8_SCHED;
            PG8_STAGE(PG8_SB(1, 1), b3 + hstep, voffB);
            PG8_WAIT_V(6); PG8_BAR; PG8_MMA(1, 1, At, B1); PG8_BAR;
            }
        }
        if constexpr (ALIGN_EPI) { if (wr == 0) PG8_BAR; }
        E(acc, cur, wr, wc, fr, fq); if (SDUP & 32) { asm volatile("" ::: "memory"); E(acc, cur, wr, wc, fr, fq); } S.done(cur);
        if (!has_next) break;
#pragma unroll
        for (int a = 0; a < 2; ++a)
#pragma unroll
            for (int b = 0; b < 2; ++b)
#pragma unroll
                for (int m = 0; m < 4; ++m)
#pragma unroll
                    for (int n = 0; n < 2; ++n) acc[a][b][m][n] = (f32x4){0.f, 0.f, 0.f, 0.f};
        cur = nxt; cA = nA; cB = nB; ++ui;
        if constexpr (ALIGN_EPI) { if (wr == 1) PG8_BAR; }
    }
    PG8_WAIT_V(0);
    if constexpr (!ALIGN_EPI) { if (wr == 0) PG8_BAR; }
    PG8_BAR;
#undef PG8_SA
#undef PG8_SB
#undef PG8_STAGE
#undef PG8_LDA
#undef PG8_LDB
#undef PG8_MMA
#undef PG8_WAIT_V
#undef PG8_WAIT_L
#undef PG8_BAR
#undef PG8_SCHED
}
}

constexpr int BATCH = 8, SEQ = 4096, DM = 1024, MROWS = BATCH * SEQ, DEPTH = 4;
constexpr int NIN = 3072, CIN = 3080, DFF = 2816, NUP = 2 * DFF;
constexpr float EPS = 1e-6f;
constexpr size_t M512 = (size_t)MROWS * 512;
constexpr int NPHASE = 2 + 6 * DEPTH;

constexpr size_t MiB = 1u << 20;
constexpr size_t WS_CTL = 0, CTL_ZERO_BYTES = 64 * 1024;
constexpr size_t WS_COS = 1 * MiB, WS_SIN = 2 * MiB;
constexpr size_t WS_SS = 3 * MiB;
constexpr size_t WS_GLI = 5 * MiB, WS_GLF = 5 * MiB + 512 * 1024;
constexpr size_t WS_WG = 6 * MiB;
constexpr size_t WS_WM = 6 * MiB + 256 * 1024;
constexpr size_t WS_NST = 7 * MiB;
constexpr size_t WS_W = 8 * MiB;
constexpr size_t W_IN_OFF = 0, W_OUT_OFF = (size_t)NIN * DM * 2, W_UP_OFF = W_OUT_OFF + (size_t)DM * DM * 2, W_DOWN_OFF = W_UP_OFF + (size_t)NUP * DM * 2, W_LAYER = W_DOWN_OFF + (size_t)DM * DFF * 2;
constexpr size_t WS_HB = 106 * MiB;
constexpr size_t WS_MIX = 170 * MiB;
constexpr size_t WS_PROJ = 234 * MiB;
constexpr size_t WS_TST = 426 * MiB;
constexpr size_t WS_END = 460 * MiB;
static_assert(WS_W + 4 * W_LAYER <= WS_HB && WS_TST + (size_t)256 * 256 * 128 * 4 <= WS_END, "ws map");

constexpr int RING_BYTES = 131072;
constexpr int LDS_BYTES = 147456;
constexpr int P0_SCR_BYTES = 8 * 16640;
constexpr int RSTD_OFF = P0_SCR_BYTES;
constexpr int LDSCTL_OFF = LDS_BYTES - 256;
static_assert(RSTD_OFF >= RING_BYTES && RSTD_OFF + 12 * 256 * 4 <= LDSCTL_OFF, "LDS map");

#define GAS __attribute__((address_space(1)))
#define LAS __attribute__((address_space(3)))
#define DI __device__ __forceinline__
typedef unsigned short bf16_t;
typedef short bf16x8 __attribute__((ext_vector_type(8)));
typedef short bf16x4 __attribute__((ext_vector_type(4)));
typedef float f32x4 __attribute__((ext_vector_type(4)));
typedef float f32x16 __attribute__((ext_vector_type(16)));
typedef unsigned u32x4 __attribute__((ext_vector_type(4)));
typedef unsigned u32x2 __attribute__((ext_vector_type(2)));

DI unsigned pk2(float lo, float hi) { typedef __bf16 b2 __attribute__((ext_vector_type(2))); b2 v; v.x = (__bf16)lo; v.y = (__bf16)hi; return __builtin_bit_cast(unsigned, v); }
DI float bf2f(unsigned short x) { return __uint_as_float(((unsigned)x) << 16); }
DI float bflo(unsigned w) { return __uint_as_float(w << 16); }
DI float bfhi(unsigned w) { return __uint_as_float(w & 0xffff0000u); }
DI float fexp(float x) { return __builtin_amdgcn_exp2f(x * 1.4426950408889634f); }
DI float frcp(float x) { return __builtin_amdgcn_rcpf(x); }
DI float sigmoid_f(float x) { return frcp(1.f + fexp(-x)); }
DI float silu_f(float x) { return x * sigmoid_f(x); }
DI float gelu_tanh_f(float x) { return x * sigmoid_f(1.5957691216057308f * (x + 0.044715f * x * x * x)); }
template <int CTRL> DI float dpp_f(float v) { return __int_as_float(__builtin_amdgcn_mov_dpp(__float_as_int(v), CTRL, 0xF, 0xF, true)); }
DI float xor16_f(float v) { return __int_as_float(__builtin_amdgcn_ds_swizzle(__float_as_int(v), 0x401F)); }
DI float sum_xor32(float v) { const auto r = __builtin_amdgcn_permlane32_swap(__float_as_uint(v), __float_as_uint(v), false, false); return __uint_as_float(r[0]) + __uint_as_float(r[1]); }
DI float sum_xor16_32(float v) { v += xor16_f(v); return sum_xor32(v); }
DI float wave_sum(float v) {
    v += dpp_f<0xB1>(v); v += dpp_f<0x4E>(v); v += dpp_f<0x141>(v); v += dpp_f<0x140>(v);
    return sum_xor16_32(v);
}
template <int CTRL, int ROWMASK, bool IS_MAX> DI float scan_step(float v, const float ident) {
    const float t = __int_as_float(__builtin_amdgcn_update_dpp(__float_as_int(ident), __float_as_int(v), CTRL, ROWMASK, 0xF, false));
    return IS_MAX ? fmaxf(v, t) : v + t;
}
template <bool IS_MAX> DI float wave_scan(float v) {
    const float id = IS_MAX ? -3.0e38f : 0.f;
    v = scan_step<0x111, 0xF, IS_MAX>(v, id); v = scan_step<0x112, 0xF, IS_MAX>(v, id); v = scan_step<0x114, 0xF, IS_MAX>(v, id); v = scan_step<0x118, 0xF, IS_MAX>(v, id);
    v = scan_step<0x142, 0xA, IS_MAX>(v, id);
    v = scan_step<0x143, 0xC, IS_MAX>(v, id);
    return v;
}
DI float lane63(float v) { return __int_as_float(__builtin_amdgcn_readlane(__float_as_int(v), 63)); }

#define XB_TMO      128
#define XB_XCNT(j)  (256  + 64 * (j))
#define XB_XSUB(j)  (1280 + 64 * (j))
#define XB_XGEN(j)  (2304 + 64 * (j))
#define XB_TOP      3328
#define XB_TOPGEN   3392
#define XCD_BAR_WORDS 3456
#define XB_SPIN_CAP (1u << 18)

__device__ __forceinline__ unsigned xb_ld(unsigned* p)              { return __hip_atomic_load(p, __ATOMIC_RELAXED, __HIP_MEMORY_SCOPE_AGENT); }
__device__ __forceinline__ unsigned xb_add(unsigned* p, unsigned v) { return __hip_atomic_fetch_add(p, v, __ATOMIC_RELAXED, __HIP_MEMORY_SCOPE_AGENT); }
__device__ __forceinline__ unsigned xb_xcc_id() { return (unsigned)__builtin_amdgcn_s_getreg((3 << 11) | 20) & 0xFu; }
#define XB_SPIN(cond, bar) do { unsigned _sp = 0; while (cond) { __builtin_amdgcn_s_sleep(1); \
    if ((++_sp & 255u) == 0u) { if (xb_ld(&(bar)[XB_TMO])) break; if (_sp > XB_SPIN_CAP) { atomicAdd(&(bar)[XB_TMO], 1u); break; } } } } while (0)

struct XcdBarrier { unsigned* bar; unsigned x; volatile LAS unsigned* st; };

__device__ __forceinline__ XcdBarrier xcd_barrier_post(unsigned* bar, volatile LAS unsigned* st, int tid) {
    XcdBarrier b; b.bar = bar; b.x = xb_xcc_id(); b.st = st;
    if (tid == 0) (void)xb_add(&bar[XB_XCNT(b.x)], 1u);
    return b;
}
__device__ __forceinline__ void xcd_barrier_complete(unsigned* bar, unsigned x, unsigned& nloc, unsigned& nx) {
    const unsigned G = gridDim.x * gridDim.y * gridDim.z;
    unsigned sum, cnt, mine, sp = 0u;
    for (;;) {
        sum = 0u; cnt = 0u; mine = 0u;
#pragma unroll
        for (unsigned j = 0; j < 16; ++j) { const unsigned c = xb_ld(&bar[XB_XCNT(j)]); sum += c; cnt += (c > 0u) ? 1u : 0u; mine = (j == x) ? c : mine; }
        if (sum == G) break;
        __builtin_amdgcn_s_sleep(1);
        if ((++sp & 255u) == 0u) { if (xb_ld(&bar[XB_TMO])) break; if (sp > XB_SPIN_CAP) { atomicAdd(&bar[XB_TMO], 1u); break; } }
    }
    nloc = mine > 0u ? mine : 1u; nx = cnt > 0u ? cnt : 1u;
}
__device__ __forceinline__ void xcd_barrier(const XcdBarrier& b, int tid) {
    asm volatile("s_waitcnt vmcnt(0)" ::: "memory");
    __syncthreads();
    if (tid == 0) {
        unsigned* bar = b.bar;
        __builtin_amdgcn_s_waitcnt(0);
        unsigned nloc = b.st[0], nx = b.st[1];
        if (nloc == 0u) { xcd_barrier_complete(bar, b.x, nloc, nx); b.st[0] = nloc; b.st[1] = nx; }
        const unsigned old = xb_add(&bar[XB_XSUB(b.x)], 1u);
        const unsigned gen = old / nloc;
        if (old + 1u == (gen + 1u) * nloc) {
            __builtin_amdgcn_fence(__ATOMIC_RELEASE, "agent");
            asm volatile("s_waitcnt vmcnt(0)" ::: "memory");
            const unsigned og = xb_add(&bar[XB_TOP], 1u);
            const unsigned tg = og / nx;
            if (og + 1u == (tg + 1u) * nx) xb_add(&bar[XB_TOPGEN], 1u);
            else XB_SPIN(xb_ld(&bar[XB_TOPGEN]) == tg, bar);
            __builtin_amdgcn_fence(__ATOMIC_ACQUIRE, "agent");
            xb_add(&bar[XB_XGEN(b.x)], 1u);
            asm volatile("s_waitcnt vmcnt(0)" ::: "memory");
        } else {
            XB_SPIN(xb_ld(&bar[XB_XGEN(b.x)]) == gen, bar);
            __builtin_amdgcn_fence(__ATOMIC_ACQUIRE, "agent");
            asm volatile("s_waitcnt vmcnt(0)" ::: "memory");
        }
    }
    __syncthreads();
}

struct Frame {
    LAS unsigned char* lds;
    int tid, lane, wave, G;
    const float* const __attribute__((address_space(4)))* in;
    float* H;
    unsigned char* ws;
};
DI bf16_t* W_in(const Frame& F, int L)   { return (bf16_t*)(F.ws + WS_W + (size_t)L * W_LAYER + W_IN_OFF); }
DI bf16_t* W_out(const Frame& F, int L)  { return (bf16_t*)(F.ws + WS_W + (size_t)L * W_LAYER + W_OUT_OFF); }
DI bf16_t* W_up(const Frame& F, int L)   { return (bf16_t*)(F.ws + WS_W + (size_t)L * W_LAYER + W_UP_OFF); }
DI bf16_t* W_down(const Frame& F, int L) { return (bf16_t*)(F.ws + WS_W + (size_t)L * W_LAYER + W_DOWN_OFF); }

template <class Sched>
DI void rstd_table(Frame& F, const Sched& S, const float* __restrict__ SS) {
    LAS float* T = (LAS float*)(F.lds + RSTD_OFF); pg8::Unit u;
    for (int i0 = 0; S.next(i0, u); i0 += 4) {
        f32x4 sp[2][4]; bool ok[2];
#pragma unroll
        for (int k = 0; k < 2; ++k) { const int i = i0 + 2 * k + (F.tid >> 8); ok[k] = S.next(i, u);
            if (ok[k]) { const float* p = SS + (size_t)(256 * u.pm + (F.tid & 255)) * 16;
#pragma unroll
                for (int q = 0; q < 4; ++q) sp[k][q] = *(const f32x4*)(p + 4 * q); } }
#pragma unroll
        for (int k = 0; k < 2; ++k) if (ok[k]) { const int i = i0 + 2 * k + (F.tid >> 8); float s = 0.f;
#pragma unroll
            for (int q = 0; q < 4; ++q) s += (sp[k][q].x + sp[k][q].y) + (sp[k][q].z + sp[k][q].w);
            T[i * 256 + (F.tid & 255)] = 1.0f / sqrtf(s * (1.0f / DM) + EPS); }
    }
    __syncthreads();
}
DI void row_rstd8(const LAS float* T, int ui, int wr, int fr, float (&rs)[2][4]) {
#pragma unroll
    for (int ai = 0; ai < 2; ++ai)
#pragma unroll
        for (int m = 0; m < 4; ++m) rs[ai][m] = T[ui * 256 + ai * 128 + wr * 64 + m * 16 + fr];
}
DI void store8(bf16_t* p, const f32x4& v0, const f32x4& v1) { u32x4 w; w.x = pk2(v0[0], v0[1]); w.y = pk2(v0[2], v0[3]); w.z = pk2(v1[0], v1[1]); w.w = pk2(v1[2], v1[3]); *(u32x4*)p = w; }

struct EpiInA {
    static constexpr bool PERM = true;
    bf16_t* P; const LAS float* RT; const float* COS; const float* SIN;
    DI void operator()(const f32x4 (&acc)[2][2][4][2], const pg8::Unit& u, int wr, int wc, int fr, int fq) const {
        const int row0 = u.pm * 256 + wr * 64 + fr, colw = wc * 32 + 8 * fq, typ = u.pn >> 1;
        float rsv[2][4]; row_rstd8(RT, u.ui, wr, fr, rsv);
#pragma unroll
        for (int ai = 0; ai < 2; ++ai) {
            f32x4 cc[4], sn[4];
            if (typ < 2) {
#pragma unroll
                for (int m = 0; m < 4; ++m) { const int pos = (row0 + ai * 128 + m * 16) & (SEQ - 1); cc[m] = *(const f32x4*)(COS + pos * 64 + (colw >> 1)); sn[m] = *(const f32x4*)(SIN + pos * 64 + (colw >> 1)); } }
#pragma unroll
            for (int m = 0; m < 4; ++m) {
                const int row = row0 + ai * 128 + m * 16;
                const float rs = rsv[ai][m];
                const int bb = row >> 12, tq = row & (SEQ - 1);
                bf16_t* rowp = (typ < 4) ? P + (size_t)typ * M512 + ((size_t)((bb * 4 + 2 * (u.pn & 1)) * SEQ + tq)) * 128 + colw
                                         : P + (size_t)typ * M512 + (size_t)row * 512 + (u.pn & 1) * 256 + colw;
                const size_t bjs = (typ < 4) ? (size_t)SEQ * 128 : 128;
                if (typ < 2) {
                    const f32x4 c4 = cc[m], s4 = sn[m];
#pragma unroll
                    for (int bj = 0; bj < 2; ++bj) { const f32x4 a0 = acc[ai][bj][m][0] * rs, a1 = acc[ai][bj][m][1] * rs; f32x4 v0, v1;
                        v0[0] = a0[0] * c4[0] - a0[1] * s4[0]; v0[1] = a0[0] * s4[0] + a0[1] * c4[0];
                        v0[2] = a0[2] * c4[1] - a0[3] * s4[1]; v0[3] = a0[2] * s4[1] + a0[3] * c4[1];
                        v1[0] = a1[0] * c4[2] - a1[1] * s4[2]; v1[1] = a1[0] * s4[2] + a1[1] * c4[2];
                        v1[2] = a1[2] * c4[3] - a1[3] * s4[3]; v1[3] = a1[2] * s4[3] + a1[3] * c4[3];
                        store8(rowp + bj * bjs, v0, v1); }
                } else {
#pragma unroll
                    for (int bj = 0; bj < 2; ++bj) { f32x4 v0 = acc[ai][bj][m][0] * rs, v1 = acc[ai][bj][m][1] * rs;
                        if (typ == 3) {
#pragma unroll
                            for (int j = 0; j < 4; ++j) { v0[j] = silu_f(v0[j]); v1[j] = silu_f(v1[j]); } }
                        else if (typ >= 4) {
#pragma unroll
                            for (int j = 0; j < 4; ++j) { v0[j] = gelu_tanh_f(v0[j]); v1[j] = gelu_tanh_f(v1[j]); } }
                        store8(rowp + bj * bjs, v0, v1); }
                }
            }
        }
    }
};
struct EpiInC {
    static constexpr bool PERM = true;
    bf16_t* P; const LAS float* RT;
    DI void operator()(const f32x4 (&acc)[2][2][4][2], const pg8::Unit& u, int wr, int wc, int fr, int fq) const {
        const int row0 = u.pm * 256 + wr * 64 + fr, colw = wc * 32 + 8 * fq; const bool sg = u.pn >= 8;
        float rsv[2][4]; row_rstd8(RT, u.ui, wr, fr, rsv);
#pragma unroll
        for (int ai = 0; ai < 2; ++ai)
#pragma unroll
            for (int m = 0; m < 4; ++m) {
                const int row = row0 + ai * 128 + m * 16;
                const float rs = rsv[ai][m];
                const int bb = row >> 12, tq = row & (SEQ - 1);
                bf16_t* rowp; size_t bjs;
                if (u.pn < 4) { rowp = P + (size_t)(u.pn >> 1) * M512 + ((size_t)((bb * 4 + 2 * (u.pn & 1)) * SEQ + tq)) * 128 + colw; bjs = (size_t)SEQ * 128; }
                else { rowp = P + (size_t)(u.pn < 8 ? 2 : 4) * M512 + ((size_t)((bb * 4 + (u.pn & 3)) * SEQ + tq)) * 256 + colw; bjs = 128; }
#pragma unroll
                for (int bj = 0; bj < 2; ++bj) { f32x4 v0 = acc[ai][bj][m][0] * rs, v1 = acc[ai][bj][m][1] * rs;
                    if (sg) {
#pragma unroll
                        for (int j = 0; j < 4; ++j) { v0[j] = sigmoid_f(v0[j]); v1[j] = sigmoid_f(v1[j]); } }
                    store8(rowp + bj * bjs, v0, v1); }
            }
    }
};
struct EpiRes {
    static constexpr bool PERM = true;
    bf16_t* HB; float* SS; float sgn;
    DI void operator()(const f32x4 (&acc)[2][2][4][2], const pg8::Unit& u, int wr, int wc, int fr, int fq) const {
        const int row0 = u.pm * 256 + wr * 64 + fr, col0 = u.pn * 256 + wc * 32 + 8 * fq;
#pragma unroll
        for (int ai = 0; ai < 2; ++ai) {
            u32x4 hv[4][2];
#pragma unroll
            for (int m = 0; m < 4; ++m) { const bf16_t* bp = HB + (size_t)(row0 + ai * 128 + m * 16) * DM + col0;
#pragma unroll
                for (int bj = 0; bj < 2; ++bj) hv[m][bj] = *(const u32x4*)(bp + bj * 128); }
#pragma unroll
            for (int m = 0; m < 4; ++m) {
                const int row = row0 + ai * 128 + m * 16;
                bf16_t* bp = HB + (size_t)row * DM + col0; float ssum = 0.f;
#pragma unroll
                for (int bj = 0; bj < 2; ++bj) {
                    const u32x4 w = hv[m][bj];
                    const f32x4 b0 = {bflo(w.x), bfhi(w.x), bflo(w.y), bfhi(w.y)}, b1 = {bflo(w.z), bfhi(w.z), bflo(w.w), bfhi(w.w)};
                    const f32x4 h0 = b0 + acc[ai][bj][m][0] * sgn, h1 = b1 + acc[ai][bj][m][1] * sgn;
                    store8(bp + bj * 128, h0, h1);
                    ssum += (h0[0] * h0[0] + h0[1] * h0[1]) + (h0[2] * h0[2] + h0[3] * h0[3]) + (h1[0] * h1[0] + h1[1] * h1[1]) + (h1[2] * h1[2] + h1[3] * h1[3]);
                }
                ssum = sum_xor16_32(ssum);
                if (fq == 0) SS[(size_t)row * 16 + u.pn * 4 + wc] = ssum;
            }
        }
    }
};
struct EpiSwiGLU {
    static constexpr bool PERM = true;
    bf16_t* ACT; const LAS float* RT;
    DI void operator()(const f32x4 (&acc)[2][2][4][2], const pg8::Unit& u, int wr, int wc, int fr, int fq) const {
        const int row0 = u.pm * 256 + wr * 64 + fr, col0 = u.pn * 128 + wc * 32 + 8 * fq;
        float rsv[2][4]; row_rstd8(RT, u.ui, wr, fr, rsv);
#pragma unroll
        for (int ai = 0; ai < 2; ++ai)
#pragma unroll
            for (int m = 0; m < 4; ++m) {
                const int row = row0 + ai * 128 + m * 16;
                const float rs = rsv[ai][m];
                const f32x4 g0 = acc[ai][0][m][0] * rs, g1 = acc[ai][0][m][1] * rs, u0 = acc[ai][1][m][0] * rs, u1 = acc[ai][1][m][1] * rs; f32x4 v0, v1;
#pragma unroll
                for (int j = 0; j < 4; ++j) { v0[j] = silu_f(g0[j]) * u0[j]; v1[j] = silu_f(g1[j]) * u1[j]; }
                store8(ACT + (size_t)row * DFF + col0, v0, v1);
            }
    }
};

template <class Map>
DI void cvt_item(const float* src, int ld, const float* gain, bf16_t* WT, int K, int n0, int k0, const Map& mp, LAS float* scr, int lane) {
    const int sc = mp.col(n0 + lane); const float scale = mp.scale(n0 + lane);
    float wv[64];
    const float* sp = src + (size_t)k0 * ld + sc;
#pragma unroll
    for (int i = 0; i < 64; ++i) wv[i] = sp[(size_t)i * ld];
#pragma unroll
    for (int i = 0; i < 64; ++i) { const float gk = gain ? gain[k0 + i] : 1.0f; scr[i * 65 + lane] = wv[i] * (gk * scale); }
    asm volatile("s_waitcnt lgkmcnt(0)" ::: "memory");
    const int c = lane & 7;
#pragma unroll
    for (int j = 0; j < 8; ++j) { const int n = (lane >> 3) + 8 * j; const LAS float* s = scr + (8 * c) * 65 + n;
        u32x4 o; o.x = pk2(s[0 * 65], s[1 * 65]); o.y = pk2(s[2 * 65], s[3 * 65]); o.z = pk2(s[4 * 65], s[5 * 65]); o.w = pk2(s[6 * 65], s[7 * 65]);
        *(u32x4*)(WT + (size_t)(n0 + n) * K + k0 + 8 * c) = o; }
    asm volatile("s_waitcnt lgkmcnt(0)" ::: "memory");
}
struct MapId { DI int col(int n) const { return n; } DI float scale(int) const { return 1.0f; } };
struct MapInA { DI int col(int n) const { if (n >= 1024) return n; const int p = n & 127; return (n & ~127) + (p >> 1) + 64 * (p & 1); } DI float scale(int n) const { return (n >= 512 && n < 1024) ? 0.08838834764831845f : 1.0f; } };
struct MapInC { DI int col(int n) const { return n; } DI float scale(int n) const { return (n >= 512 && n < 1024) ? 0.08838834764831845f : 1.0f; } };
struct MapUp  { DI int col(int n) const { return 128 * (n >> 8) + (n & 127); } DI float scale(int) const { return 1.0f; } };

constexpr int I_IN = 16 * 48, I_OUT = 16 * 16, I_UP = 16 * 88, I_DOWN = 44 * 16, I_LAYER = I_IN + I_OUT + I_UP + I_DOWN;
DI void p0_weights(Frame& F, int first, int count, int worker, int nworkers) {
    LAS float* scr = (LAS float*)(F.lds + F.wave * 16640);
    for (int k = worker; k < count; k += nworkers) { const int it = first + k;
        const int L = it / I_LAYER; int r = it % I_LAYER; const int j = L >> 1;
        if (r < I_IN) { const int kb = r / 48, nb = r % 48;
            if (L & 1) cvt_item(F.in[11] + (size_t)j * DM * CIN, CIN, F.in[1] + L * DM, W_in(F, L), DM, 64 * nb, 64 * kb, MapInC(), scr, F.lane);
            else       cvt_item(F.in[4] + (size_t)j * DM * NIN, NIN, F.in[1] + L * DM, W_in(F, L), DM, 64 * nb, 64 * kb, MapInA(), scr, F.lane);
            continue; }
        r -= I_IN;
        if (r < I_OUT) { const int kb = r / 16, nb = r % 16;
            cvt_item(((L & 1) ? F.in[12] : F.in[5]) + (size_t)j * DM * DM, DM, nullptr, W_out(F, L), DM, 64 * nb, 64 * kb, MapId(), scr, F.lane); continue; }
        r -= I_OUT;
        if (r < I_UP) { const int kb = r / 88, nb = r % 88; const int n0 = 64 * nb; const bool up = (n0 >> 7) & 1;
            cvt_item((up ? F.in[17] : F.in[16]) + (size_t)L * DM * DFF, DFF, F.in[2] + L * DM, W_up(F, L), DM, n0, 64 * kb, MapUp(), scr, F.lane); continue; }
        r -= I_UP;
        { const int kb = r / 16, nb = r % 16;
          cvt_item(F.in[18] + (size_t)L * DFF * DM, DM, nullptr, W_down(F, L), DFF, 64 * nb, 64 * kb, MapId(), scr, F.lane); }
    }
}
DI void p0_prologue(Frame& F) {
    const int gw = blockIdx.x * 8 + F.wave, NGW = F.G * 8;
    p0_weights(F, 0, DEFER_WEIGHTS ? I_IN : DEPTH * I_LAYER, gw, NGW);
    float* SS = (float*)(F.ws + WS_SS); bf16_t* HB = (bf16_t*)(F.ws + WS_HB);
    for (int m2 = gw; m2 < MROWS / 2; m2 += NGW) {
        f32x4 v[2][4];
#pragma unroll
        for (int rr = 0; rr < 2; ++rr) { const f32x4* xr = (const f32x4*)(F.in[0] + (size_t)(2 * m2 + rr) * DM) + F.lane;
#pragma unroll
            for (int q = 0; q < 4; ++q) v[rr][q] = xr[64 * q]; }
#pragma unroll
        for (int rr = 0; rr < 2; ++rr) { const int m = 2 * m2 + rr; u32x2* br = (u32x2*)(HB + (size_t)m * DM) + F.lane; float s = 0.f;
#pragma unroll
            for (int q = 0; q < 4; ++q) { const f32x4 x = v[rr][q]; s += (x.x * x.x + x.y * x.y) + (x.z * x.z + x.w * x.w); u32x2 o; o.x = pk2(x.x, x.y); o.y = pk2(x.z, x.w); br[64 * q] = o; }
            s = wave_sum(s);
            if (F.lane < 16) SS[(size_t)m * 16 + F.lane] = (F.lane == 0) ? s : 0.f; }
    }
    const int gt = blockIdx.x * 512 + F.tid, NGT = F.G * 512;
    float* COS = (float*)(F.ws + WS_COS); float* SIN = (float*)(F.ws + WS_SIN);
    for (int e = gt; e < SEQ * 64; e += NGT) {
        const int pos = e >> 6, i = e & 63;
        const float inv = exp2f(-(float)i * (13.287712379549449f / 64.0f));
        const float ang = (float)pos * inv;
        const double a = (double)ang; const double n = rint(a * 0.15915494309189535); const float rr = (float)(a - n * 6.283185307179586);
        COS[e] = cosf(rr); SIN[e] = sinf(rr);
    }
    float* WG = (float*)(F.ws + WS_WG);
    for (int e = gt; e < 2 * 8 * DM; e += NGT) { const int j = e >> 13, c = (e >> 10) & 7, k = e & 1023;
        WG[e] = F.in[11][(size_t)j * DM * CIN + (size_t)k * CIN + 3072 + c] * F.in[1][(2 * j + 1) * DM + k]; }
    bf16_t* WM = (bf16_t*)(F.ws + WS_WM);
    for (int e = gt; e < 2 * 4 * 128 * 128; e += NGT) { const int p = (e >> 7) & 127, q = e & 127; const float w = ((q >> 6) <= (p >> 6)) ? F.in[9][e] : 0.f; WM[e] = (bf16_t)(pk2(w, 0.f) & 0xffffu); }
}

DI void gate_step(Frame& F, int L) {
    const int j = L >> 1; const int gw = blockIdx.x * 8 + F.wave, NGW = F.G * 8;
    const float* SS = (const float*)(F.ws + WS_SS); const bf16_t* HB = (const bf16_t*)(F.ws + WS_HB); const float* WG = (const float*)(F.ws + WS_WG) + j * 8 * DM;
    float* GLI = (float*)(F.ws + WS_GLI); float* GLF = (float*)(F.ws + WS_GLF);
    for (int m4 = gw; m4 < MROWS / 4; m4 += NGW) {
        u32x4 a0[4], a1[4]; float ssv[4];
#pragma unroll
        for (int rr = 0; rr < 4; ++rr) { const int m = 4 * m4 + rr; a0[rr] = *((const u32x4*)(HB + (size_t)m * DM) + F.lane); a1[rr] = *((const u32x4*)(HB + (size_t)m * DM + 512) + F.lane);
            ssv[rr] = (F.lane < 16) ? SS[(size_t)m * 16 + F.lane] : 0.f; }
#pragma unroll
        for (int rr = 0; rr < 4; ++rr) {
            const int m = 4 * m4 + rr; float x[16];
            x[0] = bflo(a0[rr].x); x[1] = bfhi(a0[rr].x); x[2] = bflo(a0[rr].y); x[3] = bfhi(a0[rr].y); x[4] = bflo(a0[rr].z); x[5] = bfhi(a0[rr].z); x[6] = bflo(a0[rr].w); x[7] = bfhi(a0[rr].w);
            x[8] = bflo(a1[rr].x); x[9] = bfhi(a1[rr].x); x[10] = bflo(a1[rr].y); x[11] = bfhi(a1[rr].y); x[12] = bflo(a1[rr].z); x[13] = bfhi(a1[rr].z); x[14] = bflo(a1[rr].w); x[15] = bfhi(a1[rr].w);
            const float ssp = wave_sum(ssv[rr]);
            const float rs = 1.0f / sqrtf(ssp * (1.0f / DM) + EPS);
            float myv = 0.f;
#pragma unroll
            for (int c = 0; c < 8; ++c) {
                const f32x4* w0 = (const f32x4*)(WG + c * DM + 8 * F.lane); const f32x4* w1 = (const f32x4*)(WG + c * DM + 512 + 8 * F.lane);
                const f32x4 wa = w0[0], wb = w0[1], wc2 = w1[0], wd = w1[1];
                float d = x[0] * wa.x + x[1] * wa.y + x[2] * wa.z + x[3] * wa.w + x[4] * wb.x + x[5] * wb.y + x[6] * wb.z + x[7] * wb.w
                        + x[8] * wc2.x + x[9] * wc2.y + x[10] * wc2.z + x[11] * wc2.w + x[12] * wd.x + x[13] * wd.y + x[14] * wd.z + x[15] * wd.w;
                d = wave_sum(d);
                if (F.lane == c) myv = d * rs;
            }
            if (F.lane < 8) {
                const int hh = F.lane & 3; const int b = m >> 12, t = m & (SEQ - 1); const size_t idx = (size_t)(b * 4 + hh) * SEQ + t;
                if (F.lane < 4) GLI[idx] = myv + F.in[13][j * 4 + hh];
                else { const float xx = myv + F.in[14][j * 4 + hh]; GLF[idx] = (xx >= 0.f) ? -log1pf(expf(-xx)) : (xx - log1pf(expf(xx))); }
            }
        }
    }
}

DI void final_norm(Frame& F) {
    const int gw = blockIdx.x * 8 + F.wave, NGW = F.G * 8; const float* SS = (const float*)(F.ws + WS_SS); const bf16_t* HB = (const bf16_t*)(F.ws + WS_HB); const f32x4* gv = (const f32x4*)F.in[3] + F.lane;
    f32x4 g[4];
#pragma unroll
    for (int q = 0; q < 4; ++q) g[q] = gv[64 * q];
    for (int m4 = gw; m4 < MROWS / 4; m4 += NGW) {
        u32x2 w[4][4]; float ssv[4];
#pragma unroll
        for (int rr = 0; rr < 4; ++rr) { const int m = 4 * m4 + rr; const u32x2* br = (const u32x2*)(HB + (size_t)m * DM) + F.lane;
#pragma unroll
            for (int q = 0; q < 4; ++q) w[rr][q] = br[64 * q];
            ssv[rr] = (F.lane < 16) ? SS[(size_t)m * 16 + F.lane] : 0.f; }
#pragma unroll
        for (int rr = 0; rr < 4; ++rr) { const int m = 4 * m4 + rr; f32x4* hr = (f32x4*)(F.H + (size_t)m * DM) + F.lane;
            const float rs = 1.0f / sqrtf(wave_sum(ssv[rr]) * (1.0f / DM) + EPS);
#pragma unroll
            for (int q = 0; q < 4; ++q) { const f32x4 v = {bflo(w[rr][q].x), bfhi(w[rr][q].x), bflo(w[rr][q].y), bfhi(w[rr][q].y)}; hr[64 * q] = v * rs * g[q]; } }
    }
}

DI int opaque(int x) { asm volatile("" : "+v"(x)); return x; }
DI int crow(int i, int h) { return (i & 3) + 8 * (i >> 2) + 4 * h; }
constexpr int QLD = 136, PLD = 72, KWLD = 160;
constexpr int QS_OFF = 0, KS_OFF = 17408, KW_OFF = 34816, VS_OFF = 55296, PS_OFF = 92160;
constexpr int SA_OFF = 101376, SCM_OFF = SA_OFF + 2048, SMT_OFF = SCM_OFF + 2048, SMISC_OFF = SMT_OFF + 2048;
constexpr int PQ_OFF = SMISC_OFF + 256, MS_OFF = PQ_OFF + 512, LS_OFF = MS_OFF + 320;
constexpr int STAT_OFF = LS_OFF + 320, NV_OFF = STAT_OFF + 4096, PSUM_OFF = NV_OFF + 512, QN_OFF = PSUM_OFF + 1024, GAIN_OFF = QN_OFF + 256, LA_END = GAIN_OFF + 1024;
static_assert(LA_END <= RING_BYTES, "mixer LDS");

DI bf16x8 gather_col(const LAS bf16_t* base, int ld, int col, int s0) {
    bf16x8 r;
#pragma unroll
    for (int j = 0; j < 8; ++j) r[j] = (short)base[(s0 + j) * ld + col];
    return r;
}
DI bf16x8 tr_frag(const LAS bf16_t* tile, int ld, int col0, int s0, int lane) {
    const int i16 = lane & 15, q = i16 >> 2, p = i16 & 3, blk = (lane >> 4) & 1, hh = lane >> 5;
    const LAS bf16_t* a = tile + (s0 + 8 * hh + q) * ld + col0 + 16 * blk + 4 * p;
    const bf16x4 lo = __builtin_amdgcn_ds_read_tr16_b64_v4i16((LAS bf16x4*)a), hi = __builtin_amdgcn_ds_read_tr16_b64_v4i16((LAS bf16x4*)(a + 4 * ld));
    return __builtin_shufflevector(lo, hi, 0, 1, 2, 3, 4, 5, 6, 7);
}
DI bf16x8 pack_acc(const f32x16& x, int s) {
    u32x4 p; p.x = pk2(x[8 * s + 0], x[8 * s + 1]); p.y = pk2(x[8 * s + 2], x[8 * s + 3]); p.z = pk2(x[8 * s + 4], x[8 * s + 5]); p.w = pk2(x[8 * s + 6], x[8 * s + 7]);
    return __builtin_bit_cast(bf16x8, p);
}
#define MFMA32(a, b, c) __builtin_amdgcn_mfma_f32_32x32x16_bf16((a), (b), (c), 0, 0, 0)
#define MFMA16(a, b, c) __builtin_amdgcn_mfma_f32_16x16x32_bf16((a), (b), (c), 0, 0, 0)

DI void mlstm_scan(Frame& F, int b, int h, int g) {
    LAS float* SA = (LAS float*)(F.lds + SA_OFF); LAS float* SCM = (LAS float*)(F.lds + SCM_OFF); LAS float* SMT = (LAS float*)(F.lds + SMT_OFF); LAS float* SM = (LAS float*)(F.lds + SMISC_OFF);
    LAS float* PQ = (LAS float*)(F.lds + PQ_OFF); LAS float* MS = (LAS float*)(F.lds + MS_OFF); LAS float* LS = (LAS float*)(F.lds + LS_OFF);
    const float* GLI = (const float*)(F.ws + WS_GLI) + (size_t)(b * 4 + h) * SEQ; const float* GLF = (const float*)(F.ws + WS_GLF) + (size_t)(b * 4 + h) * SEQ;
    const int lane = opaque(F.lane), w = F.wave;
    if (w <= g) {
        float li[8], lf[8]; const float* gli = GLI + w * 512 + lane; const float* glf = GLF + w * 512 + lane;
#pragma unroll
        for (int c = 0; c < 8; ++c) { li[c] = gli[c * 64]; lf[c] = glf[c * 64]; }
#pragma unroll
        for (int c = 0; c < 8; ++c) {
            const float bs = wave_scan<false>(lf[c]); const float a = li[c] - bs; const float cmx = wave_scan<true>(a);
            const float amax = lane63(cmx), b63 = lane63(bs);
            if (lane == 0) { PQ[(8 * w + c) * 2] = b63; PQ[(8 * w + c) * 2 + 1] = amax; }
            if (w == g) { (SA + lane)[c * 64] = a; (SCM + lane)[c * 64] = cmx; (SMT + lane)[c * 64] = bs; }
        }
    }
    __syncthreads();
    if (w == 0) {
        const bool live = lane < 8 * (g + 1);
        float P = live ? PQ[lane * 2] : 0.f; const float am = live ? PQ[lane * 2 + 1] : -3.0e38f; float Q = live ? am + P : -3.0e38f;
#define SCAN_PQ(CTRL, RM) { const float tP = __int_as_float(__builtin_amdgcn_update_dpp(0, __float_as_int(P), CTRL, RM, 0xF, false)); \
                            const float tQ = __int_as_float(__builtin_amdgcn_update_dpp(__float_as_int(-3.0e38f), __float_as_int(Q), CTRL, RM, 0xF, false)); Q = fmaxf(tQ + P, Q); P = tP + P; }
        SCAN_PQ(0x111, 0xF) SCAN_PQ(0x112, 0xF) SCAN_PQ(0x114, 0xF) SCAN_PQ(0x118, 0xF) SCAN_PQ(0x142, 0xA) SCAN_PQ(0x143, 0xC)
#undef SCAN_PQ
        const float mnext = fmaxf(P, Q);
        MS[lane + 1] = mnext; if (lane == 0) MS[0] = 0.f;
        const float mprev = MS[lane];
        const float la = live ? (mprev - fmaxf(mprev, am)) : 0.f;
        const float Linc = wave_scan<false>(la);
        LS[lane + 1] = Linc; if (lane == 0) LS[0] = 0.f;
    }
    __syncthreads();
    {
        const int i = F.tid, c = i >> 6; const float mprev = MS[8 * g + c]; const float cm = fmaxf(mprev, SCM[i]); SCM[i] = cm; SMT[i] = SMT[i] + cm;
        if (i < 8) SM[i] = MS[8 * g + i];
        if (i >= 16 && i < 25) SM[i] = LS[8 * (i - 16)];
    }
}

template <int MODE, bool PASS2> struct ChunkRegs { u32x4 k[2]; u32x4 q[PASS2 ? 2 : 1]; u32x4 v[(MODE ? 256 : 128) / 64]; };
template <int MODE, bool PASS2>
DI void la_load(ChunkRegs<MODE, PASS2>& R, const bf16_t* PROJ, int bh, int T0, int tid) {
    constexpr int DV = MODE ? 256 : 128;
    const bf16_t* Q = PROJ + ((size_t)bh * SEQ + T0) * 128; const bf16_t* K = Q + M512; const bf16_t* V = PROJ + 2 * M512 + ((size_t)bh * SEQ + T0) * DV;
#pragma unroll
    for (int i = 0; i < 2; ++i) { const int p = tid + 512 * i;
        R.k[i] = *(const u32x4*)(K + p * 8);
        if (PASS2) R.q[i] = *(const u32x4*)(Q + p * 8); }
#pragma unroll
    for (int i = 0; i < DV / 64; ++i) { const int p = tid + 512 * i; R.v[i] = *(const u32x4*)(V + p * 8); }
}
template <int MODE, bool PASS2>
DI void la_write(Frame& F, const ChunkRegs<MODE, PASS2>& R, int c, float lg2, int tid) {
    constexpr int DV = MODE ? 256 : 128, VLD = DV + 32;
    LAS bf16_t* Qs = (LAS bf16_t*)(F.lds + QS_OFF); LAS bf16_t* Ks = (LAS bf16_t*)(F.lds + KS_OFF); LAS bf16_t* Kw = (LAS bf16_t*)(F.lds + KW_OFF); LAS bf16_t* Vs = (LAS bf16_t*)(F.lds + VS_OFF);
    const LAS float* SA = (const LAS float*)(F.lds + SA_OFF); const LAS float* SCM = (const LAS float*)(F.lds + SCM_OFF);
#pragma unroll
    for (int i = 0; i < 2; ++i) { const int p = tid + 512 * i, t = p >> 4, cp = (p & 15) * 8; const u32x4 kv = R.k[i];
        float ck;
        if (MODE) ck = fexp(SA[c * 64 + t] - SCM[c * 64 + 63]); else ck = __builtin_amdgcn_exp2f(lg2 * (float)(63 - t));
        u32x4 kw; kw.x = pk2(bflo(kv.x) * ck, bfhi(kv.x) * ck); kw.y = pk2(bflo(kv.y) * ck, bfhi(kv.y) * ck); kw.z = pk2(bflo(kv.z) * ck, bfhi(kv.z) * ck); kw.w = pk2(bflo(kv.w) * ck, bfhi(kv.w) * ck);
        *(LAS u32x4*)(Kw + t * KWLD + cp) = kw;
        if (PASS2) { *(LAS u32x4*)(Ks + t * QLD + cp) = kv; *(LAS u32x4*)(Qs + t * QLD + cp) = R.q[i]; }
    }
#pragma unroll
    for (int i = 0; i < DV / 64; ++i) { const int p = tid + 512 * i, t = p / (DV / 8), cp = (p % (DV / 8)) * 8; *(LAS u32x4*)(Vs + t * VLD + cp) = R.v[i]; }
}

template <int MODE>
DI void la_pass1(Frame& F, int unit) {
    constexpr int DV = MODE ? 256 : 128, VLD = DV + 32, ND = MODE ? 4 : 2;
    const int b = unit >> 5, h = (unit >> 3) & 3, g = unit & 7, row0 = b * SEQ + g * 512;
    const int w = F.wave; int lane = F.lane, r = lane & 31, hh = lane >> 5;
    const int eb = MODE ? w : (w & 3), dt0 = MODE ? 0 : 2 * (w >> 2), e0 = 32 * eb;
    const bf16_t* PROJ = (const bf16_t*)(F.ws + WS_PROJ);
    LAS bf16_t* Kw = (LAS bf16_t*)(F.lds + KW_OFF); LAS bf16_t* Vs = (LAS bf16_t*)(F.lds + VS_OFF);
    const LAS float* SCM = (const LAS float*)(F.lds + SCM_OFF); const LAS float* SM = (const LAS float*)(F.lds + SMISC_OFF); LAS float* NV = (LAS float*)(F.lds + NV_OFF);
    const float lg2 = log2f(1.0f - exp2f(-5.0f - (float)h));
    ChunkRegs<MODE, false> R; la_load<MODE, false>(R, PROJ, b * 4 + h, g * 512, opaque(F.tid));
    if (MODE) { mlstm_scan(F, b, h, g); if (F.tid < 128) NV[F.tid] = 0.f; }
    __syncthreads();
    f32x16 C[ND];
#pragma unroll
    for (int d = 0; d < ND; ++d)
#pragma unroll
        for (int i = 0; i < 16; ++i) C[d][i] = 0.f;
    for (int c = 0; c < 8; ++c) {
        lane = opaque(F.lane); r = lane & 31; hh = lane >> 5; const int tid_o = opaque(F.tid);
        la_write<MODE, false>(F, R, c, lg2, tid_o);
        __syncthreads();
        if (c < 7) la_load<MODE, false>(R, PROJ, b * 4 + h, g * 512 + 64 * (c + 1), tid_o);
        const float alpha = MODE ? fexp(SM[c] - SCM[c * 64 + 63]) : __builtin_amdgcn_exp2f(lg2 * 64.0f);
        bf16x8 vf[4];
#pragma unroll
        for (int ks = 0; ks < 4; ++ks) vf[ks] = tr_frag(Vs, VLD, e0, 16 * ks, lane);
#pragma unroll
        for (int d = 0; d < ND; ++d) {
#pragma unroll
            for (int i = 0; i < 16; ++i) C[d][i] *= alpha;
#pragma unroll
            for (int ks = 0; ks < 4; ++ks) { const bf16x8 ka = tr_frag(Kw, KWLD, 32 * (dt0 + d), 16 * ks, lane); C[d] = MFMA32(ka, vf[ks], C[d]); }
        }
        if (MODE) {
            const int dd = 16 * w + (lane & 15), sq = lane >> 4; float s = 0.f;
#pragma unroll
            for (int q = 0; q < 16; ++q) s += bf2f(Kw[(16 * sq + q) * KWLD + dd]);
            s = sum_xor16_32(s);
            if (lane < 16) NV[dd] = alpha * NV[dd] + s;
        }
        __syncthreads();
    }
    bf16_t* T = (bf16_t*)(F.ws + WS_TST) + (size_t)unit * DV * 128;
#pragma unroll
    for (int d = 0; d < ND; ++d)
#pragma unroll
        for (int q = 0; q < 4; ++q) { u32x2 v; v.x = pk2(C[d][4 * q], C[d][4 * q + 1]); v.y = pk2(C[d][4 * q + 2], C[d][4 * q + 3]);
            *(u32x2*)(T + (size_t)(e0 + r) * 128 + 32 * (dt0 + d) + 8 * q + 4 * hh) = v; }
    if (MODE && F.tid < 128) ((float*)(F.ws + WS_NST))[unit * 128 + F.tid] = NV[F.tid];
    __syncthreads();
}

template <int MODE>
DI void la_pass2(Frame& F, int unit, int j) {
    constexpr int DV = MODE ? 256 : 128, VLD = DV + 32, NT = MODE ? 2 : 1;
    const int b = unit >> 5, h = (unit >> 3) & 3, g = unit & 7, row0 = b * SEQ + g * 512;
    const int w = F.wave; int lane = F.lane, r = lane & 31, hh = lane >> 5, r16 = lane & 15, q4 = lane >> 4;
    const int eb = MODE ? w : (w & 3), tb0 = MODE ? 0 : (w >> 2), e0 = 32 * eb;
    const int ocol = DV * h;
    const bf16_t* PROJ = (const bf16_t*)(F.ws + WS_PROJ); bf16_t* MIX = (bf16_t*)(F.ws + WS_MIX);
    const bf16_t* GATE = PROJ + (MODE ? 4 : 3) * M512 + (size_t)(b * 4 + h) * SEQ * DV;
    const float* gain = MODE ? (F.in[15] + (j * 4 + h) * 256) : (F.in[6] + (j * 4 + h) * 128);
    LAS bf16_t* Qs = (LAS bf16_t*)(F.lds + QS_OFF); LAS bf16_t* Ks = (LAS bf16_t*)(F.lds + KS_OFF); LAS bf16_t* Kw = (LAS bf16_t*)(F.lds + KW_OFF); LAS bf16_t* Vs = (LAS bf16_t*)(F.lds + VS_OFF); LAS bf16_t* Ps = (LAS bf16_t*)(F.lds + PS_OFF);
    const LAS float* SA = (const LAS float*)(F.lds + SA_OFF); const LAS float* SCM = (const LAS float*)(F.lds + SCM_OFF); const LAS float* SMT = (const LAS float*)(F.lds + SMT_OFF); const LAS float* SM = (const LAS float*)(F.lds + SMISC_OFF);
    LAS float* STAT = (LAS float*)(F.lds + STAT_OFF); LAS float* NV = (LAS float*)(F.lds + NV_OFF); LAS float* PSUM = (LAS float*)(F.lds + PSUM_OFF); LAS float* QN = (LAS float*)(F.lds + QN_OFF);
    const float lg2 = log2f(1.0f - exp2f(-5.0f - (float)h));
    ChunkRegs<MODE, true> R; la_load<MODE, true>(R, PROJ, b * 4 + h, g * 512, opaque(F.tid));
    LAS float* GAIN = (LAS float*)(F.lds + GAIN_OFF); if (F.tid < DV) GAIN[F.tid] = gain[F.tid];
    if (MODE) mlstm_scan(F, b, h, g);
    __syncthreads();
    f32x16 C[4];
#pragma unroll
    for (int d = 0; d < 4; ++d)
#pragma unroll
        for (int i = 0; i < 16; ++i) C[d][i] = 0.f;
    float nacc = 0.f;
    for (int gp = 0; gp < g; ++gp) {
        const float coef = MODE ? fexp(SM[16 + g] - SM[16 + gp + 1]) : __builtin_amdgcn_exp2f(lg2 * (float)(512 * (g - 1 - gp)));
        const bf16_t* T = (const bf16_t*)(F.ws + WS_TST) + (size_t)(unit - g + gp) * DV * 128 + (size_t)(e0 + r) * 128 + 4 * hh;
        u32x2 tv[4][4];
#pragma unroll
        for (int d = 0; d < 4; ++d)
#pragma unroll
            for (int q = 0; q < 4; ++q) tv[d][q] = *(const u32x2*)(T + 32 * d + 8 * q);
#pragma unroll
        for (int d = 0; d < 4; ++d)
#pragma unroll
            for (int q = 0; q < 4; ++q) { const u32x2 v = tv[d][q];
                C[d][4 * q] += coef * bflo(v.x); C[d][4 * q + 1] += coef * bfhi(v.x); C[d][4 * q + 2] += coef * bflo(v.y); C[d][4 * q + 3] += coef * bfhi(v.y); }
        if (MODE && F.tid < 128) nacc += coef * ((const float*)(F.ws + WS_NST))[(unit - g + gp) * 128 + F.tid];
    }
    if (MODE && F.tid < 128) NV[F.tid] = nacc;
    for (int c = 0; c < 8; ++c) {
        const int R0 = row0 + 64 * c;
        lane = opaque(F.lane); r = lane & 31; hh = lane >> 5; r16 = lane & 15; q4 = lane >> 4; const int tid_o = opaque(F.tid);
        la_write<MODE, true>(F, R, c, lg2, tid_o);
        if (SDUP & 1) { asm volatile("" ::: "memory"); la_write<MODE, true>(F, R, c, lg2, tid_o); }
        __syncthreads();
        if (SDUP & 16) __syncthreads();
        if (c < 7) la_load<MODE, true>(R, PROJ, b * 4 + h, g * 512 + 64 * (c + 1), tid_o);
        u32x2 gt[NT][4];
#pragma unroll
        for (int tt = 0; tt < NT; ++tt)
#pragma unroll
            for (int q = 0; q < 4; ++q) gt[tt][q] = *(const u32x2*)(GATE + (size_t)(g * 512 + 64 * c + 32 * (tb0 + tt) + r) * DV + e0 + 8 * q + 4 * hh);
        for (int srep = 0; srep < ((SDUP & 2) ? 2 : 1); ++srep) {
        if (srep) asm volatile("" ::: "memory");
#pragma unroll
        for (int i = 0; i < 2; ++i) {
            const int tt = 2 * w + i, si = tt >> 2, ti = tt & 3;
            f32x4 x = {0.f, 0.f, 0.f, 0.f};
#pragma unroll
            for (int kk = 0; kk < 4; ++kk) { const bf16x8 ka = *(const LAS bf16x8*)(Ks + (16 * si + r16) * QLD + 32 * kk + 8 * q4); const bf16x8 qb = *(const LAS bf16x8*)(Qs + (16 * ti + r16) * QLD + 32 * kk + 8 * q4); x = MFMA16(ka, qb, x); }
            const int t = 16 * ti + r16; float p[4];
#pragma unroll
            for (int q = 0; q < 4; ++q) { const int s = 16 * si + 4 * q4 + q; float wgt;
                if (MODE) wgt = (s <= t) ? fexp(SA[c * 64 + s] - SCM[c * 64 + t]) : 0.f;
                else { const int dlt = t > s ? t - s : s - t; wgt = __builtin_amdgcn_exp2f(lg2 * (float)dlt); }
                p[q] = x[q] * wgt; }
            u32x2 pw; pw.x = pk2(p[0], p[1]); pw.y = pk2(p[2], p[3]);
            *(LAS u32x2*)(Ps + t * PLD + 16 * si + 4 * q4) = pw;
            if (MODE) { float cs = (bflo(pw.x) + bfhi(pw.x)) + (bflo(pw.y) + bfhi(pw.y)); cs = sum_xor16_32(cs); if (q4 == 0) PSUM[si * 64 + t] = cs; }
        }
        if (MODE) {
            const int t = 8 * w + (lane >> 3), part = lane & 7;
            const u32x4 qa = *(const LAS u32x4*)(Qs + t * QLD + 16 * part), qb2 = *(const LAS u32x4*)(Qs + t * QLD + 16 * part + 8);
            const f32x4 n0 = *(const LAS f32x4*)(NV + 16 * part), n1 = *(const LAS f32x4*)(NV + 16 * part + 4), n2 = *(const LAS f32x4*)(NV + 16 * part + 8), n3 = *(const LAS f32x4*)(NV + 16 * part + 12);
            float qn = bflo(qa.x) * n0.x + bfhi(qa.x) * n0.y + bflo(qa.y) * n0.z + bfhi(qa.y) * n0.w + bflo(qa.z) * n1.x + bfhi(qa.z) * n1.y + bflo(qa.w) * n1.z + bfhi(qa.w) * n1.w
                     + bflo(qb2.x) * n2.x + bfhi(qb2.x) * n2.y + bflo(qb2.y) * n2.z + bfhi(qb2.y) * n2.w + bflo(qb2.z) * n3.x + bfhi(qb2.z) * n3.y + bflo(qb2.w) * n3.z + bfhi(qb2.w) * n3.w;
            qn += dpp_f<0xB1>(qn); qn += dpp_f<0x4E>(qn); qn += dpp_f<0x141>(qn);
            if (part == 0) QN[t] = qn;
        }
        }
        __syncthreads();
        if (SDUP & 16) __syncthreads();
        bf16x8 vf[4];
#pragma unroll
        for (int ks = 0; ks < 4; ++ks) vf[ks] = tr_frag(Vs, VLD, e0, 16 * ks, lane);
        float cqv[NT], rinvv[NT];
#pragma unroll
        for (int tt = 0; tt < NT; ++tt) {
            const int t = 32 * (tb0 + tt) + r;
            if (MODE) {
                const float cq = fexp(SM[c] - SCM[c * 64 + t]);
                const float den = ((PSUM[t] + PSUM[64 + t]) + (PSUM[128 + t] + PSUM[192 + t])) + cq * QN[t];
                cqv[tt] = cq; rinvv[tt] = 1.0f / fmaxf(fabsf(den), fexp(-SMT[c * 64 + t]));
            } else { cqv[tt] = __builtin_amdgcn_exp2f(lg2 * (float)(t + 1)); rinvv[tt] = 1.f; }
        }
        f32x16 o2[NT], val[NT];
        for (int orep = 0; orep < ((SDUP & 4) ? 2 : 1); ++orep) {
        if (orep) asm volatile("" ::: "memory");
#pragma unroll
        for (int tt = 0; tt < NT; ++tt)
#pragma unroll
            for (int i = 0; i < 16; ++i) { o2[tt][i] = 0.f; val[tt][i] = 0.f; }
#pragma unroll
        for (int d = 0; d < 4; ++d) {
#pragma unroll
            for (int s2 = 0; s2 < 2; ++s2) { const bf16x8 ca = pack_acc(C[d], s2);
#pragma unroll
                for (int tt = 0; tt < NT; ++tt) { const int t = 32 * (tb0 + tt) + r;
                    const bf16x4 qlo = *(const LAS bf16x4*)(Qs + t * QLD + 32 * d + 16 * s2 + 4 * hh), qhi = *(const LAS bf16x4*)(Qs + t * QLD + 32 * d + 16 * s2 + 4 * hh + 8);
                    const bf16x8 qb = __builtin_shufflevector(qlo, qhi, 0, 1, 2, 3, 4, 5, 6, 7);
                    o2[tt] = MFMA32(ca, qb, o2[tt]); } }
            __builtin_amdgcn_sched_barrier(0);
        }
#pragma unroll
        for (int tt = 0; tt < NT; ++tt) { const int t = 32 * (tb0 + tt) + r;
#pragma unroll
            for (int ks = 0; ks < 4; ++ks) { const bf16x8 pb = *(const LAS bf16x8*)(Ps + t * PLD + 16 * ks + 8 * hh); val[tt] = MFMA32(vf[ks], pb, val[tt]); } }
#pragma unroll
        for (int tt = 0; tt < NT; ++tt) { const int t = 32 * (tb0 + tt) + r;
            float s1 = 0.f, s2s = 0.f;
#pragma unroll
            for (int i = 0; i < 16; ++i) { const float v = (val[tt][i] + cqv[tt] * o2[tt][i]) * rinvv[tt]; val[tt][i] = v; s1 += v; s2s += v * v; }
            s1 = sum_xor32(s1); s2s = sum_xor32(s2s);
            if (hh == 0) { STAT[(w * 64 + t) * 2] = s1; STAT[(w * 64 + t) * 2 + 1] = s2s; }
        }
        }
        __syncthreads();
        if (SDUP & 16) __syncthreads();
        for (int frep = 0; frep < ((SDUP & 8) ? 2 : 1); ++frep) {
        if (frep) asm volatile("" ::: "memory");
#pragma unroll
        for (int tt = 0; tt < NT; ++tt) {
            const int t = 32 * (tb0 + tt) + r; float S1 = 0.f, S2 = 0.f;
#pragma unroll
            for (int ww = 0; ww < (MODE ? 8 : 4); ++ww) { const int wi = MODE ? ww : (4 * tb0 + ww); S1 += STAT[(wi * 64 + t) * 2]; S2 += STAT[(wi * 64 + t) * 2 + 1]; }
            const float mean = S1 * (1.0f / DV); const float var = fmaxf(S2 * (1.0f / DV) - mean * mean, 0.f); const float rs = 1.0f / sqrtf(var + EPS);
            const size_t rowoff = (size_t)(R0 + t);
#pragma unroll
            for (int q = 0; q < 4; ++q) { const int e = e0 + 8 * q + 4 * hh;
                const f32x4 gn = *(const LAS f32x4*)(GAIN + e); const u32x2 gtv = gt[tt][q];
                const float y0 = (val[tt][4 * q] - mean) * rs * gn.x * bflo(gtv.x), y1 = (val[tt][4 * q + 1] - mean) * rs * gn.y * bfhi(gtv.x);
                const float y2 = (val[tt][4 * q + 2] - mean) * rs * gn.z * bflo(gtv.y), y3 = (val[tt][4 * q + 3] - mean) * rs * gn.w * bfhi(gtv.y);
                u32x2 o; o.x = pk2(y0, y1); o.y = pk2(y2, y3); *(u32x2*)(MIX + rowoff * DM + ocol + e) = o; }
        }
        }
        __builtin_amdgcn_sched_barrier(0);
        const float alpha = MODE ? fexp(SM[c] - SCM[c * 64 + 63]) : __builtin_amdgcn_exp2f(lg2 * 64.0f);
#pragma unroll
        for (int d = 0; d < 4; ++d) {
#pragma unroll
            for (int i = 0; i < 16; ++i) C[d][i] *= alpha;
#pragma unroll
            for (int ks = 0; ks < 4; ++ks) { const bf16x8 ka = tr_frag(Kw, KWLD, 32 * d, 16 * ks, lane); C[d] = MFMA32(ka, vf[ks], C[d]); }
        }
        if (SDUP & 64) {
            f32x16 dm;
#pragma unroll
            for (int i = 0; i < 16; ++i) dm[i] = 0.f;
            asm volatile("" ::: "memory");
#pragma unroll
            for (int d = 0; d < 4; ++d)
#pragma unroll
                for (int ks = 0; ks < 4; ++ks) { const bf16x8 ka = tr_frag(Kw, KWLD, 32 * d, 16 * ks, lane); dm = MFMA32(ka, vf[ks], dm); }
            asm volatile("" :: "v"(dm));
        }
        if (SDUP & 128) {
            f32x16 dm;
#pragma unroll
            for (int i = 0; i < 16; ++i) dm[i] = 0.f;
            asm volatile("" ::: "memory");
#pragma unroll
            for (int d = 0; d < 4; ++d)
#pragma unroll
                for (int s2 = 0; s2 < 2; ++s2) { const bf16x8 ca = pack_acc(C[d], s2);
#pragma unroll
                    for (int tt = 0; tt < NT; ++tt) { const int t = 32 * (tb0 + tt) + r;
                        const bf16x4 qlo = *(const LAS bf16x4*)(Qs + t * QLD + 32 * d + 16 * s2 + 4 * hh), qhi = *(const LAS bf16x4*)(Qs + t * QLD + 32 * d + 16 * s2 + 4 * hh + 8);
                        const bf16x8 qb = __builtin_shufflevector(qlo, qhi, 0, 1, 2, 3, 4, 5, 6, 7);
                        dm = MFMA32(ca, qb, dm); } }
            asm volatile("" :: "v"(dm));
        }
        if (MODE) {
            const int dd = 16 * w + (lane & 15), sq = lane >> 4; float s = 0.f;
#pragma unroll
            for (int q = 0; q < 16; ++q) s += bf2f(Kw[(16 * sq + q) * KWLD + dd]);
            s = sum_xor16_32(s);
            if (lane < 16) NV[dd] = alpha * NV[dd] + s;
        }
        __syncthreads();
        if (SDUP & 16) __syncthreads();
    }
}

constexpr int VN_OFF = 0, SGST_OFF = 34816;
DI void sgu_unit(Frame& F, int unit, int j) {
    const int row0 = unit * 128; const int w = F.wave; int lane = F.lane, r = lane & 31, hh = lane >> 5;
    const bf16_t* PROJ = (const bf16_t*)(F.ws + WS_PROJ); bf16_t* MIX = (bf16_t*)(F.ws + WS_MIX);
    LAS bf16_t* Vn = (LAS bf16_t*)(F.lds + VN_OFF); LAS float* ST = (LAS float*)(F.lds + SGST_OFF);
    const float* lng = F.in[7] + j * 512; const float* lnb = F.in[8] + j * 512;
    {
        u32x4 vv[16];
#pragma unroll
        for (int i = 0; i < 16; ++i) vv[i] = *((const u32x4*)(PROJ + 5 * M512 + (size_t)(row0 + 16 * w + i) * 512) + lane);
#pragma unroll
        for (int i = 0; i < 16; ++i) { const int p = 16 * w + i; const u32x4 v = vv[i];
            const float x0 = bflo(v.x), x1 = bfhi(v.x), x2 = bflo(v.y), x3 = bfhi(v.y), x4 = bflo(v.z), x5 = bfhi(v.z), x6 = bflo(v.w), x7 = bfhi(v.w);
            float s = ((x0 + x1) + (x2 + x3)) + ((x4 + x5) + (x6 + x7)); s = wave_sum(s); const float mean = s * (1.0f / 512.0f);
            const float d0 = x0 - mean, d1 = x1 - mean, d2 = x2 - mean, d3 = x3 - mean, d4 = x4 - mean, d5 = x5 - mean, d6 = x6 - mean, d7 = x7 - mean;
            float q = ((d0 * d0 + d1 * d1) + (d2 * d2 + d3 * d3)) + ((d4 * d4 + d5 * d5) + (d6 * d6 + d7 * d7)); q = wave_sum(q);
            if (lane == 0) { ST[2 * p] = mean; ST[2 * p + 1] = 1.0f / sqrtf(q * (1.0f / 512.0f) + EPS); } }
    }
    __syncthreads();
    const int dtl = w & 3, pt0 = 2 * (w >> 2);
    for (int gq = 0; gq < 4; ++gq) {
        lane = opaque(F.lane); r = lane & 31; hh = lane >> 5; const int tid_o = opaque(F.tid);
#pragma unroll
        for (int i = 0; i < 4; ++i) { const int pc = tid_o + 512 * i, q = pc >> 4, cp = (pc & 15) * 8; const int col = 128 * gq + cp;
            const u32x4 v = *(const u32x4*)(PROJ + 5 * M512 + (size_t)(row0 + q) * 512 + col); const float mean = ST[2 * q], rs = ST[2 * q + 1];
            const f32x4 g0 = *(const f32x4*)(lng + col), g1 = *(const f32x4*)(lng + col + 4), b0 = *(const f32x4*)(lnb + col), b1 = *(const f32x4*)(lnb + col + 4);
            u32x4 o; o.x = pk2((bflo(v.x) - mean) * rs * g0.x + b0.x, (bfhi(v.x) - mean) * rs * g0.y + b0.y); o.y = pk2((bflo(v.y) - mean) * rs * g0.z + b0.z, (bfhi(v.y) - mean) * rs * g0.w + b0.w);
            o.z = pk2((bflo(v.z) - mean) * rs * g1.x + b1.x, (bfhi(v.z) - mean) * rs * g1.y + b1.y); o.w = pk2((bflo(v.w) - mean) * rs * g1.z + b1.z, (bfhi(v.w) - mean) * rs * g1.w + b1.w);
            *(LAS u32x4*)(Vn + q * QLD + cp) = o; }
        __syncthreads();
        const bf16_t* WM = (const bf16_t*)(F.ws + WS_WM) + (size_t)(j * 4 + gq) * 128 * 128;
        unsigned short uv[2][16];
#pragma unroll
        for (int pt = 0; pt < 2; ++pt)
#pragma unroll
            for (int i = 0; i < 16; ++i) uv[pt][i] = PROJ[4 * M512 + (size_t)(row0 + 32 * (pt0 + pt) + crow(i, hh)) * 512 + 128 * gq + 32 * dtl + r];
        f32x16 acc[2];
#pragma unroll
        for (int i = 0; i < 16; ++i) { acc[0][i] = 0.f; acc[1][i] = 0.f; }
#pragma unroll
        for (int ks = 0; ks < 8; ++ks) { const bf16x8 vb = gather_col(Vn, QLD, 32 * dtl + r, 16 * ks + 8 * hh);
#pragma unroll
            for (int pt = 0; pt < 2; ++pt) { const bf16x8 wa = *(const bf16x8*)(WM + (size_t)(32 * (pt0 + pt) + r) * 128 + 16 * ks + 8 * hh); acc[pt] = MFMA32(wa, vb, acc[pt]); } }
        const float* bs = F.in[10] + (j * 4 + gq) * 128;
#pragma unroll
        for (int pt = 0; pt < 2; ++pt)
#pragma unroll
            for (int i = 0; i < 16; ++i) { const int p = 32 * (pt0 + pt) + crow(i, hh); const int col = 128 * gq + 32 * dtl + r;
                MIX[(size_t)(row0 + p) * DM + 512 + col] = (bf16_t)(pk2(bf2f(uv[pt][i]) * (acc[pt][i] + bs[p]), 0.f) & 0xffffu); if ((i & 3) == 3) asm volatile("" ::: "memory"); }
        __syncthreads();
    }
}

struct Args { const float* in[19]; float* out; unsigned char* ws; int ph_lo, ph_hi; };
__global__ void __launch_bounds__(512, 2) fwd(Args args) {
    extern __shared__ __attribute__((aligned(16))) unsigned char lds_raw[];
    Frame F;
    F.lds = (LAS unsigned char*)lds_raw;
    const int wave_s = __builtin_amdgcn_readfirstlane(threadIdx.x >> 6);
    F.tid = threadIdx.x; F.lane = F.tid & 63; F.wave = wave_s; F.G = gridDim.x;
    F.in = (const float* const __attribute__((address_space(4)))*)__builtin_amdgcn_kernarg_segment_ptr();
    F.H = args.out; F.ws = args.ws;
    volatile LAS unsigned* MISC = (volatile LAS unsigned*)(F.lds + LDSCTL_OFF);
    if (F.tid < 64) MISC[F.tid] = 0u;
    __syncthreads();
    if (ONE_LAUNCH) (void)xcd_barrier_post((unsigned*)(F.ws + WS_CTL), MISC + 8, F.tid);
    const int lo = ONE_LAUNCH ? 0 : args.ph_lo, hi = ONE_LAUNCH ? NPHASE : args.ph_hi;
#define IN(k) (lo <= (k) && (k) < hi)
#define REFRESH() do { F.lane = opaque((int)__builtin_amdgcn_mbcnt_hi(~0u, __builtin_amdgcn_mbcnt_lo(~0u, 0u))); F.wave = wave_s; F.tid = wave_s * 64 + F.lane; \
        { unsigned long long z_ = 0ull; asm volatile("" : "+s"(z_)); F.ws = args.ws + z_; } } while (0)
#define SEAM(k) do { if (ONE_LAUNCH && IN((k) + 1)) { REFRESH(); XcdBarrier bb_; bb_.bar = (unsigned*)(F.ws + WS_CTL); bb_.x = xb_xcc_id(); bb_.st = (volatile LAS unsigned*)(F.lds + LDSCTL_OFF) + 8; xcd_barrier(bb_, F.tid); if (DUP_MASK & 4096) xcd_barrier(bb_, F.tid); } } while (0)
#define SS ((const float*)(F.ws + WS_SS))
#define HB ((bf16_t*)(F.ws + WS_HB))
#define MIX ((bf16_t*)(F.ws + WS_MIX))
#define PROJ ((bf16_t*)(F.ws + WS_PROJ))

    if ((PH_MASK & 1) && IN(0)) { REPS(1) { REFRESH(); p0_prologue(F); } SEAM(0); }
    for (int L = 0; L < DEPTH; ++L) {
        const int pb = 1 + 6 * L, j = L >> 1;
        if (IN(pb)) {
            REFRESH();
            const int dgrp = (blockIdx.x >> 3) & 1, dworker = ((blockIdx.x >> 4) * 8 + (blockIdx.x & 7)) * 8 + F.wave, dnw = (F.G / 2) * 8;
            if (DEFER_WEIGHTS && L == 0 && dgrp == 0) { for (int k2 = dworker; 2 * k2 < DEPTH * I_LAYER - I_IN; k2 += dnw) p0_weights(F, I_IN + 2 * k2, 1, 0, 1); __syncthreads(); }
            pg8::Gemm g{HB, W_in(F, L), MROWS, NIN, DM}; pg8::StaticOrder S; S.init(MROWS, NIN, F.G, (int)blockIdx.x);
            if (L & 1) { if (PH_MASK & 2) REPS(2) { rstd_table(F, S, SS); EpiInC E{PROJ, (const LAS float*)(F.lds + RSTD_OFF)}; pg8::gemm_phase<EpiInC, pg8::StaticOrder, GEMM_ALIGN, GEMM_SP2>(F.lds, g, S, E, F.tid); } if (PH_MASK & 4) gate_step(F, L); }
            else if (PH_MASK & 8) REPS(8) { rstd_table(F, S, SS); EpiInA E{PROJ, (const LAS float*)(F.lds + RSTD_OFF), (const float*)(F.ws + WS_COS), (const float*)(F.ws + WS_SIN)}; pg8::gemm_phase<EpiInA, pg8::StaticOrder, GEMM_ALIGN, GEMM_SP2>(F.lds, g, S, E, F.tid); }
            if (DEFER_WEIGHTS && L == 0 && dgrp == 1) { REFRESH(); for (int k2 = dworker; 2 * k2 + 1 < DEPTH * I_LAYER - I_IN; k2 += dnw) p0_weights(F, I_IN + 2 * k2 + 1, 1, 0, 1); }
            SEAM(pb);
        }
        if (IN(pb + 1)) {
            REFRESH();
            for (int u = blockIdx.x; u < 256; u += F.G) { if (L & 1) { if (PH_MASK & 16) REPS(16) la_pass1<1>(F, u); } else { if (PH_MASK & 32) REPS(32) la_pass1<0>(F, u); if (PH_MASK & 64) REPS(64) sgu_unit(F, u, j); } }
            SEAM(pb + 1);
        }
        if (IN(pb + 2)) {
            REFRESH();
            for (int u = blockIdx.x; u < 256; u += F.G) { if (L & 1) { if (PH_MASK & 128) REPS(128) la_pass2<1>(F, u, j); } else { if (PH_MASK & 256) REPS(256) la_pass2<0>(F, u, j); } }
            SEAM(pb + 2);
        }
        if (IN(pb + 3)) {
            REFRESH();
            pg8::Gemm g{MIX, W_out(F, L), MROWS, DM, DM}; pg8::StaticOrder S; S.init(MROWS, DM, F.G, (int)blockIdx.x);
            if (PH_MASK & 512) for (int rep_ = 0; rep_ < ((DUP_MASK & 512) ? 3 : 1); ++rep_) { EpiRes E{HB, (float*)(F.ws + WS_SS), (rep_ == 1) ? -1.f : 1.f}; pg8::gemm_phase<EpiRes, pg8::StaticOrder, GEMM_ALIGN, GEMM_SP2>(F.lds, g, S, E, F.tid); if (ONE_LAUNCH && rep_ + 1 < ((DUP_MASK & 512) ? 3 : 1)) { REFRESH(); XcdBarrier bb_; bb_.bar = (unsigned*)(F.ws + WS_CTL); bb_.x = xb_xcc_id(); bb_.st = (volatile LAS unsigned*)(F.lds + LDSCTL_OFF) + 8; xcd_barrier(bb_, F.tid); } }
            SEAM(pb + 3);
        }
        if (IN(pb + 4)) {
            REFRESH();
            pg8::Gemm g{HB, W_up(F, L), MROWS, NUP, DM}; pg8::StaticOrder S; S.init(MROWS, NUP, F.G, (int)blockIdx.x);
            if (PH_MASK & 1024) REPS(1024) { rstd_table(F, S, SS); EpiSwiGLU E{PROJ, (const LAS float*)(F.lds + RSTD_OFF)}; pg8::gemm_phase<EpiSwiGLU, pg8::StaticOrder, GEMM_ALIGN, GEMM_SP2>(F.lds, g, S, E, F.tid); }
            SEAM(pb + 4);
        }
        if (IN(pb + 5)) {
            REFRESH();
            pg8::Gemm g{PROJ, W_down(F, L), MROWS, DM, DFF}; pg8::StaticOrder S; S.init(MROWS, DM, F.G, (int)blockIdx.x);
            if (PH_MASK & 2048) for (int rep_ = 0; rep_ < ((DUP_MASK & 2048) ? 3 : 1); ++rep_) { EpiRes E{HB, (float*)(F.ws + WS_SS), (rep_ == 1) ? -1.f : 1.f}; pg8::gemm_phase<EpiRes, pg8::StaticOrder, GEMM_ALIGN, GEMM_SP2>(F.lds, g, S, E, F.tid); if (ONE_LAUNCH && rep_ + 1 < ((DUP_MASK & 2048) ? 3 : 1)) { REFRESH(); XcdBarrier bb_; bb_.bar = (unsigned*)(F.ws + WS_CTL); bb_.x = xb_xcc_id(); bb_.st = (volatile LAS unsigned*)(F.lds + LDSCTL_OFF) + 8; xcd_barrier(bb_, F.tid); } }
            SEAM(pb + 5);
        }
    }
    if ((PH_MASK & 4096) && IN(NPHASE - 1)) { REFRESH(); final_norm(F); }
#undef IN
#undef SEAM
#undef REFRESH
#undef SS
#undef HB
#undef MIX
#undef PROJ
}

extern "C" void kernel_launch(void* const* d_in, const int* in_sizes, int n_in, void* d_out, int out_size, void* d_ws, size_t ws_size, hipStream_t stream) {
    static int grid = 0;
    if (grid == 0) {
        if (n_in != 19 || out_size != MROWS * DM || ws_size < WS_END) { fprintf(stderr, "kernel_launch: unexpected problem shape (n_in %d, out %d, ws %zu)\n", n_in, out_size, ws_size); grid = -1; return; }
        int dev = 0, cus = 0, per_cu = 0;
        if (hipGetDevice(&dev) != hipSuccess || hipDeviceGetAttribute(&cus, hipDeviceAttributeMultiprocessorCount, dev) != hipSuccess) { grid = -1; return; }
        if (hipFuncSetAttribute((const void*)fwd, hipFuncAttributeMaxDynamicSharedMemorySize, LDS_BYTES) != hipSuccess) { fprintf(stderr, "kernel_launch: hipFuncSetAttribute failed\n"); grid = -1; return; }
        if (hipOccupancyMaxActiveBlocksPerMultiprocessor(&per_cu, (const void*)fwd, 512, LDS_BYTES) != hipSuccess || per_cu < 1) { fprintf(stderr, "kernel_launch: occupancy query says %d\n", per_cu); (void)hipGetLastError(); grid = -1; return; }
        grid = cus;
    }
    if (grid < 0) return;
    (void)hipMemsetAsync((char*)d_ws + WS_CTL, 0, CTL_ZERO_BYTES, stream);
    Args a{};
    for (int i = 0; i < 19; ++i) a.in[i] = (const float*)d_in[i];
    a.out = (float*)d_out; a.ws = (unsigned char*)d_ws;
    if (ONE_LAUNCH) { a.ph_lo = 0; a.ph_hi = NPHASE; hipLaunchKernelGGL(fwd, dim3(grid), dim3(512), LDS_BYTES, stream, a); }
    else for (int p = 0; p < NPHASE; ++p) { a.ph_lo = p; a.ph_hi = p + 1; hipLaunchKernelGGL(fwd, dim3(grid), dim3(512), LDS_BYTES, stream, a); }
}
```

```cpp
#include <hip/hip_runtime.h>
#include <cstdio>
#include <cstdint>

#ifndef PH_MASK
#define PH_MASK 8191
#endif
#ifndef DUP_MASK
#define DUP_MASK 0
#endif
#define REPS(bit) for (int rep_ = 0; rep_ < ((DUP_MASK & (bit)) ? 2 : 1); ++rep_)
#ifndef GEMM_ALIGN
#define GEMM_ALIGN true
#endif
#ifndef GEMM_SP2
#define GEMM_SP2 true
#endif
#ifndef ONE_LAUNCH
#define ONE_LAUNCH 1
#endif

#ifndef SDUP
#define SDUP 0
#endif
namespace pg8 {
#define PG8_LAS __attribute__((address_space(3)))
typedef unsigned short bf16_t;
typedef short bf16x8 __attribute__((ext_vector_type(8)));
typedef float f32x4 __attribute__((ext_vector_type(4)));
typedef unsigned u32x4 __attribute__((ext_vector_type(4)));
constexpr int BM = 256, BK = 64, HALF = 128, HTB = HALF * BK * 2  , STAGE_BYTES = 8 * HTB, NXCD = 8, WGM = 8;

__host__ __device__ __forceinline__ int lds_byte(int r, int c) { const int st = (r >> 4) * 2 + (c >> 5), rr = r & 15, cc = c & 31, ob = rr * 64 + cc * 2; return st * 1024 + (ob ^ (((ob >> 9) & 1) << 5)); }
__host__ __device__ __forceinline__ void stage_rc(int b, int& R, int& C) { const int st = b / 1024, sb = b % 1024, swz = sb ^ (((sb >> 9) & 1) << 5); R = (st >> 1) * 16 + swz / 64; C = (st & 1) * 32 + (swz % 64) / 2; }
__host__ __device__ __forceinline__ int perm32(int rho) { const int n = rho >> 4, i = rho & 15; return 8 * (i >> 2) + 4 * n + (i & 3); }

struct Unit { int pm, pn, ui; };
struct Gemm { const bf16_t* A; const bf16_t* Bt; int M, N, K; };

struct StaticOrder {
    int nM, nN, nwg, G, c;
    __host__ __device__ void init(int M, int N, int G_, int c_) { nM = M / BM; nN = N / BM; nwg = nM * nN; G = G_; c = c_; }
    __host__ __device__ bool next(int i, Unit& u) const {
        const long L = (long)i * G + c; if (L >= nwg) return false;
        int wgid = (int)L; { const int q = nwg / NXCD, r = nwg % NXCD, xcd = wgid % NXCD, off = wgid / NXCD; wgid = (xcd < r ? xcd * (q + 1) : r * (q + 1) + (xcd - r) * q) + off; }
        const int nig = WGM * nN, gid = wgid / nig, fm = gid * WGM, gsz = (nM % WGM == 0) ? WGM : ((nM - fm) < WGM ? (nM - fm) : WGM);
        u.pm = fm + ((wgid % nig) % gsz); u.pn = (wgid % nig) / gsz; u.ui = i; return true;
    }
    __device__ __forceinline__ void a_ready(const Unit&) const {}
    __device__ __forceinline__ void done(const Unit&) const {}
};

template <class Epi, class Sched, bool ALIGN_EPI = false, bool SP2 = false>
__device__ __forceinline__ void gemm_phase(PG8_LAS unsigned char* lds, const Gemm g, const Sched& S, const Epi& E, int tid_) {
    asm volatile("" : "+v"(tid_));
    const int tid = tid_, wid = __builtin_amdgcn_readfirstlane(tid >> 6), lane = tid & 63, wr = wid >> 2, wc = wid & 3, fr = lane & 15, fq = lane >> 4;
    const int K = g.K, nt = K / BK;
    unsigned voffA[2], voffB[2];
#pragma unroll
    for (int i = 0; i < 2; ++i) { int R, C; stage_rc(tid * 16 + i * 8192, R, C); const int Rb = Epi::PERM ? ((R & ~31) + perm32(R & 31)) : R;
        voffA[i] = (unsigned)(R * K + C) * 2u; voffB[i] = (unsigned)(Rb * K + C) * 2u; }
    const size_t kstep = (size_t)(BK * 2);
    const size_t hstep = (size_t)HALF * K * 2;
    const size_t tstep = 2 * hstep;
    const unsigned ldsw = (unsigned)wid * 1024u;
    const int aoff = lds_byte(wr * 64 + fr, fq * 8), boff = lds_byte(wc * 32 + fr, fq * 8);
#define PG8_SA(b, h) (((b) * 2 + (h)) * HTB)
#define PG8_SB(b, h) ((4 + (b) * 2 + (h)) * HTB)
#define PG8_STAGE(bufoff, gbase, voff) do { _Pragma("unroll") for (int _i = 0; _i < 2; ++_i) \
        __builtin_amdgcn_global_load_lds((const unsigned*)((const char*)(gbase) + (voff)[_i]), (PG8_LAS unsigned*)(lds + (bufoff) + ldsw + _i * 8192), 16, 0, 0); } while (0)
#define PG8_LDA(dst, b, h) do { _Pragma("unroll") for (int m = 0; m < 4; ++m) _Pragma("unroll") for (int k = 0; k < 2; ++k) dst[m][k] = *(const PG8_LAS bf16x8*)(lds + PG8_SA(b, h) + aoff + m * 2048 + k * 1024); } while (0)
#define PG8_LDB(dst, b, h) do { _Pragma("unroll") for (int n = 0; n < 2; ++n) _Pragma("unroll") for (int k = 0; k < 2; ++k) dst[n][k] = *(const PG8_LAS bf16x8*)(lds + PG8_SB(b, h) + boff + n * 2048 + k * 1024); } while (0)
#define PG8_MMA(ai, bj, At, Bt) do { __builtin_amdgcn_s_setprio(1); _Pragma("unroll") for (int m = 0; m < 4; ++m) _Pragma("unroll") for (int n = 0; n < 2; ++n) _Pragma("unroll") for (int k = 0; k < 2; ++k) \
        acc[ai][bj][m][n] = __builtin_amdgcn_mfma_f32_16x16x32_bf16(Bt[n][k], At[m][k], acc[ai][bj][m][n], 0, 0, 0); __builtin_amdgcn_s_setprio(0); } while (0)
#define PG8_WAIT_V(n) asm volatile("s_waitcnt vmcnt(" #n ")" ::: "memory")
#define PG8_WAIT_L(n) asm volatile("s_waitcnt lgkmcnt(" #n ")" ::: "memory")
#define PG8_BAR __builtin_amdgcn_s_barrier()
#define PG8_SCHED __builtin_amdgcn_sched_barrier(0)
    Unit cur, nxt; int ui = 0;
    if (!S.next(0, cur)) return;
    f32x4 acc[2][2][4][2];
#pragma unroll
    for (int a = 0; a < 2; ++a)
#pragma unroll
        for (int b = 0; b < 2; ++b)
#pragma unroll
            for (int m = 0; m < 4; ++m)
#pragma unroll
                for (int n = 0; n < 2; ++n) acc[a][b][m][n] = (f32x4){0.f, 0.f, 0.f, 0.f};
    bf16x8 At[4][2], B0[2][2], B1[2][2];
    const char* cA = (const char*)g.A + (size_t)cur.pm * tstep; const char* cB = (const char*)g.Bt + (size_t)cur.pn * tstep;
    S.a_ready(cur);
    if constexpr (SP2) {
        PG8_STAGE(PG8_SB(0, 0), cB, voffB); PG8_STAGE(PG8_SB(0, 1), cB + hstep, voffB); PG8_STAGE(PG8_SA(0, 0), cA, voffA); PG8_STAGE(PG8_SA(0, 1), cA + hstep, voffA);
        if (wr == 1) PG8_BAR;
        PG8_WAIT_V(2); PG8_BAR;
        PG8_STAGE(PG8_SB(1, 0), cB + kstep, voffB); PG8_STAGE(PG8_SA(1, 0), cA + kstep, voffA); PG8_STAGE(PG8_SB(1, 1), cB + hstep + kstep, voffB);
        PG8_WAIT_V(6); PG8_BAR;
    } else {
        PG8_STAGE(PG8_SB(0, 0), cB, voffB); PG8_STAGE(PG8_SA(0, 0), cA, voffA); PG8_STAGE(PG8_SB(0, 1), cB + hstep, voffB); PG8_STAGE(PG8_SA(0, 1), cA + hstep, voffA);
        if (wr == 1) PG8_BAR;
        PG8_WAIT_V(4); PG8_BAR;
        PG8_STAGE(PG8_SB(1, 0), cB + kstep, voffB); PG8_STAGE(PG8_SA(1, 0), cA + kstep, voffA); PG8_STAGE(PG8_SB(1, 1), cB + hstep + kstep, voffB);
        PG8_WAIT_V(6); PG8_BAR;
    }
    for (;;) {
        const bool has_next = S.next(ui + 1, nxt);
        const char* nA = has_next ? (const char*)g.A + (size_t)nxt.pm * tstep : cA; const char* nB = has_next ? (const char*)g.Bt + (size_t)nxt.pn * tstep : cB;
        for (int t = 0; t < nt; t += 2) {
            const bool last = (t == nt - 2);
            const char* a1 = cA + (size_t)(t + 1) * kstep;
            const char* a2 = last ? nA : cA + (size_t)(t + 2) * kstep; const char* b2 = last ? nB : cB + (size_t)(t + 2) * kstep;
            const char* a3 = a2 + kstep; const char* b3 = b2 + kstep;
            if (last && has_next) S.a_ready(nxt);
            if constexpr (SP2) {
            PG8_LDB(B0, 0, 0); PG8_LDB(B1, 0, 1); PG8_SCHED; PG8_LDA(At, 0, 0); PG8_STAGE(PG8_SA(1, 1), a1 + hstep, voffA);
            PG8_WAIT_V(8); PG8_WAIT_L(0); PG8_BAR; PG8_MMA(0, 0, At, B0); PG8_MMA(0, 1, At, B1); PG8_BAR; PG8_SCHED;
            PG8_LDA(At, 0, 1); PG8_STAGE(PG8_SB(0, 0), b2, voffB); PG8_STAGE(PG8_SB(0, 1), b2 + hstep, voffB); PG8_STAGE(PG8_SA(0, 0), a2, voffA);
            PG8_WAIT_V(8); PG8_WAIT_L(0); PG8_BAR; PG8_MMA(1, 0, At, B0); PG8_MMA(1, 1, At, B1); PG8_BAR; PG8_SCHED;
            PG8_LDB(B0, 1, 0); PG8_LDB(B1, 1, 1); PG8_SCHED; PG8_LDA(At, 1, 0); PG8_STAGE(PG8_SA(0, 1), a2 + hstep, voffA);
            PG8_WAIT_V(8); PG8_WAIT_L(0); PG8_BAR; PG8_MMA(0, 0, At, B0); PG8_MMA(0, 1, At, B1); PG8_BAR; PG8_SCHED;
            PG8_LDA(At, 1, 1); PG8_STAGE(PG8_SB(1, 0), b3, voffB); PG8_STAGE(PG8_SB(1, 1), b3 + hstep, voffB); PG8_STAGE(PG8_SA(1, 0), a3, voffA);
            PG8_WAIT_V(8); PG8_WAIT_L(0); PG8_BAR; PG8_MMA(1, 0, At, B0); PG8_MMA(1, 1, At, B1); PG8_BAR; PG8_SCHED;
            } else {
            PG8_LDB(B0, 0, 0); PG8_SCHED; PG8_LDA(At, 0, 0); PG8_STAGE(PG8_SA(1, 1), a1 + hstep, voffA);
            PG8_WAIT_L(8); PG8_BAR; PG8_WAIT_L(0); PG8_MMA(0, 0, At, B0); PG8_BAR; PG8_SCHED;
            PG8_LDB(B1, 0, 1); PG8_STAGE(PG8_SB(0, 0), b2, voffB);
            PG8_BAR; PG8_WAIT_L(0); PG8_MMA(0, 1, At, B1); PG8_BAR;
            PG8_LDA(At, 0, 1); PG8_STAGE(PG8_SA(0, 0), a2, voffA);
            PG8_BAR; PG8_WAIT_L(0); PG8_MMA(1, 0, At, B0); PG8_BAR; PG8_SCHED;
            PG8_STAGE(PG8_SB(0, 1), b2 + hstep, voffB);
            PG8_WAIT_V(6); PG8_BAR; PG8_MMA(1, 1, At, B1); PG8_BAR;
            PG8_LDB(B0, 1, 0); PG8_SCHED; PG8_LDA(At, 1, 0); PG8_STAGE(PG8_SA(0, 1), a2 + hstep, voffA);
            PG8_WAIT_L(8); PG8_BAR; PG8_WAIT_L(0); PG8_MMA(0, 0, At, B0); PG8_BAR; PG8_SCHED;
            PG8_LDB(B1, 1, 1); PG8_STAGE(PG8_SB(1, 0), b3, voffB);
            PG8_BAR; PG8_WAIT_L(0); PG8_MMA(0, 1, At, B1); PG8_BAR;
            PG8_LDA(At, 1, 1); PG8_STAGE(PG8_SA(1, 0), a3, voffA);
            PG8_BAR; PG8_WAIT_L(0); PG8_MMA(1, 0, At, B0); PG8_BAR; PG8_SCHED;
            PG8_STAGE(PG8_SB(1, 1), b3 + hstep, voffB);
            PG8_WAIT_V(6); PG8_BAR; PG8_MMA(1, 1, At, B1); PG8_BAR;
            }
        }
        if constexpr (ALIGN_EPI) { if (wr == 0) PG8_BAR; }
        E(acc, cur, wr, wc, fr, fq); if (SDUP & 32) { asm volatile("" ::: "memory"); E(acc, cur, wr, wc, fr, fq); } S.done(cur);
        if (!has_next) break;
#pragma unroll
        for (int a = 0; a < 2; ++a)
#pragma unroll
            for (int b = 0; b < 2; ++b)
#pragma unroll
                for (int m = 0; m < 4; ++m)
#pragma unroll
                    for (int n = 0; n < 2; ++n) acc[a][b][m][n] = (f32x4){0.f, 0.f, 0.f, 0.f};
        cur = nxt; cA = nA; cB = nB; ++ui;
        if constexpr (ALIGN_EPI) { if (wr == 1) PG8_BAR; }
    }
    PG8_WAIT_V(0);
    if constexpr (!ALIGN_EPI) { if (wr == 0) PG8_BAR; }
    PG8_BAR;
#undef PG8_SA
#undef PG8_SB
#undef PG8_STAGE
#undef PG8_LDA
#undef PG8_LDB
#undef PG8_MMA
#undef PG8_WAIT_V
#undef PG8_WAIT_L
#undef PG8_BAR
#undef PG8_SCHED
}
}

constexpr int BATCH = 8, SEQ = 4096, DM = 1024, MROWS = BATCH * SEQ, DEPTH = 4;
constexpr int NIN = 3072, CIN = 3080, DFF = 2816, NUP = 2 * DFF;
constexpr float EPS = 1e-6f;
constexpr size_t M512 = (size_t)MROWS * 512;
constexpr int NPHASE = 2 + 6 * DEPTH;

constexpr size_t MiB = 1u << 20;
constexpr size_t WS_CTL = 0, CTL_ZERO_BYTES = 64 * 1024;
constexpr size_t WS_COS = 1 * MiB, WS_SIN = 2 * MiB;
constexpr size_t WS_SS = 3 * MiB;
constexpr size_t WS_GLI = 5 * MiB, WS_GLF = 5 * MiB + 512 * 1024;
constexpr size_t WS_WG = 6 * MiB;
constexpr size_t WS_WM = 6 * MiB + 256 * 1024;
constexpr size_t WS_NST = 7 * MiB;
constexpr size_t WS_W = 8 * MiB;
constexpr size_t W_IN_OFF = 0, W_OUT_OFF = (size_t)NIN * DM * 2, W_UP_OFF = W_OUT_OFF + (size_t)DM * DM * 2, W_DOWN_OFF = W_UP_OFF + (size_t)NUP * DM * 2, W_LAYER = W_DOWN_OFF + (size_t)DM * DFF * 2;
constexpr size_t WS_HB = 106 * MiB;
constexpr size_t WS_MIX = 170 * MiB;
constexpr size_t WS_PROJ = 234 * MiB;
constexpr size_t WS_TST = 426 * MiB;
constexpr size_t WS_END = 460 * MiB;
static_assert(WS_W + 4 * W_LAYER <= WS_HB && WS_TST + (size_t)256 * 256 * 128 * 4 <= WS_END, "ws map");

constexpr int RING_BYTES = 131072;
constexpr int LDS_BYTES = 147456;
constexpr int P0_SCR_BYTES = 8 * 16640;
constexpr int RSTD_OFF = P0_SCR_BYTES;
constexpr int LDSCTL_OFF = LDS_BYTES - 256;
static_assert(RSTD_OFF >= RING_BYTES && RSTD_OFF + 12 * 256 * 4 <= LDSCTL_OFF, "LDS map");

#define GAS __attribute__((address_space(1)))
#define LAS __attribute__((address_space(3)))
#define DI __device__ __forceinline__
typedef unsigned short bf16_t;
typedef short bf16x8 __attribute__((ext_vector_type(8)));
typedef short bf16x4 __attribute__((ext_vector_type(4)));
typedef float f32x4 __attribute__((ext_vector_type(4)));
typedef float f32x16 __attribute__((ext_vector_type(16)));
typedef unsigned u32x4 __attribute__((ext_vector_type(4)));
typedef unsigned u32x2 __attribute__((ext_vector_type(2)));

DI unsigned pk2(float lo, float hi) { typedef __bf16 b2 __attribute__((ext_vector_type(2))); b2 v; v.x = (__bf16)lo; v.y = (__bf16)hi; return __builtin_bit_cast(unsigned, v); }
DI float bf2f(unsigned short x) { return __uint_as_float(((unsigned)x) << 16); }
DI float bflo(unsigned w) { return __uint_as_float(w << 16); }
DI float bfhi(unsigned w) { return __uint_as_float(w & 0xffff0000u); }
DI float fexp(float x) { return __builtin_amdgcn_exp2f(x * 1.4426950408889634f); }
DI float frcp(float x) { return __builtin_amdgcn_rcpf(x); }
DI float sigmoid_f(float x) { return frcp(1.f + fexp(-x)); }
DI float silu_f(float x) { return x * sigmoid_f(x); }
DI float gelu_tanh_f(float x) { return x * sigmoid_f(1.5957691216057308f * (x + 0.044715f * x * x * x)); }
template <int CTRL> DI float dpp_f(float v) { return __int_as_float(__builtin_amdgcn_mov_dpp(__float_as_int(v), CTRL, 0xF, 0xF, true)); }
DI float xor16_f(float v) { return __int_as_float(__builtin_amdgcn_ds_swizzle(__float_as_int(v), 0x401F)); }
DI float sum_xor32(float v) { const auto r = __builtin_amdgcn_permlane32_swap(__float_as_uint(v), __float_as_uint(v), false, false); return __uint_as_float(r[0]) + __uint_as_float(r[1]); }
DI float sum_xor16_32(float v) { v += xor16_f(v); return sum_xor32(v); }
DI float wave_sum(float v) {
    v += dpp_f<0xB1>(v); v += dpp_f<0x4E>(v); v += dpp_f<0x141>(v); v += dpp_f<0x140>(v);
    return sum_xor16_32(v);
}
template <int CTRL, int ROWMASK, bool IS_MAX> DI float scan_step(float v, const float ident) {
    const float t = __int_as_float(__builtin_amdgcn_update_dpp(__float_as_int(ident), __float_as_int(v), CTRL, ROWMASK, 0xF, false));
    return IS_MAX ? fmaxf(v, t) : v + t;
}
template <bool IS_MAX> DI float wave_scan(float v) {
    const float id = IS_MAX ? -3.0e38f : 0.f;
    v = scan_step<0x111, 0xF, IS_MAX>(v, id); v = scan_step<0x112, 0xF, IS_MAX>(v, id); v = scan_step<0x114, 0xF, IS_MAX>(v, id); v = scan_step<0x118, 0xF, IS_MAX>(v, id);
    v = scan_step<0x142, 0xA, IS_MAX>(v, id);
    v = scan_step<0x143, 0xC, IS_MAX>(v, id);
    return v;
}
DI float lane63(float v) { return __int_as_float(__builtin_amdgcn_readlane(__float_as_int(v), 63)); }

#define XB_TMO      128
#define XB_XCNT(j)  (256  + 64 * (j))
#define XB_XSUB(j)  (1280 + 64 * (j))
#define XB_XGEN(j)  (2304 + 64 * (j))
#define XB_TOP      3328
#define XB_TOPGEN   3392
#define XCD_BAR_WORDS 3456
#define XB_SPIN_CAP (1u << 18)

__device__ __forceinline__ unsigned xb_ld(unsigned* p)              { return __hip_atomic_load(p, __ATOMIC_RELAXED, __HIP_MEMORY_SCOPE_AGENT); }
__device__ __forceinline__ unsigned xb_add(unsigned* p, unsigned v) { return __hip_atomic_fetch_add(p, v, __ATOMIC_RELAXED, __HIP_MEMORY_SCOPE_AGENT); }
__device__ __forceinline__ unsigned xb_xcc_id() { return (unsigned)__builtin_amdgcn_s_getreg((3 << 11) | 20) & 0xFu; }
#define XB_SPIN(cond, bar) do { unsigned _sp = 0; while (cond) { __builtin_amdgcn_s_sleep(1); \
    if ((++_sp & 255u) == 0u) { if (xb_ld(&(bar)[XB_TMO])) break; if (_sp > XB_SPIN_CAP) { atomicAdd(&(bar)[XB_TMO], 1u); break; } } } } while (0)

struct XcdBarrier { unsigned* bar; unsigned x; volatile LAS unsigned* st; };

__device__ __forceinline__ XcdBarrier xcd_barrier_post(unsigned* bar, volatile LAS unsigned* st, int tid) {
    XcdBarrier b; b.bar = bar; b.x = xb_xcc_id(); b.st = st;
    if (tid == 0) (void)xb_add(&bar[XB_XCNT(b.x)], 1u);
    return b;
}
__device__ __forceinline__ void xcd_barrier_complete(unsigned* bar, unsigned x, unsigned& nloc, unsigned& nx) {
    const unsigned G = gridDim.x * gridDim.y * gridDim.z;
    unsigned sum, cnt, mine, sp = 0u;
    for (;;) {
        sum = 0u; cnt = 0u; mine = 0u;
#pragma unroll
        for (unsigned j = 0; j < 16; ++j) { const unsigned c = xb_ld(&bar[XB_XCNT(j)]); sum += c; cnt += (c > 0u) ? 1u : 0u; mine = (j == x) ? c : mine; }
        if (sum == G) break;
        __builtin_amdgcn_s_sleep(1);
        if ((++sp & 255u) == 0u) { if (xb_ld(&bar[XB_TMO])) break; if (sp > XB_SPIN_CAP) { atomicAdd(&bar[XB_TMO], 1u); break; } }
    }
    nloc = mine > 0u ? mine : 1u; nx = cnt > 0u ? cnt : 1u;
}
__device__ __forceinline__ void xcd_barrier(const XcdBarrier& b, int tid) {
    asm volatile("s_waitcnt vmcnt(0)" ::: "memory");
    __syncthreads();
    if (tid == 0) {
        unsigned* bar = b.bar;
        __builtin_amdgcn_s_waitcnt(0);
        unsigned nloc = b.st[0], nx = b.st[1];
        if (nloc == 0u) { xcd_barrier_complete(bar, b.x, nloc, nx); b.st[0] = nloc; b.st[1] = nx; }
        const unsigned old = xb_add(&bar[XB_XSUB(b.x)], 1u);
        const unsigned gen = old / nloc;
        if (old + 1u == (gen + 1u) * nloc) {
            __builtin_amdgcn_fence(__ATOMIC_RELEASE, "agent");
            asm volatile("s_waitcnt vmcnt(0)" ::: "memory");
            const unsigned og = xb_add(&bar[XB_TOP], 1u);
            const unsigned tg = og / nx;
            if (og + 1u == (tg + 1u) * nx) xb_add(&bar[XB_TOPGEN], 1u);
            else XB_SPIN(xb_ld(&bar[XB_TOPGEN]) == tg, bar);
            __builtin_amdgcn_fence(__ATOMIC_ACQUIRE, "agent");
            xb_add(&bar[XB_XGEN(b.x)], 1u);
            asm volatile("s_waitcnt vmcnt(0)" ::: "memory");
        } else {
            XB_SPIN(xb_ld(&bar[XB_XGEN(b.x)]) == gen, bar);
            __builtin_amdgcn_fence(__ATOMIC_ACQUIRE, "agent");
            asm volatile("s_waitcnt vmcnt(0)" ::: "memory");
        }
    }
    __syncthreads();
}

struct Frame {
    LAS unsigned char* lds;
    int tid, lane, wave, G;
    const float* const __attribute__((address_space(4)))* in;
    float* H;
    unsigned char* ws;
};
DI bf16_t* W_in(const Frame& F, int L)   { return (bf16_t*)(F.ws + WS_W + (size_t)L * W_LAYER + W_IN_OFF); }
DI bf16_t* W_out(const Frame& F, int L)  { return (bf16_t*)(F.ws + WS_W + (size_t)L * W_LAYER + W_OUT_OFF); }
DI bf16_t* W_up(const Frame& F, int L)   { return (bf16_t*)(F.ws + WS_W + (size_t)L * W_LAYER + W_UP_OFF); }
DI bf16_t* W_down(const Frame& F, int L) { return (bf16_t*)(F.ws + WS_W + (size_t)L * W_LAYER + W_DOWN_OFF); }

template <class Sched>
DI void rstd_table(Frame& F, const Sched& S, const float* __restrict__ SS) {
    LAS float* T = (LAS float*)(F.lds + RSTD_OFF); pg8::Unit u;
    for (int i0 = 0; S.next(i0, u); i0 += 4) {
        f32x4 sp[2][4]; bool ok[2];
#pragma unroll
        for (int k = 0; k < 2; ++k) { const int i = i0 + 2 * k + (F.tid >> 8); ok[k] = S.next(i, u);
            if (ok[k]) { const float* p = SS + (size_t)(256 * u.pm + (F.tid & 255)) * 16;
#pragma unroll
                for (int q = 0; q < 4; ++q) sp[k][q] = *(const f32x4*)(p + 4 * q); } }
#pragma unroll
        for (int k = 0; k < 2; ++k) if (ok[k]) { const int i = i0 + 2 * k + (F.tid >> 8); float s = 0.f;
#pragma unroll
            for (int q = 0; q < 4; ++q) s += (sp[k][q].x + sp[k][q].y) + (sp[k][q].z + sp[k][q].w);
            T[i * 256 + (F.tid & 255)] = 1.0f / sqrtf(s * (1.0f / DM) + EPS); }
    }
    __syncthreads();
}
DI void row_rstd8(const LAS float* T, int ui, int wr, int fr, float (&rs)[2][4]) {
#pragma unroll
    for (int ai = 0; ai < 2; ++ai)
#pragma unroll
        for (int m = 0; m < 4; ++m) rs[ai][m] = T[ui * 256 + ai * 128 + wr * 64 + m * 16 + fr];
}
DI void store8(bf16_t* p, const f32x4& v0, const f32x4& v1) { u32x4 w; w.x = pk2(v0[0], v0[1]); w.y = pk2(v0[2], v0[3]); w.z = pk2(v1[0], v1[1]); w.w = pk2(v1[2], v1[3]); *(u32x4*)p = w; }

struct EpiInA {
    static constexpr bool PERM = true;
    bf16_t* P; const LAS float* RT; const float* COS; const float* SIN;
    DI void operator()(const f32x4 (&acc)[2][2][4][2], const pg8::Unit& u, int wr, int wc, int fr, int fq) const {
        const int row0 = u.pm * 256 + wr * 64 + fr, colw = wc * 32 + 8 * fq, typ = u.pn >> 1;
        float rsv[2][4]; row_rstd8(RT, u.ui, wr, fr, rsv);
#pragma unroll
        for (int ai = 0; ai < 2; ++ai) {
            f32x4 cc[4], sn[4];
            if (typ < 2) {
#pragma unroll
                for (int m = 0; m < 4; ++m) { const int pos = (row0 + ai * 128 + m * 16) & (SEQ - 1); cc[m] = *(const f32x4*)(COS + pos * 64 + (colw >> 1)); sn[m] = *(const f32x4*)(SIN + pos * 64 + (colw >> 1)); } }
#pragma unroll
            for (int m = 0; m < 4; ++m) {
                const int row = row0 + ai * 128 + m * 16;
                const float rs = rsv[ai][m];
                const int bb = row >> 12, tq = row & (SEQ - 1);
                bf16_t* rowp = (typ < 4) ? P + (size_t)typ * M512 + ((size_t)((bb * 4 + 2 * (u.pn & 1)) * SEQ + tq)) * 128 + colw
                                         : P + (size_t)typ * M512 + (size_t)row * 512 + (u.pn & 1) * 256 + colw;
                const size_t bjs = (typ < 4) ? (size_t)SEQ * 128 : 128;
                if (typ < 2) {
                    const f32x4 c4 = cc[m], s4 = sn[m];
#pragma unroll
                    for (int bj = 0; bj < 2; ++bj) { const f32x4 a0 = acc[ai][bj][m][0] * rs, a1 = acc[ai][bj][m][1] * rs; f32x4 v0, v1;
                        v0[0] = a0[0] * c4[0] - a0[1] * s4[0]; v0[1] = a0[0] * s4[0] + a0[1] * c4[0];
                        v0[2] = a0[2] * c4[1] - a0[3] * s4[1]; v0[3] = a0[2] * s4[1] + a0[3] * c4[1];
                        v1[0] = a1[0] * c4[2] - a1[1] * s4[2]; v1[1] = a1[0] * s4[2] + a1[1] * c4[2];
                        v1[2] = a1[2] * c4[3] - a1[3] * s4[3]; v1[3] = a1[2] * s4[3] + a1[3] * c4[3];
                        store8(rowp + bj * bjs, v0, v1); }
                } else {
#pragma unroll
                    for (int bj = 0; bj < 2; ++bj) { f32x4 v0 = acc[ai][bj][m][0] * rs, v1 = acc[ai][bj][m][1] * rs;
                        if (typ == 3) {
#pragma unroll
                            for (int j = 0; j < 4; ++j) { v0[j] = silu_f(v0[j]); v1[j] = silu_f(v1[j]); } }
                        else if (typ >= 4) {
#pragma unroll
                            for (int j = 0; j < 4; ++j) { v0[j] = gelu_tanh_f(v0[j]); v1[j] = gelu_tanh_f(v1[j]); } }
                        store8(rowp + bj * bjs, v0, v1); }
                }
            }
        }
    }
};
struct EpiInC {
    static constexpr bool PERM = true;
    bf16_t* P; const LAS float* RT;
    DI void operator()(const f32x4 (&acc)[2][2][4][2], const pg8::Unit& u, int wr, int wc, int fr, int fq) const {
        const int row0 = u.pm * 256 + wr * 64 + fr, colw = wc * 32 + 8 * fq; const bool sg = u.pn >= 8;
        float rsv[2][4]; row_rstd8(RT, u.ui, wr, fr, rsv);
#pragma unroll
        for (int ai = 0; ai < 2; ++ai)
#pragma unroll
            for (int m = 0; m < 4; ++m) {
                const int row = row0 + ai * 128 + m * 16;
                const float rs = rsv[ai][m];
                const int bb = row >> 12, tq = row & (SEQ - 1);
                bf16_t* rowp; size_t bjs;
                if (u.pn < 4) { rowp = P + (size_t)(u.pn >> 1) * M512 + ((size_t)((bb * 4 + 2 * (u.pn & 1)) * SEQ + tq)) * 128 + colw; bjs = (size_t)SEQ * 128; }
                else { rowp = P + (size_t)(u.pn < 8 ? 2 : 4) * M512 + ((size_t)((bb * 4 + (u.pn & 3)) * SEQ + tq)) * 256 + colw; bjs = 128; }
#pragma unroll
                for (int bj = 0; bj < 2; ++bj) { f32x4 v0 = acc[ai][bj][m][0] * rs, v1 = acc[ai][bj][m][1] * rs;
                    if (sg) {
#pragma unroll
                        for (int j = 0; j < 4; ++j) { v0[j] = sigmoid_f(v0[j]); v1[j] = sigmoid_f(v1[j]); } }
                    store8(rowp + bj * bjs, v0, v1); }
            }
    }
};
struct EpiRes {
    static constexpr bool PERM = true;
    bf16_t* HB; float* SS; float sgn;
    DI void operator()(const f32x4 (&acc)[2][2][4][2], const pg8::Unit& u, int wr, int wc, int fr, int fq) const {
        const int row0 = u.pm * 256 + wr * 64 + fr, col0 = u.pn * 256 + wc * 32 + 8 * fq;
#pragma unroll
        for (int ai = 0; ai < 2; ++ai) {
            u32x4 hv[4][2];
#pragma unroll
            for (int m = 0; m < 4; ++m) { const bf16_t* bp = HB + (size_t)(row0 + ai * 128 + m * 16) * DM + col0;
#pragma unroll
                for (int bj = 0; bj < 2; ++bj) hv[m][bj] = *(const u32x4*)(bp + bj * 128); }
#pragma unroll
            for (int m = 0; m < 4; ++m) {
                const int row = row0 + ai * 128 + m * 16;
                bf16_t* bp = HB + (size_t)row * DM + col0; float ssum = 0.f;
#pragma unroll
                for (int bj = 0; bj < 2; ++bj) {
                    const u32x4 w = hv[m][bj];
                    const f32x4 b0 = {bflo(w.x), bfhi(w.x), bflo(w.y), bfhi(w.y)}, b1 = {bflo(w.z), bfhi(w.z), bflo(w.w), bfhi(w.w)};
                    const f32x4 h0 = b0 + acc[ai][bj][m][0] * sgn, h1 = b1 + acc[ai][bj][m][1] * sgn;
                    store8(bp + bj * 128, h0, h1);
                    ssum += (h0[0] * h0[0] + h0[1] * h0[1]) + (h0[2] * h0[2] + h0[3] * h0[3]) + (h1[0] * h1[0] + h1[1] * h1[1]) + (h1[2] * h1[2] + h1[3] * h1[3]);
                }
                ssum = sum_xor16_32(ssum);
                if (fq == 0) SS[(size_t)row * 16 + u.pn * 4 + wc] = ssum;
            }
        }
    }
};
struct EpiSwiGLU {
    static constexpr bool PERM = true;
    bf16_t* ACT; const LAS float* RT;
    DI void operator()(const f32x4 (&acc)[2][2][4][2], const pg8::Unit& u, int wr, int wc, int fr, int fq) const {
        const int row0 = u.pm * 256 + wr * 64 + fr, col0 = u.pn * 128 + wc * 32 + 8 * fq;
        float rsv[2][4]; row_rstd8(RT, u.ui, wr, fr, rsv);
#pragma unroll
        for (int ai = 0; ai < 2; ++ai)
#pragma unroll
            for (int m = 0; m < 4; ++m) {
                const int row = row0 + ai * 128 + m * 16;
                const float rs = rsv[ai][m];
                const f32x4 g0 = acc[ai][0][m][0] * rs, g1 = acc[ai][0][m][1] * rs, u0 = acc[ai][1][m][0] * rs, u1 = acc[ai][1][m][1] * rs; f32x4 v0, v1;
#pragma unroll
                for (int j = 0; j < 4; ++j) { v0[j] = silu_f(g0[j]) * u0[j]; v1[j] = silu_f(g1[j]) * u1[j]; }
                store8(ACT + (size_t)row * DFF + col0, v0, v1);
            }
    }
};

template <class Map>
DI void cvt_item(const float* src, int ld, const float* gain, bf16_t* WT, int K, int n0, int k0, const Map& mp, LAS float* scr, int lane) {
    const int sc = mp.col(n0 + lane); const float scale = mp.scale(n0 + lane);
    float wv[64];
    const float* sp = src + (size_t)k0 * ld + sc;
#pragma unroll
    for (int i = 0; i < 64; ++i) wv[i] = sp[(size_t)i * ld];
#pragma unroll
    for (int i = 0; i < 64; ++i) { const float gk = gain ? gain[k0 + i] : 1.0f; scr[i * 65 + lane] = wv[i] * (gk * scale); }
    asm volatile("s_waitcnt lgkmcnt(0)" ::: "memory");
    const int c = lane & 7;
#pragma unroll
    for (int j = 0; j < 8; ++j) { const int n = (lane >> 3) + 8 * j; const LAS float* s = scr + (8 * c) * 65 + n;
        u32x4 o; o.x = pk2(s[0 * 65], s[1 * 65]); o.y = pk2(s[2 * 65], s[3 * 65]); o.z = pk2(s[4 * 65], s[5 * 65]); o.w = pk2(s[6 * 65], s[7 * 65]);
        *(u32x4*)(WT + (size_t)(n0 + n) * K + k0 + 8 * c) = o; }
    asm volatile("s_waitcnt lgkmcnt(0)" ::: "memory");
}
struct MapId { DI int col(int n) const { return n; } DI float scale(int) const { return 1.0f; } };
struct MapInA { DI int col(int n) const { if (n >= 1024) return n; const int p = n & 127; return (n & ~127) + (p >> 1) + 64 * (p & 1); } DI float scale(int n) const { return (n >= 512 && n < 1024) ? 0.08838834764831845f : 1.0f; } };
struct MapInC { DI int col(int n) const { return n; } DI float scale(int n) const { return (n >= 512 && n < 1024) ? 0.08838834764831845f : 1.0f; } };
struct MapUp  { DI int col(int n) const { return 128 * (n >> 8) + (n & 127); } DI float scale(int) const { return 1.0f; } };

DI void p0_prologue(Frame& F) {
    LAS float* scr = (LAS float*)(F.lds + F.wave * 16640);
    const int gw = blockIdx.x * 8 + F.wave, NGW = F.G * 8;
    constexpr int I_IN = 16 * 48, I_OUT = 16 * 16, I_UP = 16 * 88, I_DOWN = 44 * 16, I_LAYER = I_IN + I_OUT + I_UP + I_DOWN;
    for (int it = gw; it < DEPTH * I_LAYER; it += NGW) {
        const int L = it / I_LAYER; int r = it % I_LAYER; const int j = L >> 1;
        if (r < I_IN) { const int kb = r / 48, nb = r % 48;
            if (L & 1) cvt_item(F.in[11] + (size_t)j * DM * CIN, CIN, F.in[1] + L * DM, W_in(F, L), DM, 64 * nb, 64 * kb, MapInC(), scr, F.lane);
            else       cvt_item(F.in[4] + (size_t)j * DM * NIN, NIN, F.in[1] + L * DM, W_in(F, L), DM, 64 * nb, 64 * kb, MapInA(), scr, F.lane);
            continue; }
        r -= I_IN;
        if (r < I_OUT) { const int kb = r / 16, nb = r % 16;
            cvt_item(((L & 1) ? F.in[12] : F.in[5]) + (size_t)j * DM * DM, DM, nullptr, W_out(F, L), DM, 64 * nb, 64 * kb, MapId(), scr, F.lane); continue; }
        r -= I_OUT;
        if (r < I_UP) { const int kb = r / 88, nb = r % 88; const int n0 = 64 * nb; const bool up = (n0 >> 7) & 1;
            cvt_item((up ? F.in[17] : F.in[16]) + (size_t)L * DM * DFF, DFF, F.in[2] + L * DM, W_up(F, L), DM, n0, 64 * kb, MapUp(), scr, F.lane); continue; }
        r -= I_UP;
        { const int kb = r / 16, nb = r % 16;
          cvt_item(F.in[18] + (size_t)L * DFF * DM, DM, nullptr, W_down(F, L), DFF, 64 * nb, 64 * kb, MapId(), scr, F.lane); }
    }
    float* SS = (float*)(F.ws + WS_SS); bf16_t* HB = (bf16_t*)(F.ws + WS_HB);
    for (int m2 = gw; m2 < MROWS / 2; m2 += NGW) {
        f32x4 v[2][4];
#pragma unroll
        for (int rr = 0; rr < 2; ++rr) { const f32x4* xr = (const f32x4*)(F.in[0] + (size_t)(2 * m2 + rr) * DM) + F.lane;
#pragma unroll
            for (int q = 0; q < 4; ++q) v[rr][q] = xr[64 * q]; }
#pragma unroll
        for (int rr = 0; rr < 2; ++rr) { const int m = 2 * m2 + rr; u32x2* br = (u32x2*)(HB + (size_t)m * DM) + F.lane; float s = 0.f;
#pragma unroll
            for (int q = 0; q < 4; ++q) { const f32x4 x = v[rr][q]; s += (x.x * x.x + x.y * x.y) + (x.z * x.z + x.w * x.w); u32x2 o; o.x = pk2(x.x, x.y); o.y = pk2(x.z, x.w); br[64 * q] = o; }
            s = wave_sum(s);
            if (F.lane < 16) SS[(size_t)m * 16 + F.lane] = (F.lane == 0) ? s : 0.f; }
    }
    const int gt = blockIdx.x * 512 + F.tid, NGT = F.G * 512;
    float* COS = (float*)(F.ws + WS_COS); float* SIN = (float*)(F.ws + WS_SIN);
    for (int e = gt; e < SEQ * 64; e += NGT) {
        const int pos = e >> 6, i = e & 63;
        const float inv = exp2f(-(float)i * (13.287712379549449f / 64.0f));
        const float ang = (float)pos * inv;
        const double a = (double)ang; const double n = rint(a * 0.15915494309189535); const float rr = (float)(a - n * 6.283185307179586);
        COS[e] = cosf(rr); SIN[e] = sinf(rr);
    }
    float* WG = (float*)(F.ws + WS_WG);
    for (int e = gt; e < 2 * 8 * DM; e += NGT) { const int j = e >> 13, c = (e >> 10) & 7, k = e & 1023;
        WG[e] = F.in[11][(size_t)j * DM * CIN + (size_t)k * CIN + 3072 + c] * F.in[1][(2 * j + 1) * DM + k]; }
    bf16_t* WM = (bf16_t*)(F.ws + WS_WM);
    for (int e = gt; e < 2 * 4 * 128 * 128; e += NGT) { const int p = (e >> 7) & 127, q = e & 127; const float w = ((q >> 6) <= (p >> 6)) ? F.in[9][e] : 0.f; WM[e] = (bf16_t)(pk2(w, 0.f) & 0xffffu); }
}

DI void gate_step(Frame& F, int L) {
    const int j = L >> 1; const int gw = blockIdx.x * 8 + F.wave, NGW = F.G * 8;
    const float* SS = (const float*)(F.ws + WS_SS); const bf16_t* HB = (const bf16_t*)(F.ws + WS_HB); const float* WG = (const float*)(F.ws + WS_WG) + j * 8 * DM;
    float* GLI = (float*)(F.ws + WS_GLI); float* GLF = (float*)(F.ws + WS_GLF);
    for (int m4 = gw; m4 < MROWS / 4; m4 += NGW) {
        u32x4 a0[4], a1[4]; float ssv[4];
#pragma unroll
        for (int rr = 0; rr < 4; ++rr) { const int m = 4 * m4 + rr; a0[rr] = *((const u32x4*)(HB + (size_t)m * DM) + F.lane); a1[rr] = *((const u32x4*)(HB + (size_t)m * DM + 512) + F.lane);
            ssv[rr] = (F.lane < 16) ? SS[(size_t)m * 16 + F.lane] : 0.f; }
#pragma unroll
        for (int rr = 0; rr < 4; ++rr) {
            const int m = 4 * m4 + rr; float x[16];
            x[0] = bflo(a0[rr].x); x[1] = bfhi(a0[rr].x); x[2] = bflo(a0[rr].y); x[3] = bfhi(a0[rr].y); x[4] = bflo(a0[rr].z); x[5] = bfhi(a0[rr].z); x[6] = bflo(a0[rr].w); x[7] = bfhi(a0[rr].w);
            x[8] = bflo(a1[rr].x); x[9] = bfhi(a1[rr].x); x[10] = bflo(a1[rr].y); x[11] = bfhi(a1[rr].y); x[12] = bflo(a1[rr].z); x[13] = bfhi(a1[rr].z); x[14] = bflo(a1[rr].w); x[15] = bfhi(a1[rr].w);
            const float ssp = wave_sum(ssv[rr]);
            const float rs = 1.0f / sqrtf(ssp * (1.0f / DM) + EPS);
            float myv = 0.f;
#pragma unroll
            for (int c = 0; c < 8; ++c) {
                const f32x4* w0 = (const f32x4*)(WG + c * DM + 8 * F.lane); const f32x4* w1 = (const f32x4*)(WG + c * DM + 512 + 8 * F.lane);
                const f32x4 wa = w0[0], wb = w0[1], wc2 = w1[0], wd = w1[1];
                float d = x[0] * wa.x + x[1] * wa.y + x[2] * wa.z + x[3] * wa.w + x[4] * wb.x + x[5] * wb.y + x[6] * wb.z + x[7] * wb.w
                        + x[8] * wc2.x + x[9] * wc2.y + x[10] * wc2.z + x[11] * wc2.w + x[12] * wd.x + x[13] * wd.y + x[14] * wd.z + x[15] * wd.w;
                d = wave_sum(d);
                if (F.lane == c) myv = d * rs;
            }
            if (F.lane < 8) {
                const int hh = F.lane & 3; const int b = m >> 12, t = m & (SEQ - 1); const size_t idx = (size_t)(b * 4 + hh) * SEQ + t;
                if (F.lane < 4) GLI[idx] = myv + F.in[13][j * 4 + hh];
                else { const float xx = myv + F.in[14][j * 4 + hh]; GLF[idx] = (xx >= 0.f) ? -log1pf(expf(-xx)) : (xx - log1pf(expf(xx))); }
            }
        }
    }
}

DI void final_norm(Frame& F) {
    const int gw = blockIdx.x * 8 + F.wave, NGW = F.G * 8; const float* SS = (const float*)(F.ws + WS_SS); const bf16_t* HB = (const bf16_t*)(F.ws + WS_HB); const f32x4* gv = (const f32x4*)F.in[3] + F.lane;
    f32x4 g[4];
#pragma unroll
    for (int q = 0; q < 4; ++q) g[q] = gv[64 * q];
    for (int m4 = gw; m4 < MROWS / 4; m4 += NGW) {
        u32x2 w[4][4]; float ssv[4];
#pragma unroll
        for (int rr = 0; rr < 4; ++rr) { const int m = 4 * m4 + rr; const u32x2* br = (const u32x2*)(HB + (size_t)m * DM) + F.lane;
#pragma unroll
            for (int q = 0; q < 4; ++q) w[rr][q] = br[64 * q];
            ssv[rr] = (F.lane < 16) ? SS[(size_t)m * 16 + F.lane] : 0.f; }
#pragma unroll
        for (int rr = 0; rr < 4; ++rr) { const int m = 4 * m4 + rr; f32x4* hr = (f32x4*)(F.H + (size_t)m * DM) + F.lane;
            const float rs = 1.0f / sqrtf(wave_sum(ssv[rr]) * (1.0f / DM) + EPS);
#pragma unroll
            for (int q = 0; q < 4; ++q) { const f32x4 v = {bflo(w[rr][q].x), bfhi(w[rr][q].x), bflo(w[rr][q].y), bfhi(w[rr][q].y)}; hr[64 * q] = v * rs * g[q]; } }
    }
}

DI int opaque(int x) { asm volatile("" : "+v"(x)); return x; }
DI int crow(int i, int h) { return (i & 3) + 8 * (i >> 2) + 4 * h; }
constexpr int QLD = 136, PLD = 72, KWLD = 160;
constexpr int QS_OFF = 0, KS_OFF = 17408, KW_OFF = 34816, VS_OFF = 55296, PS_OFF = 92160;
constexpr int SA_OFF = 101376, SCM_OFF = SA_OFF + 2048, SMT_OFF = SCM_OFF + 2048, SMISC_OFF = SMT_OFF + 2048;
constexpr int PQ_OFF = SMISC_OFF + 256, MS_OFF = PQ_OFF + 512, LS_OFF = MS_OFF + 320;
constexpr int STAT_OFF = LS_OFF + 320, NV_OFF = STAT_OFF + 4096, PSUM_OFF = NV_OFF + 512, QN_OFF = PSUM_OFF + 1024, GAIN_OFF = QN_OFF + 256, LA_END = GAIN_OFF + 1024;
static_assert(LA_END <= RING_BYTES, "mixer LDS");

DI bf16x8 gather_col(const LAS bf16_t* base, int ld, int col, int s0) {
    bf16x8 r;
#pragma unroll
    for (int j = 0; j < 8; ++j) r[j] = (short)base[(s0 + j) * ld + col];
    return r;
}
DI bf16x8 tr_frag(const LAS bf16_t* tile, int ld, int col0, int s0, int lane) {
    const int i16 = lane & 15, q = i16 >> 2, p = i16 & 3, blk = (lane >> 4) & 1, hh = lane >> 5;
    const LAS bf16_t* a = tile + (s0 + 8 * hh + q) * ld + col0 + 16 * blk + 4 * p;
    const bf16x4 lo = __builtin_amdgcn_ds_read_tr16_b64_v4i16((LAS bf16x4*)a), hi = __builtin_amdgcn_ds_read_tr16_b64_v4i16((LAS bf16x4*)(a + 4 * ld));
    return __builtin_shufflevector(lo, hi, 0, 1, 2, 3, 4, 5, 6, 7);
}
DI bf16x8 pack_acc(const f32x16& x, int s) {
    u32x4 p; p.x = pk2(x[8 * s + 0], x[8 * s + 1]); p.y = pk2(x[8 * s + 2], x[8 * s + 3]); p.z = pk2(x[8 * s + 4], x[8 * s + 5]); p.w = pk2(x[8 * s + 6], x[8 * s + 7]);
    return __builtin_bit_cast(bf16x8, p);
}
#define MFMA32(a, b, c) __builtin_amdgcn_mfma_f32_32x32x16_bf16((a), (b), (c), 0, 0, 0)
#define MFMA16(a, b, c) __builtin_amdgcn_mfma_f32_16x16x32_bf16((a), (b), (c), 0, 0, 0)

DI void mlstm_scan(Frame& F, int b, int h, int g) {
    LAS float* SA = (LAS float*)(F.lds + SA_OFF); LAS float* SCM = (LAS float*)(F.lds + SCM_OFF); LAS float* SMT = (LAS float*)(F.lds + SMT_OFF); LAS float* SM = (LAS float*)(F.lds + SMISC_OFF);
    LAS float* PQ = (LAS float*)(F.lds + PQ_OFF); LAS float* MS = (LAS float*)(F.lds + MS_OFF); LAS float* LS = (LAS float*)(F.lds + LS_OFF);
    const float* GLI = (const float*)(F.ws + WS_GLI) + (size_t)(b * 4 + h) * SEQ; const float* GLF = (const float*)(F.ws + WS_GLF) + (size_t)(b * 4 + h) * SEQ;
    const int lane = opaque(F.lane), w = F.wave;
    if (w <= g) {
        float li[8], lf[8]; const float* gli = GLI + w * 512 + lane; const float* glf = GLF + w * 512 + lane;
#pragma unroll
        for (int c = 0; c < 8; ++c) { li[c] = gli[c * 64]; lf[c] = glf[c * 64]; }
#pragma unroll
        for (int c = 0; c < 8; ++c) {
            const float bs = wave_scan<false>(lf[c]); const float a = li[c] - bs; const float cmx = wave_scan<true>(a);
            const float amax = lane63(cmx), b63 = lane63(bs);
            if (lane == 0) { PQ[(8 * w + c) * 2] = b63; PQ[(8 * w + c) * 2 + 1] = amax; }
            if (w == g) { (SA + lane)[c * 64] = a; (SCM + lane)[c * 64] = cmx; (SMT + lane)[c * 64] = bs; }
        }
    }
    __syncthreads();
    if (w == 0) {
        const bool live = lane < 8 * (g + 1);
        float P = live ? PQ[lane * 2] : 0.f; const float am = live ? PQ[lane * 2 + 1] : -3.0e38f; float Q = live ? am + P : -3.0e38f;
#define SCAN_PQ(CTRL, RM) { const float tP = __int_as_float(__builtin_amdgcn_update_dpp(0, __float_as_int(P), CTRL, RM, 0xF, false)); \
                            const float tQ = __int_as_float(__builtin_amdgcn_update_dpp(__float_as_int(-3.0e38f), __float_as_int(Q), CTRL, RM, 0xF, false)); Q = fmaxf(tQ + P, Q); P = tP + P; }
        SCAN_PQ(0x111, 0xF) SCAN_PQ(0x112, 0xF) SCAN_PQ(0x114, 0xF) SCAN_PQ(0x118, 0xF) SCAN_PQ(0x142, 0xA) SCAN_PQ(0x143, 0xC)
#undef SCAN_PQ
        const float mnext = fmaxf(P, Q);
        MS[lane + 1] = mnext; if (lane == 0) MS[0] = 0.f;
        const float mprev = MS[lane];
        const float la = live ? (mprev - fmaxf(mprev, am)) : 0.f;
        const float Linc = wave_scan<false>(la);
        LS[lane + 1] = Linc; if (lane == 0) LS[0] = 0.f;
    }
    __syncthreads();
    {
        const int i = F.tid, c = i >> 6; const float mprev = MS[8 * g + c]; const float cm = fmaxf(mprev, SCM[i]); SCM[i] = cm; SMT[i] = SMT[i] + cm;
        if (i < 8) SM[i] = MS[8 * g + i];
        if (i >= 16 && i < 25) SM[i] = LS[8 * (i - 16)];
    }
}

template <int MODE, bool PASS2> struct ChunkRegs { u32x4 k[2]; u32x4 q[PASS2 ? 2 : 1]; u32x4 v[(MODE ? 256 : 128) / 64]; };
template <int MODE, bool PASS2>
DI void la_load(ChunkRegs<MODE, PASS2>& R, const bf16_t* PROJ, int bh, int T0, int tid) {
    constexpr int DV = MODE ? 256 : 128;
    const bf16_t* Q = PROJ + ((size_t)bh * SEQ + T0) * 128; const bf16_t* K = Q + M512; const bf16_t* V = PROJ + 2 * M512 + ((size_t)bh * SEQ + T0) * DV;
#pragma unroll
    for (int i = 0; i < 2; ++i) { const int p = tid + 512 * i;
        R.k[i] = *(const u32x4*)(K + p * 8);
        if (PASS2) R.q[i] = *(const u32x4*)(Q + p * 8); }
#pragma unroll
    for (int i = 0; i < DV / 64; ++i) { const int p = tid + 512 * i; R.v[i] = *(const u32x4*)(V + p * 8); }
}
template <int MODE, bool PASS2>
DI void la_write(Frame& F, const ChunkRegs<MODE, PASS2>& R, int c, float lg2, int tid) {
    constexpr int DV = MODE ? 256 : 128, VLD = DV + 32;
    LAS bf16_t* Qs = (LAS bf16_t*)(F.lds + QS_OFF); LAS bf16_t* Ks = (LAS bf16_t*)(F.lds + KS_OFF); LAS bf16_t* Kw = (LAS bf16_t*)(F.lds + KW_OFF); LAS bf16_t* Vs = (LAS bf16_t*)(F.lds + VS_OFF);
    const LAS float* SA = (const LAS float*)(F.lds + SA_OFF); const LAS float* SCM = (const LAS float*)(F.lds + SCM_OFF);
#pragma unroll
    for (int i = 0; i < 2; ++i) { const int p = tid + 512 * i, t = p >> 4, cp = (p & 15) * 8; const u32x4 kv = R.k[i];
        float ck;
        if (MODE) ck = fexp(SA[c * 64 + t] - SCM[c * 64 + 63]); else ck = __builtin_amdgcn_exp2f(lg2 * (float)(63 - t));
        u32x4 kw; kw.x = pk2(bflo(kv.x) * ck, bfhi(kv.x) * ck); kw.y = pk2(bflo(kv.y) * ck, bfhi(kv.y) * ck); kw.z = pk2(bflo(kv.z) * ck, bfhi(kv.z) * ck); kw.w = pk2(bflo(kv.w) * ck, bfhi(kv.w) * ck);
        *(LAS u32x4*)(Kw + t * KWLD + cp) = kw;
        if (PASS2) { *(LAS u32x4*)(Ks + t * QLD + cp) = kv; *(LAS u32x4*)(Qs + t * QLD + cp) = R.q[i]; }
    }
#pragma unroll
    for (int i = 0; i < DV / 64; ++i) { const int p = tid + 512 * i, t = p / (DV / 8), cp = (p % (DV / 8)) * 8; *(LAS u32x4*)(Vs + t * VLD + cp) = R.v[i]; }
}

template <int MODE>
DI void la_pass1(Frame& F, int unit) {
    constexpr int DV = MODE ? 256 : 128, VLD = DV + 32, ND = MODE ? 4 : 2;
    const int b = unit >> 5, h = (unit >> 3) & 3, g = unit & 7, row0 = b * SEQ + g * 512;
    const int w = F.wave; int lane = F.lane, r = lane & 31, hh = lane >> 5;
    const int eb = MODE ? w : (w & 3), dt0 = MODE ? 0 : 2 * (w >> 2), e0 = 32 * eb;
    const bf16_t* PROJ = (const bf16_t*)(F.ws + WS_PROJ);
    LAS bf16_t* Kw = (LAS bf16_t*)(F.lds + KW_OFF); LAS bf16_t* Vs = (LAS bf16_t*)(F.lds + VS_OFF);
    const LAS float* SCM = (const LAS float*)(F.lds + SCM_OFF); const LAS float* SM = (const LAS float*)(F.lds + SMISC_OFF); LAS float* NV = (LAS float*)(F.lds + NV_OFF);
    const float lg2 = log2f(1.0f - exp2f(-5.0f - (float)h));
    ChunkRegs<MODE, false> R; la_load<MODE, false>(R, PROJ, b * 4 + h, g * 512, opaque(F.tid));
    if (MODE) { mlstm_scan(F, b, h, g); if (F.tid < 128) NV[F.tid] = 0.f; }
    __syncthreads();
    f32x16 C[ND];
#pragma unroll
    for (int d = 0; d < ND; ++d)
#pragma unroll
        for (int i = 0; i < 16; ++i) C[d][i] = 0.f;
    for (int c = 0; c < 8; ++c) {
        lane = opaque(F.lane); r = lane & 31; hh = lane >> 5; const int tid_o = opaque(F.tid);
        la_write<MODE, false>(F, R, c, lg2, tid_o);
        __syncthreads();
        if (c < 7) la_load<MODE, false>(R, PROJ, b * 4 + h, g * 512 + 64 * (c + 1), tid_o);
        const float alpha = MODE ? fexp(SM[c] - SCM[c * 64 + 63]) : __builtin_amdgcn_exp2f(lg2 * 64.0f);
        bf16x8 vf[4];
#pragma unroll
        for (int ks = 0; ks < 4; ++ks) vf[ks] = tr_frag(Vs, VLD, e0, 16 * ks, lane);
#pragma unroll
        for (int d = 0; d < ND; ++d) {
#pragma unroll
            for (int i = 0; i < 16; ++i) C[d][i] *= alpha;
#pragma unroll
            for (int ks = 0; ks < 4; ++ks) { const bf16x8 ka = tr_frag(Kw, KWLD, 32 * (dt0 + d), 16 * ks, lane); C[d] = MFMA32(ka, vf[ks], C[d]); }
        }
        if (MODE) {
            const int dd = 16 * w + (lane & 15), sq = lane >> 4; float s = 0.f;
#pragma unroll
            for (int q = 0; q < 16; ++q) s += bf2f(Kw[(16 * sq + q) * KWLD + dd]);
            s = sum_xor16_32(s);
            if (lane < 16) NV[dd] = alpha * NV[dd] + s;
        }
        __syncthreads();
    }
    bf16_t* T = (bf16_t*)(F.ws + WS_TST) + (size_t)unit * DV * 128;
#pragma unroll
    for (int d = 0; d < ND; ++d)
#pragma unroll
        for (int q = 0; q < 4; ++q) { u32x2 v; v.x = pk2(C[d][4 * q], C[d][4 * q + 1]); v.y = pk2(C[d][4 * q + 2], C[d][4 * q + 3]);
            *(u32x2*)(T + (size_t)(e0 + r) * 128 + 32 * (dt0 + d) + 8 * q + 4 * hh) = v; }
    if (MODE && F.tid < 128) ((float*)(F.ws + WS_NST))[unit * 128 + F.tid] = NV[F.tid];
    __syncthreads();
}

template <int MODE>
DI void la_pass2(Frame& F, int unit, int j) {
    constexpr int DV = MODE ? 256 : 128, VLD = DV + 32, NT = MODE ? 2 : 1;
    const int b = unit >> 5, h = (unit >> 3) & 3, g = unit & 7, row0 = b * SEQ + g * 512;
    const int w = F.wave; int lane = F.lane, r = lane & 31, hh = lane >> 5, r16 = lane & 15, q4 = lane >> 4;
    const int eb = MODE ? w : (w & 3), tb0 = MODE ? 0 : (w >> 2), e0 = 32 * eb;
    const int ocol = DV * h;
    const bf16_t* PROJ = (const bf16_t*)(F.ws + WS_PROJ); bf16_t* MIX = (bf16_t*)(F.ws + WS_MIX);
    const bf16_t* GATE = PROJ + (MODE ? 4 : 3) * M512 + (size_t)(b * 4 + h) * SEQ * DV;
    const float* gain = MODE ? (F.in[15] + (j * 4 + h) * 256) : (F.in[6] + (j * 4 + h) * 128);
    LAS bf16_t* Qs = (LAS bf16_t*)(F.lds + QS_OFF); LAS bf16_t* Ks = (LAS bf16_t*)(F.lds + KS_OFF); LAS bf16_t* Kw = (LAS bf16_t*)(F.lds + KW_OFF); LAS bf16_t* Vs = (LAS bf16_t*)(F.lds + VS_OFF); LAS bf16_t* Ps = (LAS bf16_t*)(F.lds + PS_OFF);
    const LAS float* SA = (const LAS float*)(F.lds + SA_OFF); const LAS float* SCM = (const LAS float*)(F.lds + SCM_OFF); const LAS float* SMT = (const LAS float*)(F.lds + SMT_OFF); const LAS float* SM = (const LAS float*)(F.lds + SMISC_OFF);
    LAS float* STAT = (LAS float*)(F.lds + STAT_OFF); LAS float* NV = (LAS float*)(F.lds + NV_OFF); LAS float* PSUM = (LAS float*)(F.lds + PSUM_OFF); LAS float* QN = (LAS float*)(F.lds + QN_OFF);
    const float lg2 = log2f(1.0f - exp2f(-5.0f - (float)h));
    ChunkRegs<MODE, true> R; la_load<MODE, true>(R, PROJ, b * 4 + h, g * 512, opaque(F.tid));
    LAS float* GAIN = (LAS float*)(F.lds + GAIN_OFF); if (F.tid < DV) GAIN[F.tid] = gain[F.tid];
    if (MODE) mlstm_scan(F, b, h, g);
    __syncthreads();
    f32x16 C[4];
#pragma unroll
    for (int d = 0; d < 4; ++d)
#pragma unroll
        for (int i = 0; i < 16; ++i) C[d][i] = 0.f;
    float nacc = 0.f;
    for (int gp = 0; gp < g; ++gp) {
        const float coef = MODE ? fexp(SM[16 + g] - SM[16 + gp + 1]) : __builtin_amdgcn_exp2f(lg2 * (float)(512 * (g - 1 - gp)));
        const bf16_t* T = (const bf16_t*)(F.ws + WS_TST) + (size_t)(unit - g + gp) * DV * 128 + (size_t)(e0 + r) * 128 + 4 * hh;
        u32x2 tv[4][4];
#pragma unroll
        for (int d = 0; d < 4; ++d)
#pragma unroll
            for (int q = 0; q < 4; ++q) tv[d][q] = *(const u32x2*)(T + 32 * d + 8 * q);
#pragma unroll
        for (int d = 0; d < 4; ++d)
#pragma unroll
            for (int q = 0; q < 4; ++q) { const u32x2 v = tv[d][q];
                C[d][4 * q] += coef * bflo(v.x); C[d][4 * q + 1] += coef * bfhi(v.x); C[d][4 * q + 2] += coef * bflo(v.y); C[d][4 * q + 3] += coef * bfhi(v.y); }
        if (MODE && F.tid < 128) nacc += coef * ((const float*)(F.ws + WS_NST))[(unit - g + gp) * 128 + F.tid];
    }
    if (MODE && F.tid < 128) NV[F.tid] = nacc;
    for (int c = 0; c < 8; ++c) {
        const int R0 = row0 + 64 * c;
        lane = opaque(F.lane); r = lane & 31; hh = lane >> 5; r16 = lane & 15; q4 = lane >> 4; const int tid_o = opaque(F.tid);
        la_write<MODE, true>(F, R, c, lg2, tid_o);
        if (SDUP & 1) { asm volatile("" ::: "memory"); la_write<MODE, true>(F, R, c, lg2, tid_o); }
        __syncthreads();
        if (SDUP & 16) __syncthreads();
        if (c < 7) la_load<MODE, true>(R, PROJ, b * 4 + h, g * 512 + 64 * (c + 1), tid_o);
        u32x2 gt[NT][4];
#pragma unroll
        for (int tt = 0; tt < NT; ++tt)
#pragma unroll
            for (int q = 0; q < 4; ++q) gt[tt][q] = *(const u32x2*)(GATE + (size_t)(g * 512 + 64 * c + 32 * (tb0 + tt) + r) * DV + e0 + 8 * q + 4 * hh);
        for (int srep = 0; srep < ((SDUP & 2) ? 2 : 1); ++srep) {
        if (srep) asm volatile("" ::: "memory");
#pragma unroll
        for (int i = 0; i < 2; ++i) {
            const int tt = 2 * w + i, si = tt >> 2, ti = tt & 3;
            f32x4 x = {0.f, 0.f, 0.f, 0.f};
#pragma unroll
            for (int kk = 0; kk < 4; ++kk) { const bf16x8 ka = *(const LAS bf16x8*)(Ks + (16 * si + r16) * QLD + 32 * kk + 8 * q4); const bf16x8 qb = *(const LAS bf16x8*)(Qs + (16 * ti + r16) * QLD + 32 * kk + 8 * q4); x = MFMA16(ka, qb, x); }
            const int t = 16 * ti + r16; float p[4];
#pragma unroll
            for (int q = 0; q < 4; ++q) { const int s = 16 * si + 4 * q4 + q; float wgt;
                if (MODE) wgt = (s <= t) ? fexp(SA[c * 64 + s] - SCM[c * 64 + t]) : 0.f;
                else { const int dlt = t > s ? t - s : s - t; wgt = __builtin_amdgcn_exp2f(lg2 * (float)dlt); }
                p[q] = x[q] * wgt; }
            u32x2 pw; pw.x = pk2(p[0], p[1]); pw.y = pk2(p[2], p[3]);
            *(LAS u32x2*)(Ps + t * PLD + 16 * si + 4 * q4) = pw;
            if (MODE) { float cs = (bflo(pw.x) + bfhi(pw.x)) + (bflo(pw.y) + bfhi(pw.y)); cs = sum_xor16_32(cs); if (q4 == 0) PSUM[si * 64 + t] = cs; }
        }
        if (MODE) {
            const int t = 8 * w + (lane >> 3), part = lane & 7;
            const u32x4 qa = *(const LAS u32x4*)(Qs + t * QLD + 16 * part), qb2 = *(const LAS u32x4*)(Qs + t * QLD + 16 * part + 8);
            const f32x4 n0 = *(const LAS f32x4*)(NV + 16 * part), n1 = *(const LAS f32x4*)(NV + 16 * part + 4), n2 = *(const LAS f32x4*)(NV + 16 * part + 8), n3 = *(const LAS f32x4*)(NV + 16 * part + 12);
            float qn = bflo(qa.x) * n0.x + bfhi(qa.x) * n0.y + bflo(qa.y) * n0.z + bfhi(qa.y) * n0.w + bflo(qa.z) * n1.x + bfhi(qa.z) * n1.y + bflo(qa.w) * n1.z + bfhi(qa.w) * n1.w
                     + bflo(qb2.x) * n2.x + bfhi(qb2.x) * n2.y + bflo(qb2.y) * n2.z + bfhi(qb2.y) * n2.w + bflo(qb2.z) * n3.x + bfhi(qb2.z) * n3.y + bflo(qb2.w) * n3.z + bfhi(qb2.w) * n3.w;
            qn += dpp_f<0xB1>(qn); qn += dpp_f<0x4E>(qn); qn += dpp_f<0x141>(qn);
            if (part == 0) QN[t] = qn;
        }
        }
        __syncthreads();
        if (SDUP & 16) __syncthreads();
        bf16x8 vf[4];
#pragma unroll
        for (int ks = 0; ks < 4; ++ks) vf[ks] = tr_frag(Vs, VLD, e0, 16 * ks, lane);
        float cqv[NT], rinvv[NT];
#pragma unroll
        for (int tt = 0; tt < NT; ++tt) {
            const int t = 32 * (tb0 + tt) + r;
            if (MODE) {
                const float cq = fexp(SM[c] - SCM[c * 64 + t]);
                const float den = ((PSUM[t] + PSUM[64 + t]) + (PSUM[128 + t] + PSUM[192 + t])) + cq * QN[t];
                cqv[tt] = cq; rinvv[tt] = 1.0f / fmaxf(fabsf(den), fexp(-SMT[c * 64 + t]));
            } else { cqv[tt] = __builtin_amdgcn_exp2f(lg2 * (float)(t + 1)); rinvv[tt] = 1.f; }
        }
        f32x16 o2[NT], val[NT];
        for (int orep = 0; orep < ((SDUP & 4) ? 2 : 1); ++orep) {
        if (orep) asm volatile("" ::: "memory");
#pragma unroll
        for (int tt = 0; tt < NT; ++tt)
#pragma unroll
            for (int i = 0; i < 16; ++i) { o2[tt][i] = 0.f; val[tt][i] = 0.f; }
#pragma unroll
        for (int d = 0; d < 4; ++d) {
#pragma unroll
            for (int s2 = 0; s2 < 2; ++s2) { const bf16x8 ca = pack_acc(C[d], s2);
#pragma unroll
                for (int tt = 0; tt < NT; ++tt) { const int t = 32 * (tb0 + tt) + r;
                    const bf16x4 qlo = *(const LAS bf16x4*)(Qs + t * QLD + 32 * d + 16 * s2 + 4 * hh), qhi = *(const LAS bf16x4*)(Qs + t * QLD + 32 * d + 16 * s2 + 4 * hh + 8);
                    const bf16x8 qb = __builtin_shufflevector(qlo, qhi, 0, 1, 2, 3, 4, 5, 6, 7);
                    o2[tt] = MFMA32(ca, qb, o2[tt]); } }
            __builtin_amdgcn_sched_barrier(0);
        }
#pragma unroll
        for (int tt = 0; tt < NT; ++tt) { const int t = 32 * (tb0 + tt) + r;
#pragma unroll
            for (int ks = 0; ks < 4; ++ks) { const bf16x8 pb = *(const LAS bf16x8*)(Ps + t * PLD + 16 * ks + 8 * hh); val[tt] = MFMA32(vf[ks], pb, val[tt]); } }
#pragma unroll
        for (int tt = 0; tt < NT; ++tt) { const int t = 32 * (tb0 + tt) + r;
            float s1 = 0.f, s2s = 0.f;
#pragma unroll
            for (int i = 0; i < 16; ++i) { const float v = (val[tt][i] + cqv[tt] * o2[tt][i]) * rinvv[tt]; val[tt][i] = v; s1 += v; s2s += v * v; }
            s1 = sum_xor32(s1); s2s = sum_xor32(s2s);
            if (hh == 0) { STAT[(w * 64 + t) * 2] = s1; STAT[(w * 64 + t) * 2 + 1] = s2s; }
        }
        }
        __syncthreads();
        if (SDUP & 16) __syncthreads();
        for (int frep = 0; frep < ((SDUP & 8) ? 2 : 1); ++frep) {
        if (frep) asm volatile("" ::: "memory");
#pragma unroll
        for (int tt = 0; tt < NT; ++tt) {
            const int t = 32 * (tb0 + tt) + r; float S1 = 0.f, S2 = 0.f;
#pragma unroll
            for (int ww = 0; ww < (MODE ? 8 : 4); ++ww) { const int wi = MODE ? ww : (4 * tb0 + ww); S1 += STAT[(wi * 64 + t) * 2]; S2 += STAT[(wi * 64 + t) * 2 + 1]; }
            const float mean = S1 * (1.0f / DV); const float var = fmaxf(S2 * (1.0f / DV) - mean * mean, 0.f); const float rs = 1.0f / sqrtf(var + EPS);
            const size_t rowoff = (size_t)(R0 + t);
#pragma unroll
            for (int q = 0; q < 4; ++q) { const int e = e0 + 8 * q + 4 * hh;
                const f32x4 gn = *(const LAS f32x4*)(GAIN + e); const u32x2 gtv = gt[tt][q];
                const float y0 = (val[tt][4 * q] - mean) * rs * gn.x * bflo(gtv.x), y1 = (val[tt][4 * q + 1] - mean) * rs * gn.y * bfhi(gtv.x);
                const float y2 = (val[tt][4 * q + 2] - mean) * rs * gn.z * bflo(gtv.y), y3 = (val[tt][4 * q + 3] - mean) * rs * gn.w * bfhi(gtv.y);
                u32x2 o; o.x = pk2(y0, y1); o.y = pk2(y2, y3); *(u32x2*)(MIX + rowoff * DM + ocol + e) = o; }
        }
        }
        __builtin_amdgcn_sched_barrier(0);
        const float alpha = MODE ? fexp(SM[c] - SCM[c * 64 + 63]) : __builtin_amdgcn_exp2f(lg2 * 64.0f);
#pragma unroll
        for (int d = 0; d < 4; ++d) {
#pragma unroll
            for (int i = 0; i < 16; ++i) C[d][i] *= alpha;
#pragma unroll
            for (int ks = 0; ks < 4; ++ks) { const bf16x8 ka = tr_frag(Kw, KWLD, 32 * d, 16 * ks, lane); C[d] = MFMA32(ka, vf[ks], C[d]); }
        }
        if (SDUP & 64) {
            f32x16 dm;
#pragma unroll
            for (int i = 0; i < 16; ++i) dm[i] = 0.f;
            asm volatile("" ::: "memory");
#pragma unroll
            for (int d = 0; d < 4; ++d)
#pragma unroll
                for (int ks = 0; ks < 4; ++ks) { const bf16x8 ka = tr_frag(Kw, KWLD, 32 * d, 16 * ks, lane); dm = MFMA32(ka, vf[ks], dm); }
            asm volatile("" :: "v"(dm));
        }
        if (SDUP & 128) {
            f32x16 dm;
#pragma unroll
            for (int i = 0; i < 16; ++i) dm[i] = 0.f;
            asm volatile("" ::: "memory");
#pragma unroll
            for (int d = 0; d < 4; ++d)
#pragma unroll
                for (int s2 = 0; s2 < 2; ++s2) { const bf16x8 ca = pack_acc(C[d], s2);
#pragma unroll
                    for (int tt = 0; tt < NT; ++tt) { const int t = 32 * (tb0 + tt) + r;
                        const bf16x4 qlo = *(const LAS bf16x4*)(Qs + t * QLD + 32 * d + 16 * s2 + 4 * hh), qhi = *(const LAS bf16x4*)(Qs + t * QLD + 32 * d + 16 * s2 + 4 * hh + 8);
                        const bf16x8 qb = __builtin_shufflevector(qlo, qhi, 0, 1, 2, 3, 4, 5, 6, 7);
                        dm = MFMA32(ca, qb, dm); } }
            asm volatile("" :: "v"(dm));
        }
        if (MODE) {
            const int dd = 16 * w + (lane & 15), sq = lane >> 4; float s = 0.f;
#pragma unroll
            for (int q = 0; q < 16; ++q) s += bf2f(Kw[(16 * sq + q) * KWLD + dd]);
            s = sum_xor16_32(s);
            if (lane < 16) NV[dd] = alpha * NV[dd] + s;
        }
        __syncthreads();
        if (SDUP & 16) __syncthreads();
    }
}

constexpr int VN_OFF = 0, SGST_OFF = 34816;
DI void sgu_unit(Frame& F, int unit, int j) {
    const int row0 = unit * 128; const int w = F.wave; int lane = F.lane, r = lane & 31, hh = lane >> 5;
    const bf16_t* PROJ = (const bf16_t*)(F.ws + WS_PROJ); bf16_t* MIX = (bf16_t*)(F.ws + WS_MIX);
    LAS bf16_t* Vn = (LAS bf16_t*)(F.lds + VN_OFF); LAS float* ST = (LAS float*)(F.lds + SGST_OFF);
    const float* lng = F.in[7] + j * 512; const float* lnb = F.in[8] + j * 512;
    {
        u32x4 vv[16];
#pragma unroll
        for (int i = 0; i < 16; ++i) vv[i] = *((const u32x4*)(PROJ + 5 * M512 + (size_t)(row0 + 16 * w + i) * 512) + lane);
#pragma unroll
        for (int i = 0; i < 16; ++i) { const int p = 16 * w + i; const u32x4 v = vv[i];
            const float x0 = bflo(v.x), x1 = bfhi(v.x), x2 = bflo(v.y), x3 = bfhi(v.y), x4 = bflo(v.z), x5 = bfhi(v.z), x6 = bflo(v.w), x7 = bfhi(v.w);
            float s = ((x0 + x1) + (x2 + x3)) + ((x4 + x5) + (x6 + x7)); s = wave_sum(s); const float mean = s * (1.0f / 512.0f);
            const float d0 = x0 - mean, d1 = x1 - mean, d2 = x2 - mean, d3 = x3 - mean, d4 = x4 - mean, d5 = x5 - mean, d6 = x6 - mean, d7 = x7 - mean;
            float q = ((d0 * d0 + d1 * d1) + (d2 * d2 + d3 * d3)) + ((d4 * d4 + d5 * d5) + (d6 * d6 + d7 * d7)); q = wave_sum(q);
            if (lane == 0) { ST[2 * p] = mean; ST[2 * p + 1] = 1.0f / sqrtf(q * (1.0f / 512.0f) + EPS); } }
    }
    __syncthreads();
    const int dtl = w & 3, pt0 = 2 * (w >> 2);
    for (int gq = 0; gq < 4; ++gq) {
        lane = opaque(F.lane); r = lane & 31; hh = lane >> 5; const int tid_o = opaque(F.tid);
#pragma unroll
        for (int i = 0; i < 4; ++i) { const int pc = tid_o + 512 * i, q = pc >> 4, cp = (pc & 15) * 8; const int col = 128 * gq + cp;
            const u32x4 v = *(const u32x4*)(PROJ + 5 * M512 + (size_t)(row0 + q) * 512 + col); const float mean = ST[2 * q], rs = ST[2 * q + 1];
            const f32x4 g0 = *(const f32x4*)(lng + col), g1 = *(const f32x4*)(lng + col + 4), b0 = *(const f32x4*)(lnb + col), b1 = *(const f32x4*)(lnb + col + 4);
            u32x4 o; o.x = pk2((bflo(v.x) - mean) * rs * g0.x + b0.x, (bfhi(v.x) - mean) * rs * g0.y + b0.y); o.y = pk2((bflo(v.y) - mean) * rs * g0.z + b0.z, (bfhi(v.y) - mean) * rs * g0.w + b0.w);
            o.z = pk2((bflo(v.z) - mean) * rs * g1.x + b1.x, (bfhi(v.z) - mean) * rs * g1.y + b1.y); o.w = pk2((bflo(v.w) - mean) * rs * g1.z + b1.z, (bfhi(v.w) - mean) * rs * g1.w + b1.w);
            *(LAS u32x4*)(Vn + q * QLD + cp) = o; }
        __syncthreads();
        const bf16_t* WM = (const bf16_t*)(F.ws + WS_WM) + (size_t)(j * 4 + gq) * 128 * 128;
        unsigned short uv[2][16];
#pragma unroll
        for (int pt = 0; pt < 2; ++pt)
#pragma unroll
            for (int i = 0; i < 16; ++i) uv[pt][i] = PROJ[4 * M512 + (size_t)(row0 + 32 * (pt0 + pt) + crow(i, hh)) * 512 + 128 * gq + 32 * dtl + r];
        f32x16 acc[2];
#pragma unroll
        for (int i = 0; i < 16; ++i) { acc[0][i] = 0.f; acc[1][i] = 0.f; }
#pragma unroll
        for (int ks = 0; ks < 8; ++ks) { const bf16x8 vb = gather_col(Vn, QLD, 32 * dtl + r, 16 * ks + 8 * hh);
#pragma unroll
            for (int pt = 0; pt < 2; ++pt) { const bf16x8 wa = *(const bf16x8*)(WM + (size_t)(32 * (pt0 + pt) + r) * 128 + 16 * ks + 8 * hh); acc[pt] = MFMA32(wa, vb, acc[pt]); } }
        const float* bs = F.in[10] + (j * 4 + gq) * 128;
#pragma unroll
        for (int pt = 0; pt < 2; ++pt)
#pragma unroll
            for (int i = 0; i < 16; ++i) { const int p = 32 * (pt0 + pt) + crow(i, hh); const int col = 128 * gq + 32 * dtl + r;
                MIX[(size_t)(row0 + p) * DM + 512 + col] = (bf16_t)(pk2(bf2f(uv[pt][i]) * (acc[pt][i] + bs[p]), 0.f) & 0xffffu); if ((i & 3) == 3) asm volatile("" ::: "memory"); }
        __syncthreads();
    }
}

struct Args { const float* in[19]; float* out; unsigned char* ws; int ph_lo, ph_hi; };
__global__ void __launch_bounds__(512, 2) fwd(Args args) {
    extern __shared__ __attribute__((aligned(16))) unsigned char lds_raw[];
    Frame F;
    F.lds = (LAS unsigned char*)lds_raw;
    const int wave_s = __builtin_amdgcn_readfirstlane(threadIdx.x >> 6);
    F.tid = threadIdx.x; F.lane = F.tid & 63; F.wave = wave_s; F.G = gridDim.x;
    F.in = (const float* const __attribute__((address_space(4)))*)__builtin_amdgcn_kernarg_segment_ptr();
    F.H = args.out; F.ws = args.ws;
    volatile LAS unsigned* MISC = (volatile LAS unsigned*)(F.lds + LDSCTL_OFF);
    if (F.tid < 64) MISC[F.tid] = 0u;
    __syncthreads();
    if (ONE_LAUNCH) (void)xcd_barrier_post((unsigned*)(F.ws + WS_CTL), MISC + 8, F.tid);
    const int lo = ONE_LAUNCH ? 0 : args.ph_lo, hi = ONE_LAUNCH ? NPHASE : args.ph_hi;
#define IN(k) (lo <= (k) && (k) < hi)
#define REFRESH() do { F.lane = opaque((int)__builtin_amdgcn_mbcnt_hi(~0u, __builtin_amdgcn_mbcnt_lo(~0u, 0u))); F.wave = wave_s; F.tid = wave_s * 64 + F.lane; \
        { unsigned long long z_ = 0ull; asm volatile("" : "+s"(z_)); F.ws = args.ws + z_; } } while (0)
#define SEAM(k) do { if (ONE_LAUNCH && IN((k) + 1)) { REFRESH(); XcdBarrier bb_; bb_.bar = (unsigned*)(F.ws + WS_CTL); bb_.x = xb_xcc_id(); bb_.st = (volatile LAS unsigned*)(F.lds + LDSCTL_OFF) + 8; xcd_barrier(bb_, F.tid); if (DUP_MASK & 4096) xcd_barrier(bb_, F.tid); } } while (0)
#define SS ((const float*)(F.ws + WS_SS))
#define HB ((bf16_t*)(F.ws + WS_HB))
#define MIX ((bf16_t*)(F.ws + WS_MIX))
#define PROJ ((bf16_t*)(F.ws + WS_PROJ))

    if ((PH_MASK & 1) && IN(0)) { REPS(1) { REFRESH(); p0_prologue(F); } SEAM(0); }
    for (int L = 0; L < DEPTH; ++L) {
        const int pb = 1 + 6 * L, j = L >> 1;
        if (IN(pb)) {
            REFRESH();
            pg8::Gemm g{HB, W_in(F, L), MROWS, NIN, DM}; pg8::StaticOrder S; S.init(MROWS, NIN, F.G, (int)blockIdx.x);
            if (L & 1) { if (PH_MASK & 2) REPS(2) { rstd_table(F, S, SS); EpiInC E{PROJ, (const LAS float*)(F.lds + RSTD_OFF)}; pg8::gemm_phase<EpiInC, pg8::StaticOrder, GEMM_ALIGN, GEMM_SP2>(F.lds, g, S, E, F.tid); } if (PH_MASK & 4) gate_step(F, L); }
            else if (PH_MASK & 8) REPS(8) { rstd_table(F, S, SS); EpiInA E{PROJ, (const LAS float*)(F.lds + RSTD_OFF), (const float*)(F.ws + WS_COS), (const float*)(F.ws + WS_SIN)}; pg8::gemm_phase<EpiInA, pg8::StaticOrder, GEMM_ALIGN, GEMM_SP2>(F.lds, g, S, E, F.tid); }
            SEAM(pb);
        }
        if (IN(pb + 1)) {
            REFRESH();
            for (int u = blockIdx.x; u < 256; u += F.G) { if (L & 1) { if (PH_MASK & 16) REPS(16) la_pass1<1>(F, u); } else { if (PH_MASK & 32) REPS(32) la_pass1<0>(F, u); if (PH_MASK & 64) REPS(64) sgu_unit(F, u, j); } }
            SEAM(pb + 1);
        }
        if (IN(pb + 2)) {
            REFRESH();
            for (int u = blockIdx.x; u < 256; u += F.G) { if (L & 1) { if (PH_MASK & 128) REPS(128) la_pass2<1>(F, u, j); } else { if (PH_MASK & 256) REPS(256) la_pass2<0>(F, u, j); } }
            SEAM(pb + 2);
        }
        if (IN(pb + 3)) {
            REFRESH();
            pg8::Gemm g{MIX, W_out(F, L), MROWS, DM, DM}; pg8::StaticOrder S; S.init(MROWS, DM, F.G, (int)blockIdx.x);
            if (PH_MASK & 512) for (int rep_ = 0; rep_ < ((DUP_MASK & 512) ? 3 : 1); ++rep_) { EpiRes E{HB, (float*)(F.ws + WS_SS), (rep_ == 1) ? -1.f : 1.f}; pg8::gemm_phase<EpiRes, pg8::StaticOrder, GEMM_ALIGN, GEMM_SP2>(F.lds, g, S, E, F.tid); if (ONE_LAUNCH && rep_ + 1 < ((DUP_MASK & 512) ? 3 : 1)) { REFRESH(); XcdBarrier bb_; bb_.bar = (unsigned*)(F.ws + WS_CTL); bb_.x = xb_xcc_id(); bb_.st = (volatile LAS unsigned*)(F.lds + LDSCTL_OFF) + 8; xcd_barrier(bb_, F.tid); } }
            SEAM(pb + 3);
        }
        if (IN(pb + 4)) {
            REFRESH();
            pg8::Gemm g{HB, W_up(F, L), MROWS, NUP, DM}; pg8::StaticOrder S; S.init(MROWS, NUP, F.G, (int)blockIdx.x);
            if (PH_MASK & 1024) REPS(1024) { rstd_table(F, S, SS); EpiSwiGLU E{PROJ, (const LAS float*)(F.lds + RSTD_OFF)}; pg8::gemm_phase<EpiSwiGLU, pg8::StaticOrder, GEMM_ALIGN, GEMM_SP2>(F.lds, g, S, E, F.tid); }
            SEAM(pb + 4);
        }
        if (IN(pb + 5)) {
            REFRESH();
            pg8::Gemm g{PROJ, W_down(F, L), MROWS, DM, DFF}; pg8::StaticOrder S; S.init(MROWS, DM, F.G, (int)blockIdx.x);
            if (PH_MASK & 2048) for (int rep_ = 0; rep_ < ((DUP_MASK & 2048) ? 3 : 1); ++rep_) { EpiRes E{HB, (float*)(F.ws + WS_SS), (rep_ == 1) ? -1.f : 1.f}; pg8::gemm_phase<EpiRes, pg8::StaticOrder, GEMM_ALIGN, GEMM_SP2>(F.lds, g, S, E, F.tid); if (ONE_LAUNCH && rep_ + 1 < ((DUP_MASK & 2048) ? 3 : 1)) { REFRESH(); XcdBarrier bb_; bb_.bar = (unsigned*)(F.ws + WS_CTL); bb_.x = xb_xcc_id(); bb_.st = (volatile LAS unsigned*)(F.lds + LDSCTL_OFF) + 8; xcd_barrier(bb_, F.tid); } }
            SEAM(pb + 5);
        }
    }
    if ((PH_MASK & 4096) && IN(NPHASE - 1)) { REFRESH(); final_norm(F); }
#undef IN
#undef SEAM
#undef REFRESH
#undef SS
#undef HB
#undef MIX
#undef PROJ
}

extern "C" void kernel_launch(void* const* d_in, const int* in_sizes, int n_in, void* d_out, int out_size, void* d_ws, size_t ws_size, hipStream_t stream) {
    static int grid = 0;
    if (grid == 0) {
        if (n_in != 19 || out_size != MROWS * DM || ws_size < WS_END) { fprintf(stderr, "kernel_launch: unexpected problem shape (n_in %d, out %d, ws %zu)\n", n_in, out_size, ws_size); grid = -1; return; }
        int dev = 0, cus = 0, per_cu = 0;
        if (hipGetDevice(&dev) != hipSuccess || hipDeviceGetAttribute(&cus, hipDeviceAttributeMultiprocessorCount, dev) != hipSuccess) { grid = -1; return; }
        if (hipFuncSetAttribute((const void*)fwd, hipFuncAttributeMaxDynamicSharedMemorySize, LDS_BYTES) != hipSuccess) { fprintf(stderr, "kernel_launch: hipFuncSetAttribute failed\n"); grid = -1; return; }
        if (hipOccupancyMaxActiveBlocksPerMultiprocessor(&per_cu, (const void*)fwd, 512, LDS_BYTES) != hipSuccess || per_cu < 1) { fprintf(stderr, "kernel_launch: occupancy query says %d\n", per_cu); (void)hipGetLastError(); grid = -1; return; }
        grid = cus;
    }
    if (grid < 0) return;
    (void)hipMemsetAsync((char*)d_ws + WS_CTL, 0, CTL_ZERO_BYTES, stream);
    Args a{};
    for (int i = 0; i < 19; ++i) a.in[i] = (const float*)d_in[i];
    a.out = (float*)d_out; a.ws = (unsigned char*)d_ws;
    if (ONE_LAUNCH) { a.ph_lo = 0; a.ph_hi = NPHASE; hipLaunchKernelGGL(fwd, dim3(grid), dim3(512), LDS_BYTES, stream, a); }
    else for (int p = 0; p < NPHASE; ++p) { a.ph_lo = p; a.ph_hi = p + 1; hipLaunchKernelGGL(fwd, dim3(grid), dim3(512), LDS_BYTES, stream, a); }
}
```

```cpp
#include <hip/hip_runtime.h>
#include <cstdio>
#include <cstdint>

#ifndef PH_MASK
#define PH_MASK 8191
#endif
#ifndef DUP_MASK
#define DUP_MASK 0
#endif
#define REPS(bit) for (int rep_ = 0; rep_ < ((DUP_MASK & (bit)) ? 2 : 1); ++rep_)
#ifndef GEMM_ALIGN
#define GEMM_ALIGN true
#endif
#ifndef GEMM_SP2
#define GEMM_SP2 true
#endif
#ifndef ONE_LAUNCH
#define ONE_LAUNCH 1
#endif

#ifndef SDUP
#define TP_SEAM_MASK 0u
#define TP_PHASE_MASK 0u
#define TP_SCALE 4u
#define TP_FIXED 0u
#define TP_STAT 0
#define GRP_ROT 0u
#define TP_END 0u
#define FSEC 0
#define TPROBE ((TP_SEAM_MASK | TP_PHASE_MASK | TP_FIXED | TP_END | FSEC) != 0u)
#define FS_T0(id) unsigned fs_t_ = 0u; if (FSEC == (id)) fs_t_ = (unsigned)__builtin_amdgcn_s_memrealtime()
#define FS_T1(id) do { if (FSEC == (id) && F.tid == 0) { volatile LAS unsigned* w_ = (volatile LAS unsigned*)(F.lds + LDSCTL_OFF); w_[13] = w_[13] + ((unsigned)__builtin_amdgcn_s_memrealtime() - fs_t_); } } while (0)
#define SDUP 0
#endif
namespace pg8 {
#define PG8_LAS __attribute__((address_space(3)))
typedef unsigned short bf16_t;
typedef short bf16x8 __attribute__((ext_vector_type(8)));
typedef float f32x4 __attribute__((ext_vector_type(4)));
typedef unsigned u32x4 __attribute__((ext_vector_type(4)));
constexpr int BM = 256, BK = 64, HALF = 128, HTB = HALF * BK * 2  , STAGE_BYTES = 8 * HTB, NXCD = 8, WGM = 4;

__host__ __device__ __forceinline__ int lds_byte(int r, int c) { const int st = (r >> 4) * 2 + (c >> 5), rr = r & 15, cc = c & 31, ob = rr * 64 + cc * 2; return st * 1024 + (ob ^ (((ob >> 9) & 1) << 5)); }
__host__ __device__ __forceinline__ void stage_rc(int b, int& R, int& C) { const int st = b / 1024, sb = b % 1024, swz = sb ^ (((sb >> 9) & 1) << 5); R = (st >> 1) * 16 + swz / 64; C = (st & 1) * 32 + (swz % 64) / 2; }
__host__ __device__ __forceinline__ int perm32(int rho) { const int n = rho >> 4, i = rho & 15; return 8 * (i >> 2) + 4 * n + (i & 3); }

struct Unit { int pm, pn, ui; };
struct Gemm { const bf16_t* A; const bf16_t* Bt; int M, N, K; size_t apad; };

struct StaticOrder {
    int nM, nN, nwg, G, c;
    __host__ __device__ void init(int M, int N, int G_, int c_) { nM = M / BM; nN = N / BM; nwg = nM * nN; G = G_; c = c_; }
    __host__ __device__ bool next(int i, Unit& u) const {
        const long L = (long)i * G + c; if (L >= nwg) return false;
        int wgid = (int)L; { const int q = nwg / NXCD, r = nwg % NXCD, xcd = wgid % NXCD, off = wgid / NXCD; wgid = (xcd < r ? xcd * (q + 1) : r * (q + 1) + (xcd - r) * q) + off; }
        const int nig = WGM * nN, gid = wgid / nig, fm = gid * WGM, gsz = (nM % WGM == 0) ? WGM : ((nM - fm) < WGM ? (nM - fm) : WGM);
        u.pm = fm + ((wgid % nig) % gsz); u.pn = (wgid % nig) / gsz; u.ui = i; return true;
    }
    __device__ __forceinline__ void a_ready(const Unit&) const {}
    __device__ __forceinline__ void done(const Unit&) const {}
};

template <class Epi, class Sched, bool ALIGN_EPI = false, bool SP2 = false>
__device__ __forceinline__ void gemm_phase(PG8_LAS unsigned char* lds, const Gemm g, const Sched& S, const Epi& E, int tid_) {
    asm volatile("" : "+v"(tid_));
    const int tid = tid_, wid = __builtin_amdgcn_readfirstlane(tid >> 6), lane = tid & 63, wr = wid >> 2, wc = wid & 3, fr = lane & 15, fq = lane >> 4;
    const int K = g.K, nt = K / BK;
    unsigned voffA[2], voffB[2];
#pragma unroll
    for (int i = 0; i < 2; ++i) { int R, C; stage_rc(tid * 16 + i * 8192, R, C); const int Rb = Epi::PERM ? ((R & ~31) + perm32(R & 31)) : R;
        voffA[i] = (unsigned)(R * K + C) * 2u; voffB[i] = (unsigned)(Rb * K + C) * 2u; }
    const size_t kstep = (size_t)(BK * 2);
    const size_t hstep = (size_t)HALF * K * 2;
    const size_t tstep = 2 * hstep;
    const unsigned ldsw = (unsigned)wid * 1024u;
    const int aoff = lds_byte(wr * 64 + fr, fq * 8), boff = lds_byte(wc * 32 + fr, fq * 8);
#define PG8_SA(b, h) (((b) * 2 + (h)) * HTB)
#define PG8_SB(b, h) ((4 + (b) * 2 + (h)) * HTB)
#define PG8_STAGE(bufoff, gbase, voff) do { _Pragma("unroll") for (int _i = 0; _i < 2; ++_i) \
        __builtin_amdgcn_global_load_lds((const unsigned*)((const char*)(gbase) + (voff)[_i]), (PG8_LAS unsigned*)(lds + (bufoff) + ldsw + _i * 8192), 16, 0, 0); } while (0)
#define PG8_LDA(dst, b, h) do { _Pragma("unroll") for (int m = 0; m < 4; ++m) _Pragma("unroll") for (int k = 0; k < 2; ++k) dst[m][k] = *(const PG8_LAS bf16x8*)(lds + PG8_SA(b, h) + aoff + m * 2048 + k * 1024); } while (0)
#define PG8_LDB(dst, b, h) do { _Pragma("unroll") for (int n = 0; n < 2; ++n) _Pragma("unroll") for (int k = 0; k < 2; ++k) dst[n][k] = *(const PG8_LAS bf16x8*)(lds + PG8_SB(b, h) + boff + n * 2048 + k * 1024); } while (0)
#define PG8_MMA(ai, bj, At, Bt) do { __builtin_amdgcn_s_setprio(1); _Pragma("unroll") for (int m = 0; m < 4; ++m) _Pragma("unroll") for (int n = 0; n < 2; ++n) _Pragma("unroll") for (int k = 0; k < 2; ++k) \
        acc[ai][bj][m][n] = __builtin_amdgcn_mfma_f32_16x16x32_bf16(Bt[n][k], At[m][k], acc[ai][bj][m][n], 0, 0, 0); __builtin_amdgcn_s_setprio(0); } while (0)
#define PG8_WAIT_V(n) asm volatile("s_waitcnt vmcnt(" #n ")" ::: "memory")
#define PG8_WAIT_L(n) asm volatile("s_waitcnt lgkmcnt(" #n ")" ::: "memory")
#define PG8_BAR __builtin_amdgcn_s_barrier()
#define PG8_SCHED __builtin_amdgcn_sched_barrier(0)
    Unit cur, nxt; int ui = 0;
    if (!S.next(0, cur)) return;
    f32x4 acc[2][2][4][2];
#pragma unroll
    for (int a = 0; a < 2; ++a)
#pragma unroll
        for (int b = 0; b < 2; ++b)
#pragma unroll
            for (int m = 0; m < 4; ++m)
#pragma unroll
                for (int n = 0; n < 2; ++n) acc[a][b][m][n] = (f32x4){0.f, 0.f, 0.f, 0.f};
    bf16x8 At[4][2], B0[2][2], B1[2][2];
    const char* cA = (const char*)g.A + (size_t)cur.pm * tstep + (size_t)(cur.pm >> 4) * g.apad; const char* cB = (const char*)g.Bt + (size_t)cur.pn * tstep;
    S.a_ready(cur);
    if constexpr (SP2) {
        PG8_STAGE(PG8_SB(0, 0), cB, voffB); PG8_STAGE(PG8_SB(0, 1), cB + hstep, voffB); PG8_STAGE(PG8_SA(0, 0), cA, voffA); PG8_STAGE(PG8_SA(0, 1), cA + hstep, voffA);
        if (wr == 1) PG8_BAR;
        PG8_WAIT_V(2); PG8_BAR;
        PG8_STAGE(PG8_SB(1, 0), cB + kstep, voffB); PG8_STAGE(PG8_SA(1, 0), cA + kstep, voffA); PG8_STAGE(PG8_SB(1, 1), cB + hstep + kstep, voffB);
        PG8_WAIT_V(6); PG8_BAR;
    } else {
        PG8_STAGE(PG8_SB(0, 0), cB, voffB); PG8_STAGE(PG8_SA(0, 0), cA, voffA); PG8_STAGE(PG8_SB(0, 1), cB + hstep, voffB); PG8_STAGE(PG8_SA(0, 1), cA + hstep, voffA);
        if (wr == 1) PG8_BAR;
        PG8_WAIT_V(4); PG8_BAR;
        PG8_STAGE(PG8_SB(1, 0), cB + kstep, voffB); PG8_STAGE(PG8_SA(1, 0), cA + kstep, voffA); PG8_STAGE(PG8_SB(1, 1), cB + hstep + kstep, voffB);
        PG8_WAIT_V(6); PG8_BAR;
    }
    for (;;) {
        const bool has_next = S.next(ui + 1, nxt);
        const char* nA = has_next ? (const char*)g.A + (size_t)nxt.pm * tstep + (size_t)(nxt.pm >> 4) * g.apad : cA; const char* nB = has_next ? (const char*)g.Bt + (size_t)nxt.pn * tstep : cB;
        for (int t = 0; t < nt; t += 2) {
            const bool last = (t == nt - 2);
            const char* a1 = cA + (size_t)(t + 1) * kstep;
            const char* a2 = last ? nA : cA + (size_t)(t + 2) * kstep; const char* b2 = last ? nB : cB + (size_t)(t + 2) * kstep;
            const char* a3 = a2 + kstep; const char* b3 = b2 + kstep;
            if (last && has_next) S.a_ready(nxt);
            if constexpr (SP2) {
            PG8_LDB(B0, 0, 0); PG8_LDB(B1, 0, 1); PG8_SCHED; PG8_LDA(At, 0, 0); PG8_STAGE(PG8_SA(1, 1), a1 + hstep, voffA);
            PG8_WAIT_V(8); PG8_WAIT_L(0); PG8_BAR; PG8_MMA(0, 0, At, B0); PG8_MMA(0, 1, At, B1); PG8_BAR; PG8_SCHED;
            PG8_LDA(At, 0, 1); PG8_STAGE(PG8_SB(0, 0), b2, voffB); PG8_STAGE(PG8_SB(0, 1), b2 + hstep, voffB); PG8_STAGE(PG8_SA(0, 0), a2, voffA);
            PG8_WAIT_V(8); PG8_WAIT_L(0); PG8_BAR; PG8_MMA(1, 0, At, B0); PG8_MMA(1, 1, At, B1); PG8_BAR; PG8_SCHED;
            PG8_LDB(B0, 1, 0); PG8_LDB(B1, 1, 1); PG8_SCHED; PG8_LDA(At, 1, 0); PG8_STAGE(PG8_SA(0, 1), a2 + hstep, voffA);
            PG8_WAIT_V(8); PG8_WAIT_L(0); PG8_BAR; PG8_MMA(0, 0, At, B0); PG8_MMA(0, 1, At, B1); PG8_BAR; PG8_SCHED;
            PG8_LDA(At, 1, 1); PG8_STAGE(PG8_SB(1, 0), b3, voffB); PG8_STAGE(PG8_SB(1, 1), b3 + hstep, voffB); PG8_STAGE(PG8_SA(1, 0), a3, voffA);
            PG8_WAIT_V(8); PG8_WAIT_L(0); PG8_BAR; PG8_MMA(1, 0, At, B0); PG8_MMA(1, 1, At, B1); PG8_BAR; PG8_SCHED;
            } else {
            PG8_LDB(B0, 0, 0); PG8_SCHED; PG8_LDA(At, 0, 0); PG8_STAGE(PG8_SA(1, 1), a1 + hstep, voffA);
            PG8_WAIT_L(8); PG8_BAR; PG8_WAIT_L(0); PG8_MMA(0, 0, At, B0); PG8_BAR; PG8_SCHED;
            PG8_LDB(B1, 0, 1); PG8_STAGE(PG8_SB(0, 0), b2, voffB);
            PG8_BAR; PG8_WAIT_L(0); PG8_MMA(0, 1, At, B1); PG8_BAR;
            PG8_LDA(At, 0, 1); PG8_STAGE(PG8_SA(0, 0), a2, voffA);
            PG8_BAR; PG8_WAIT_L(0); PG8_MMA(1, 0, At, B0); PG8_BAR; PG8_SCHED;
            PG8_STAGE(PG8_SB(0, 1), b2 + hstep, voffB);
            PG8_WAIT_V(6); PG8_BAR; PG8_MMA(1, 1, At, B1); PG8_BAR;
            PG8_LDB(B0, 1, 0); PG8_SCHED; PG8_LDA(At, 1, 0); PG8_STAGE(PG8_SA(0, 1), a2 + hstep, voffA);
            PG8_WAIT_L(8); PG8_BAR; PG8_WAIT_L(0); PG8_MMA(0, 0, At, B0); PG8_BAR; PG8_SCHED;
            PG8_LDB(B1, 1, 1); PG8_STAGE(PG8_SB(1, 0), b3, voffB);
            PG8_BAR; PG8_WAIT_L(0); PG8_MMA(0, 1, At, B1); PG8_BAR;
            PG8_LDA(At, 1, 1); PG8_STAGE(PG8_SA(1, 0), a3, voffA);
            PG8_BAR; PG8_WAIT_L(0); PG8_MMA(1, 0, At, B0); PG8_BAR; PG8_SCHED;
            PG8_STAGE(PG8_SB(1, 1), b3 + hstep, voffB);
            PG8_WAIT_V(6); PG8_BAR; PG8_MMA(1, 1, At, B1); PG8_BAR;
            }
        }
        if constexpr (ALIGN_EPI) { if (wr == 0) PG8_BAR; }
        E(acc, cur, wr, wc, fr, fq); if (SDUP & 32) { asm volatile("" ::: "memory"); E(acc, cur, wr, wc, fr, fq); } S.done(cur);
        if (!has_next) break;
#pragma unroll
        for (int a = 0; a < 2; ++a)
#pragma unroll
            for (int b = 0; b < 2; ++b)
#pragma unroll
                for (int m = 0; m < 4; ++m)
#pragma unroll
                    for (int n = 0; n < 2; ++n) { typedef float f32x2_ __attribute__((ext_vector_type(2))); f32x2_ z0, z1;
                        asm volatile("v_mov_b64 %0, 0" : "=v"(z0)); asm volatile("v_mov_b64 %0, 0" : "=v"(z1));
                        acc[a][b][m][n] = __builtin_shufflevector(z0, z1, 0, 1, 2, 3); }
        cur = nxt; cA = nA; cB = nB; ++ui;
        if constexpr (ALIGN_EPI) { if (wr == 1) PG8_BAR; }
    }
    PG8_WAIT_V(0);
    if constexpr (!ALIGN_EPI) { if (wr == 0) PG8_BAR; }
    PG8_BAR;
#undef PG8_SA
#undef PG8_SB
#undef PG8_STAGE
#undef PG8_LDA
#undef PG8_LDB
#undef PG8_MMA
#undef PG8_WAIT_V
#undef PG8_WAIT_L
#undef PG8_BAR
#undef PG8_SCHED
}
}

constexpr int BATCH = 8, SEQ = 4096, DM = 1024, MROWS = BATCH * SEQ, DEPTH = 4;
constexpr int NIN = 3072, CIN = 3080, DFF = 2816, NUP = 2 * DFF;
constexpr float EPS = 1e-6f;
constexpr size_t M512B = (size_t)SEQ * 512, PBLK = (size_t)SEQ * NIN;
constexpr int NPHASE = 2 + 6 * DEPTH;

constexpr size_t MiB = 1u << 20;
constexpr size_t WS_CTL = 0, CTL_ZERO_BYTES = 64 * 1024;
constexpr size_t WS_COS = 1 * MiB, WS_SIN = 2 * MiB;
constexpr size_t WS_SS = 3 * MiB;
constexpr size_t WS_GLI = 5 * MiB, WS_GLF = 5 * MiB + 512 * 1024;
constexpr size_t WS_WG = 6 * MiB;
constexpr size_t WS_WM = 6 * MiB + 256 * 1024;
constexpr size_t WS_NST = 7 * MiB;
constexpr size_t WS_DG = 7 * MiB + 512 * 1024;
constexpr size_t WS_W = 8 * MiB;
constexpr size_t W_IN_OFF = 0, W_OUT_OFF = (size_t)NIN * DM * 2, W_UP_OFF = W_OUT_OFF + (size_t)DM * DM * 2, W_DOWN_OFF = W_UP_OFF + (size_t)NUP * DM * 2, W_LAYER = W_DOWN_OFF + (size_t)DM * DFF * 2;
constexpr size_t WS_HB = 106 * MiB;
constexpr size_t WS_MIX = 170 * MiB;
constexpr size_t WS_PROJ = 234 * MiB;
constexpr size_t WS_TST = 426 * MiB;
constexpr size_t WS_END = 460 * MiB;
static_assert(WS_W + 4 * W_LAYER <= WS_HB && WS_TST + (size_t)256 * 256 * 128 * 4 <= WS_END, "ws map");

constexpr int RING_BYTES = 131072;
constexpr int LDS_BYTES = 147456;
constexpr int P0_SCR_BYTES = 8 * 16640;
constexpr int RSTD_OFF = P0_SCR_BYTES;
constexpr int LDSCTL_OFF = LDS_BYTES - 256;
static_assert(RSTD_OFF >= RING_BYTES && RSTD_OFF + 12 * 256 * 4 <= LDSCTL_OFF, "LDS map");

#define GAS __attribute__((address_space(1)))
#define LAS __attribute__((address_space(3)))
#define DI __device__ __forceinline__
typedef unsigned short bf16_t;
typedef short bf16x8 __attribute__((ext_vector_type(8)));
typedef short bf16x4 __attribute__((ext_vector_type(4)));
typedef float f32x4 __attribute__((ext_vector_type(4)));
typedef float f32x16 __attribute__((ext_vector_type(16)));
typedef unsigned u32x4 __attribute__((ext_vector_type(4)));
typedef unsigned u32x2 __attribute__((ext_vector_type(2)));

DI unsigned pk2(float lo, float hi) { typedef __bf16 b2 __attribute__((ext_vector_type(2))); b2 v; v.x = (__bf16)lo; v.y = (__bf16)hi; return __builtin_bit_cast(unsigned, v); }
DI float bf2f(unsigned short x) { return __uint_as_float(((unsigned)x) << 16); }
DI float bflo(unsigned w) { return __uint_as_float(w << 16); }
DI float bfhi(unsigned w) { return __uint_as_float(w & 0xffff0000u); }
DI float fexp(float x) { return __builtin_amdgcn_exp2f(x * 1.4426950408889634f); }
DI float frcp(float x) { return __builtin_amdgcn_rcpf(x); }
DI float sigmoid_f(float x) { return frcp(1.f + fexp(-x)); }
DI float silu_f(float x) { return x * sigmoid_f(x); }
DI float gelu_tanh_f(float x) { return x * sigmoid_f(1.5957691216057308f * (x + 0.044715f * x * x * x)); }
template <int CTRL> DI float dpp_f(float v) { return __int_as_float(__builtin_amdgcn_mov_dpp(__float_as_int(v), CTRL, 0xF, 0xF, true)); }
DI float xor16_f(float v) { return __int_as_float(__builtin_amdgcn_ds_swizzle(__float_as_int(v), 0x401F)); }
DI float sum_xor32(float v) { const auto r = __builtin_amdgcn_permlane32_swap(__float_as_uint(v), __float_as_uint(v), false, false); return __uint_as_float(r[0]) + __uint_as_float(r[1]); }
DI float sum_xor16_32(float v) { v += xor16_f(v); return sum_xor32(v); }
DI float wave_sum(float v) {
    v += dpp_f<0xB1>(v); v += dpp_f<0x4E>(v); v += dpp_f<0x141>(v); v += dpp_f<0x140>(v);
    return sum_xor16_32(v);
}
template <int CTRL, int ROWMASK, bool IS_MAX> DI float scan_step(float v, const float ident) {
    const float t = __int_as_float(__builtin_amdgcn_update_dpp(__float_as_int(ident), __float_as_int(v), CTRL, ROWMASK, 0xF, false));
    return IS_MAX ? fmaxf(v, t) : v + t;
}
template <bool IS_MAX> DI float wave_scan(float v) {
    const float id = IS_MAX ? -3.0e38f : 0.f;
    v = scan_step<0x111, 0xF, IS_MAX>(v, id); v = scan_step<0x112, 0xF, IS_MAX>(v, id); v = scan_step<0x114, 0xF, IS_MAX>(v, id); v = scan_step<0x118, 0xF, IS_MAX>(v, id);
    v = scan_step<0x142, 0xA, IS_MAX>(v, id);
    v = scan_step<0x143, 0xC, IS_MAX>(v, id);
    return v;
}
DI float lane63(float v) { return __int_as_float(__builtin_amdgcn_readlane(__float_as_int(v), 63)); }

#define XB_TMO      128
#define XB_XCNT(j)  (256  + 64 * (j))
#define XB_XSUB(j)  (1280 + 64 * (j))
#define XB_XGEN(j)  (2304 + 64 * (j))
#define XB_TOP      3328
#define XB_TOPGEN   3392
#define XCD_BAR_WORDS 3456
#define XB_SPIN_CAP (1u << 18)

__device__ __forceinline__ unsigned xb_ld(unsigned* p)              { return __hip_atomic_load(p, __ATOMIC_RELAXED, __HIP_MEMORY_SCOPE_AGENT); }
__device__ __forceinline__ unsigned xb_add(unsigned* p, unsigned v) { return __hip_atomic_fetch_add(p, v, __ATOMIC_RELAXED, __HIP_MEMORY_SCOPE_AGENT); }
__device__ __forceinline__ unsigned xb_xcc_id() { return (unsigned)__builtin_amdgcn_s_getreg((3 << 11) | 20) & 0xFu; }
#define XB_SPIN(cond, bar) do { unsigned _sp = 0; while (cond) { __builtin_amdgcn_s_sleep(1); \
    if ((++_sp & 255u) == 0u) { if (xb_ld(&(bar)[XB_TMO])) break; if (_sp > XB_SPIN_CAP) { atomicAdd(&(bar)[XB_TMO], 1u); break; } } } } while (0)

struct XcdBarrier { unsigned* bar; unsigned x; volatile LAS unsigned* st; };

__device__ __forceinline__ XcdBarrier xcd_barrier_post(unsigned* bar, volatile LAS unsigned* st, int tid) {
    XcdBarrier b; b.bar = bar; b.x = xb_xcc_id(); b.st = st;
    if (tid == 0) (void)xb_add(&bar[XB_XCNT(b.x)], 1u);
    return b;
}
__device__ __forceinline__ void xcd_barrier_complete(unsigned* bar, unsigned x, unsigned& nloc, unsigned& nx) {
    const unsigned G = gridDim.x * gridDim.y * gridDim.z;
    unsigned sum, cnt, mine, sp = 0u;
    for (;;) {
        sum = 0u; cnt = 0u; mine = 0u;
#pragma unroll
        for (unsigned j = 0; j < 16; ++j) { const unsigned c = xb_ld(&bar[XB_XCNT(j)]); sum += c; cnt += (c > 0u) ? 1u : 0u; mine = (j == x) ? c : mine; }
        if (sum == G) break;
        __builtin_amdgcn_s_sleep(1);
        if ((++sp & 255u) == 0u) { if (xb_ld(&bar[XB_TMO])) break; if (sp > XB_SPIN_CAP) { atomicAdd(&bar[XB_TMO], 1u); break; } }
    }
    nloc = mine > 0u ? mine : 1u; nx = cnt > 0u ? cnt : 1u;
}
__device__ __forceinline__ void xcd_barrier(const XcdBarrier& b, int tid) {
    asm volatile("s_waitcnt vmcnt(0)" ::: "memory");
    __syncthreads();
    if (tid == 0) {
        unsigned* bar = b.bar;
        __builtin_amdgcn_s_waitcnt(0);
        unsigned nloc = b.st[0], nx = b.st[1];
        if (nloc == 0u) { xcd_barrier_complete(bar, b.x, nloc, nx); b.st[0] = nloc; b.st[1] = nx; }
        const unsigned old = xb_add(&bar[XB_XSUB(b.x)], 1u);
        const unsigned gen = old / nloc;
        if (old + 1u == (gen + 1u) * nloc) {
            __builtin_amdgcn_fence(__ATOMIC_RELEASE, "agent");
            asm volatile("s_waitcnt vmcnt(0)" ::: "memory");
            const unsigned og = xb_add(&bar[XB_TOP], 1u);
            const unsigned tg = og / nx;
            if (og + 1u == (tg + 1u) * nx) xb_add(&bar[XB_TOPGEN], 1u);
            else XB_SPIN(xb_ld(&bar[XB_TOPGEN]) == tg, bar);
            __builtin_amdgcn_fence(__ATOMIC_ACQUIRE, "agent");
            xb_add(&bar[XB_XGEN(b.x)], 1u);
            asm volatile("s_waitcnt vmcnt(0)" ::: "memory");
        } else {
            XB_SPIN(xb_ld(&bar[XB_XGEN(b.x)]) == gen, bar);
            __builtin_amdgcn_fence(__ATOMIC_ACQUIRE, "agent");
            asm volatile("s_waitcnt vmcnt(0)" ::: "memory");
        }
    }
    __syncthreads();
}

#define XB_GCNT(g)  (4096 + 64 * (g))
#define XB_IDS      5120
DI void grp_barrier(unsigned* bar, unsigned grp, unsigned n, bool fast, int tid) {
    asm volatile("s_waitcnt vmcnt(0)" ::: "memory");
    __syncthreads();
    if (tid == 0) {
        __builtin_amdgcn_s_waitcnt(0);
        if (!fast) { __builtin_amdgcn_fence(__ATOMIC_RELEASE, "agent"); asm volatile("s_waitcnt vmcnt(0)" ::: "memory"); }
        asm volatile("buffer_inv sc1" ::: "memory");
        const unsigned old = xb_add(&bar[XB_GCNT(grp)], 1u);
        const unsigned target = (old / n + 1u) * n;
        if (old + 1u != target) XB_SPIN((int)(xb_ld(&bar[XB_GCNT(grp)]) - target) < 0, bar);
        __builtin_amdgcn_fence(__ATOMIC_ACQUIRE, "workgroup");
        asm volatile("s_waitcnt vmcnt(0)" ::: "memory");
    }
    __syncthreads();
}
DI int m4_map(int m4, int G) { return G == 256 ? (((m4 >> 3) & 7) * 1024 + ((m4 >> 6) & 31) * 8 + (m4 & 7) + 256 * (m4 >> 11)) : m4; }

struct Frame {
    LAS unsigned char* lds;
    int tid, lane, wave, G, blk;
    const float* const __attribute__((address_space(4)))* in;
    float* H;
    unsigned char* ws;
};
DI bf16_t* W_in(const Frame& F, int L)   { return (bf16_t*)(F.ws + WS_W + (size_t)L * W_LAYER + W_IN_OFF); }
DI bf16_t* W_out(const Frame& F, int L)  { return (bf16_t*)(F.ws + WS_W + (size_t)L * W_LAYER + W_OUT_OFF); }
DI bf16_t* W_up(const Frame& F, int L)   { return (bf16_t*)(F.ws + WS_W + (size_t)L * W_LAYER + W_UP_OFF); }
DI bf16_t* W_down(const Frame& F, int L) { return (bf16_t*)(F.ws + WS_W + (size_t)L * W_LAYER + W_DOWN_OFF); }

template <class Sched>
DI void rstd_table(Frame& F, const Sched& S, const float* __restrict__ SS) {
    LAS float* T = (LAS float*)(F.lds + RSTD_OFF); pg8::Unit u;
    for (int i0 = 0; S.next(i0, u); i0 += 4) {
        f32x4 sp[2][4]; bool ok[2];
#pragma unroll
        for (int k = 0; k < 2; ++k) { const int i = i0 + 2 * k + (F.tid >> 8); ok[k] = S.next(i, u);
            if (ok[k]) { const float* p = SS + (size_t)(256 * u.pm + (F.tid & 255)) * 16;
#pragma unroll
                for (int q = 0; q < 4; ++q) sp[k][q] = *(const f32x4*)(p + 4 * q); } }
#pragma unroll
        for (int k = 0; k < 2; ++k) if (ok[k]) { const int i = i0 + 2 * k + (F.tid >> 8); float s = 0.f;
#pragma unroll
            for (int q = 0; q < 4; ++q) s += (sp[k][q].x + sp[k][q].y) + (sp[k][q].z + sp[k][q].w);
            T[i * 256 + (F.tid & 255)] = 1.0f / sqrtf(s * (1.0f / DM) + EPS); }
    }
    __syncthreads();
}
DI void row_rstd8(const LAS float* T, int ui, int wr, int fr, float (&rs)[2][4]) {
#pragma unroll
    for (int ai = 0; ai < 2; ++ai)
#pragma unroll
        for (int m = 0; m < 4; ++m) rs[ai][m] = T[ui * 256 + ai * 128 + wr * 64 + m * 16 + fr];
}
DI void store8(bf16_t* p, const f32x4& v0, const f32x4& v1) { u32x4 w; w.x = pk2(v0[0], v0[1]); w.y = pk2(v0[2], v0[3]); w.z = pk2(v1[0], v1[1]); w.w = pk2(v1[2], v1[3]); *(u32x4*)p = w; }

struct EpiInA {
    static constexpr bool PERM = true;
    bf16_t* P; const LAS float* RT; const float* COS; const float* SIN;
    DI void operator()(const f32x4 (&acc)[2][2][4][2], const pg8::Unit& u, int wr, int wc, int fr, int fq) const {
        const int row0 = u.pm * 256 + wr * 64 + fr, colw = wc * 32 + 8 * fq, typ = u.pn >> 1;
        float rsv[2][4]; row_rstd8(RT, u.ui, wr, fr, rsv);
#pragma unroll
        for (int ai = 0; ai < 2; ++ai) {
            f32x4 cc[4], sn[4];
            if (typ < 2) {
#pragma unroll
                for (int m = 0; m < 4; ++m) { const int pos = (row0 + ai * 128 + m * 16) & (SEQ - 1); cc[m] = *(const f32x4*)(COS + pos * 64 + (colw >> 1)); sn[m] = *(const f32x4*)(SIN + pos * 64 + (colw >> 1)); } }
#pragma unroll
            for (int m = 0; m < 4; ++m) {
                const int row = row0 + ai * 128 + m * 16;
                const float rs = rsv[ai][m];
                const int bb = row >> 12, tq = row & (SEQ - 1);
                bf16_t* rowp = (typ < 4) ? P + (size_t)bb * PBLK + (size_t)typ * M512B + ((size_t)((2 * (u.pn & 1)) * SEQ + tq)) * 128 + colw
                                         : P + (size_t)bb * PBLK + (size_t)typ * M512B + (size_t)tq * 512 + (u.pn & 1) * 256 + colw;
                const size_t bjs = (typ < 4) ? (size_t)SEQ * 128 : 128;
                if (typ < 2) {
                    const f32x4 c4 = cc[m], s4 = sn[m];
#pragma unroll
                    for (int bj = 0; bj < 2; ++bj) { const f32x4 a0 = acc[ai][bj][m][0] * rs, a1 = acc[ai][bj][m][1] * rs; f32x4 v0, v1;
                        v0[0] = a0[0] * c4[0] - a0[1] * s4[0]; v0[1] = a0[0] * s4[0] + a0[1] * c4[0];
                        v0[2] = a0[2] * c4[1] - a0[3] * s4[1]; v0[3] = a0[2] * s4[1] + a0[3] * c4[1];
                        v1[0] = a1[0] * c4[2] - a1[1] * s4[2]; v1[1] = a1[0] * s4[2] + a1[1] * c4[2];
                        v1[2] = a1[2] * c4[3] - a1[3] * s4[3]; v1[3] = a1[2] * s4[3] + a1[3] * c4[3];
                        store8(rowp + bj * bjs, v0, v1); }
                } else {
#pragma unroll
                    for (int bj = 0; bj < 2; ++bj) { f32x4 v0 = acc[ai][bj][m][0] * rs, v1 = acc[ai][bj][m][1] * rs;
                        if (typ == 3) {
#pragma unroll
                            for (int j = 0; j < 4; ++j) { v0[j] = silu_f(v0[j]); v1[j] = silu_f(v1[j]); } }
                        else if (typ >= 4) {
#pragma unroll
                            for (int j = 0; j < 4; ++j) { v0[j] = gelu_tanh_f(v0[j]); v1[j] = gelu_tanh_f(v1[j]); } }
                        store8(rowp + bj * bjs, v0, v1); }
                }
            }
        }
    }
};
struct EpiInC {
    static constexpr bool PERM = true;
    bf16_t* P; const LAS float* RT;
    DI void operator()(const f32x4 (&acc)[2][2][4][2], const pg8::Unit& u, int wr, int wc, int fr, int fq) const {
        const int row0 = u.pm * 256 + wr * 64 + fr, colw = wc * 32 + 8 * fq; const bool sg = u.pn >= 8;
        float rsv[2][4]; row_rstd8(RT, u.ui, wr, fr, rsv);
#pragma unroll
        for (int ai = 0; ai < 2; ++ai)
#pragma unroll
            for (int m = 0; m < 4; ++m) {
                const int row = row0 + ai * 128 + m * 16;
                const float rs = rsv[ai][m];
                const int bb = row >> 12, tq = row & (SEQ - 1);
                bf16_t* rowp; size_t bjs;
                if (u.pn < 4) { rowp = P + (size_t)bb * PBLK + (size_t)(u.pn >> 1) * M512B + ((size_t)((2 * (u.pn & 1)) * SEQ + tq)) * 128 + colw; bjs = (size_t)SEQ * 128; }
                else { rowp = P + (size_t)bb * PBLK + (size_t)(u.pn < 8 ? 2 : 4) * M512B + ((size_t)((u.pn & 3) * SEQ + tq)) * 256 + colw; bjs = 128; }
#pragma unroll
                for (int bj = 0; bj < 2; ++bj) { f32x4 v0 = acc[ai][bj][m][0] * rs, v1 = acc[ai][bj][m][1] * rs;
                    if (sg) {
#pragma unroll
                        for (int j = 0; j < 4; ++j) { v0[j] = sigmoid_f(v0[j]); v1[j] = sigmoid_f(v1[j]); } }
                    store8(rowp + bj * bjs, v0, v1); }
            }
    }
};
struct EpiRes {
    static constexpr bool PERM = true;
    bf16_t* HB; float* SS; float sgn;
    DI void operator()(const f32x4 (&acc)[2][2][4][2], const pg8::Unit& u, int wr, int wc, int fr, int fq) const {
        const int row0 = u.pm * 256 + wr * 64 + fr, col0 = u.pn * 256 + wc * 32 + 8 * fq;
#pragma unroll
        for (int ai = 0; ai < 2; ++ai) {
            u32x4 hv[4][2];
#pragma unroll
            for (int m = 0; m < 4; ++m) { const bf16_t* bp = HB + (size_t)(row0 + ai * 128 + m * 16) * DM + col0;
#pragma unroll
                for (int bj = 0; bj < 2; ++bj) hv[m][bj] = *(const u32x4*)(bp + bj * 128); }
#pragma unroll
            for (int m = 0; m < 4; ++m) {
                const int row = row0 + ai * 128 + m * 16;
                bf16_t* bp = HB + (size_t)row * DM + col0; float ssum = 0.f;
#pragma unroll
                for (int bj = 0; bj < 2; ++bj) {
                    const u32x4 w = hv[m][bj];
                    const f32x4 b0 = {bflo(w.x), bfhi(w.x), bflo(w.y), bfhi(w.y)}, b1 = {bflo(w.z), bfhi(w.z), bflo(w.w), bfhi(w.w)};
                    const f32x4 h0 = b0 + acc[ai][bj][m][0] * sgn, h1 = b1 + acc[ai][bj][m][1] * sgn;
                    store8(bp + bj * 128, h0, h1);
                    ssum += (h0[0] * h0[0] + h0[1] * h0[1]) + (h0[2] * h0[2] + h0[3] * h0[3]) + (h1[0] * h1[0] + h1[1] * h1[1]) + (h1[2] * h1[2] + h1[3] * h1[3]);
                }
                ssum = sum_xor16_32(ssum);
                if (fq == 0) SS[(size_t)row * 16 + u.pn * 4 + wc] = ssum;
            }
        }
    }
};
struct EpiSwiGLU {
    static constexpr bool PERM = true;
    bf16_t* ACT; const LAS float* RT;
    DI void operator()(const f32x4 (&acc)[2][2][4][2], const pg8::Unit& u, int wr, int wc, int fr, int fq) const {
        const int row0 = u.pm * 256 + wr * 64 + fr, col0 = u.pn * 128 + wc * 32 + 8 * fq;
        float rsv[2][4]; row_rstd8(RT, u.ui, wr, fr, rsv);
#pragma unroll
        for (int ai = 0; ai < 2; ++ai)
#pragma unroll
            for (int m = 0; m < 4; ++m) {
                const int row = row0 + ai * 128 + m * 16;
                const float rs = rsv[ai][m];
                const f32x4 g0 = acc[ai][0][m][0] * rs, g1 = acc[ai][0][m][1] * rs, u0 = acc[ai][1][m][0] * rs, u1 = acc[ai][1][m][1] * rs; f32x4 v0, v1;
#pragma unroll
                for (int j = 0; j < 4; ++j) { v0[j] = silu_f(g0[j]) * u0[j]; v1[j] = silu_f(g1[j]) * u1[j]; }
                store8(ACT + (size_t)(row >> 12) * PBLK + (size_t)(row & (SEQ - 1)) * DFF + col0, v0, v1);
            }
    }
};

template <class Map>
DI void cvt_item(const float* src, int ld, const float* gain, bf16_t* WT, int K, int n0, int k0, const Map& mp, LAS float* scr, int lane) {
    const int sc = mp.col(n0 + lane); const float scale = mp.scale(n0 + lane);
    float wv[64];
    const float* sp = src + (size_t)k0 * ld + sc;
#pragma unroll
    for (int i = 0; i < 64; ++i) wv[i] = sp[(size_t)i * ld];
#pragma unroll
    for (int i = 0; i < 64; ++i) { const float gk = gain ? gain[k0 + i] : 1.0f; scr[i * 65 + lane] = wv[i] * (gk * scale); }
    asm volatile("s_waitcnt lgkmcnt(0)" ::: "memory");
    const int c = lane & 7;
#pragma unroll
    for (int j = 0; j < 8; ++j) { const int n = (lane >> 3) + 8 * j; const LAS float* s = scr + (8 * c) * 65 + n;
        u32x4 o; o.x = pk2(s[0 * 65], s[1 * 65]); o.y = pk2(s[2 * 65], s[3 * 65]); o.z = pk2(s[4 * 65], s[5 * 65]); o.w = pk2(s[6 * 65], s[7 * 65]);
        *(u32x4*)(WT + (size_t)(n0 + n) * K + k0 + 8 * c) = o; }
    asm volatile("s_waitcnt lgkmcnt(0)" ::: "memory");
}
struct MapId { DI int col(int n) const { return n; } DI float scale(int) const { return 1.0f; } };
struct MapInA { DI int col(int n) const { if (n >= 1024) return n; const int p = n & 127; return (n & ~127) + (p >> 1) + 64 * (p & 1); } DI float scale(int n) const { return (n >= 512 && n < 1024) ? 0.08838834764831845f : 1.0f; } };
struct MapInC { DI int col(int n) const { return n; } DI float scale(int n) const { return (n >= 512 && n < 1024) ? 0.08838834764831845f : 1.0f; } };
struct MapUp  { DI int col(int n) const { return 128 * (n >> 8) + (n & 127); } DI float scale(int) const { return 1.0f; } };

DI void p0_prologue(Frame& F) {
    LAS float* scr = (LAS float*)(F.lds + F.wave * 16640);
    const int gw = F.blk * 8 + F.wave, NGW = F.G * 8;
    constexpr int I_IN = 16 * 48, I_OUT = 16 * 16, I_UP = 16 * 88, I_DOWN = 44 * 16, I_LAYER = I_IN + I_OUT + I_UP + I_DOWN;
    for (int it = gw; it < DEPTH * I_LAYER; it += NGW) {
        const int L = it / I_LAYER; int r = it % I_LAYER; const int j = L >> 1;
        if (r < I_IN) { const int kb = r / 48, nb = r % 48;
            if (L & 1) cvt_item(F.in[11] + (size_t)j * DM * CIN, CIN, F.in[1] + L * DM, W_in(F, L), DM, 64 * nb, 64 * kb, MapInC(), scr, F.lane);
            else       cvt_item(F.in[4] + (size_t)j * DM * NIN, NIN, F.in[1] + L * DM, W_in(F, L), DM, 64 * nb, 64 * kb, MapInA(), scr, F.lane);
            continue; }
        r -= I_IN;
        if (r < I_OUT) { const int kb = r / 16, nb = r % 16;
            cvt_item(((L & 1) ? F.in[12] : F.in[5]) + (size_t)j * DM * DM, DM, nullptr, W_out(F, L), DM, 64 * nb, 64 * kb, MapId(), scr, F.lane); continue; }
        r -= I_OUT;
        if (r < I_UP) { const int kb = r / 88, nb = r % 88; const int n0 = 64 * nb; const bool up = (n0 >> 7) & 1;
            cvt_item((up ? F.in[17] : F.in[16]) + (size_t)L * DM * DFF, DFF, F.in[2] + L * DM, W_up(F, L), DM, n0, 64 * kb, MapUp(), scr, F.lane); continue; }
        r -= I_UP;
        { const int kb = r / 16, nb = r % 16;
          cvt_item(F.in[18] + (size_t)L * DFF * DM, DM, nullptr, W_down(F, L), DFF, 64 * nb, 64 * kb, MapId(), scr, F.lane); }
    }
    float* SS = (float*)(F.ws + WS_SS); bf16_t* HB = (bf16_t*)(F.ws + WS_HB);
    for (int m2 = gw; m2 < MROWS / 2; m2 += NGW) {
        f32x4 v[2][4];
#pragma unroll
        for (int rr = 0; rr < 2; ++rr) { const f32x4* xr = (const f32x4*)(F.in[0] + (size_t)(2 * m2 + rr) * DM) + F.lane;
#pragma unroll
            for (int q = 0; q < 4; ++q) v[rr][q] = xr[64 * q]; }
#pragma unroll
        for (int rr = 0; rr < 2; ++rr) { const int m = 2 * m2 + rr; u32x2* br = (u32x2*)(HB + (size_t)m * DM) + F.lane; float s = 0.f;
#pragma unroll
            for (int q = 0; q < 4; ++q) { const f32x4 x = v[rr][q]; s += (x.x * x.x + x.y * x.y) + (x.z * x.z + x.w * x.w); u32x2 o; o.x = pk2(x.x, x.y); o.y = pk2(x.z, x.w); br[64 * q] = o; }
            s = wave_sum(s);
            if (F.lane < 16) SS[(size_t)m * 16 + F.lane] = (F.lane == 0) ? s : 0.f; }
    }
    const int gt = F.blk * 512 + F.tid, NGT = F.G * 512;
    float* COS = (float*)(F.ws + WS_COS); float* SIN = (float*)(F.ws + WS_SIN);
    for (int e = gt; e < SEQ * 64; e += NGT) {
        const int pos = e >> 6, i = e & 63;
        const float inv = exp2f(-(float)i * (13.287712379549449f / 64.0f));
        const float ang = (float)pos * inv;
        const double a = (double)ang; const double n = rint(a * 0.15915494309189535); const float rr = (float)(a - n * 6.283185307179586);
        COS[e] = cosf(rr); SIN[e] = sinf(rr);
    }
    float* WG = (float*)(F.ws + WS_WG);
    for (int e = gt; e < 2 * 8 * DM; e += NGT) { const int j = e >> 13, c = (e >> 10) & 7, k = e & 1023;
        WG[e] = F.in[11][(size_t)j * DM * CIN + (size_t)k * CIN + 3072 + c] * F.in[1][(2 * j + 1) * DM + k]; }
    bf16_t* WM = (bf16_t*)(F.ws + WS_WM);
    for (int e = gt; e < 2 * 4 * 128 * 128; e += NGT) { const int p = (e >> 7) & 127, q = e & 127; const float w = ((q >> 6) <= (p >> 6)) ? F.in[9][e] : 0.f; WM[e] = (bf16_t)(pk2(w, 0.f) & 0xffffu); }
}

DI void gate_step(Frame& F, int L) {
    const int j = L >> 1; const int gw = F.blk * 8 + F.wave, NGW = F.G * 8;
    const float* SS = (const float*)(F.ws + WS_SS); const bf16_t* HB = (const bf16_t*)(F.ws + WS_HB); const float* WG = (const float*)(F.ws + WS_WG) + j * 8 * DM;
    float* GLI = (float*)(F.ws + WS_GLI); float* GLF = (float*)(F.ws + WS_GLF);
    for (int m4l = gw; m4l < MROWS / 4; m4l += NGW) {
        const int m4 = m4_map(m4l, F.G);
        u32x4 a0[4], a1[4]; float ssv[4];
#pragma unroll
        for (int rr = 0; rr < 4; ++rr) { const int m = 4 * m4 + rr; a0[rr] = *((const u32x4*)(HB + (size_t)m * DM) + F.lane); a1[rr] = *((const u32x4*)(HB + (size_t)m * DM + 512) + F.lane);
            ssv[rr] = (F.lane < 16) ? SS[(size_t)m * 16 + F.lane] : 0.f; }
#pragma unroll
        for (int rr = 0; rr < 4; ++rr) {
            const int m = 4 * m4 + rr; float x[16];
            x[0] = bflo(a0[rr].x); x[1] = bfhi(a0[rr].x); x[2] = bflo(a0[rr].y); x[3] = bfhi(a0[rr].y); x[4] = bflo(a0[rr].z); x[5] = bfhi(a0[rr].z); x[6] = bflo(a0[rr].w); x[7] = bfhi(a0[rr].w);
            x[8] = bflo(a1[rr].x); x[9] = bfhi(a1[rr].x); x[10] = bflo(a1[rr].y); x[11] = bfhi(a1[rr].y); x[12] = bflo(a1[rr].z); x[13] = bfhi(a1[rr].z); x[14] = bflo(a1[rr].w); x[15] = bfhi(a1[rr].w);
            const float ssp = wave_sum(ssv[rr]);
            const float rs = 1.0f / sqrtf(ssp * (1.0f / DM) + EPS);
            float myv = 0.f;
#pragma unroll
            for (int c = 0; c < 8; ++c) {
                const f32x4* w0 = (const f32x4*)(WG + c * DM + 8 * F.lane); const f32x4* w1 = (const f32x4*)(WG + c * DM + 512 + 8 * F.lane);
                const f32x4 wa = w0[0], wb = w0[1], wc2 = w1[0], wd = w1[1];
                float d = x[0] * wa.x + x[1] * wa.y + x[2] * wa.z + x[3] * wa.w + x[4] * wb.x + x[5] * wb.y + x[6] * wb.z + x[7] * wb.w
                        + x[8] * wc2.x + x[9] * wc2.y + x[10] * wc2.z + x[11] * wc2.w + x[12] * wd.x + x[13] * wd.y + x[14] * wd.z + x[15] * wd.w;
                d = wave_sum(d);
                if (F.lane == c) myv = d * rs;
            }
            if (F.lane < 8) {
                const int hh = F.lane & 3; const int b = m >> 12, t = m & (SEQ - 1); const size_t idx = (size_t)(b * 4 + hh) * SEQ + t;
                if (F.lane < 4) GLI[idx] = myv + F.in[13][j * 4 + hh];
                else { const float xx = myv + F.in[14][j * 4 + hh]; GLF[idx] = (xx >= 0.f) ? -log1pf(expf(-xx)) : (xx - log1pf(expf(xx))); }
            }
        }
    }
}

DI void final_norm(Frame& F) {
    const int gw = F.blk * 8 + F.wave, NGW = F.G * 8; const float* SS = (const float*)(F.ws + WS_SS); const bf16_t* HB = (const bf16_t*)(F.ws + WS_HB); const f32x4* gv = (const f32x4*)F.in[3] + F.lane;
    f32x4 g[4];
#pragma unroll
    for (int q = 0; q < 4; ++q) g[q] = gv[64 * q];
    for (int m4l = gw; m4l < MROWS / 4; m4l += NGW) {
        const int m4 = m4_map(m4l, F.G);
        u32x2 w[4][4]; float ssv[4];
#pragma unroll
        for (int rr = 0; rr < 4; ++rr) { const int m = 4 * m4 + rr; const u32x2* br = (const u32x2*)(HB + (size_t)m * DM) + F.lane;
#pragma unroll
            for (int q = 0; q < 4; ++q) w[rr][q] = br[64 * q];
            ssv[rr] = (F.lane < 16) ? SS[(size_t)m * 16 + F.lane] : 0.f; }
#pragma unroll
        for (int rr = 0; rr < 4; ++rr) { const int m = 4 * m4 + rr; f32x4* hr = (f32x4*)(F.H + (size_t)m * DM) + F.lane;
            const float rs = 1.0f / sqrtf(wave_sum(ssv[rr]) * (1.0f / DM) + EPS);
#pragma unroll
            for (int q = 0; q < 4; ++q) { const f32x4 v = {bflo(w[rr][q].x), bfhi(w[rr][q].x), bflo(w[rr][q].y), bfhi(w[rr][q].y)}; hr[64 * q] = v * rs * g[q]; } }
    }
}

DI int opaque(int x) { asm volatile("" : "+v"(x)); return x; }
DI int crow(int i, int h) { return (i & 3) + 8 * (i >> 2) + 4 * h; }
constexpr int QLD = 136, PLD = 72, KWLD = 160;
constexpr int QS_OFF = 0, KS_OFF = 17408, KW_OFF = 34816, VS_OFF = 55296, PS_OFF = 92160;
constexpr int SA_OFF = 101376, SCM_OFF = SA_OFF + 2048, SMT_OFF = SCM_OFF + 2048, SMISC_OFF = SMT_OFF + 2048;
constexpr int PQ_OFF = SMISC_OFF + 256, MS_OFF = PQ_OFF + 512, LS_OFF = MS_OFF + 320;
constexpr int STAT_OFF = LS_OFF + 320, NV_OFF = STAT_OFF + 4096, PSUM_OFF = NV_OFF + 512, QN_OFF = PSUM_OFF + 1024, GAIN_OFF = QN_OFF + 256, LA_END = GAIN_OFF + 1024;
static_assert(LA_END <= RING_BYTES, "mixer LDS");

DI bf16x8 gather_col(const LAS bf16_t* base, int ld, int col, int s0) {
    bf16x8 r;
#pragma unroll
    for (int j = 0; j < 8; ++j) r[j] = (short)base[(s0 + j) * ld + col];
    return r;
}
DI bf16x8 tr_frag(const LAS bf16_t* tile, int ld, int col0, int s0, int lane) {
    const int i16 = lane & 15, q = i16 >> 2, p = i16 & 3, blk = (lane >> 4) & 1, hh = lane >> 5;
    const LAS bf16_t* a = tile + (s0 + 8 * hh + q) * ld + col0 + 16 * blk + 4 * p;
    const bf16x4 lo = __builtin_amdgcn_ds_read_tr16_b64_v4i16((LAS bf16x4*)a), hi = __builtin_amdgcn_ds_read_tr16_b64_v4i16((LAS bf16x4*)(a + 4 * ld));
    return __builtin_shufflevector(lo, hi, 0, 1, 2, 3, 4, 5, 6, 7);
}
DI bf16x8 pack_acc(const f32x16& x, int s) {
    u32x4 p; p.x = pk2(x[8 * s + 0], x[8 * s + 1]); p.y = pk2(x[8 * s + 2], x[8 * s + 3]); p.z = pk2(x[8 * s + 4], x[8 * s + 5]); p.w = pk2(x[8 * s + 6], x[8 * s + 7]);
    return __builtin_bit_cast(bf16x8, p);
}
#define MFMA32(a, b, c) __builtin_amdgcn_mfma_f32_32x32x16_bf16((a), (b), (c), 0, 0, 0)
#define MFMA16(a, b, c) __builtin_amdgcn_mfma_f32_16x16x32_bf16((a), (b), (c), 0, 0, 0)

DI void mlstm_scan(Frame& F, int b, int h, int g) {
    LAS float* SA = (LAS float*)(F.lds + SA_OFF); LAS float* SCM = (LAS float*)(F.lds + SCM_OFF); LAS float* SMT = (LAS float*)(F.lds + SMT_OFF); LAS float* SM = (LAS float*)(F.lds + SMISC_OFF);
    LAS float* PQ = (LAS float*)(F.lds + PQ_OFF); LAS float* MS = (LAS float*)(F.lds + MS_OFF); LAS float* LS = (LAS float*)(F.lds + LS_OFF);
    const float* GLI = (const float*)(F.ws + WS_GLI) + (size_t)(b * 4 + h) * SEQ; const float* GLF = (const float*)(F.ws + WS_GLF) + (size_t)(b * 4 + h) * SEQ;
    const int lane = opaque(F.lane), w = F.wave;
    if (w <= g) {
        float li[8], lf[8]; const float* gli = GLI + w * 512 + lane; const float* glf = GLF + w * 512 + lane;
#pragma unroll
        for (int c = 0; c < 8; ++c) { li[c] = gli[c * 64]; lf[c] = glf[c * 64]; }
#pragma unroll
        for (int c = 0; c < 8; ++c) {
            const float bs = wave_scan<false>(lf[c]); const float a = li[c] - bs; const float cmx = wave_scan<true>(a);
            const float amax = lane63(cmx), b63 = lane63(bs);
            if (lane == 0) { PQ[(8 * w + c) * 2] = b63; PQ[(8 * w + c) * 2 + 1] = amax; }
            if (w == g) { (SA + lane)[c * 64] = a; (SCM + lane)[c * 64] = cmx; (SMT + lane)[c * 64] = bs; }
        }
    }
    __syncthreads();
    if (w == 0) {
        const bool live = lane < 8 * (g + 1);
        float P = live ? PQ[lane * 2] : 0.f; const float am = live ? PQ[lane * 2 + 1] : -3.0e38f; float Q = live ? am + P : -3.0e38f;
#define SCAN_PQ(CTRL, RM) { const float tP = __int_as_float(__builtin_amdgcn_update_dpp(0, __float_as_int(P), CTRL, RM, 0xF, false)); \
                            const float tQ = __int_as_float(__builtin_amdgcn_update_dpp(__float_as_int(-3.0e38f), __float_as_int(Q), CTRL, RM, 0xF, false)); Q = fmaxf(tQ + P, Q); P = tP + P; }
        SCAN_PQ(0x111, 0xF) SCAN_PQ(0x112, 0xF) SCAN_PQ(0x114, 0xF) SCAN_PQ(0x118, 0xF) SCAN_PQ(0x142, 0xA) SCAN_PQ(0x143, 0xC)
#undef SCAN_PQ
        const float mnext = fmaxf(P, Q);
        MS[lane + 1] = mnext; if (lane == 0) MS[0] = 0.f;
        const float mprev = MS[lane];
        const float la = live ? (mprev - fmaxf(mprev, am)) : 0.f;
        const float Linc = wave_scan<false>(la);
        LS[lane + 1] = Linc; if (lane == 0) LS[0] = 0.f;
    }
    __syncthreads();
    {
        const int i = F.tid, c = i >> 6; const float mprev = MS[8 * g + c]; const float cm = fmaxf(mprev, SCM[i]); SCM[i] = cm; SMT[i] = SMT[i] + cm;
        if (i < 8) SM[i] = MS[8 * g + i];
        if (i >= 16 && i < 25) SM[i] = LS[8 * (i - 16)];
    }
}

template <int MODE, bool PASS2> struct ChunkRegs { u32x4 k[2]; u32x4 q[PASS2 ? 2 : 1]; u32x4 v[(MODE ? 256 : 128) / 64]; };
template <int MODE, bool PASS2>
DI void la_load(ChunkRegs<MODE, PASS2>& R, const bf16_t* PROJ, int bh, int T0, int tid) {
    constexpr int DV = MODE ? 256 : 128;
    const bf16_t* Q = PROJ + ((size_t)bh * SEQ + T0) * 128; const bf16_t* K = Q + M512B; const bf16_t* V = PROJ + 2 * M512B + ((size_t)bh * SEQ + T0) * DV;
#pragma unroll
    for (int i = 0; i < 2; ++i) { const int p = tid + 512 * i;
        R.k[i] = *(const u32x4*)(K + p * 8);
        if (PASS2) R.q[i] = *(const u32x4*)(Q + p * 8); }
#pragma unroll
    for (int i = 0; i < DV / 64; ++i) { const int p = tid + 512 * i; R.v[i] = *(const u32x4*)(V + p * 8); }
}
template <int MODE, bool PASS2>
DI void la_write(Frame& F, const ChunkRegs<MODE, PASS2>& R, int c, float lg2, int tid) {
    constexpr int DV = MODE ? 256 : 128, VLD = DV + 32;
    LAS bf16_t* Qs = (LAS bf16_t*)(F.lds + QS_OFF); LAS bf16_t* Ks = (LAS bf16_t*)(F.lds + KS_OFF); LAS bf16_t* Kw = (LAS bf16_t*)(F.lds + KW_OFF); LAS bf16_t* Vs = (LAS bf16_t*)(F.lds + VS_OFF);
    const LAS float* SA = (const LAS float*)(F.lds + SA_OFF); const LAS float* SCM = (const LAS float*)(F.lds + SCM_OFF);
#pragma unroll
    for (int i = 0; i < 2; ++i) { const int p = tid + 512 * i, t = p >> 4, cp = (p & 15) * 8; const u32x4 kv = R.k[i];
        float ck;
        if (MODE) ck = fexp(SA[c * 64 + t] - SCM[c * 64 + 63]); else ck = __builtin_amdgcn_exp2f(lg2 * (float)(63 - t));
        u32x4 kw; kw.x = pk2(bflo(kv.x) * ck, bfhi(kv.x) * ck); kw.y = pk2(bflo(kv.y) * ck, bfhi(kv.y) * ck); kw.z = pk2(bflo(kv.z) * ck, bfhi(kv.z) * ck); kw.w = pk2(bflo(kv.w) * ck, bfhi(kv.w) * ck);
        *(LAS u32x4*)(Kw + t * KWLD + cp) = kw;
        if (PASS2) { *(LAS u32x4*)(Ks + t * QLD + cp) = kv; *(LAS u32x4*)(Qs + t * QLD + cp) = R.q[i]; }
    }
#pragma unroll
    for (int i = 0; i < DV / 64; ++i) { const int p = tid + 512 * i, t = p / (DV / 8), cp = (p % (DV / 8)) * 8; *(LAS u32x4*)(Vs + t * VLD + cp) = R.v[i]; }
}

template <int MODE>
DI void la_pass1(Frame& F, int unit) {
    constexpr int DV = MODE ? 256 : 128, VLD = DV + 32, ND = MODE ? 4 : 2;
    const int b = unit >> 5, h = (unit >> 3) & 3, g = unit & 7, row0 = b * SEQ + g * 512;
    const int w = F.wave; int lane = F.lane, r = lane & 31, hh = lane >> 5;
    const int eb = MODE ? w : (w & 3), dt0 = MODE ? 0 : 2 * (w >> 2), e0 = 32 * eb;
    const bf16_t* PROJ = (const bf16_t*)(F.ws + WS_PROJ) + (size_t)b * PBLK;
    LAS bf16_t* Kw = (LAS bf16_t*)(F.lds + KW_OFF); LAS bf16_t* Vs = (LAS bf16_t*)(F.lds + VS_OFF);
    const LAS float* SCM = (const LAS float*)(F.lds + SCM_OFF); const LAS float* SM = (const LAS float*)(F.lds + SMISC_OFF); LAS float* NV = (LAS float*)(F.lds + NV_OFF);
    const float lg2 = log2f(1.0f - exp2f(-5.0f - (float)h));
    ChunkRegs<MODE, false> R; la_load<MODE, false>(R, PROJ, h, g * 512, opaque(F.tid));
    if (MODE) { mlstm_scan(F, b, h, g); if (F.tid < 128) NV[F.tid] = 0.f; }
    __syncthreads();
    f32x16 C[ND];
#pragma unroll
    for (int d = 0; d < ND; ++d)
#pragma unroll
        for (int i = 0; i < 16; ++i) C[d][i] = 0.f;
    for (int c = 0; c < 8; ++c) {
        lane = opaque(F.lane); r = lane & 31; hh = lane >> 5; const int tid_o = opaque(F.tid);
        la_write<MODE, false>(F, R, c, lg2, tid_o);
        __syncthreads();
        if (c < 7) la_load<MODE, false>(R, PROJ, h, g * 512 + 64 * (c + 1), tid_o);
        const float alpha = MODE ? fexp(SM[c] - SCM[c * 64 + 63]) : __builtin_amdgcn_exp2f(lg2 * 64.0f);
        bf16x8 vf[4];
#pragma unroll
        for (int ks = 0; ks < 4; ++ks) vf[ks] = tr_frag(Vs, VLD, e0, 16 * ks, lane);
#pragma unroll
        for (int d = 0; d < ND; ++d) {
#pragma unroll
            for (int i = 0; i < 16; ++i) C[d][i] *= alpha;
#pragma unroll
            for (int ks = 0; ks < 4; ++ks) { const bf16x8 ka = tr_frag(Kw, KWLD, 32 * (dt0 + d), 16 * ks, lane); C[d] = MFMA32(ka, vf[ks], C[d]); }
        }
        if (MODE) {
            const int dd = 16 * w + (lane & 15), sq = lane >> 4; float s = 0.f;
#pragma unroll
            for (int q = 0; q < 16; ++q) s += bf2f(Kw[(16 * sq + q) * KWLD + dd]);
            s = sum_xor16_32(s);
            if (lane < 16) NV[dd] = alpha * NV[dd] + s;
        }
        __syncthreads();
    }
    bf16_t* T = (bf16_t*)(F.ws + WS_TST) + (size_t)unit * DV * 128;
#pragma unroll
    for (int d = 0; d < ND; ++d)
#pragma unroll
        for (int q = 0; q < 4; ++q) { u32x2 v; v.x = pk2(C[d][4 * q], C[d][4 * q + 1]); v.y = pk2(C[d][4 * q + 2], C[d][4 * q + 3]);
            *(u32x2*)(T + (size_t)(e0 + r) * 128 + 32 * (dt0 + d) + 8 * q + 4 * hh) = v; }
    if (MODE && F.tid < 128) ((float*)(F.ws + WS_NST))[unit * 128 + F.tid] = NV[F.tid];
    if (MODE && F.tid == 0) ((float*)(F.ws + WS_DG))[unit] = SM[16 + g + 1] - SM[16 + g];
    __syncthreads();
}

template <int MODE>
DI void state_scan(Frame& F, int unit) {
    constexpr int DV = MODE ? 256 : 128, NW = MODE ? 4 : 2;
    const int h = (unit >> 3) & 3, i = unit & 7, ub = unit - i;
    typedef unsigned uw __attribute__((ext_vector_type(NW)));
    bf16_t* T0 = (bf16_t*)(F.ws + WS_TST) + (size_t)ub * DV * 128 + (size_t)i * (DV / 8) * 128 + F.tid * (2 * NW);
    uw tv[7];
#pragma unroll
    for (int gp = 0; gp < 7; ++gp) tv[gp] = *(const uw*)(T0 + (size_t)gp * DV * 128);
    float dg[7];
    if (MODE) {
#pragma unroll
        for (int gp = 0; gp < 7; ++gp) dg[gp] = fexp(((const float*)(F.ws + WS_DG))[ub + gp]);
    } else { const float lg2 = log2f(1.0f - exp2f(-5.0f - (float)h)); const float d = __builtin_amdgcn_exp2f(lg2 * 512.0f);
#pragma unroll
        for (int gp = 0; gp < 7; ++gp) dg[gp] = d; }
    float nt[7]; float* NS = (float*)(F.ws + WS_NST) + (size_t)ub * 128 + F.tid;
    const bool nrow = MODE && i == 0 && F.tid < 128;
    if (nrow) {
#pragma unroll
        for (int gp = 0; gp < 7; ++gp) nt[gp] = NS[gp * 128]; }
    float acc[2 * NW];
#pragma unroll
    for (int k = 0; k < 2 * NW; ++k) acc[k] = 0.f;
#pragma unroll
    for (int gp = 0; gp < 7; ++gp) { uw o;
#pragma unroll
        for (int k = 0; k < NW; ++k) { acc[2 * k] = dg[gp] * acc[2 * k] + bflo(tv[gp][k]); acc[2 * k + 1] = dg[gp] * acc[2 * k + 1] + bfhi(tv[gp][k]); o[k] = pk2(acc[2 * k], acc[2 * k + 1]); }
        *(uw*)(T0 + (size_t)(gp + 1) * DV * 128) = o; }
    if (nrow) { float na = 0.f;
#pragma unroll
        for (int gp = 0; gp < 7; ++gp) { na = dg[gp] * na + nt[gp]; NS[(gp + 1) * 128] = na; } }
}

template <int MODE>
DI void la_pass2(Frame& F, int unit, int j) {
    constexpr int DV = MODE ? 256 : 128, VLD = DV + 32, NT = MODE ? 2 : 1;
    const int b = unit >> 5, h = (unit >> 3) & 3, g = unit & 7, row0 = b * SEQ + g * 512;
    const int w = F.wave; int lane = F.lane, r = lane & 31, hh = lane >> 5, r16 = lane & 15, q4 = lane >> 4;
    const int eb = MODE ? w : (w & 3), tb0 = MODE ? 0 : (w >> 2), e0 = 32 * eb;
    const int ocol = DV * h;
    const bf16_t* PROJ = (const bf16_t*)(F.ws + WS_PROJ) + (size_t)b * PBLK; bf16_t* MIX = (bf16_t*)(F.ws + WS_MIX);
    const bf16_t* GATE = PROJ + (MODE ? 4 : 3) * M512B + (size_t)h * SEQ * DV;
    const float* gain = MODE ? (F.in[15] + (j * 4 + h) * 256) : (F.in[6] + (j * 4 + h) * 128);
    LAS bf16_t* Qs = (LAS bf16_t*)(F.lds + QS_OFF); LAS bf16_t* Ks = (LAS bf16_t*)(F.lds + KS_OFF); LAS bf16_t* Kw = (LAS bf16_t*)(F.lds + KW_OFF); LAS bf16_t* Vs = (LAS bf16_t*)(F.lds + VS_OFF); LAS bf16_t* Ps = (LAS bf16_t*)(F.lds + PS_OFF);
    const LAS float* SA = (const LAS float*)(F.lds + SA_OFF); const LAS float* SCM = (const LAS float*)(F.lds + SCM_OFF); const LAS float* SMT = (const LAS float*)(F.lds + SMT_OFF); const LAS float* SM = (const LAS float*)(F.lds + SMISC_OFF);
    LAS float* STAT = (LAS float*)(F.lds + STAT_OFF); LAS float* NV = (LAS float*)(F.lds + NV_OFF); LAS float* PSUM = (LAS float*)(F.lds + PSUM_OFF); LAS float* QN = (LAS float*)(F.lds + QN_OFF);
    const float lg2 = log2f(1.0f - exp2f(-5.0f - (float)h));
    ChunkRegs<MODE, true> R; la_load<MODE, true>(R, PROJ, h, g * 512, opaque(F.tid));
    LAS float* GAIN = (LAS float*)(F.lds + GAIN_OFF); if (F.tid < DV) GAIN[F.tid] = gain[F.tid];
    if (MODE) mlstm_scan(F, b, h, g);
    __syncthreads();
    f32x16 C[4];
    {
        const bf16_t* T = (const bf16_t*)(F.ws + WS_TST) + (size_t)unit * DV * 128 + (size_t)(e0 + r) * 128 + 4 * hh;
        u32x2 tv[4][4];
#pragma unroll
        for (int d = 0; d < 4; ++d)
#pragma unroll
            for (int q = 0; q < 4; ++q) { if (g > 0) tv[d][q] = *(const u32x2*)(T + 32 * d + 8 * q); else { tv[d][q].x = 0u; tv[d][q].y = 0u; } }
#pragma unroll
        for (int d = 0; d < 4; ++d)
#pragma unroll
            for (int q = 0; q < 4; ++q) { const u32x2 v = tv[d][q]; C[d][4 * q] = bflo(v.x); C[d][4 * q + 1] = bfhi(v.x); C[d][4 * q + 2] = bflo(v.y); C[d][4 * q + 3] = bfhi(v.y); }
        if (MODE && F.tid < 128) NV[F.tid] = (g > 0) ? ((const float*)(F.ws + WS_NST))[unit * 128 + F.tid] : 0.f;
    }
    for (int c = 0; c < 8; ++c) {
        const int R0 = row0 + 64 * c;
        lane = opaque(F.lane); r = lane & 31; hh = lane >> 5; r16 = lane & 15; q4 = lane >> 4; const int tid_o = opaque(F.tid);
        la_write<MODE, true>(F, R, c, lg2, tid_o);
        if (SDUP & 1) { asm volatile("" ::: "memory"); la_write<MODE, true>(F, R, c, lg2, tid_o); }
        __syncthreads();
        if (SDUP & 16) __syncthreads();
        if (c < 7) la_load<MODE, true>(R, PROJ, h, g * 512 + 64 * (c + 1), tid_o);
        u32x2 gt[NT][4];
#pragma unroll
        for (int tt = 0; tt < NT; ++tt)
#pragma unroll
            for (int q = 0; q < 4; ++q) gt[tt][q] = *(const u32x2*)(GATE + (size_t)(g * 512 + 64 * c + 32 * (tb0 + tt) + r) * DV + e0 + 8 * q + 4 * hh);
        for (int srep = 0; srep < ((SDUP & 2) ? 2 : 1); ++srep) {
        if (srep) asm volatile("" ::: "memory");
#pragma unroll
        for (int i = 0; i < 2; ++i) {
            const int tt = 2 * w + i, si = tt >> 2, ti = tt & 3;
            f32x4 x = {0.f, 0.f, 0.f, 0.f};
#pragma unroll
            for (int kk = 0; kk < 4; ++kk) { const bf16x8 ka = *(const LAS bf16x8*)(Ks + (16 * si + r16) * QLD + 32 * kk + 8 * q4); const bf16x8 qb = *(const LAS bf16x8*)(Qs + (16 * ti + r16) * QLD + 32 * kk + 8 * q4); x = MFMA16(ka, qb, x); }
            const int t = 16 * ti + r16; float p[4];
#pragma unroll
            for (int q = 0; q < 4; ++q) { const int s = 16 * si + 4 * q4 + q; float wgt;
                if (MODE) wgt = (s <= t) ? fexp(SA[c * 64 + s] - SCM[c * 64 + t]) : 0.f;
                else { const int dlt = t > s ? t - s : s - t; wgt = __builtin_amdgcn_exp2f(lg2 * (float)dlt); }
                p[q] = x[q] * wgt; }
            u32x2 pw; pw.x = pk2(p[0], p[1]); pw.y = pk2(p[2], p[3]);
            *(LAS u32x2*)(Ps + t * PLD + 16 * si + 4 * q4) = pw;
            if (MODE) { float cs = (bflo(pw.x) + bfhi(pw.x)) + (bflo(pw.y) + bfhi(pw.y)); cs = sum_xor16_32(cs); if (q4 == 0) PSUM[si * 64 + t] = cs; }
        }
        if (MODE) {
            const int t = 8 * w + (lane >> 3), part = lane & 7;
            const u32x4 qa = *(const LAS u32x4*)(Qs + t * QLD + 16 * part), qb2 = *(const LAS u32x4*)(Qs + t * QLD + 16 * part + 8);
            const f32x4 n0 = *(const LAS f32x4*)(NV + 16 * part), n1 = *(const LAS f32x4*)(NV + 16 * part + 4), n2 = *(const LAS f32x4*)(NV + 16 * part + 8), n3 = *(const LAS f32x4*)(NV + 16 * part + 12);
            float qn = bflo(qa.x) * n0.x + bfhi(qa.x) * n0.y + bflo(qa.y) * n0.z + bfhi(qa.y) * n0.w + bflo(qa.z) * n1.x + bfhi(qa.z) * n1.y + bflo(qa.w) * n1.z + bfhi(qa.w) * n1.w
                     + bflo(qb2.x) * n2.x + bfhi(qb2.x) * n2.y + bflo(qb2.y) * n2.z + bfhi(qb2.y) * n2.w + bflo(qb2.z) * n3.x + bfhi(qb2.z) * n3.y + bflo(qb2.w) * n3.z + bfhi(qb2.w) * n3.w;
            qn += dpp_f<0xB1>(qn); qn += dpp_f<0x4E>(qn); qn += dpp_f<0x141>(qn);
            if (part == 0) QN[t] = qn;
        }
        }
        __syncthreads();
        if (SDUP & 16) __syncthreads();
        bf16x8 vf[4];
#pragma unroll
        for (int ks = 0; ks < 4; ++ks) vf[ks] = tr_frag(Vs, VLD, e0, 16 * ks, lane);
        float cqv[NT], rinvv[NT];
#pragma unroll
        for (int tt = 0; tt < NT; ++tt) {
            const int t = 32 * (tb0 + tt) + r;
            if (MODE) {
                const float cq = fexp(SM[c] - SCM[c * 64 + t]);
                const float den = ((PSUM[t] + PSUM[64 + t]) + (PSUM[128 + t] + PSUM[192 + t])) + cq * QN[t];
                cqv[tt] = cq; rinvv[tt] = 1.0f / fmaxf(fabsf(den), fexp(-SMT[c * 64 + t]));
            } else { cqv[tt] = __builtin_amdgcn_exp2f(lg2 * (float)(t + 1)); rinvv[tt] = 1.f; }
        }
        f32x16 o2[NT], val[NT];
        for (int orep = 0; orep < ((SDUP & 4) ? 2 : 1); ++orep) {
        if (orep) asm volatile("" ::: "memory");
#pragma unroll
        for (int tt = 0; tt < NT; ++tt)
#pragma unroll
            for (int i = 0; i < 16; ++i) { o2[tt][i] = 0.f; val[tt][i] = 0.f; }
#pragma unroll
        for (int d = 0; d < 4; ++d) {
#pragma unroll
            for (int s2 = 0; s2 < 2; ++s2) { const bf16x8 ca = pack_acc(C[d], s2);
#pragma unroll
                for (int tt = 0; tt < NT; ++tt) { const int t = 32 * (tb0 + tt) + r;
                    const bf16x4 qlo = *(const LAS bf16x4*)(Qs + t * QLD + 32 * d + 16 * s2 + 4 * hh), qhi = *(const LAS bf16x4*)(Qs + t * QLD + 32 * d + 16 * s2 + 4 * hh + 8);
                    const bf16x8 qb = __builtin_shufflevector(qlo, qhi, 0, 1, 2, 3, 4, 5, 6, 7);
                    o2[tt] = MFMA32(ca, qb, o2[tt]); } }
            __builtin_amdgcn_sched_barrier(0);
        }
#pragma unroll
        for (int tt = 0; tt < NT; ++tt) { const int t = 32 * (tb0 + tt) + r;
#pragma unroll
            for (int ks = 0; ks < 4; ++ks) { const bf16x8 pb = *(const LAS bf16x8*)(Ps + t * PLD + 16 * ks + 8 * hh); val[tt] = MFMA32(vf[ks], pb, val[tt]); } }
#pragma unroll
        for (int tt = 0; tt < NT; ++tt) { const int t = 32 * (tb0 + tt) + r;
            float s1 = 0.f, s2s = 0.f;
#pragma unroll
            for (int i = 0; i < 16; ++i) { const float v = (val[tt][i] + cqv[tt] * o2[tt][i]) * rinvv[tt]; val[tt][i] = v; s1 += v; s2s += v * v; }
            s1 = sum_xor32(s1); s2s = sum_xor32(s2s);
            if (hh == 0) { STAT[(w * 64 + t) * 2] = s1; STAT[(w * 64 + t) * 2 + 1] = s2s; }
        }
        }
        __syncthreads();
        if (SDUP & 16) __syncthreads();
        for (int frep = 0; frep < ((SDUP & 8) ? 2 : 1); ++frep) {
        if (frep) asm volatile("" ::: "memory");
#pragma unroll
        for (int tt = 0; tt < NT; ++tt) {
            const int t = 32 * (tb0 + tt) + r; float S1 = 0.f, S2 = 0.f;
#pragma unroll
            for (int ww = 0; ww < (MODE ? 8 : 4); ++ww) { const int wi = MODE ? ww : (4 * tb0 + ww); S1 += STAT[(wi * 64 + t) * 2]; S2 += STAT[(wi * 64 + t) * 2 + 1]; }
            const float mean = S1 * (1.0f / DV); const float var = fmaxf(S2 * (1.0f / DV) - mean * mean, 0.f); const float rs = 1.0f / sqrtf(var + EPS);
            const size_t rowoff = (size_t)(R0 + t);
#pragma unroll
            for (int q = 0; q < 4; ++q) { const int e = e0 + 8 * q + 4 * hh;
                const f32x4 gn = *(const LAS f32x4*)(GAIN + e); const u32x2 gtv = gt[tt][q];
                const float y0 = (val[tt][4 * q] - mean) * rs * gn.x * bflo(gtv.x), y1 = (val[tt][4 * q + 1] - mean) * rs * gn.y * bfhi(gtv.x);
                const float y2 = (val[tt][4 * q + 2] - mean) * rs * gn.z * bflo(gtv.y), y3 = (val[tt][4 * q + 3] - mean) * rs * gn.w * bfhi(gtv.y);
                u32x2 o; o.x = pk2(y0, y1); o.y = pk2(y2, y3); *(u32x2*)(MIX + rowoff * DM + ocol + e) = o; }
        }
        }
        __builtin_amdgcn_sched_barrier(0);
        const float alpha = MODE ? fexp(SM[c] - SCM[c * 64 + 63]) : __builtin_amdgcn_exp2f(lg2 * 64.0f);
#pragma unroll
        for (int d = 0; d < 4; ++d) {
#pragma unroll
            for (int i = 0; i < 16; ++i) C[d][i] *= alpha;
#pragma unroll
            for (int ks = 0; ks < 4; ++ks) { const bf16x8 ka = tr_frag(Kw, KWLD, 32 * d, 16 * ks, lane); C[d] = MFMA32(ka, vf[ks], C[d]); }
        }
        if (SDUP & 64) {
            f32x16 dm;
#pragma unroll
            for (int i = 0; i < 16; ++i) dm[i] = 0.f;
            asm volatile("" ::: "memory");
#pragma unroll
            for (int d = 0; d < 4; ++d)
#pragma unroll
                for (int ks = 0; ks < 4; ++ks) { const bf16x8 ka = tr_frag(Kw, KWLD, 32 * d, 16 * ks, lane); dm = MFMA32(ka, vf[ks], dm); }
            asm volatile("" :: "v"(dm));
        }
        if (SDUP & 128) {
            f32x16 dm;
#pragma unroll
            for (int i = 0; i < 16; ++i) dm[i] = 0.f;
            asm volatile("" ::: "memory");
#pragma unroll
            for (int d = 0; d < 4; ++d)
#pragma unroll
                for (int s2 = 0; s2 < 2; ++s2) { const bf16x8 ca = pack_acc(C[d], s2);
#pragma unroll
                    for (int tt = 0; tt < NT; ++tt) { const int t = 32 * (tb0 + tt) + r;
                        const bf16x4 qlo = *(const LAS bf16x4*)(Qs + t * QLD + 32 * d + 16 * s2 + 4 * hh), qhi = *(const LAS bf16x4*)(Qs + t * QLD + 32 * d + 16 * s2 + 4 * hh + 8);
                        const bf16x8 qb = __builtin_shufflevector(qlo, qhi, 0, 1, 2, 3, 4, 5, 6, 7);
                        dm = MFMA32(ca, qb, dm); } }
            asm volatile("" :: "v"(dm));
        }
        if (MODE) {
            const int dd = 16 * w + (lane & 15), sq = lane >> 4; float s = 0.f;
#pragma unroll
            for (int q = 0; q < 16; ++q) s += bf2f(Kw[(16 * sq + q) * KWLD + dd]);
            s = sum_xor16_32(s);
            if (lane < 16) NV[dd] = alpha * NV[dd] + s;
        }
        __syncthreads();
        if (SDUP & 16) __syncthreads();
    }
}

constexpr int VN_OFF = 0, SGST_OFF = 34816;
#define LBAR() do { asm volatile("s_waitcnt lgkmcnt(0)" ::: "memory"); __builtin_amdgcn_s_barrier(); asm volatile("" ::: "memory"); } while (0)
DI void sgu_unit(Frame& F, int unit, int j) {
    const int row0 = unit * 128, t0 = (unit & 31) * 128; const int w = F.wave; int lane = F.lane, r = lane & 31, hh = lane >> 5;
    const bf16_t* PROJ = (const bf16_t*)(F.ws + WS_PROJ) + (size_t)(unit >> 5) * PBLK; bf16_t* MIX = (bf16_t*)(F.ws + WS_MIX);
    LAS bf16_t* Vn = (LAS bf16_t*)(F.lds + VN_OFF); LAS float* ST = (LAS float*)(F.lds + SGST_OFF);
    const float* lng = F.in[7] + j * 512; const float* lnb = F.in[8] + j * 512;
    u32x4 vs[4];
    { const int tid_o = opaque(F.tid);
#pragma unroll
      for (int i = 0; i < 4; ++i) { const int pc = tid_o + 512 * i, q = pc >> 4, cp = (pc & 15) * 8; vs[i] = *(const u32x4*)(PROJ + 5 * M512B + (size_t)(t0 + q) * 512 + cp); } }
    {
        u32x4 vv[16];
#pragma unroll
        for (int i = 0; i < 16; ++i) vv[i] = *((const u32x4*)(PROJ + 5 * M512B + (size_t)(t0 + 16 * w + i) * 512) + lane);
#pragma unroll
        for (int i = 0; i < 16; ++i) { const int p = 16 * w + i; const u32x4 v = vv[i];
            const float x0 = bflo(v.x), x1 = bfhi(v.x), x2 = bflo(v.y), x3 = bfhi(v.y), x4 = bflo(v.z), x5 = bfhi(v.z), x6 = bflo(v.w), x7 = bfhi(v.w);
            float s = ((x0 + x1) + (x2 + x3)) + ((x4 + x5) + (x6 + x7)); s = wave_sum(s); const float mean = s * (1.0f / 512.0f);
            const float d0 = x0 - mean, d1 = x1 - mean, d2 = x2 - mean, d3 = x3 - mean, d4 = x4 - mean, d5 = x5 - mean, d6 = x6 - mean, d7 = x7 - mean;
            float q = ((d0 * d0 + d1 * d1) + (d2 * d2 + d3 * d3)) + ((d4 * d4 + d5 * d5) + (d6 * d6 + d7 * d7)); q = wave_sum(q);
            if (lane == 0) { ST[2 * p] = mean; ST[2 * p + 1] = 1.0f / sqrtf(q * (1.0f / 512.0f) + EPS); } }
    }
    LBAR();
    const int dtl = w & 3, pt0 = 2 * (w >> 2);
    for (int gq = 0; gq < 4; ++gq) {
        lane = opaque(F.lane); r = lane & 31; hh = lane >> 5; const int tid_o = opaque(F.tid);
        const bf16_t* WM = (const bf16_t*)(F.ws + WS_WM) + (size_t)(j * 4 + gq) * 128 * 128;
        bf16x8 wa[8][2];
#pragma unroll
        for (int ks = 0; ks < 8; ++ks)
#pragma unroll
            for (int pt = 0; pt < 2; ++pt) wa[ks][pt] = *(const bf16x8*)(WM + (size_t)(32 * (pt0 + pt) + r) * 128 + 16 * ks + 8 * hh);
#pragma unroll
        for (int i = 0; i < 4; ++i) { const int pc = tid_o + 512 * i, q = pc >> 4, cp = (pc & 15) * 8; const int col = 128 * gq + cp;
            const u32x4 v = vs[i]; const float mean = ST[2 * q], rs = ST[2 * q + 1];
            const f32x4 g0 = *(const f32x4*)(lng + col), g1 = *(const f32x4*)(lng + col + 4), b0 = *(const f32x4*)(lnb + col), b1 = *(const f32x4*)(lnb + col + 4);
            u32x4 o; o.x = pk2((bflo(v.x) - mean) * rs * g0.x + b0.x, (bfhi(v.x) - mean) * rs * g0.y + b0.y); o.y = pk2((bflo(v.y) - mean) * rs * g0.z + b0.z, (bfhi(v.y) - mean) * rs * g0.w + b0.w);
            o.z = pk2((bflo(v.z) - mean) * rs * g1.x + b1.x, (bfhi(v.z) - mean) * rs * g1.y + b1.y); o.w = pk2((bflo(v.w) - mean) * rs * g1.z + b1.z, (bfhi(v.w) - mean) * rs * g1.w + b1.w);
            *(LAS u32x4*)(Vn + q * QLD + cp) = o; }
        if (gq < 3) {
#pragma unroll
            for (int i = 0; i < 4; ++i) { const int pc = tid_o + 512 * i, q = pc >> 4, cp = (pc & 15) * 8; vs[i] = *(const u32x4*)(PROJ + 5 * M512B + (size_t)(t0 + q) * 512 + 128 * (gq + 1) + cp); } }
        u32x4 uq[2][2];
#pragma unroll
        for (int pt = 0; pt < 2; ++pt)
#pragma unroll
            for (int pr = 0; pr < 2; ++pr) uq[pt][pr] = *(const u32x4*)(PROJ + 4 * M512B + (size_t)(t0 + 32 * (pt0 + pt) + r) * 512 + 128 * gq + 32 * dtl + 8 * (2 * pr + hh));
        const float* bs = F.in[10] + (j * 4 + gq) * 128;
        float bsv[2];
#pragma unroll
        for (int pt = 0; pt < 2; ++pt) bsv[pt] = bs[32 * (pt0 + pt) + r];
        LBAR();
        f32x16 acc[2];
#pragma unroll
        for (int i = 0; i < 16; ++i) { acc[0][i] = 0.f; acc[1][i] = 0.f; }
#pragma unroll
        for (int ks = 0; ks < 8; ++ks) { const bf16x8 vb = gather_col(Vn, QLD, 32 * dtl + r, 16 * ks + 8 * hh);
#pragma unroll
            for (int pt = 0; pt < 2; ++pt) acc[pt] = MFMA32(vb, wa[ks][pt], acc[pt]); }
#pragma unroll
        for (int pt = 0; pt < 2; ++pt) { const int pp = 32 * (pt0 + pt) + r; const float bv = bsv[pt];
#pragma unroll
            for (int pr = 0; pr < 2; ++pr) {
                const auto sx = __builtin_amdgcn_permlane32_swap(uq[pt][pr].x, uq[pt][pr].z, false, false), sy = __builtin_amdgcn_permlane32_swap(uq[pt][pr].y, uq[pt][pr].w, false, false);
                const int i0 = 8 * pr;
                const unsigned a0 = pk2(bflo(sx[0]) * (acc[pt][i0 + 0] + bv), bfhi(sx[0]) * (acc[pt][i0 + 1] + bv)), a1 = pk2(bflo(sy[0]) * (acc[pt][i0 + 2] + bv), bfhi(sy[0]) * (acc[pt][i0 + 3] + bv));
                const unsigned b0 = pk2(bflo(sx[1]) * (acc[pt][i0 + 4] + bv), bfhi(sx[1]) * (acc[pt][i0 + 5] + bv)), b1 = pk2(bflo(sy[1]) * (acc[pt][i0 + 6] + bv), bfhi(sy[1]) * (acc[pt][i0 + 7] + bv));
                const auto tx = __builtin_amdgcn_permlane32_swap(a0, b0, false, false), ty = __builtin_amdgcn_permlane32_swap(a1, b1, false, false);
                u32x4 o; o.x = tx[0]; o.y = ty[0]; o.z = tx[1]; o.w = ty[1];
                *(u32x4*)(MIX + (size_t)(row0 + pp) * DM + 512 + 128 * gq + 32 * dtl + 8 * (2 * pr + hh)) = o; } }
        LBAR();
    }
}

static_assert(BATCH == pg8::NXCD && MROWS / pg8::BM / pg8::NXCD == SEQ / pg8::BM && (SEQ / pg8::BM) % pg8::WGM == 0 && SEQ / pg8::BM == 16, "the unit order deals row blocks 16x .. 16x+15 (batch element x) to the workgroups with blockIdx % 8 == x");
struct Args { const float* in[19]; float* out; unsigned char* ws; int ph_lo, ph_hi; };
__global__ void __launch_bounds__(512, 2) fwd(Args args) {
    extern __shared__ __attribute__((aligned(16))) unsigned char lds_raw[];
    Frame F;
    F.lds = (LAS unsigned char*)lds_raw;
    const int wave_s = __builtin_amdgcn_readfirstlane(threadIdx.x >> 6);
    F.tid = threadIdx.x; F.lane = F.tid & 63; F.wave = wave_s; F.G = gridDim.x; F.blk = (int)((blockIdx.x & ~7u) | ((blockIdx.x + GRP_ROT) & 7u));
    F.in = (const float* const __attribute__((address_space(4)))*)__builtin_amdgcn_kernarg_segment_ptr();
    F.H = args.out; F.ws = args.ws;
    volatile LAS unsigned* MISC = (volatile LAS unsigned*)(F.lds + LDSCTL_OFF);
    if (F.tid < 64) MISC[F.tid] = 0u;
    __syncthreads();
    if (ONE_LAUNCH) { (void)xcd_barrier_post((unsigned*)(F.ws + WS_CTL), MISC + 8, F.tid); if (F.tid == 0) __hip_atomic_store((unsigned*)(F.ws + WS_CTL) + XB_IDS + blockIdx.x, xb_xcc_id() + 1u, __ATOMIC_RELAXED, __HIP_MEMORY_SCOPE_AGENT); }
    const int lo = ONE_LAUNCH ? 0 : args.ph_lo, hi = ONE_LAUNCH ? NPHASE : args.ph_hi;
#define IN(k) (lo <= (k) && (k) < hi)
#define REFRESH() do { F.lane = opaque((int)__builtin_amdgcn_mbcnt_hi(~0u, __builtin_amdgcn_mbcnt_lo(~0u, 0u))); F.wave = wave_s; F.tid = wave_s * 64 + F.lane; \
        { unsigned long long z_ = 0ull; asm volatile("" : "+s"(z_)); F.ws = args.ws + z_; int g_ = (int)gridDim.x, b_ = (int)((blockIdx.x & ~7u) | ((blockIdx.x + GRP_ROT) & 7u)); asm volatile("" : "+v"(g_), "+v"(b_)); F.G = __builtin_amdgcn_readfirstlane(g_); F.blk = __builtin_amdgcn_readfirstlane(b_); } } while (0)
#define SEAM(k, ty) do { if (ONE_LAUNCH && IN((k) + 1)) GBAR((k) == 0, ty); } while (0)
#define GBAR(first, ty) do { { REFRESH(); \
        const unsigned md_ = (first) ? 0u : (unsigned)__builtin_amdgcn_readfirstlane((int)((volatile LAS unsigned*)(F.lds + LDSCTL_OFF))[12]); \
        unsigned ta_ = 0u; if (TPROBE) { ta_ = (unsigned)__builtin_amdgcn_s_memrealtime(); if (((TP_PHASE_MASK >> (ty)) & 1u) && F.tid == 0) TPW[13] = TPW[13] + (ta_ - TPW[14]); } \
        if (md_ == 0u) { XcdBarrier bb_; bb_.bar = (unsigned*)(F.ws + WS_CTL); bb_.x = xb_xcc_id(); bb_.st = (volatile LAS unsigned*)(F.lds + LDSCTL_OFF) + 8; xcd_barrier(bb_, F.tid); } \
        else grp_barrier((unsigned*)(F.ws + WS_CTL), (unsigned)F.blk & 7u, (unsigned)F.G >> 3, md_ == 2u, F.tid); \
        if (TPROBE && F.tid == 0) { const unsigned tb_ = (unsigned)__builtin_amdgcn_s_memrealtime(); TPW[14] = tb_; if ((TP_SEAM_MASK >> (ty)) & 1u) TPW[13] = TPW[13] + (tb_ - ta_); } } } while (0)
#define SS ((const float*)(F.ws + WS_SS))
#define HB ((bf16_t*)(F.ws + WS_HB))
#define MIX ((bf16_t*)(F.ws + WS_MIX))
#define PROJ ((bf16_t*)(F.ws + WS_PROJ))

#define TPW ((volatile LAS unsigned*)(F.lds + LDSCTL_OFF))
    if (TPROBE && F.tid == 0) { TPW[13] = 0u; TPW[14] = (unsigned)__builtin_amdgcn_s_memrealtime(); }
    if ((PH_MASK & 1) && IN(0)) { REPS(1) { REFRESH(); p0_prologue(F); } SEAM(0, 0); }
    if (ONE_LAUNCH) {
        REFRESH();
        if (F.G == 256 && F.tid < 64) {
            unsigned* bar = (unsigned*)(F.ws + WS_CTL);
            const unsigned mine = xb_xcc_id() + 1u, theirs = (F.tid < 32) ? xb_ld(bar + XB_IDS + (blockIdx.x & 7) + 8 * F.tid) : mine;
            const bool all_same = __builtin_amdgcn_ballot_w64(theirs != mine) == 0ull;
            if (F.tid == 0) ((volatile LAS unsigned*)(F.lds + LDSCTL_OFF))[12] = all_same ? 2u : 1u;
        }
        __syncthreads();
    }
    for (int L = 0; L < DEPTH; ++L) {
        const int pb = 1 + 6 * L, j = L >> 1;
        if (IN(pb)) {
            REFRESH();
            pg8::Gemm g{HB, W_in(F, L), MROWS, NIN, DM}; pg8::StaticOrder S; S.init(MROWS, NIN, F.G, F.blk);
            if (L & 1) { if (PH_MASK & 2) REPS(2) { rstd_table(F, S, SS); EpiInC E{PROJ, (const LAS float*)(F.lds + RSTD_OFF)}; pg8::gemm_phase<EpiInC, pg8::StaticOrder, GEMM_ALIGN, GEMM_SP2>(F.lds, g, S, E, F.tid); } if (PH_MASK & 4) gate_step(F, L); }
            else if (PH_MASK & 8) REPS(8) { rstd_table(F, S, SS); EpiInA E{PROJ, (const LAS float*)(F.lds + RSTD_OFF), (const float*)(F.ws + WS_COS), (const float*)(F.ws + WS_SIN)}; pg8::gemm_phase<EpiInA, pg8::StaticOrder, GEMM_ALIGN, GEMM_SP2>(F.lds, g, S, E, F.tid); }
            SEAM(pb, 1);
        }
        if (IN(pb + 1)) {
            REFRESH();
            for (int u0 = F.blk; u0 < 256; u0 += F.G) { int u = (F.G == 256) ? ((u0 & 7) * 32 + (u0 >> 3)) : u0; asm volatile("" : "+v"(u)); u = __builtin_amdgcn_readfirstlane(u);
                if (L & 1) { if ((PH_MASK & 16) && (u & 7) != 7) { FS_T0(3); la_pass1<1>(F, u); FS_T1(3); } } else { if ((PH_MASK & 32) && (u & 7) != 7) { FS_T0(2); la_pass1<0>(F, u); FS_T1(2); } if (PH_MASK & 64) { FS_T0(1); sgu_unit(F, u, j); FS_T1(1); } } }
            SEAM(pb + 1, 2);
        }
        if (IN(pb + 2)) {
            REFRESH();
            for (int u0 = F.blk; u0 < 256; u0 += F.G) { int u = (F.G == 256) ? ((u0 & 7) * 32 + (u0 >> 3)) : u0; asm volatile("" : "+v"(u)); u = __builtin_amdgcn_readfirstlane(u);
                { FS_T0(6); if (L & 1) state_scan<1>(F, u); else state_scan<0>(F, u); FS_T1(6); } }
            GBAR(false, 7);
            REFRESH();
            for (int u0 = F.blk; u0 < 256; u0 += F.G) { int u = (F.G == 256) ? ((u0 & 7) * 32 + (u0 >> 3)) : u0; asm volatile("" : "+v"(u)); u = __builtin_amdgcn_readfirstlane(u);
                if (L & 1) { if (PH_MASK & 128) { FS_T0(5); la_pass2<1>(F, u, j); FS_T1(5); } } else { if (PH_MASK & 256) { FS_T0(4); la_pass2<0>(F, u, j); FS_T1(4); } } }
            SEAM(pb + 2, 3);
        }
        if (IN(pb + 3)) {
            REFRESH();
            pg8::Gemm g{MIX, W_out(F, L), MROWS, DM, DM}; pg8::StaticOrder S; S.init(MROWS, DM, F.G, F.blk);
            if (PH_MASK & 512) for (int rep_ = 0; rep_ < ((DUP_MASK & 512) ? 3 : 1); ++rep_) { EpiRes E{HB, (float*)(F.ws + WS_SS), (rep_ == 1) ? -1.f : 1.f}; pg8::gemm_phase<EpiRes, pg8::StaticOrder, GEMM_ALIGN, GEMM_SP2>(F.lds, g, S, E, F.tid); if (ONE_LAUNCH && rep_ + 1 < ((DUP_MASK & 512) ? 3 : 1)) { REFRESH(); XcdBarrier bb_; bb_.bar = (unsigned*)(F.ws + WS_CTL); bb_.x = xb_xcc_id(); bb_.st = (volatile LAS unsigned*)(F.lds + LDSCTL_OFF) + 8; xcd_barrier(bb_, F.tid); } }
            SEAM(pb + 3, 4);
        }
        if (IN(pb + 4)) {
            REFRESH();
            pg8::Gemm g{HB, W_up(F, L), MROWS, NUP, DM}; pg8::StaticOrder S; S.init(MROWS, NUP, F.G, F.blk);
            if (PH_MASK & 1024) REPS(1024) { rstd_table(F, S, SS); EpiSwiGLU E{PROJ, (const LAS float*)(F.lds + RSTD_OFF)}; pg8::gemm_phase<EpiSwiGLU, pg8::StaticOrder, GEMM_ALIGN, GEMM_SP2>(F.lds, g, S, E, F.tid); }
            SEAM(pb + 4, 5);
        }
        if (IN(pb + 5)) {
            REFRESH();
            pg8::Gemm g{PROJ, W_down(F, L), MROWS, DM, DFF, (PBLK - (size_t)SEQ * DFF) * 2}; pg8::StaticOrder S; S.init(MROWS, DM, F.G, F.blk);
            if (PH_MASK & 2048) for (int rep_ = 0; rep_ < ((DUP_MASK & 2048) ? 3 : 1); ++rep_) { EpiRes E{HB, (float*)(F.ws + WS_SS), (rep_ == 1) ? -1.f : 1.f}; pg8::gemm_phase<EpiRes, pg8::StaticOrder, GEMM_ALIGN, GEMM_SP2>(F.lds, g, S, E, F.tid); if (ONE_LAUNCH && rep_ + 1 < ((DUP_MASK & 2048) ? 3 : 1)) { REFRESH(); XcdBarrier bb_; bb_.bar = (unsigned*)(F.ws + WS_CTL); bb_.x = xb_xcc_id(); bb_.st = (volatile LAS unsigned*)(F.lds + LDSCTL_OFF) + 8; xcd_barrier(bb_, F.tid); } }
            SEAM(pb + 5, 6);
        }
    }
    if ((PH_MASK & 4096) && IN(NPHASE - 1)) { REFRESH(); final_norm(F); }
    if (TPROBE) {
        REFRESH();
        if (((TP_PHASE_MASK >> 7) & 1u) && F.tid == 0) TPW[13] = TPW[13] + ((unsigned)__builtin_amdgcn_s_memrealtime() - TPW[14]);
        if (TP_STAT == 4 && F.tid == 0) __hip_atomic_store((unsigned*)(F.ws + WS_CTL) + 8192 + 1024 + F.blk, (unsigned)__builtin_amdgcn_s_memrealtime(), __ATOMIC_RELAXED, __HIP_MEMORY_SCOPE_AGENT);
        if (TP_END) { const unsigned te_ = (unsigned)__builtin_amdgcn_s_memrealtime(); { XcdBarrier bb_; bb_.bar = (unsigned*)(F.ws + WS_CTL); bb_.x = xb_xcc_id(); bb_.st = (volatile LAS unsigned*)(F.lds + LDSCTL_OFF) + 8; xcd_barrier(bb_, F.tid); }
            if (F.tid == 0) TPW[13] = TPW[13] + ((unsigned)__builtin_amdgcn_s_memrealtime() - te_); }
        const unsigned tp_acc = TPW[13];
        unsigned* tpc = (unsigned*)(F.ws + WS_CTL) + 8192;
        if (F.tid == 0) { (void)xb_add(tpc, tp_acc); __hip_atomic_store(tpc + 16 + 2 * blockIdx.x, tp_acc, __ATOMIC_RELAXED, __HIP_MEMORY_SCOPE_AGENT); __hip_atomic_store(tpc + 17 + 2 * blockIdx.x, xb_xcc_id(), __ATOMIC_RELAXED, __HIP_MEMORY_SCOPE_AGENT); }
        { XcdBarrier bb_; bb_.bar = (unsigned*)(F.ws + WS_CTL); bb_.x = xb_xcc_id(); bb_.st = (volatile LAS unsigned*)(F.lds + LDSCTL_OFF) + 8; xcd_barrier(bb_, F.tid); }
        if (TP_STAT == 3 && blockIdx.x == 0) {
            volatile LAS unsigned* sm = (volatile LAS unsigned*)F.lds; LAS unsigned* sma = (LAS unsigned*)F.lds;
            if (F.tid < 64) sm[F.tid] = 0u;
            __syncthreads();
            const unsigned myx = F.tid < F.G ? (xb_ld(tpc + 17 + 2 * F.tid) & 15u) : 0u;
            if (F.tid < F.G) __hip_atomic_fetch_add(sma + 48 + myx, 1u, __ATOMIC_RELAXED, __HIP_MEMORY_SCOPE_WORKGROUP);
            for (int k = 0; k < NPHASE - 1; ++k) {
                if (F.tid < 17) sm[F.tid] = 0u;
                __syncthreads();
                if (F.tid < F.G) { const unsigned a_ = xb_ld(tpc + 1024 + k * 256 + F.tid); __hip_atomic_fetch_max(sma + myx, a_, __ATOMIC_RELAXED, __HIP_MEMORY_SCOPE_WORKGROUP); __hip_atomic_fetch_max(sma + 16, a_, __ATOMIC_RELAXED, __HIP_MEMORY_SCOPE_WORKGROUP); }
                __syncthreads();
                if (F.tid < 16 && ((TP_SEAM_MASK >> k) & 1u)) sm[32 + F.tid] = sm[32 + F.tid] + (sm[16] - sm[F.tid]);
                __syncthreads();
            }
            if (F.tid == 0) { unsigned mn = 0xffffffffu; for (int x = 0; x < 16; ++x) if (sm[48 + x]) mn = sm[32 + x] < mn ? sm[32 + x] : mn; sm[60] = mn; }
            __syncthreads();
        }
        if (TP_STAT == 4 && blockIdx.x == 0) {
            volatile LAS unsigned* sm = (volatile LAS unsigned*)F.lds; LAS unsigned* sma = (LAS unsigned*)F.lds;
            if (F.tid < 64) sm[F.tid] = 0u;
            __syncthreads();
            if (F.tid < F.G) { const unsigned a_ = xb_ld(tpc + 1024 + F.tid); __hip_atomic_fetch_max(sma + (F.tid & 7), a_, __ATOMIC_RELAXED, __HIP_MEMORY_SCOPE_WORKGROUP); }
            __syncthreads();
            if (F.tid == 0) { unsigned mx = sm[0], mn = sm[0], ix = 0u; for (unsigned x = 1; x < 8; ++x) { if ((int)(sm[x] - mx) > 0) { mx = sm[x]; ix = x; } if ((int)(sm[x] - mn) < 0) mn = sm[x]; }
                unsigned rg = (mx - mn) / 100u; rg = rg > 199u ? 199u : rg; const unsigned hw = xb_ld(tpc + 17 + 2 * ((ix - GRP_ROT) & 7u)) & 15u; sm[60] = (200u * hw + rg) * 100u; }
            __syncthreads();
        }
        if (blockIdx.x == 0 && F.tid == 0) {
            unsigned long long dl = (unsigned long long)xb_ld(tpc) * TP_SCALE / (unsigned)F.G + TP_FIXED;
            if (TP_STAT) {
                volatile LAS unsigned* sm = (volatile LAS unsigned*)F.lds;
                for (int x = 0; x < 32; ++x) sm[x] = 0u;
                for (int i = 0; i < F.G; ++i) { const unsigned w_ = xb_ld(tpc + 16 + 2 * i), x_ = xb_ld(tpc + 17 + 2 * i) & 15u; sm[x_] = sm[x_] + w_; sm[16 + x_] = sm[16 + x_] + 1u; }
                unsigned mx = 0u, mn = 0xffffffffu; unsigned long long dev = 0ull;
                for (int x = 0; x < 16; ++x) if (sm[16 + x]) { const unsigned m_ = sm[x] / sm[16 + x]; mx = m_ > mx ? m_ : mx; mn = m_ < mn ? m_ : mn; }
                if (TP_STAT == 2) {
                    for (int i = 0; i < F.G; ++i) { const unsigned w_ = xb_ld(tpc + 16 + 2 * i), x_ = xb_ld(tpc + 17 + 2 * i) & 15u; const unsigned m_ = sm[x_] / sm[16 + x_]; dev += w_ > m_ ? w_ - m_ : m_ - w_; }
                    dl = dev * TP_SCALE / (unsigned)F.G;
                } else if (TP_STAT == 3) dl = (unsigned long long)sm[60] * TP_SCALE;
                else if (TP_STAT == 4) dl = sm[60];
                else dl = (unsigned long long)(mx - mn) * TP_SCALE;
            }
            const unsigned long long t0 = __builtin_amdgcn_s_memrealtime();
            while (__builtin_amdgcn_s_memrealtime() - t0 < dl) __builtin_amdgcn_s_sleep(8);
        }
    }
#undef IN
#undef SEAM
#undef REFRESH
#undef SS
#undef HB
#undef MIX
#undef PROJ
}

extern "C" void kernel_launch(void* const* d_in, const int* in_sizes, int n_in, void* d_out, int out_size, void* d_ws, size_t ws_size, hipStream_t stream) {
    static int grid = 0;
    if (grid == 0) {
        if (n_in != 19 || out_size != MROWS * DM || ws_size < WS_END) { fprintf(stderr, "kernel_launch: unexpected problem shape (n_in %d, out %d, ws %zu)\n", n_in, out_size, ws_size); grid = -1; return; }
        int dev = 0, cus = 0, per_cu = 0;
        if (hipGetDevice(&dev) != hipSuccess || hipDeviceGetAttribute(&cus, hipDeviceAttributeMultiprocessorCount, dev) != hipSuccess) { grid = -1; return; }
        if (hipFuncSetAttribute((const void*)fwd, hipFuncAttributeMaxDynamicSharedMemorySize, LDS_BYTES) != hipSuccess) { fprintf(stderr, "kernel_launch: hipFuncSetAttribute failed\n"); grid = -1; return; }
        if (hipOccupancyMaxActiveBlocksPerMultiprocessor(&per_cu, (const void*)fwd, 512, LDS_BYTES) != hipSuccess || per_cu < 1) { fprintf(stderr, "kernel_launch: occupancy query says %d\n", per_cu); (void)hipGetLastError(); grid = -1; return; }
        grid = cus;
    }
    if (grid < 0) return;
    (void)hipMemsetAsync((char*)d_ws + WS_CTL, 0, CTL_ZERO_BYTES, stream);
    Args a{};
    for (int i = 0; i < 19; ++i) a.in[i] = (const float*)d_in[i];
    a.out = (float*)d_out; a.ws = (unsigned char*)d_ws;
    if (ONE_LAUNCH) { a.ph_lo = 0; a.ph_hi = NPHASE; hipLaunchKernelGGL(fwd, dim3(grid), dim3(512), LDS_BYTES, stream, a); }
    else for (int p = 0; p < NPHASE; ++p) { a.ph_lo = p; a.ph_hi = p + 1; hipLaunchKernelGGL(fwd, dim3(grid), dim3(512), LDS_BYTES, stream, a); }
}
```

```cpp
#include <hip/hip_runtime.h>
#include <cstdio>
#include <cstdint>

#ifndef PH_MASK
#define PH_MASK 8191
#endif
#ifndef DUP_MASK
#define DUP_MASK 0
#endif
#define REPS(bit) for (int rep_ = 0; rep_ < ((DUP_MASK & (bit)) ? 2 : 1); ++rep_)
#ifndef GEMM_ALIGN
#define GEMM_ALIGN true
#endif
#ifndef GEMM_SP2
#define GEMM_SP2 true
#endif
#ifndef ONE_LAUNCH
#define ONE_LAUNCH 1
#endif

#ifndef SDUP
#define TP_SEAM_MASK 0u
#define TP_PHASE_MASK 0u
#define TP_SCALE 4u
#define TP_FIXED 0u
#define TP_STAT 0
#define GRP_ROT 0u
#define TP_END 0u
#define SECP 0
#define SECP_MODE 1
#define FSEC 0
#define TPROBE ((TP_SEAM_MASK | TP_PHASE_MASK | TP_FIXED | TP_END | FSEC | SECP) != 0u)
#define FS_T0(id) unsigned fs_t_ = 0u; if (FSEC == (id)) fs_t_ = (unsigned)__builtin_amdgcn_s_memrealtime()
#define FS_T1(id) do { if (FSEC == (id) && F.tid == 0) { volatile LAS unsigned* w_ = (volatile LAS unsigned*)(F.lds + LDSCTL_OFF); w_[13] = w_[13] + ((unsigned)__builtin_amdgcn_s_memrealtime() - fs_t_); } } while (0)
#define SDUP 0
#endif
namespace pg8 {
#define PG8_LAS __attribute__((address_space(3)))
typedef unsigned short bf16_t;
typedef short bf16x8 __attribute__((ext_vector_type(8)));
typedef float f32x4 __attribute__((ext_vector_type(4)));
typedef unsigned u32x4 __attribute__((ext_vector_type(4)));
constexpr int BM = 256, BK = 64, HALF = 128, HTB = HALF * BK * 2  , STAGE_BYTES = 8 * HTB, NXCD = 8, WGM = 4;

__host__ __device__ __forceinline__ int lds_byte(int r, int c) { const int st = (r >> 4) * 2 + (c >> 5), rr = r & 15, cc = c & 31, ob = rr * 64 + cc * 2; return st * 1024 + (ob ^ (((ob >> 9) & 1) << 5)); }
__host__ __device__ __forceinline__ void stage_rc(int b, int& R, int& C) { const int st = b / 1024, sb = b % 1024, swz = sb ^ (((sb >> 9) & 1) << 5); R = (st >> 1) * 16 + swz / 64; C = (st & 1) * 32 + (swz % 64) / 2; }
__host__ __device__ __forceinline__ int perm32(int rho) { const int n = rho >> 4, i = rho & 15; return 8 * (i >> 2) + 4 * n + (i & 3); }

struct Unit { int pm, pn, ui; };
struct Gemm { const bf16_t* A; const bf16_t* Bt; int M, N, K; size_t apad; int blk; };

struct StaticOrder {
    int nM, nN, nwg, G, c;
    __host__ __device__ void init(int M, int N, int G_, int c_) { nM = M / BM; nN = N / BM; nwg = nM * nN; G = G_; c = c_; }
    __host__ __device__ bool next(int i, Unit& u) const {
        const long L = (long)i * G + c; if (L >= nwg) return false;
        int wgid = (int)L; { const int q = nwg / NXCD, r = nwg % NXCD, xcd = wgid % NXCD, off = wgid / NXCD; wgid = (xcd < r ? xcd * (q + 1) : r * (q + 1) + (xcd - r) * q) + off; }
        const int nig = WGM * nN, gid = wgid / nig, fm = gid * WGM, gsz = (nM % WGM == 0) ? WGM : ((nM - fm) < WGM ? (nM - fm) : WGM);
        u.pm = fm + ((wgid % nig) % gsz); u.pn = (wgid % nig) / gsz; u.ui = i; return true;
    }
    __device__ __forceinline__ void a_ready(const Unit&) const {}
    __device__ __forceinline__ void done(const Unit&) const {}
};

template <class Epi, class Sched, bool ALIGN_EPI = false, bool SP2 = false>
__device__ __forceinline__ void gemm_phase(PG8_LAS unsigned char* lds, const Gemm g, const Sched& S, const Epi& E, int tid_) {
    asm volatile("" : "+v"(tid_));
    const int tid = tid_, wid = __builtin_amdgcn_readfirstlane(tid >> 6), lane = tid & 63, wr = wid >> 2, wc = wid & 3, fr = lane & 15, fq = lane >> 4;
    const int K = g.K, nt = K / BK;
    unsigned voffA[2], voffB[2];
#pragma unroll
    for (int i = 0; i < 2; ++i) { int R, C; stage_rc(tid * 16 + i * 8192, R, C); const int Rb = Epi::PERM ? ((R & ~31) + perm32(R & 31)) : R;
        voffA[i] = (g.blk & 1) ? (unsigned)((C >> 5) * (BM * 32) + R * 32 + (C & 31)) * 2u : (unsigned)(R * K + C) * 2u; voffB[i] = (g.blk & 2) ? (unsigned)((C >> 5) * (BM * 32) + Rb * 32 + (C & 31)) * 2u : (unsigned)(Rb * K + C) * 2u; }
    const size_t kstepA = (g.blk & 1) ? (size_t)(2 * BM * 32 * 2) : (size_t)(BK * 2), kstepB = (g.blk & 2) ? (size_t)(2 * BM * 32 * 2) : (size_t)(BK * 2);
    const size_t hstepA = (g.blk & 1) ? (size_t)(HALF * 32 * 2) : (size_t)HALF * K * 2, hstepB = (g.blk & 2) ? (size_t)(HALF * 32 * 2) : (size_t)HALF * K * 2;
    const size_t tstep = (size_t)BM * K * 2;
    const unsigned ldsw = (unsigned)wid * 1024u;
    const int aoff = lds_byte(wr * 64 + fr, fq * 8), boff = lds_byte(wc * 32 + fr, fq * 8);
#define PG8_SA(b, h) (((b) * 2 + (h)) * HTB)
#define PG8_SB(b, h) ((4 + (b) * 2 + (h)) * HTB)
#define PG8_STAGE(bufoff, gbase, voff) do { _Pragma("unroll") for (int _i = 0; _i < 2; ++_i) \
        __builtin_amdgcn_global_load_lds((const unsigned*)((const char*)(gbase) + (voff)[_i]), (PG8_LAS unsigned*)(lds + (bufoff) + ldsw + _i * 8192), 16, 0, 0); } while (0)
#define PG8_LDA(dst, b, h) do { _Pragma("unroll") for (int m = 0; m < 4; ++m) _Pragma("unroll") for (int k = 0; k < 2; ++k) dst[m][k] = *(const PG8_LAS bf16x8*)(lds + PG8_SA(b, h) + aoff + m * 2048 + k * 1024); } while (0)
#define PG8_LDB(dst, b, h) do { _Pragma("unroll") for (int n = 0; n < 2; ++n) _Pragma("unroll") for (int k = 0; k < 2; ++k) dst[n][k] = *(const PG8_LAS bf16x8*)(lds + PG8_SB(b, h) + boff + n * 2048 + k * 1024); } while (0)
#define PG8_MMA(ai, bj, At, Bt) do { __builtin_amdgcn_s_setprio(1); _Pragma("unroll") for (int m = 0; m < 4; ++m) _Pragma("unroll") for (int n = 0; n < 2; ++n) _Pragma("unroll") for (int k = 0; k < 2; ++k) \
        acc[ai][bj][m][n] = __builtin_amdgcn_mfma_f32_16x16x32_bf16(Bt[n][k], At[m][k], acc[ai][bj][m][n], 0, 0, 0); __builtin_amdgcn_s_setprio(0); } while (0)
#define PG8_WAIT_V(n) asm volatile("s_waitcnt vmcnt(" #n ")" ::: "memory")
#define PG8_WAIT_L(n) asm volatile("s_waitcnt lgkmcnt(" #n ")" ::: "memory")
#define PG8_BAR __builtin_amdgcn_s_barrier()
#define PG8_SCHED __builtin_amdgcn_sched_barrier(0)
    Unit cur, nxt; int ui = 0;
    if (!S.next(0, cur)) return;
    f32x4 acc[2][2][4][2];
#pragma unroll
    for (int a = 0; a < 2; ++a)
#pragma unroll
        for (int b = 0; b < 2; ++b)
#pragma unroll
            for (int m = 0; m < 4; ++m)
#pragma unroll
                for (int n = 0; n < 2; ++n) acc[a][b][m][n] = (f32x4){0.f, 0.f, 0.f, 0.f};
    bf16x8 At[4][2], B0[2][2], B1[2][2];
    const char* cA = (const char*)g.A + (size_t)cur.pm * tstep + (size_t)(cur.pm >> 4) * g.apad; const char* cB = (const char*)g.Bt + (size_t)cur.pn * tstep;
    S.a_ready(cur);
    if constexpr (SP2) {
        PG8_STAGE(PG8_SB(0, 0), cB, voffB); PG8_STAGE(PG8_SB(0, 1), cB + hstepB, voffB); PG8_STAGE(PG8_SA(0, 0), cA, voffA); PG8_STAGE(PG8_SA(0, 1), cA + hstepA, voffA);
        if (wr == 1) PG8_BAR;
        PG8_WAIT_V(2); PG8_BAR;
        PG8_STAGE(PG8_SB(1, 0), cB + kstepB, voffB); PG8_STAGE(PG8_SA(1, 0), cA + kstepA, voffA); PG8_STAGE(PG8_SB(1, 1), cB + hstepB + kstepB, voffB);
        PG8_WAIT_V(6); PG8_BAR;
    } else {
        PG8_STAGE(PG8_SB(0, 0), cB, voffB); PG8_STAGE(PG8_SA(0, 0), cA, voffA); PG8_STAGE(PG8_SB(0, 1), cB + hstepB, voffB); PG8_STAGE(PG8_SA(0, 1), cA + hstepA, voffA);
        if (wr == 1) PG8_BAR;
        PG8_WAIT_V(4); PG8_BAR;
        PG8_STAGE(PG8_SB(1, 0), cB + kstepB, voffB); PG8_STAGE(PG8_SA(1, 0), cA + kstepA, voffA); PG8_STAGE(PG8_SB(1, 1), cB + hstepB + kstepB, voffB);
        PG8_WAIT_V(6); PG8_BAR;
    }
    for (;;) {
        const bool has_next = S.next(ui + 1, nxt);
        const char* nA = has_next ? (const char*)g.A + (size_t)nxt.pm * tstep + (size_t)(nxt.pm >> 4) * g.apad : cA; const char* nB = has_next ? (const char*)g.Bt + (size_t)nxt.pn * tstep : cB;
        for (int t = 0; t < nt; t += 2) {
            const bool last = (t == nt - 2);
            const char* a1 = cA + (size_t)(t + 1) * kstepA;
            const char* a2 = last ? nA : cA + (size_t)(t + 2) * kstepA; const char* b2 = last ? nB : cB + (size_t)(t + 2) * kstepB;
            const char* a3 = a2 + kstepA; const char* b3 = b2 + kstepB;
            if (last && has_next) S.a_ready(nxt);
            if constexpr (SP2) {
            PG8_LDB(B0, 0, 0); PG8_LDB(B1, 0, 1); PG8_SCHED; PG8_LDA(At, 0, 0); PG8_STAGE(PG8_SA(1, 1), a1 + hstepA, voffA);
            PG8_WAIT_V(8); PG8_WAIT_L(0); PG8_BAR; PG8_MMA(0, 0, At, B0); PG8_MMA(0, 1, At, B1); PG8_BAR; PG8_SCHED;
            PG8_LDA(At, 0, 1); PG8_STAGE(PG8_SB(0, 0), b2, voffB); PG8_STAGE(PG8_SB(0, 1), b2 + hstepB, voffB); PG8_STAGE(PG8_SA(0, 0), a2, voffA);
            PG8_WAIT_V(8); PG8_WAIT_L(0); PG8_BAR; PG8_MMA(1, 0, At, B0); PG8_MMA(1, 1, At, B1); PG8_BAR; PG8_SCHED;
            PG8_LDB(B0, 1, 0); PG8_LDB(B1, 1, 1); PG8_SCHED; PG8_LDA(At, 1, 0); PG8_STAGE(PG8_SA(0, 1), a2 + hstepA, voffA);
            PG8_WAIT_V(8); PG8_WAIT_L(0); PG8_BAR; PG8_MMA(0, 0, At, B0); PG8_MMA(0, 1, At, B1); PG8_BAR; PG8_SCHED;
            PG8_LDA(At, 1, 1); PG8_STAGE(PG8_SB(1, 0), b3, voffB); PG8_STAGE(PG8_SB(1, 1), b3 + hstepB, voffB); PG8_STAGE(PG8_SA(1, 0), a3, voffA);
            PG8_WAIT_V(8); PG8_WAIT_L(0); PG8_BAR; PG8_MMA(1, 0, At, B0); PG8_MMA(1, 1, At, B1); PG8_BAR; PG8_SCHED;
            } else {
            PG8_LDB(B0, 0, 0); PG8_SCHED; PG8_LDA(At, 0, 0); PG8_STAGE(PG8_SA(1, 1), a1 + hstepA, voffA);
            PG8_WAIT_L(8); PG8_BAR; PG8_WAIT_L(0); PG8_MMA(0, 0, At, B0); PG8_BAR; PG8_SCHED;
            PG8_LDB(B1, 0, 1); PG8_STAGE(PG8_SB(0, 0), b2, voffB);
            PG8_BAR; PG8_WAIT_L(0); PG8_MMA(0, 1, At, B1); PG8_BAR;
            PG8_LDA(At, 0, 1); PG8_STAGE(PG8_SA(0, 0), a2, voffA);
            PG8_BAR; PG8_WAIT_L(0); PG8_MMA(1, 0, At, B0); PG8_BAR; PG8_SCHED;
            PG8_STAGE(PG8_SB(0, 1), b2 + hstepB, voffB);
            PG8_WAIT_V(6); PG8_BAR; PG8_MMA(1, 1, At, B1); PG8_BAR;
            PG8_LDB(B0, 1, 0); PG8_SCHED; PG8_LDA(At, 1, 0); PG8_STAGE(PG8_SA(0, 1), a2 + hstepA, voffA);
            PG8_WAIT_L(8); PG8_BAR; PG8_WAIT_L(0); PG8_MMA(0, 0, At, B0); PG8_BAR; PG8_SCHED;
            PG8_LDB(B1, 1, 1); PG8_STAGE(PG8_SB(1, 0), b3, voffB);
            PG8_BAR; PG8_WAIT_L(0); PG8_MMA(0, 1, At, B1); PG8_BAR;
            PG8_LDA(At, 1, 1); PG8_STAGE(PG8_SA(1, 0), a3, voffA);
            PG8_BAR; PG8_WAIT_L(0); PG8_MMA(1, 0, At, B0); PG8_BAR; PG8_SCHED;
            PG8_STAGE(PG8_SB(1, 1), b3 + hstepB, voffB);
            PG8_WAIT_V(6); PG8_BAR; PG8_MMA(1, 1, At, B1); PG8_BAR;
            }
        }
        if constexpr (ALIGN_EPI) { if (wr == 0) PG8_BAR; }
        E(acc, cur, wr, wc, fr, fq); if (SDUP & 32) { asm volatile("" ::: "memory"); E(acc, cur, wr, wc, fr, fq); } S.done(cur);
        if (!has_next) break;
#pragma unroll
        for (int a = 0; a < 2; ++a)
#pragma unroll
            for (int b = 0; b < 2; ++b)
#pragma unroll
                for (int m = 0; m < 4; ++m)
#pragma unroll
                    for (int n = 0; n < 2; ++n) { typedef float f32x2_ __attribute__((ext_vector_type(2))); f32x2_ z0, z1;
                        asm volatile("v_mov_b64 %0, 0" : "=v"(z0)); asm volatile("v_mov_b64 %0, 0" : "=v"(z1));
                        acc[a][b][m][n] = __builtin_shufflevector(z0, z1, 0, 1, 2, 3); }
        cur = nxt; cA = nA; cB = nB; ++ui;
        if constexpr (ALIGN_EPI) { if (wr == 1) PG8_BAR; }
    }
    PG8_WAIT_V(0);
    if constexpr (!ALIGN_EPI) { if (wr == 0) PG8_BAR; }
    PG8_BAR;
#undef PG8_SA
#undef PG8_SB
#undef PG8_STAGE
#undef PG8_LDA
#undef PG8_LDB
#undef PG8_MMA
#undef PG8_WAIT_V
#undef PG8_WAIT_L
#undef PG8_BAR
#undef PG8_SCHED
}
}

constexpr int BATCH = 8, SEQ = 4096, DM = 1024, MROWS = BATCH * SEQ, DEPTH = 4;
constexpr int NIN = 3072, CIN = 3080, DFF = 2816, NUP = 2 * DFF;
constexpr float EPS = 1e-6f;
constexpr size_t M512B = (size_t)SEQ * 512, PBLK = (size_t)SEQ * NIN;
constexpr int NPHASE = 2 + 6 * DEPTH;

constexpr size_t MiB = 1u << 20;
constexpr size_t WS_CTL = 0, CTL_ZERO_BYTES = 64 * 1024;
constexpr size_t WS_COS = 1 * MiB, WS_SIN = 2 * MiB;
constexpr size_t WS_SS = 3 * MiB;
constexpr size_t WS_GLI = 5 * MiB, WS_GLF = 5 * MiB + 512 * 1024;
constexpr size_t WS_WG = 6 * MiB;
constexpr size_t WS_WM = 6 * MiB + 256 * 1024;
constexpr size_t WS_NST = 7 * MiB;
constexpr size_t WS_DG = 7 * MiB + 512 * 1024;
constexpr size_t WS_W = 8 * MiB;
constexpr size_t W_IN_OFF = 0, W_OUT_OFF = (size_t)NIN * DM * 2, W_UP_OFF = W_OUT_OFF + (size_t)DM * DM * 2, W_DOWN_OFF = W_UP_OFF + (size_t)NUP * DM * 2, W_LAYER = W_DOWN_OFF + (size_t)DM * DFF * 2;
constexpr size_t WS_HB = 106 * MiB;
constexpr size_t WS_MIX = 170 * MiB;
constexpr size_t WS_PROJ = 234 * MiB;
constexpr size_t WS_TST = 426 * MiB;
constexpr size_t WS_SCN = 444 * MiB;
constexpr size_t WS_END = 460 * MiB;
static_assert(WS_W + 4 * W_LAYER <= WS_HB && WS_TST + (size_t)256 * 256 * 128 * 4 <= WS_END, "ws map");

constexpr int RING_BYTES = 131072;
constexpr int LDS_BYTES = 147456;
constexpr int P0_SCR_BYTES = 8 * 16640;
constexpr int RSTD_OFF = P0_SCR_BYTES;
constexpr int LDSCTL_OFF = LDS_BYTES - 256;
static_assert(RSTD_OFF >= RING_BYTES && RSTD_OFF + 12 * 256 * 4 <= LDSCTL_OFF, "LDS map");

#define GAS __attribute__((address_space(1)))
#define LAS __attribute__((address_space(3)))
#define DI __device__ __forceinline__
typedef unsigned short bf16_t;
typedef short bf16x8 __attribute__((ext_vector_type(8)));
typedef short bf16x4 __attribute__((ext_vector_type(4)));
typedef float f32x4 __attribute__((ext_vector_type(4)));
typedef float f32x16 __attribute__((ext_vector_type(16)));
typedef unsigned u32x4 __attribute__((ext_vector_type(4)));
typedef unsigned u32x2 __attribute__((ext_vector_type(2)));

DI unsigned pk2(float lo, float hi) { typedef __bf16 b2 __attribute__((ext_vector_type(2))); b2 v; v.x = (__bf16)lo; v.y = (__bf16)hi; return __builtin_bit_cast(unsigned, v); }
DI float bf2f(unsigned short x) { return __uint_as_float(((unsigned)x) << 16); }
DI float bflo(unsigned w) { return __uint_as_float(w << 16); }
DI float bfhi(unsigned w) { return __uint_as_float(w & 0xffff0000u); }
DI float fexp(float x) { return __builtin_amdgcn_exp2f(x * 1.4426950408889634f); }
DI float frcp(float x) { return __builtin_amdgcn_rcpf(x); }
DI float sigmoid_f(float x) { return frcp(1.f + fexp(-x)); }
DI float silu_f(float x) { return x * sigmoid_f(x); }
DI float gelu_tanh_f(float x) { return x * sigmoid_f(1.5957691216057308f * (x + 0.044715f * x * x * x)); }
DI f32x4 sig_arg4(const f32x4 t) {
    f32x4 e; e[0] = __builtin_amdgcn_exp2f(t[0]); e[1] = __builtin_amdgcn_exp2f(t[1]); e[2] = __builtin_amdgcn_exp2f(t[2]); e[3] = __builtin_amdgcn_exp2f(t[3]);
    const f32x4 d = e + 1.0f; f32x4 r; r[0] = frcp(d[0]); r[1] = frcp(d[1]); r[2] = frcp(d[2]); r[3] = frcp(d[3]); return r; }
DI f32x4 sigmoid4(const f32x4 x) { return sig_arg4(x * -1.4426950408889634f); }
DI f32x4 silu4(const f32x4 x) { return x * sig_arg4(x * -1.4426950408889634f); }
DI f32x4 gelu_tanh4(const f32x4 x) { const f32x4 x2 = x * x; const f32x4 pp = x2 * (-1.4426950408889634f * 1.5957691216057308f * 0.044715f) + (-1.4426950408889634f * 1.5957691216057308f); return x * sig_arg4(x * pp); }
template <int CTRL> DI float dpp_f(float v) { return __int_as_float(__builtin_amdgcn_mov_dpp(__float_as_int(v), CTRL, 0xF, 0xF, true)); }
DI float xor16_f(float v) { return __int_as_float(__builtin_amdgcn_ds_swizzle(__float_as_int(v), 0x401F)); }
DI float sum_xor32(float v) { const auto r = __builtin_amdgcn_permlane32_swap(__float_as_uint(v), __float_as_uint(v), false, false); return __uint_as_float(r[0]) + __uint_as_float(r[1]); }
DI float sum_xor16_32(float v) { v += xor16_f(v); return sum_xor32(v); }
DI float wave_sum(float v) {
    v += dpp_f<0xB1>(v); v += dpp_f<0x4E>(v); v += dpp_f<0x141>(v); v += dpp_f<0x140>(v);
    return sum_xor16_32(v);
}
template <int CTRL, int ROWMASK, bool IS_MAX> DI float scan_step(float v, const float ident) {
    const float t = __int_as_float(__builtin_amdgcn_update_dpp(__float_as_int(ident), __float_as_int(v), CTRL, ROWMASK, 0xF, false));
    return IS_MAX ? fmaxf(v, t) : v + t;
}
template <bool IS_MAX> DI float wave_scan(float v) {
    const float id = IS_MAX ? -3.0e38f : 0.f;
    v = scan_step<0x111, 0xF, IS_MAX>(v, id); v = scan_step<0x112, 0xF, IS_MAX>(v, id); v = scan_step<0x114, 0xF, IS_MAX>(v, id); v = scan_step<0x118, 0xF, IS_MAX>(v, id);
    v = scan_step<0x142, 0xA, IS_MAX>(v, id);
    v = scan_step<0x143, 0xC, IS_MAX>(v, id);
    return v;
}
DI float lane63(float v) { return __int_as_float(__builtin_amdgcn_readlane(__float_as_int(v), 63)); }

#define XB_TMO      128
#define XB_XCNT(j)  (256  + 64 * (j))
#define XB_XSUB(j)  (1280 + 64 * (j))
#define XB_XGEN(j)  (2304 + 64 * (j))
#define XB_TOP      3328
#define XB_TOPGEN   3392
#define XCD_BAR_WORDS 3456
#define XB_SPIN_CAP (1u << 18)

__device__ __forceinline__ unsigned xb_ld(unsigned* p)              { return __hip_atomic_load(p, __ATOMIC_RELAXED, __HIP_MEMORY_SCOPE_AGENT); }
__device__ __forceinline__ unsigned xb_add(unsigned* p, unsigned v) { return __hip_atomic_fetch_add(p, v, __ATOMIC_RELAXED, __HIP_MEMORY_SCOPE_AGENT); }
__device__ __forceinline__ unsigned xb_xcc_id() { return (unsigned)__builtin_amdgcn_s_getreg((3 << 11) | 20) & 0xFu; }
#define XB_SPIN(cond, bar) do { unsigned _sp = 0; while (cond) { __builtin_amdgcn_s_sleep(1); \
    if ((++_sp & 255u) == 0u) { if (xb_ld(&(bar)[XB_TMO])) break; if (_sp > XB_SPIN_CAP) { atomicAdd(&(bar)[XB_TMO], 1u); break; } } } } while (0)

struct XcdBarrier { unsigned* bar; unsigned x; volatile LAS unsigned* st; };

__device__ __forceinline__ XcdBarrier xcd_barrier_post(unsigned* bar, volatile LAS unsigned* st, int tid) {
    XcdBarrier b; b.bar = bar; b.x = xb_xcc_id(); b.st = st;
    if (tid == 0) (void)xb_add(&bar[XB_XCNT(b.x)], 1u);
    return b;
}
__device__ __forceinline__ void xcd_barrier_complete(unsigned* bar, unsigned x, unsigned& nloc, unsigned& nx) {
    const unsigned G = gridDim.x * gridDim.y * gridDim.z;
    unsigned sum, cnt, mine, sp = 0u;
    for (;;) {
        sum = 0u; cnt = 0u; mine = 0u;
#pragma unroll
        for (unsigned j = 0; j < 16; ++j) { const unsigned c = xb_ld(&bar[XB_XCNT(j)]); sum += c; cnt += (c > 0u) ? 1u : 0u; mine = (j == x) ? c : mine; }
        if (sum == G) break;
        __builtin_amdgcn_s_sleep(1);
        if ((++sp & 255u) == 0u) { if (xb_ld(&bar[XB_TMO])) break; if (sp > XB_SPIN_CAP) { atomicAdd(&bar[XB_TMO], 1u); break; } }
    }
    nloc = mine > 0u ? mine : 1u; nx = cnt > 0u ? cnt : 1u;
}
__device__ __forceinline__ void xcd_barrier(const XcdBarrier& b, int tid) {
    asm volatile("s_waitcnt vmcnt(0)" ::: "memory");
    __syncthreads();
    if (tid == 0) {
        unsigned* bar = b.bar;
        __builtin_amdgcn_s_waitcnt(0);
        unsigned nloc = b.st[0], nx = b.st[1];
        if (nloc == 0u) { xcd_barrier_complete(bar, b.x, nloc, nx); b.st[0] = nloc; b.st[1] = nx; }
        const unsigned old = xb_add(&bar[XB_XSUB(b.x)], 1u);
        const unsigned gen = old / nloc;
        if (old + 1u == (gen + 1u) * nloc) {
            __builtin_amdgcn_fence(__ATOMIC_RELEASE, "agent");
            asm volatile("s_waitcnt vmcnt(0)" ::: "memory");
            const unsigned og = xb_add(&bar[XB_TOP], 1u);
            const unsigned tg = og / nx;
            if (og + 1u == (tg + 1u) * nx) xb_add(&bar[XB_TOPGEN], 1u);
            else XB_SPIN(xb_ld(&bar[XB_TOPGEN]) == tg, bar);
            __builtin_amdgcn_fence(__ATOMIC_ACQUIRE, "agent");
            xb_add(&bar[XB_XGEN(b.x)], 1u);
            asm volatile("s_waitcnt vmcnt(0)" ::: "memory");
        } else {
            XB_SPIN(xb_ld(&bar[XB_XGEN(b.x)]) == gen, bar);
            __builtin_amdgcn_fence(__ATOMIC_ACQUIRE, "agent");
            asm volatile("s_waitcnt vmcnt(0)" ::: "memory");
        }
    }
    __syncthreads();
}

#define XB_GCNT(g)  (4096 + 64 * (g))
#define XB_IDS      5120
DI void grp_barrier(unsigned* bar, unsigned grp, unsigned n, bool fast, int tid) {
    asm volatile("s_waitcnt vmcnt(0)" ::: "memory");
    __syncthreads();
    if (tid == 0) {
        __builtin_amdgcn_s_waitcnt(0);
        if (!fast) { __builtin_amdgcn_fence(__ATOMIC_RELEASE, "agent"); asm volatile("s_waitcnt vmcnt(0)" ::: "memory"); }
        asm volatile("buffer_inv sc1" ::: "memory");
        const unsigned old = xb_add(&bar[XB_GCNT(grp)], 1u);
        const unsigned target = (old / n + 1u) * n;
        if (old + 1u != target) XB_SPIN((int)(xb_ld(&bar[XB_GCNT(grp)]) - target) < 0, bar);
        __builtin_amdgcn_fence(__ATOMIC_ACQUIRE, "workgroup");
        asm volatile("s_waitcnt vmcnt(0)" ::: "memory");
    }
    __syncthreads();
}
DI void grp_arrive(unsigned* bar, unsigned grp, unsigned n, bool fast, int tid, volatile LAS unsigned* tgt) {
    asm volatile("s_waitcnt vmcnt(0)" ::: "memory");
    __syncthreads();
    if (tid == 0) {
        __builtin_amdgcn_s_waitcnt(0);
        if (!fast) { __builtin_amdgcn_fence(__ATOMIC_RELEASE, "agent"); asm volatile("s_waitcnt vmcnt(0)" ::: "memory"); }
        const unsigned old = xb_add(&bar[XB_GCNT(grp)], 1u);
        *tgt = (old / n + 1u) * n;
    }
}
DI void grp_wait(unsigned* bar, unsigned grp, int tid, volatile LAS unsigned* tgt) {
    asm volatile("s_waitcnt lgkmcnt(0)" ::: "memory"); __builtin_amdgcn_s_barrier(); asm volatile("" ::: "memory");
    if (tid == 0) {
        __builtin_amdgcn_s_waitcnt(0);
        asm volatile("buffer_inv sc1" ::: "memory");
        const unsigned target = *tgt;
        XB_SPIN((int)(xb_ld(&bar[XB_GCNT(grp)]) - target) < 0, bar);
        __builtin_amdgcn_fence(__ATOMIC_ACQUIRE, "workgroup");
        asm volatile("s_waitcnt vmcnt(0)" ::: "memory");
    }
    __syncthreads();
}
DI int m4_map(int m4, int G) { return G == 256 ? (((m4 >> 3) & 7) * 1024 + ((m4 >> 6) & 31) * 8 + (m4 & 7) + 256 * (m4 >> 11)) : m4; }

struct Frame {
    LAS unsigned char* lds;
    int tid, lane, wave, G, blk;
    const float* const __attribute__((address_space(4)))* in;
    float* H;
    unsigned char* ws;
};
DI bf16_t* W_in(const Frame& F, int L)   { return (bf16_t*)(F.ws + WS_W + (size_t)L * W_LAYER + W_IN_OFF); }
DI bf16_t* W_out(const Frame& F, int L)  { return (bf16_t*)(F.ws + WS_W + (size_t)L * W_LAYER + W_OUT_OFF); }
DI bf16_t* W_up(const Frame& F, int L)   { return (bf16_t*)(F.ws + WS_W + (size_t)L * W_LAYER + W_UP_OFF); }
DI bf16_t* W_down(const Frame& F, int L) { return (bf16_t*)(F.ws + WS_W + (size_t)L * W_LAYER + W_DOWN_OFF); }

template <class Sched>
DI void rstd_table(Frame& F, const Sched& S, const float* __restrict__ SS) {
    LAS float* T = (LAS float*)(F.lds + RSTD_OFF); pg8::Unit u;
    for (int i0 = 0; S.next(i0, u); i0 += 4) {
        f32x4 sp[2][4]; bool ok[2];
#pragma unroll
        for (int k = 0; k < 2; ++k) { const int i = i0 + 2 * k + (F.tid >> 8); ok[k] = S.next(i, u);
            if (ok[k]) { const float* p = SS + (size_t)(256 * u.pm + (F.tid & 255));
#pragma unroll
                for (int q = 0; q < 4; ++q) { sp[k][q].x = p[(size_t)(4 * q) * MROWS]; sp[k][q].y = p[(size_t)(4 * q + 1) * MROWS]; sp[k][q].z = p[(size_t)(4 * q + 2) * MROWS]; sp[k][q].w = p[(size_t)(4 * q + 3) * MROWS]; } } }
#pragma unroll
        for (int k = 0; k < 2; ++k) if (ok[k]) { const int i = i0 + 2 * k + (F.tid >> 8); float s = 0.f;
#pragma unroll
            for (int q = 0; q < 4; ++q) s += (sp[k][q].x + sp[k][q].y) + (sp[k][q].z + sp[k][q].w);
            T[i * 256 + (F.tid & 255)] = 1.0f / sqrtf(s * (1.0f / DM) + EPS); }
    }
    __syncthreads();
}
DI void row_rstd8(const LAS float* T, int ui, int wr, int fr, float (&rs)[2][4]) {
#pragma unroll
    for (int ai = 0; ai < 2; ++ai)
#pragma unroll
        for (int m = 0; m < 4; ++m) rs[ai][m] = T[ui * 256 + ai * 128 + wr * 64 + m * 16 + fr];
}
DI int tile_off(int t, int c) { return (c >> 5) * 2048 + t * 32 + (c & 31); }
DI size_t frag_off(int t, int c, int ebn) { return ((((size_t)(t >> 5) * ebn + (c >> 5)) * 2 + ((c >> 4) & 1)) * 64 + 32 * ((c >> 3) & 1) + (t & 31)) * 8; }
DI size_t mix_off(size_t row, int col) { return ((row >> 8) * 32 + (size_t)(col >> 5)) * 8192 + (row & 255) * 32 + (col & 31); }
DI void store8(bf16_t* p, const f32x4& v0, const f32x4& v1) { u32x4 w; w.x = pk2(v0[0], v0[1]); w.y = pk2(v0[2], v0[3]); w.z = pk2(v1[0], v1[1]); w.w = pk2(v1[2], v1[3]); *(u32x4*)p = w; }

struct EpiInA {
    static constexpr bool PERM = true;
    bf16_t* P; const LAS float* RT; const float* COS; const float* SIN;
    DI void operator()(const f32x4 (&acc)[2][2][4][2], const pg8::Unit& u, int wr, int wc, int fr, int fq) const {
        const int row0 = u.pm * 256 + wr * 64 + fr, colw = wc * 32 + 8 * fq, typ = u.pn >> 1;
        float rsv[2][4]; row_rstd8(RT, u.ui, wr, fr, rsv);
#pragma unroll
        for (int ai = 0; ai < 2; ++ai) {
            f32x4 cc[4], sn[4];
            if (typ < 2) {
#pragma unroll
                for (int m = 0; m < 4; ++m) { const int pos = (row0 + ai * 128 + m * 16) & (SEQ - 1); cc[m] = *(const f32x4*)(COS + ((size_t)wc * SEQ + pos) * 16 + 4 * fq); sn[m] = *(const f32x4*)(SIN + ((size_t)wc * SEQ + pos) * 16 + 4 * fq); } }
#pragma unroll
            for (int m = 0; m < 4; ++m) {
                const int row = row0 + ai * 128 + m * 16;
                const float rs = rsv[ai][m];
                const int bb = row >> 12, tq = row & (SEQ - 1);
                bf16_t* rowp = (typ < 4) ? P + (size_t)bb * PBLK + (size_t)typ * M512B + (size_t)(2 * (u.pn & 1)) * SEQ * 128 + (size_t)(tq >> 6) * 8192 + tile_off(tq & 63, colw)
                                         : P + (size_t)bb * PBLK + (size_t)typ * M512B + (size_t)tq * 512 + (u.pn & 1) * 256 + colw;
                const size_t bjs = (typ < 4) ? (size_t)SEQ * 128 : 128;
                if (typ < 2) {
                    const f32x4 c4 = cc[m], s4 = sn[m];
#pragma unroll
                    for (int bj = 0; bj < 2; ++bj) { const f32x4 a0 = acc[ai][bj][m][0] * rs, a1 = acc[ai][bj][m][1] * rs; f32x4 v0, v1;
                        v0[0] = a0[0] * c4[0] - a0[1] * s4[0]; v0[1] = a0[0] * s4[0] + a0[1] * c4[0];
                        v0[2] = a0[2] * c4[1] - a0[3] * s4[1]; v0[3] = a0[2] * s4[1] + a0[3] * c4[1];
                        v1[0] = a1[0] * c4[2] - a1[1] * s4[2]; v1[1] = a1[0] * s4[2] + a1[1] * c4[2];
                        v1[2] = a1[2] * c4[3] - a1[3] * s4[3]; v1[3] = a1[2] * s4[3] + a1[3] * c4[3];
                        store8(rowp + bj * bjs, v0, v1); }
                } else {
#pragma unroll
                    for (int bj = 0; bj < 2; ++bj) { f32x4 v0 = acc[ai][bj][m][0] * rs, v1 = acc[ai][bj][m][1] * rs;
                        if (typ == 3) {
#pragma unroll
                            for (int j = 0; j < 1; ++j) { v0 = silu4(v0); v1 = silu4(v1); } }
                        else if (typ >= 4) {
#pragma unroll
                            for (int j = 0; j < 1; ++j) { v0 = gelu_tanh4(v0); v1 = gelu_tanh4(v1); } }
                        bf16_t* dst = rowp + bj * bjs;
                        if (typ == 3) dst = P + (size_t)bb * PBLK + 3 * M512B + (size_t)(2 * (u.pn & 1) + bj) * SEQ * 128 + frag_off(tq, colw, 4);
                        else if (typ == 4) dst = P + (size_t)bb * PBLK + 4 * M512B + frag_off(tq, (u.pn & 1) * 256 + colw + bj * 128, 16);
                        store8(dst, v0, v1); }
                }
            }
        }
    }
};
struct EpiInC {
    static constexpr bool PERM = true;
    bf16_t* P; const LAS float* RT;
    DI void operator()(const f32x4 (&acc)[2][2][4][2], const pg8::Unit& u, int wr, int wc, int fr, int fq) const {
        const int row0 = u.pm * 256 + wr * 64 + fr, colw = wc * 32 + 8 * fq; const bool sg = u.pn >= 8;
        float rsv[2][4]; row_rstd8(RT, u.ui, wr, fr, rsv);
#pragma unroll
        for (int ai = 0; ai < 2; ++ai)
#pragma unroll
            for (int m = 0; m < 4; ++m) {
                const int row = row0 + ai * 128 + m * 16;
                const float rs = rsv[ai][m];
                const int bb = row >> 12, tq = row & (SEQ - 1);
                bf16_t* rowp; size_t bjs;
                if (u.pn < 4) { rowp = P + (size_t)bb * PBLK + (size_t)(u.pn >> 1) * M512B + (size_t)(2 * (u.pn & 1)) * SEQ * 128 + (size_t)(tq >> 6) * 8192 + tile_off(tq & 63, colw); bjs = (size_t)SEQ * 128; }
                else { rowp = P + (size_t)bb * PBLK + (size_t)(u.pn < 8 ? 2 : 4) * M512B + (size_t)(u.pn & 3) * SEQ * 256 + (size_t)(tq >> 6) * 16384 + tile_off(tq & 63, colw); bjs = 8192; }
#pragma unroll
                for (int bj = 0; bj < 2; ++bj) { f32x4 v0 = acc[ai][bj][m][0] * rs, v1 = acc[ai][bj][m][1] * rs;
                    if (sg) {
#pragma unroll
                        for (int j = 0; j < 1; ++j) { v0 = sigmoid4(v0); v1 = sigmoid4(v1); } }
                    bf16_t* dst = rowp + bj * bjs;
                    if (sg) dst = P + (size_t)bb * PBLK + 4 * M512B + (size_t)(u.pn & 3) * SEQ * 256 + frag_off(tq, colw + bj * 128, 8);
                    store8(dst, v0, v1); }
            }
    }
};
struct EpiRes {
    static constexpr bool PERM = true;
    bf16_t* HB; float* SS; float sgn;
    DI void operator()(const f32x4 (&acc)[2][2][4][2], const pg8::Unit& u, int wr, int wc, int fr, int fq) const {
        const int row0 = u.pm * 256 + wr * 64 + fr, col0 = u.pn * 256 + wc * 32 + 8 * fq;
#pragma unroll
        for (int ai = 0; ai < 2; ++ai) {
            u32x4 hv[4][2];
#pragma unroll
            for (int m = 0; m < 4; ++m) {
#pragma unroll
                for (int bj = 0; bj < 2; ++bj) hv[m][bj] = *(const u32x4*)(HB + mix_off((size_t)(row0 + ai * 128 + m * 16), col0 + bj * 128)); }
#pragma unroll
            for (int m = 0; m < 4; ++m) {
                const int row = row0 + ai * 128 + m * 16;
                f32x4 sq = {0.f, 0.f, 0.f, 0.f};
#pragma unroll
                for (int bj = 0; bj < 2; ++bj) {
                    const u32x4 w = hv[m][bj];
                    const f32x4 b0 = {bflo(w.x), bfhi(w.x), bflo(w.y), bfhi(w.y)}, b1 = {bflo(w.z), bfhi(w.z), bflo(w.w), bfhi(w.w)};
                    const f32x4 h0 = b0 + acc[ai][bj][m][0] * sgn, h1 = b1 + acc[ai][bj][m][1] * sgn;
                    store8(HB + mix_off((size_t)row, col0 + bj * 128), h0, h1);
                    sq += h0 * h0; sq += h1 * h1;
                }
                float ssum = (sq[0] + sq[1]) + (sq[2] + sq[3]);
                ssum = sum_xor16_32(ssum);
                if (fq == 0) SS[(size_t)(u.pn * 4 + wc) * MROWS + row] = ssum;
            }
        }
    }
};
struct EpiSwiGLU {
    static constexpr bool PERM = true;
    bf16_t* ACT; const LAS float* RT;
    DI void operator()(const f32x4 (&acc)[2][2][4][2], const pg8::Unit& u, int wr, int wc, int fr, int fq) const {
        const int row0 = u.pm * 256 + wr * 64 + fr, col0 = u.pn * 128 + wc * 32 + 8 * fq;
        float rsv[2][4]; row_rstd8(RT, u.ui, wr, fr, rsv);
#pragma unroll
        for (int ai = 0; ai < 2; ++ai)
#pragma unroll
            for (int m = 0; m < 4; ++m) {
                const int row = row0 + ai * 128 + m * 16;
                const float rs = rsv[ai][m];
                const float rsn = rs * -1.4426950408889634f, rs2 = rs * rs;
                const f32x4 v0 = (acc[ai][0][m][0] * sig_arg4(acc[ai][0][m][0] * rsn)) * (acc[ai][1][m][0] * rs2), v1 = (acc[ai][0][m][1] * sig_arg4(acc[ai][0][m][1] * rsn)) * (acc[ai][1][m][1] * rs2);
                store8(ACT + (size_t)(row >> 12) * PBLK + ((size_t)(((row & (SEQ - 1)) >> 8) * (DFF / 32) + (col0 >> 5)) * 256 + (row & 255)) * 32 + (col0 & 31), v0, v1);
            }
    }
};

#define LBAR() do { asm volatile("s_waitcnt lgkmcnt(0)" ::: "memory"); __builtin_amdgcn_s_barrier(); asm volatile("" ::: "memory"); } while (0)
template <class Map>
DI void cvt_item(const float* src, int ld, const float* gain, bf16_t* WT, int K, int n0, int k0, const Map& mp, LAS float* scr, int lane, bool blocked = false) {
    const int sc = mp.col(n0 + lane); const float scale = mp.scale(n0 + lane);
    float wv[64];
    const float* sp = src + (size_t)k0 * ld + sc;
#pragma unroll
    for (int i = 0; i < 64; ++i) wv[i] = sp[(size_t)i * ld];
#pragma unroll
    for (int i = 0; i < 64; ++i) { const float gk = gain ? gain[k0 + i] : 1.0f; scr[i * 65 + lane] = wv[i] * (gk * scale); }
    asm volatile("s_waitcnt lgkmcnt(0)" ::: "memory");
    const int c = lane & 7;
#pragma unroll
    for (int j = 0; j < 8; ++j) { const int n = (lane >> 3) + 8 * j; const LAS float* s = scr + (8 * c) * 65 + n;
        u32x4 o; o.x = pk2(s[0 * 65], s[1 * 65]); o.y = pk2(s[2 * 65], s[3 * 65]); o.z = pk2(s[4 * 65], s[5 * 65]); o.w = pk2(s[6 * 65], s[7 * 65]);
        if (blocked) *(u32x4*)(WT + ((size_t)(((n0 + n) >> 8) * (K >> 5) + ((k0 + 8 * c) >> 5)) * 256 + ((n0 + n) & 255)) * 32 + ((8 * c) & 31)) = o;
        else *(u32x4*)(WT + (size_t)(n0 + n) * K + k0 + 8 * c) = o; }
    asm volatile("s_waitcnt lgkmcnt(0)" ::: "memory");
}
struct MapId { DI int col(int n) const { return n; } DI float scale(int) const { return 1.0f; } };
struct MapInA { DI int col(int n) const { if (n >= 1024) return n; const int p = n & 127; return (n & ~127) + (p >> 1) + 64 * (p & 1); } DI float scale(int n) const { return (n >= 512 && n < 1024) ? 0.08838834764831845f : 1.0f; } };
struct MapInC { DI int col(int n) const { return n; } DI float scale(int n) const { return (n >= 512 && n < 1024) ? 0.08838834764831845f : 1.0f; } };
struct MapUp  { DI int col(int n) const { return 128 * (n >> 8) + (n & 127); } DI float scale(int) const { return 1.0f; } };

struct ItemD { const float* sp; const float* gain; bf16_t* WT; int ld, K, n0, k0; float scale; };
DI ItemD item_desc(Frame& F, int it, int lane) {
    constexpr int I_IN = 16 * 48, I_OUT = 16 * 16, I_UP = 16 * 88, I_LAYER = I_IN + I_OUT + I_UP + 44 * 16;
    const int L = it / I_LAYER; int r = it % I_LAYER; const int j = L >> 1;
    ItemD d; const float* src; int mt, kb, nb;
    if (r < I_IN) { kb = r / 48; nb = r % 48;
        if (L & 1) { src = F.in[11] + (size_t)j * DM * CIN; d.ld = CIN; mt = 2; } else { src = F.in[4] + (size_t)j * DM * NIN; d.ld = NIN; mt = 1; }
        d.gain = F.in[1] + L * DM; d.WT = W_in(F, L); d.K = DM; }
    else if (r < I_IN + I_OUT) { r -= I_IN; kb = r / 16; nb = r % 16; src = ((L & 1) ? F.in[12] : F.in[5]) + (size_t)j * DM * DM; d.ld = DM; mt = 0; d.gain = nullptr; d.WT = W_out(F, L); d.K = DM; }
    else if (r < I_IN + I_OUT + I_UP) { r -= I_IN + I_OUT; kb = r / 88; nb = r % 88; const bool up = ((64 * nb) >> 7) & 1;
        src = (up ? F.in[17] : F.in[16]) + (size_t)L * DM * DFF; d.ld = DFF; mt = 3; d.gain = F.in[2] + L * DM; d.WT = W_up(F, L); d.K = DM; }
    else { r -= I_IN + I_OUT + I_UP; kb = r / 16; nb = r % 16; src = F.in[18] + (size_t)L * DFF * DM; d.ld = DM; mt = 0; d.gain = nullptr; d.WT = W_down(F, L); d.K = DFF; }
    d.n0 = 64 * nb; d.k0 = 64 * kb;
    const int n = d.n0 + lane; int sc = n; float scale = 1.0f;
    if (mt == 1) { sc = MapInA().col(n); scale = MapInA().scale(n); } else if (mt == 2) { scale = MapInC().scale(n); } else if (mt == 3) { sc = MapUp().col(n); }
    d.sp = src + (size_t)d.k0 * d.ld + sc; d.scale = scale;
    return d;
}
DI void item_load(const ItemD& d, float (&wv)[64]) {
#pragma unroll
    for (int i = 0; i < 64; ++i) wv[i] = d.sp[(size_t)i * d.ld];
}
DI void item_finish(const ItemD& d, float (&wv)[64], LAS float* scr, int lane) {
#pragma unroll
    for (int i = 0; i < 64; ++i) { const float gk = d.gain ? d.gain[d.k0 + i] : 1.0f; scr[i * 65 + lane] = wv[i] * (gk * d.scale); }
    asm volatile("s_waitcnt lgkmcnt(0)" ::: "memory");
    const int c = lane & 7;
#pragma unroll
    for (int j = 0; j < 8; ++j) { const int n = (lane >> 3) + 8 * j; const LAS float* s = scr + (8 * c) * 65 + n;
        u32x4 o; o.x = pk2(s[0 * 65], s[1 * 65]); o.y = pk2(s[2 * 65], s[3 * 65]); o.z = pk2(s[4 * 65], s[5 * 65]); o.w = pk2(s[6 * 65], s[7 * 65]);
        *(u32x4*)(d.WT + ((size_t)(((d.n0 + n) >> 8) * (d.K >> 5) + ((d.k0 + 8 * c) >> 5)) * 256 + ((d.n0 + n) & 255)) * 32 + ((8 * c) & 31)) = o; }
    asm volatile("s_waitcnt lgkmcnt(0)" ::: "memory");
}
DI void rp_load(Frame& F, int m2, f32x4 (&v)[2][4]) {
#pragma unroll
    for (int rr = 0; rr < 2; ++rr) { const f32x4* xr = (const f32x4*)(F.in[0] + (size_t)(2 * m2 + rr) * DM) + F.lane;
#pragma unroll
        for (int q = 0; q < 4; ++q) v[rr][q] = xr[64 * q]; }
}
DI void rp_finish(Frame& F, int m2, f32x4 (&v)[2][4]) {
    float* SS = (float*)(F.ws + WS_SS); bf16_t* HB = (bf16_t*)(F.ws + WS_HB);
#pragma unroll
    for (int rr = 0; rr < 2; ++rr) { const int m = 2 * m2 + rr; float s = 0.f;
#pragma unroll
        for (int q = 0; q < 4; ++q) { const f32x4 x = v[rr][q]; s += (x.x * x.x + x.y * x.y) + (x.z * x.z + x.w * x.w); u32x2 o; o.x = pk2(x.x, x.y); o.y = pk2(x.z, x.w); *(u32x2*)(HB + mix_off((size_t)m, 4 * (F.lane + 64 * q))) = o; }
        s = wave_sum(s);
        if (F.lane == 0) SS[m] = s; }
}

DI void p0_prologue(Frame& F) {
    LAS float* scr = (LAS float*)(F.lds + F.wave * 16640);
    const int gw = F.blk * 8 + F.wave, NGW = F.G * 8;
    constexpr int I_IN = 16 * 48, I_OUT = 16 * 16, I_UP = 16 * 88, I_DOWN = 44 * 16, I_LAYER = I_IN + I_OUT + I_UP + I_DOWN, NIT = DEPTH * I_LAYER;
    if (gw < NIT) {
        float wa[64], wb[64]; int it = gw;
        ItemD da = item_desc(F, it, F.lane); item_load(da, wa);
        for (;;) {
            const int itb = it + NGW; const bool hb = itb < NIT; ItemD db = da;
            if (hb) { db = item_desc(F, itb, F.lane); item_load(db, wb); }
            item_finish(da, wa, scr, F.lane);
            if (!hb) break;
            it = itb + NGW; const bool ha = it < NIT;
            if (ha) { da = item_desc(F, it, F.lane); item_load(da, wa); }
            item_finish(db, wb, scr, F.lane);
            if (!ha) break;
        }
    }
    float* SS = (float*)(F.ws + WS_SS);
    const int rW = NIT % NGW, nlo = NGW - rW; const int EX = (rW > 0 && 2 * nlo <= MROWS / 2) ? 2 * nlo : 0; const int nex = (EX && gw >= rW) ? 2 : 0;
    auto m2of = [&](int kx) -> int { if (kx < nex) return gw - rW + kx * nlo; const int m = EX + gw + (kx - nex) * NGW; return m < MROWS / 2 ? m : -1; };
    {
        f32x4 va[2][4], vb[2][4]; int ma = m2of(0); if (ma >= 0) rp_load(F, ma, va);
        for (int kx = 0; ma >= 0; kx += 2) {
            const int mb = m2of(kx + 1); if (mb >= 0) rp_load(F, mb, vb);
            rp_finish(F, ma, va);
            if (mb < 0) break;
            ma = m2of(kx + 2); if (ma >= 0) rp_load(F, ma, va);
            rp_finish(F, mb, vb);
        }
    }
    const int gt = F.blk * 512 + F.tid, NGT = F.G * 512;
    for (int e = gt; e < 15 * MROWS / 4; e += NGT) ((f32x4*)(SS + MROWS))[e] = (f32x4){0.f, 0.f, 0.f, 0.f};
    float* COS = (float*)(F.ws + WS_COS); float* SIN = (float*)(F.ws + WS_SIN);
    for (int e = gt; e < SEQ * 64; e += NGT) {
        const int pos = e >> 6, i = e & 63;
        const float inv = exp2f(-(float)i * (13.287712379549449f / 64.0f));
        const float ang = (float)pos * inv;
        const double a = (double)ang; const double n = rint(a * 0.15915494309189535); const float rr = (float)(a - n * 6.283185307179586);
        const size_t te = (size_t)(i >> 4) * (SEQ * 16) + (size_t)pos * 16 + (i & 15);
        COS[te] = cosf(rr); SIN[te] = sinf(rr);
    }
    bf16_t* WG = (bf16_t*)(F.ws + WS_WG);
    for (int e = gt; e < 2 * 16 * DM; e += NGT) { const int j = e >> 14, c = (e >> 10) & 15, k = e & 1023;
        const float wv = (c < 8) ? F.in[11][(size_t)j * DM * CIN + (size_t)k * CIN + 3072 + c] * F.in[1][(2 * j + 1) * DM + k] : 0.f;
        const unsigned hi = pk2(wv, 0.f) & 0xffffu; const float rem = wv - __uint_as_float(hi << 16);
        WG[((size_t)(j * 2 + 0) * 16 + c) * DM + k] = (bf16_t)hi; WG[((size_t)(j * 2 + 1) * 16 + c) * DM + k] = (bf16_t)(pk2(rem, 0.f) & 0xffffu); }
    bf16_t* WM = (bf16_t*)(F.ws + WS_WM);
    for (int e = gt; e < 2 * 4 * 128 * 128; e += NGT) { const int p = (e >> 7) & 127, q = e & 127; const float w = ((q >> 6) <= (p >> 6)) ? F.in[9][e] : 0.f;
        WM[(size_t)(e >> 14) * 16384 + ((size_t)(((p >> 5) * 8 + (q >> 4)) * 64 + ((q >> 3) & 1) * 32 + (p & 31))) * 8 + (q & 7)] = (bf16_t)(pk2(w, 0.f) & 0xffffu); }
}

DI void gate_step(Frame& F, int L) {
    constexpr int WP = 1032, XP = 264;
    const int j = L >> 1; const int gw = F.blk * 8 + F.wave, NGW = F.G * 8; const int lane = F.lane, n = lane & 15, q4 = lane >> 4;
    const float* SS = (const float*)(F.ws + WS_SS); const bf16_t* HB = (const bf16_t*)(F.ws + WS_HB);
    float* GLI = (float*)(F.ws + WS_GLI); float* GLF = (float*)(F.ws + WS_GLF);
    LAS bf16_t* WB = (LAS bf16_t*)F.lds;
    LAS bf16_t* XA = (LAS bf16_t*)(F.lds + 2 * 16 * WP * 2) + F.wave * (16 * XP);
    { const bf16_t* WG = (const bf16_t*)(F.ws + WS_WG) + (size_t)(j * 2) * 16 * DM;
#pragma unroll
      for (int i = 0; i < 8; ++i) { const int pc = F.tid + 512 * i, rw = pc >> 7, cp = (pc & 127) * 8; *(LAS u32x4*)(WB + rw * WP + cp) = *(const u32x4*)(WG + (size_t)rw * DM + cp); } }
    LBAR();
    for (int m4l0 = gw; m4l0 < MROWS / 4; m4l0 += 4 * NGW) {
        u32x4 xr[4][8];
#pragma unroll
        for (int kq = 0; kq < 4; ++kq)
#pragma unroll
            for (int e = 0; e < 8; ++e) { const int m = 2 * e + (lane >> 5); int m4a = m4l0 + (m >> 2) * NGW; m4a = m4a < MROWS / 4 ? m4a : m4l0; const int rowa = 4 * m4_map(m4a, F.G) + (m & 3);
                xr[kq][e] = *(const u32x4*)(HB + mix_off((size_t)rowa, 256 * kq + 8 * (lane & 31))); }
        int m4d = m4l0 + q4 * NGW; const bool okd = m4d < MROWS / 4; m4d = okd ? m4d : m4l0; const int rowd0 = 4 * m4_map(m4d, F.G);
        f32x4 sp; { const float* pp = SS + (size_t)(4 * (n & 3)) * MROWS + rowd0 + (n >> 2); sp.x = pp[0]; sp.y = pp[MROWS]; sp.z = pp[2 * (size_t)MROWS]; sp.w = pp[3 * (size_t)MROWS]; }
        f32x4 acc = {0.f, 0.f, 0.f, 0.f}, acl = {0.f, 0.f, 0.f, 0.f};
#pragma unroll
        for (int kq = 0; kq < 4; ++kq) {
#pragma unroll
            for (int e = 0; e < 8; ++e) *(LAS u32x4*)(XA + (2 * e + (lane >> 5)) * XP + 8 * (lane & 31)) = xr[kq][e];
            asm volatile("s_waitcnt lgkmcnt(0)" ::: "memory");
#pragma unroll
            for (int ks = 0; ks < 8; ++ks) {
                const bf16x8 a = *(const LAS bf16x8*)(XA + n * XP + 32 * ks + 8 * q4);
                const bf16x8 bh = *(const LAS bf16x8*)(WB + n * WP + 256 * kq + 32 * ks + 8 * q4), bl = *(const LAS bf16x8*)(WB + (16 + n) * WP + 256 * kq + 32 * ks + 8 * q4);
                acc = __builtin_amdgcn_mfma_f32_16x16x32_bf16(a, bh, acc, 0, 0, 0); acl = __builtin_amdgcn_mfma_f32_16x16x32_bf16(a, bl, acl, 0, 0, 0); }
            asm volatile("s_waitcnt lgkmcnt(0)" ::: "memory");
        }
        acc = acc + acl;
        float ssum = (sp.x + sp.y) + (sp.z + sp.w); ssum += dpp_f<0xB1>(ssum); ssum += dpp_f<0x4E>(ssum);
        const float rsr = 1.0f / sqrtf(ssum * (1.0f / DM) + EPS);
        float rsj[4];
#pragma unroll
        for (int jr = 0; jr < 4; ++jr) rsj[jr] = __int_as_float(__builtin_amdgcn_ds_bpermute(4 * (16 * q4 + 4 * jr), __float_as_int(rsr)));
        if (okd && n < 8) {
            const int hh = n & 3; const float bi = (n < 4) ? F.in[13][j * 4 + hh] : F.in[14][j * 4 + hh];
#pragma unroll
            for (int jr = 0; jr < 4; ++jr) {
                const float rs = rsj[jr];
                const int m = rowd0 + jr; const int b = m >> 12, t = m & (SEQ - 1); const size_t idx = (size_t)(b * 4 + hh) * SEQ + t;
                const float xx = acc[jr] * rs + bi;
                if (n < 4) GLI[idx] = xx; else GLF[idx] = (xx >= 0.f) ? -log1pf(expf(-xx)) : (xx - log1pf(expf(xx)));
            }
        }
    }
    LBAR();
}

DI void final_norm(Frame& F) {
    const int gw = F.blk * 8 + F.wave, NGW = F.G * 8; const float* SS = (const float*)(F.ws + WS_SS); const bf16_t* HB = (const bf16_t*)(F.ws + WS_HB); const f32x4* gv = (const f32x4*)F.in[3] + F.lane;
    f32x4 g[4];
#pragma unroll
    for (int q = 0; q < 4; ++q) g[q] = gv[64 * q];
    auto fn_load = [&](int m4l, u32x2 (&w)[4][4], float (&ssv)[4]) { const int m4 = m4_map(m4l, F.G);
#pragma unroll
        for (int rr = 0; rr < 4; ++rr) { const int m = 4 * m4 + rr;
#pragma unroll
            for (int q = 0; q < 4; ++q) w[rr][q] = *(const u32x2*)(HB + mix_off((size_t)m, 4 * (F.lane + 64 * q)));
            ssv[rr] = (F.lane < 16) ? SS[(size_t)F.lane * MROWS + m] : 0.f; } };
    auto fn_store = [&](int m4l, u32x2 (&w)[4][4], float (&ssv)[4]) { const int m4 = m4_map(m4l, F.G);
#pragma unroll
        for (int rr = 0; rr < 4; ++rr) { const int m = 4 * m4 + rr; f32x4* hr = (f32x4*)(F.H + (size_t)m * DM) + F.lane;
            const float rs = 1.0f / sqrtf(wave_sum(ssv[rr]) * (1.0f / DM) + EPS);
#pragma unroll
            for (int q = 0; q < 4; ++q) { const f32x4 v = {bflo(w[rr][q].x), bfhi(w[rr][q].x), bflo(w[rr][q].y), bfhi(w[rr][q].y)}; __builtin_nontemporal_store(v * rs * g[q], hr + 64 * q); } } };
    int ma = gw;
    if (ma < MROWS / 4) {
        u32x2 wa[4][4], wb[4][4]; float sa[4], sb[4];
        fn_load(ma, wa, sa);
        for (;;) {
            const int mb = ma + NGW; const bool hb = mb < MROWS / 4;
            if (hb) fn_load(mb, wb, sb);
            fn_store(ma, wa, sa);
            if (!hb) break;
            ma = mb + NGW; const bool ha = ma < MROWS / 4;
            if (ha) fn_load(ma, wa, sa);
            fn_store(mb, wb, sb);
            if (!ha) break;
        }
    }
}

DI int opaque(int x) { asm volatile("" : "+v"(x)); return x; }
DI int crow(int i, int h) { return (i & 3) + 8 * (i >> 2) + 4 * h; }
constexpr int QLD = 136, PLD = 72, KWLD = 160;
constexpr int QS_OFF = 0, KS_OFF = 17408, KW_OFF = 34816, VS_OFF = 55296, PS_OFF = 92160;
constexpr int SA_OFF = 101376, SCM_OFF = SA_OFF + 2048, SMT_OFF = SCM_OFF + 2048, SMISC_OFF = SMT_OFF + 2048;
constexpr int PQ_OFF = SMISC_OFF + 256, MS_OFF = PQ_OFF + 512, LS_OFF = MS_OFF + 320;
constexpr int STAT_OFF = LS_OFF + 320, NV_OFF = STAT_OFF + 4096, PSUM_OFF = NV_OFF + 512, QN_OFF = PSUM_OFF + 1024, GAIN_OFF = QN_OFF + 256, LA_END = GAIN_OFF + 1024;
static_assert(LA_END <= RING_BYTES, "mixer LDS");

DI bf16x8 gather_col(const LAS bf16_t* base, int ld, int col, int s0) {
    bf16x8 r;
#pragma unroll
    for (int j = 0; j < 8; ++j) r[j] = (short)base[(s0 + j) * ld + col];
    return r;
}
DI bf16x8 tr_frag(const LAS bf16_t* tile, int ld, int col0, int s0, int lane) {
    const int i16 = lane & 15, q = i16 >> 2, p = i16 & 3, blk = (lane >> 4) & 1, hh = lane >> 5;
    const LAS bf16_t* a = tile + (s0 + 8 * hh + q) * ld + col0 + 16 * blk + 4 * p;
    const bf16x4 lo = __builtin_amdgcn_ds_read_tr16_b64_v4i16((LAS bf16x4*)a), hi = __builtin_amdgcn_ds_read_tr16_b64_v4i16((LAS bf16x4*)(a + 4 * ld));
    return __builtin_shufflevector(lo, hi, 0, 1, 2, 3, 4, 5, 6, 7);
}
DI bf16x8 pack_acc(const f32x16& x, int s) {
    u32x4 p; p.x = pk2(x[8 * s + 0], x[8 * s + 1]); p.y = pk2(x[8 * s + 2], x[8 * s + 3]); p.z = pk2(x[8 * s + 4], x[8 * s + 5]); p.w = pk2(x[8 * s + 6], x[8 * s + 7]);
    return __builtin_bit_cast(bf16x8, p);
}
#define MFMA32(a, b, c) __builtin_amdgcn_mfma_f32_32x32x16_bf16((a), (b), (c), 0, 0, 0)
#define MFMA16(a, b, c) __builtin_amdgcn_mfma_f32_16x16x32_bf16((a), (b), (c), 0, 0, 0)

DI void mlstm_scan(Frame& F, int b, int h, int g) {
    LAS float* SA = (LAS float*)(F.lds + SA_OFF); LAS float* SCM = (LAS float*)(F.lds + SCM_OFF); LAS float* SMT = (LAS float*)(F.lds + SMT_OFF); LAS float* SM = (LAS float*)(F.lds + SMISC_OFF);
    LAS float* PQ = (LAS float*)(F.lds + PQ_OFF); LAS float* MS = (LAS float*)(F.lds + MS_OFF); LAS float* LS = (LAS float*)(F.lds + LS_OFF);
    const float* GLI = (const float*)(F.ws + WS_GLI) + (size_t)(b * 4 + h) * SEQ; const float* GLF = (const float*)(F.ws + WS_GLF) + (size_t)(b * 4 + h) * SEQ;
    const int lane = opaque(F.lane), w = F.wave;
    if (w <= g) {
        float li[8], lf[8]; const float* gli = GLI + w * 512 + lane; const float* glf = GLF + w * 512 + lane;
#pragma unroll
        for (int c = 0; c < 8; ++c) { li[c] = gli[c * 64]; lf[c] = glf[c * 64]; }
#pragma unroll
        for (int c = 0; c < 8; ++c) {
            const float bs = wave_scan<false>(lf[c]); const float a = li[c] - bs; const float cmx = wave_scan<true>(a);
            const float amax = lane63(cmx), b63 = lane63(bs);
            if (lane == 0) { PQ[(8 * w + c) * 2] = b63; PQ[(8 * w + c) * 2 + 1] = amax; }
            if (w == g) { (SA + lane)[c * 64] = a; (SCM + lane)[c * 64] = cmx; (SMT + lane)[c * 64] = bs; }
        }
    }
    __syncthreads();
    if (w == 0) {
        const bool live = lane < 8 * (g + 1);
        float P = live ? PQ[lane * 2] : 0.f; const float am = live ? PQ[lane * 2 + 1] : -3.0e38f; float Q = live ? am + P : -3.0e38f;
#define SCAN_PQ(CTRL, RM) { const float tP = __int_as_float(__builtin_amdgcn_update_dpp(0, __float_as_int(P), CTRL, RM, 0xF, false)); \
                            const float tQ = __int_as_float(__builtin_amdgcn_update_dpp(__float_as_int(-3.0e38f), __float_as_int(Q), CTRL, RM, 0xF, false)); Q = fmaxf(tQ + P, Q); P = tP + P; }
        SCAN_PQ(0x111, 0xF) SCAN_PQ(0x112, 0xF) SCAN_PQ(0x114, 0xF) SCAN_PQ(0x118, 0xF) SCAN_PQ(0x142, 0xA) SCAN_PQ(0x143, 0xC)
#undef SCAN_PQ
        const float mnext = fmaxf(P, Q);
        MS[lane + 1] = mnext; if (lane == 0) MS[0] = 0.f;
        const float mprev = MS[lane];
        const float la = live ? (mprev - fmaxf(mprev, am)) : 0.f;
        const float Linc = wave_scan<false>(la);
        LS[lane + 1] = Linc; if (lane == 0) LS[0] = 0.f;
    }
    __syncthreads();
    {
        const int i = F.tid, c = i >> 6; const float mprev = MS[8 * g + c]; const float cm = fmaxf(mprev, SCM[i]); SCM[i] = cm; SMT[i] = SMT[i] + cm;
        if (i < 8) SM[i] = MS[8 * g + i];
        if (i >= 16 && i < 25) SM[i] = LS[8 * (i - 16)];
    }
}

DI void mlstm_save(Frame& F, int unit) {
    const LAS float* SA = (const LAS float*)(F.lds + SA_OFF); const LAS float* SCM = (const LAS float*)(F.lds + SCM_OFF); const LAS float* SMT = (const LAS float*)(F.lds + SMT_OFF); const LAS float* SM = (const LAS float*)(F.lds + SMISC_OFF);
    float* sv = (float*)(F.ws + WS_SCN) + (size_t)unit * 1600;
    sv[F.tid] = SA[F.tid]; sv[512 + F.tid] = SCM[F.tid]; sv[1024 + F.tid] = SMT[F.tid]; if (F.tid < 32) sv[1536 + F.tid] = SM[F.tid];
}
DI void mlstm_restore(Frame& F, int unit) {
    LAS float* SA = (LAS float*)(F.lds + SA_OFF); LAS float* SCM = (LAS float*)(F.lds + SCM_OFF); LAS float* SMT = (LAS float*)(F.lds + SMT_OFF); LAS float* SM = (LAS float*)(F.lds + SMISC_OFF);
    const float* sv = (const float*)(F.ws + WS_SCN) + (size_t)unit * 1600;
    const float a = sv[F.tid], c = sv[512 + F.tid], m = sv[1024 + F.tid]; float x = 0.f; if (F.tid < 32) x = sv[1536 + F.tid];
    SA[F.tid] = a; SCM[F.tid] = c; SMT[F.tid] = m; if (F.tid < 32) SM[F.tid] = x;
}
template <int MODE, bool PASS2> struct ChunkRegs { u32x4 k[2]; u32x4 q[PASS2 ? 2 : 1]; u32x4 v[(MODE ? 256 : 128) / 64]; };
template <int MODE, bool PASS2>
DI void la_load(ChunkRegs<MODE, PASS2>& R, const bf16_t* PROJ, int bh, int T0, int tid) {
    constexpr int DV = MODE ? 256 : 128;
    const bf16_t* Q = PROJ + ((size_t)bh * SEQ + T0) * 128; const bf16_t* K = Q + M512B; const bf16_t* V = PROJ + 2 * M512B + ((size_t)bh * SEQ + T0) * DV;
#pragma unroll
    for (int i = 0; i < 2; ++i) { const int p = tid + 512 * i;
        const int to = tile_off(p >> 4, (p & 15) * 8);
        R.k[i] = *(const u32x4*)(K + to);
        if (PASS2) R.q[i] = *(const u32x4*)(Q + to); }
#pragma unroll
    for (int i = 0; i < DV / 64; ++i) { const int p = tid + 512 * i; R.v[i] = *(const u32x4*)(V + tile_off(p / (DV / 8), (p % (DV / 8)) * 8)); }
}
template <int MODE, bool PASS2>
DI void la_write(Frame& F, const ChunkRegs<MODE, PASS2>& R, int c, float lg2, int tid) {
    constexpr int DV = MODE ? 256 : 128, VLD = DV + 32;
    LAS bf16_t* Qs = (LAS bf16_t*)(F.lds + QS_OFF); LAS bf16_t* Ks = (LAS bf16_t*)(F.lds + KS_OFF); LAS bf16_t* Kw = (LAS bf16_t*)(F.lds + KW_OFF); LAS bf16_t* Vs = (LAS bf16_t*)(F.lds + VS_OFF);
    const LAS float* SA = (const LAS float*)(F.lds + SA_OFF); const LAS float* SCM = (const LAS float*)(F.lds + SCM_OFF);
#pragma unroll
    for (int i = 0; i < 2; ++i) { const int p = tid + 512 * i, t = p >> 4, cp = (p & 15) * 8; const u32x4 kv = R.k[i];
        float ck;
        if (MODE) ck = fexp(SA[c * 64 + t] - SCM[c * 64 + 63]); else ck = __builtin_amdgcn_exp2f(lg2 * (float)(63 - t));
        u32x4 kw; kw.x = pk2(bflo(kv.x) * ck, bfhi(kv.x) * ck); kw.y = pk2(bflo(kv.y) * ck, bfhi(kv.y) * ck); kw.z = pk2(bflo(kv.z) * ck, bfhi(kv.z) * ck); kw.w = pk2(bflo(kv.w) * ck, bfhi(kv.w) * ck);
        *(LAS u32x4*)(Kw + t * KWLD + cp) = kw;
        if (PASS2) { *(LAS u32x4*)(Ks + t * QLD + cp) = kv; *(LAS u32x4*)(Qs + t * QLD + cp) = R.q[i]; }
    }
#pragma unroll
    for (int i = 0; i < DV / 64; ++i) { const int p = tid + 512 * i, t = p / (DV / 8), cp = (p % (DV / 8)) * 8; *(LAS u32x4*)(Vs + t * VLD + cp) = R.v[i]; }
}

template <int MODE>
DI void la_pass1(Frame& F, int unit) {
    constexpr int DV = MODE ? 256 : 128, VLD = DV + 32, ND = MODE ? 4 : 2;
    const int b = unit >> 5, h = (unit >> 3) & 3, g = unit & 7, row0 = b * SEQ + g * 512;
    const int w = F.wave; int lane = F.lane, r = lane & 31, hh = lane >> 5;
    const int eb = MODE ? w : (w & 3), dt0 = MODE ? 0 : 2 * (w >> 2), e0 = 32 * eb;
    const bf16_t* PROJ = (const bf16_t*)(F.ws + WS_PROJ) + (size_t)b * PBLK;
    LAS bf16_t* Kw = (LAS bf16_t*)(F.lds + KW_OFF); LAS bf16_t* Vs = (LAS bf16_t*)(F.lds + VS_OFF);
    const LAS float* SCM = (const LAS float*)(F.lds + SCM_OFF); const LAS float* SM = (const LAS float*)(F.lds + SMISC_OFF); LAS float* NV = (LAS float*)(F.lds + NV_OFF);
    const float lg2 = log2f(1.0f - exp2f(-5.0f - (float)h));
    ChunkRegs<MODE, false> R; la_load<MODE, false>(R, PROJ, h, g * 512, opaque(F.tid));
    if (MODE) { mlstm_scan(F, b, h, g); if (F.tid < 128) NV[F.tid] = 0.f; }
    __syncthreads();
    if (MODE) mlstm_save(F, unit);
    f32x16 C[ND];
#pragma unroll
    for (int d = 0; d < ND; ++d)
#pragma unroll
        for (int i = 0; i < 16; ++i) C[d][i] = 0.f;
    for (int c = 0; c < 8; ++c) {
        lane = opaque(F.lane); r = lane & 31; hh = lane >> 5; const int tid_o = opaque(F.tid);
        la_write<MODE, false>(F, R, c, lg2, tid_o);
        if (c < 7) la_load<MODE, false>(R, PROJ, h, g * 512 + 64 * (c + 1), tid_o);
        LBAR();
        const float alpha = MODE ? fexp(SM[c] - SCM[c * 64 + 63]) : __builtin_amdgcn_exp2f(lg2 * 64.0f);
        bf16x8 vf[4];
#pragma unroll
        for (int ks = 0; ks < 4; ++ks) vf[ks] = tr_frag(Vs, VLD, e0, 16 * ks, lane);
#pragma unroll
        for (int d = 0; d < ND; ++d) {
#pragma unroll
            for (int i = 0; i < 16; ++i) C[d][i] *= alpha;
#pragma unroll
            for (int ks = 0; ks < 4; ++ks) { const bf16x8 ka = tr_frag(Kw, KWLD, 32 * (dt0 + d), 16 * ks, lane); C[d] = MFMA32(ka, vf[ks], C[d]); }
        }
        if (MODE) {
            const int dd = 16 * w + (lane & 15), sq = lane >> 4; float s = 0.f;
#pragma unroll
            for (int q = 0; q < 16; ++q) s += bf2f(Kw[(16 * sq + q) * KWLD + dd]);
            s = sum_xor16_32(s);
            if (lane < 16) NV[dd] = alpha * NV[dd] + s;
        }
        __syncthreads();
    }
    bf16_t* T = (bf16_t*)(F.ws + WS_TST) + (size_t)unit * DV * 128;
#pragma unroll
    for (int d = 0; d < ND; ++d)
#pragma unroll
        for (int q = 0; q < 4; ++q) { u32x2 v; v.x = pk2(C[d][4 * q], C[d][4 * q + 1]); v.y = pk2(C[d][4 * q + 2], C[d][4 * q + 3]);
            *(u32x2*)(T + ((size_t)((eb * 4 + dt0 + d) * 4 + q) * 64 + lane) * 4) = v; }
    if (MODE && F.tid < 128) ((float*)(F.ws + WS_NST))[unit * 128 + F.tid] = NV[F.tid];
    if (MODE && F.tid == 0) ((float*)(F.ws + WS_DG))[unit] = SM[16 + g + 1] - SM[16 + g];
    __syncthreads();
}

template <int MODE>
DI void state_scan(Frame& F, int unit) {
    constexpr int DV = MODE ? 256 : 128, NW = MODE ? 4 : 2;
    const int h = (unit >> 3) & 3, i = unit & 7, ub = unit - i;
    typedef unsigned uw __attribute__((ext_vector_type(NW)));
    bf16_t* T0 = (bf16_t*)(F.ws + WS_TST) + (size_t)ub * DV * 128 + (size_t)i * (DV / 8) * 128 + F.tid * (2 * NW);
    uw tv[7];
#pragma unroll
    for (int gp = 0; gp < 7; ++gp) tv[gp] = *(const uw*)(T0 + (size_t)gp * DV * 128);
    float dg[7];
    if (MODE) {
#pragma unroll
        for (int gp = 0; gp < 7; ++gp) dg[gp] = fexp(((const float*)(F.ws + WS_DG))[ub + gp]);
    } else { const float lg2 = log2f(1.0f - exp2f(-5.0f - (float)h)); const float d = __builtin_amdgcn_exp2f(lg2 * 512.0f);
#pragma unroll
        for (int gp = 0; gp < 7; ++gp) dg[gp] = d; }
    float nt[7]; float* NS = (float*)(F.ws + WS_NST) + (size_t)ub * 128 + F.tid;
    const bool nrow = MODE && i == 0 && F.tid < 128;
    if (nrow) {
#pragma unroll
        for (int gp = 0; gp < 7; ++gp) nt[gp] = NS[gp * 128]; }
    float acc[2 * NW];
#pragma unroll
    for (int k = 0; k < 2 * NW; ++k) acc[k] = 0.f;
#pragma unroll
    for (int gp = 0; gp < 7; ++gp) { uw o;
#pragma unroll
        for (int k = 0; k < NW; ++k) { acc[2 * k] = dg[gp] * acc[2 * k] + bflo(tv[gp][k]); acc[2 * k + 1] = dg[gp] * acc[2 * k + 1] + bfhi(tv[gp][k]); o[k] = pk2(acc[2 * k], acc[2 * k + 1]); }
        *(uw*)(T0 + (size_t)(gp + 1) * DV * 128) = o; }
    if (nrow) { float na = 0.f;
#pragma unroll
        for (int gp = 0; gp < 7; ++gp) { na = dg[gp] * na + nt[gp]; NS[(gp + 1) * 128] = na; } }
}

#define SEC_ACC() do { if (F.tid == 0) { volatile LAS unsigned* w_ = (volatile LAS unsigned*)(F.lds + LDSCTL_OFF); w_[13] = w_[13] + ((unsigned)__builtin_amdgcn_s_memrealtime() - sc_a); } } while (0)
struct NoHook { DI void operator()() const {} };
template <int MODE, class Hook = NoHook>
DI void la_pass2(Frame& F, int unit, int j, const Hook& hook = Hook()) {
    constexpr int DV = MODE ? 256 : 128, VLD = DV + 32, NT = MODE ? 2 : 1;
    const int b = unit >> 5, h = (unit >> 3) & 3, g = unit & 7, row0 = b * SEQ + g * 512;
    const int w = F.wave; int lane = F.lane, r = lane & 31, hh = lane >> 5, r16 = lane & 15, q4 = lane >> 4;
    const int eb = MODE ? w : (w & 3), tb0 = MODE ? 0 : (w >> 2), e0 = 32 * eb;
    const int ocol = DV * h;
    const bf16_t* PROJ = (const bf16_t*)(F.ws + WS_PROJ) + (size_t)b * PBLK; bf16_t* MIX = (bf16_t*)(F.ws + WS_MIX);
    const bf16_t* GATE = PROJ + (MODE ? 4 : 3) * M512B + (size_t)h * SEQ * DV;
    const float* gain = MODE ? (F.in[15] + (j * 4 + h) * 256) : (F.in[6] + (j * 4 + h) * 128);
    LAS bf16_t* Qs = (LAS bf16_t*)(F.lds + QS_OFF); LAS bf16_t* Ks = (LAS bf16_t*)(F.lds + KS_OFF); LAS bf16_t* Kw = (LAS bf16_t*)(F.lds + KW_OFF); LAS bf16_t* Vs = (LAS bf16_t*)(F.lds + VS_OFF); LAS bf16_t* Ps = (LAS bf16_t*)(F.lds + PS_OFF);
    const LAS float* SA = (const LAS float*)(F.lds + SA_OFF); const LAS float* SCM = (const LAS float*)(F.lds + SCM_OFF); const LAS float* SMT = (const LAS float*)(F.lds + SMT_OFF); const LAS float* SM = (const LAS float*)(F.lds + SMISC_OFF);
    LAS float* STAT = (LAS float*)(F.lds + STAT_OFF); LAS float* NV = (LAS float*)(F.lds + NV_OFF); LAS float* PSUM = (LAS float*)(F.lds + PSUM_OFF); LAS float* QN = (LAS float*)(F.lds + QN_OFF);
    const float lg2 = log2f(1.0f - exp2f(-5.0f - (float)h));
    ChunkRegs<MODE, true> R; la_load<MODE, true>(R, PROJ, h, g * 512, opaque(F.tid));
    LAS float* GAIN = (LAS float*)(F.lds + GAIN_OFF); if (F.tid < DV) GAIN[F.tid] = gain[F.tid];
    if (MODE) mlstm_restore(F, unit);
    __syncthreads();
    hook();
    u32x2 tv[4][4]; float nv0 = 0.f;
    {
        const bf16_t* T = (const bf16_t*)(F.ws + WS_TST) + (size_t)unit * DV * 128 + (size_t)eb * 4096 + (size_t)lane * 4;
#pragma unroll
        for (int d = 0; d < 4; ++d)
#pragma unroll
            for (int q = 0; q < 4; ++q) { if (g > 0) tv[d][q] = *(const u32x2*)(T + (d * 4 + q) * 256); else { tv[d][q].x = 0u; tv[d][q].y = 0u; } }
        if (MODE && F.tid < 128 && g > 0) nv0 = ((const float*)(F.ws + WS_NST))[unit * 128 + F.tid];
    }
    f32x16 C[4];
#pragma unroll
    for (int d = 0; d < 4; ++d)
#pragma unroll
        for (int q = 0; q < 4; ++q) { const u32x2 v = tv[d][q]; C[d][4 * q] = bflo(v.x); C[d][4 * q + 1] = bfhi(v.x); C[d][4 * q + 2] = bflo(v.y); C[d][4 * q + 3] = bfhi(v.y); }
    if (MODE && F.tid < 128) NV[F.tid] = nv0;
    for (int c = 0; c < 8; ++c) {
        unsigned sc_a = 0u; if (SECP == 1 && MODE == SECP_MODE) sc_a = (unsigned)__builtin_amdgcn_s_memrealtime();
        const int R0 = row0 + 64 * c;
        lane = opaque(F.lane); r = lane & 31; hh = lane >> 5; r16 = lane & 15; q4 = lane >> 4; const int tid_o = opaque(F.tid);
        la_write<MODE, true>(F, R, c, lg2, tid_o);
        if (SDUP & 1) { asm volatile("" ::: "memory"); la_write<MODE, true>(F, R, c, lg2, tid_o); }
        if (c < 7) la_load<MODE, true>(R, PROJ, h, g * 512 + 64 * (c + 1), tid_o);
        LBAR();
        if (SECP == 1 && MODE == SECP_MODE) SEC_ACC(); if (SECP == 2 && MODE == SECP_MODE) sc_a = (unsigned)__builtin_amdgcn_s_memrealtime();
        if (SDUP & 16) __syncthreads();
        u32x4 gt[NT][2];
        for (int srep = 0; srep < ((SDUP & 2) ? 2 : 1); ++srep) {
        if (srep) asm volatile("" ::: "memory");
#pragma unroll
        for (int i = 0; i < 2; ++i) {
            const int tt = 2 * w + i, si = tt >> 2, ti = tt & 3;
            f32x4 x = {0.f, 0.f, 0.f, 0.f};
#pragma unroll
            for (int kk = 0; kk < 4; ++kk) { const bf16x8 ka = *(const LAS bf16x8*)(Ks + (16 * si + r16) * QLD + 32 * kk + 8 * q4); const bf16x8 qb = *(const LAS bf16x8*)(Qs + (16 * ti + r16) * QLD + 32 * kk + 8 * q4); x = MFMA16(ka, qb, x); }
            const int t = 16 * ti + r16; float p[4];
#pragma unroll
            for (int q = 0; q < 4; ++q) { const int s = 16 * si + 4 * q4 + q; float wgt;
                if (MODE) wgt = (s <= t) ? fexp(SA[c * 64 + s] - SCM[c * 64 + t]) : 0.f;
                else { const int dlt = t > s ? t - s : s - t; wgt = __builtin_amdgcn_exp2f(lg2 * (float)dlt); }
                p[q] = x[q] * wgt; }
            u32x2 pw; pw.x = pk2(p[0], p[1]); pw.y = pk2(p[2], p[3]);
            *(LAS u32x2*)(Ps + t * PLD + 16 * si + 4 * q4) = pw;
            if (MODE) { float cs = (bflo(pw.x) + bfhi(pw.x)) + (bflo(pw.y) + bfhi(pw.y)); cs = sum_xor16_32(cs); if (q4 == 0) PSUM[si * 64 + t] = cs; }
        }
#pragma unroll
        for (int tt = 0; tt < NT; ++tt)
#pragma unroll
            for (int pr = 0; pr < 2; ++pr) gt[tt][pr] = *(const u32x4*)(GATE + ((((size_t)(g * 16 + 2 * c + tb0 + tt) * (DV / 32) + eb) * 2 + pr) * 64 + lane) * 8);
        if (MODE) {
            const int t = 8 * w + (lane >> 3), part = lane & 7;
            const u32x4 qa = *(const LAS u32x4*)(Qs + t * QLD + 16 * part), qb2 = *(const LAS u32x4*)(Qs + t * QLD + 16 * part + 8);
            const f32x4 n0 = *(const LAS f32x4*)(NV + 16 * part), n1 = *(const LAS f32x4*)(NV + 16 * part + 4), n2 = *(const LAS f32x4*)(NV + 16 * part + 8), n3 = *(const LAS f32x4*)(NV + 16 * part + 12);
            float qn = bflo(qa.x) * n0.x + bfhi(qa.x) * n0.y + bflo(qa.y) * n0.z + bfhi(qa.y) * n0.w + bflo(qa.z) * n1.x + bfhi(qa.z) * n1.y + bflo(qa.w) * n1.z + bfhi(qa.w) * n1.w
                     + bflo(qb2.x) * n2.x + bfhi(qb2.x) * n2.y + bflo(qb2.y) * n2.z + bfhi(qb2.y) * n2.w + bflo(qb2.z) * n3.x + bfhi(qb2.z) * n3.y + bflo(qb2.w) * n3.z + bfhi(qb2.w) * n3.w;
            qn += dpp_f<0xB1>(qn); qn += dpp_f<0x4E>(qn); qn += dpp_f<0x141>(qn);
            if (part == 0) QN[t] = qn;
        }
        }
        LBAR();
        if (SECP == 2 && MODE == SECP_MODE) SEC_ACC(); if (SECP == 3 && MODE == SECP_MODE) sc_a = (unsigned)__builtin_amdgcn_s_memrealtime();
        if (SDUP & 16) __syncthreads();
        bf16x8 vf[4];
#pragma unroll
        for (int ks = 0; ks < 4; ++ks) vf[ks] = tr_frag(Vs, VLD, e0, 16 * ks, lane);
        float cqv[NT], rinvv[NT];
#pragma unroll
        for (int tt = 0; tt < NT; ++tt) {
            const int t = 32 * (tb0 + tt) + r;
            if (MODE) {
                const float cq = fexp(SM[c] - SCM[c * 64 + t]);
                const float den = ((PSUM[t] + PSUM[64 + t]) + (PSUM[128 + t] + PSUM[192 + t])) + cq * QN[t];
                cqv[tt] = cq; rinvv[tt] = 1.0f / fmaxf(fabsf(den), fexp(-SMT[c * 64 + t]));
            } else { cqv[tt] = __builtin_amdgcn_exp2f(lg2 * (float)(t + 1)); rinvv[tt] = 1.f; }
        }
        f32x16 o2[NT], val[NT];
        for (int orep = 0; orep < ((SDUP & 4) ? 2 : 1); ++orep) {
        if (orep) asm volatile("" ::: "memory");
#pragma unroll
        for (int tt = 0; tt < NT; ++tt)
#pragma unroll
            for (int i = 0; i < 16; ++i) { o2[tt][i] = 0.f; val[tt][i] = 0.f; }
#pragma unroll
        for (int d = 0; d < 4; ++d) {
#pragma unroll
            for (int s2 = 0; s2 < 2; ++s2) { const bf16x8 ca = pack_acc(C[d], s2);
#pragma unroll
                for (int tt = 0; tt < NT; ++tt) { const int t = 32 * (tb0 + tt) + r;
                    const bf16x4 qlo = *(const LAS bf16x4*)(Qs + t * QLD + 32 * d + 16 * s2 + 4 * hh), qhi = *(const LAS bf16x4*)(Qs + t * QLD + 32 * d + 16 * s2 + 4 * hh + 8);
                    const bf16x8 qb = __builtin_shufflevector(qlo, qhi, 0, 1, 2, 3, 4, 5, 6, 7);
                    o2[tt] = MFMA32(ca, qb, o2[tt]); } }
            __builtin_amdgcn_sched_barrier(0);
        }
#pragma unroll
        for (int tt = 0; tt < NT; ++tt) { const int t = 32 * (tb0 + tt) + r;
#pragma unroll
            for (int ks = 0; ks < 4; ++ks) { const bf16x8 pb = *(const LAS bf16x8*)(Ps + t * PLD + 16 * ks + 8 * hh); val[tt] = MFMA32(vf[ks], pb, val[tt]); } }
#pragma unroll
        for (int tt = 0; tt < NT; ++tt) { const int t = 32 * (tb0 + tt) + r;
            float s1 = 0.f, s2s = 0.f;
#pragma unroll
            for (int i = 0; i < 16; ++i) { const float v = (val[tt][i] + cqv[tt] * o2[tt][i]) * rinvv[tt]; val[tt][i] = v; s1 += v; s2s += v * v; }
            s1 = sum_xor32(s1); s2s = sum_xor32(s2s);
            if (hh == 0) { STAT[(w * 64 + t) * 2] = s1; STAT[(w * 64 + t) * 2 + 1] = s2s; }
        }
        }
        LBAR();
        if (SECP == 3 && MODE == SECP_MODE) SEC_ACC(); if (SECP == 4 && MODE == SECP_MODE) sc_a = (unsigned)__builtin_amdgcn_s_memrealtime();
        if (SDUP & 16) __syncthreads();
        for (int frep = 0; frep < ((SDUP & 8) ? 2 : 1); ++frep) {
        if (frep) asm volatile("" ::: "memory");
#pragma unroll
        for (int tt = 0; tt < NT; ++tt) {
            const int t = 32 * (tb0 + tt) + r; float S1 = 0.f, S2 = 0.f;
#pragma unroll
            for (int ww = 0; ww < (MODE ? 8 : 4); ++ww) { const int wi = MODE ? ww : (4 * tb0 + ww); S1 += STAT[(wi * 64 + t) * 2]; S2 += STAT[(wi * 64 + t) * 2 + 1]; }
            const float mean = S1 * (1.0f / DV); const float var = fmaxf(S2 * (1.0f / DV) - mean * mean, 0.f); const float rs = 1.0f / sqrtf(var + EPS);
            const size_t rowoff = (size_t)(R0 + t);
#pragma unroll
            for (int pr = 0; pr < 2; ++pr) {
                const auto sx = __builtin_amdgcn_permlane32_swap(gt[tt][pr].x, gt[tt][pr].z, false, false), sy = __builtin_amdgcn_permlane32_swap(gt[tt][pr].y, gt[tt][pr].w, false, false);
                unsigned ov[2][2];
#pragma unroll
                for (int k = 0; k < 2; ++k) { const int q = 2 * pr + k, e = e0 + 8 * q + 4 * hh; const unsigned g0 = sx[k], g1 = sy[k];
                    const f32x4 gn = *(const LAS f32x4*)(GAIN + e);
                    const float y0 = (val[tt][4 * q] - mean) * rs * gn.x * bflo(g0), y1 = (val[tt][4 * q + 1] - mean) * rs * gn.y * bfhi(g0);
                    const float y2 = (val[tt][4 * q + 2] - mean) * rs * gn.z * bflo(g1), y3 = (val[tt][4 * q + 3] - mean) * rs * gn.w * bfhi(g1);
                    ov[k][0] = pk2(y0, y1); ov[k][1] = pk2(y2, y3); }
                const auto tx = __builtin_amdgcn_permlane32_swap(ov[0][0], ov[1][0], false, false), ty = __builtin_amdgcn_permlane32_swap(ov[0][1], ov[1][1], false, false);
                u32x4 o; o.x = tx[0]; o.y = ty[0]; o.z = tx[1]; o.w = ty[1];
                *(u32x4*)(MIX + mix_off(rowoff, ocol + e0 + 8 * (2 * pr + hh))) = o; }
        }
        }
        __builtin_amdgcn_sched_barrier(0);
        if (c < 7) {
        const float alpha = MODE ? fexp(SM[c] - SCM[c * 64 + 63]) : __builtin_amdgcn_exp2f(lg2 * 64.0f);
#pragma unroll
        for (int d = 0; d < 4; ++d) {
#pragma unroll
            for (int i = 0; i < 16; ++i) C[d][i] *= alpha;
#pragma unroll
            for (int ks = 0; ks < 4; ++ks) { const bf16x8 ka = tr_frag(Kw, KWLD, 32 * d, 16 * ks, lane); C[d] = MFMA32(ka, vf[ks], C[d]); }
        }
        if (SDUP & 64) {
            f32x16 dm;
#pragma unroll
            for (int i = 0; i < 16; ++i) dm[i] = 0.f;
            asm volatile("" ::: "memory");
#pragma unroll
            for (int d = 0; d < 4; ++d)
#pragma unroll
                for (int ks = 0; ks < 4; ++ks) { const bf16x8 ka = tr_frag(Kw, KWLD, 32 * d, 16 * ks, lane); dm = MFMA32(ka, vf[ks], dm); }
            asm volatile("" :: "v"(dm));
        }
        if (SDUP & 128) {
            f32x16 dm;
#pragma unroll
            for (int i = 0; i < 16; ++i) dm[i] = 0.f;
            asm volatile("" ::: "memory");
#pragma unroll
            for (int d = 0; d < 4; ++d)
#pragma unroll
                for (int s2 = 0; s2 < 2; ++s2) { const bf16x8 ca = pack_acc(C[d], s2);
#pragma unroll
                    for (int tt = 0; tt < NT; ++tt) { const int t = 32 * (tb0 + tt) + r;
                        const bf16x4 qlo = *(const LAS bf16x4*)(Qs + t * QLD + 32 * d + 16 * s2 + 4 * hh), qhi = *(const LAS bf16x4*)(Qs + t * QLD + 32 * d + 16 * s2 + 4 * hh + 8);
                        const bf16x8 qb = __builtin_shufflevector(qlo, qhi, 0, 1, 2, 3, 4, 5, 6, 7);
                        dm = MFMA32(ca, qb, dm); } }
            asm volatile("" :: "v"(dm));
        }
        if (MODE) {
            const int dd = 16 * w + (lane & 15), sq = lane >> 4; float s = 0.f;
#pragma unroll
            for (int q = 0; q < 16; ++q) s += bf2f(Kw[(16 * sq + q) * KWLD + dd]);
            s = sum_xor16_32(s);
            if (lane < 16) NV[dd] = alpha * NV[dd] + s;
        }
        }
        LBAR();
        if (SECP == 4 && MODE == SECP_MODE) SEC_ACC();
        if (SDUP & 16) __syncthreads();
    }
}

constexpr int VN_OFF = 0, SGST_OFF = 139264;
static_assert(SGST_OFF + 1024 + 4096 <= LDSCTL_OFF, "SGU LDS");
DI void sgu_group(Frame& F, int j, int gq, int row0, int t0, int dtl, int pt0, int r, int hh, const bf16_t* PROJ, bf16_t* MIX, const LAS bf16_t* Vn, int VP,
                  const bf16x8 (&wa)[8][2], const u32x4 (&uq)[2][2], const float (&bsv)[2], bf16x8 (&wan)[8][2], u32x4 (&uqn)[2][2], float (&bsn)[2]) {
    if (gq < 3) {
        const bf16_t* WM = (const bf16_t*)(F.ws + WS_WM) + (size_t)(j * 4 + gq + 1) * 128 * 128; const float* bs = F.in[10] + (j * 4 + gq + 1) * 128;
#pragma unroll
        for (int ks = 0; ks < 8; ++ks)
#pragma unroll
            for (int pt = 0; pt < 2; ++pt) wan[ks][pt] = *(const bf16x8*)(WM + ((size_t)((pt0 + pt) * 8 + ks) * 64 + 32 * hh + r) * 8);
#pragma unroll
        for (int pt = 0; pt < 2; ++pt) { bsn[pt] = bs[32 * (pt0 + pt) + r];
#pragma unroll
            for (int pr = 0; pr < 2; ++pr) uqn[pt][pr] = *(const u32x4*)(PROJ + 4 * M512B + ((((size_t)((t0 >> 5) + pt0 + pt) * 16 + 4 * (gq + 1) + dtl) * 2 + pr) * 64 + 32 * hh + r) * 8); }
    }
    f32x16 acc[2];
#pragma unroll
    for (int i = 0; i < 16; ++i) { acc[0][i] = 0.f; acc[1][i] = 0.f; }
#pragma unroll
    for (int ks = 0; ks < 8; ++ks) { const bf16x8 vb = tr_frag(Vn, VP, 128 * gq + 32 * dtl, 16 * ks, 32 * hh + r);
#pragma unroll
        for (int pt = 0; pt < 2; ++pt) acc[pt] = MFMA32(vb, wa[ks][pt], acc[pt]); }
#pragma unroll
    for (int pt = 0; pt < 2; ++pt) { const int pp = 32 * (pt0 + pt) + r; const float bv = bsv[pt];
#pragma unroll
        for (int pr = 0; pr < 2; ++pr) {
            const auto sx = __builtin_amdgcn_permlane32_swap(uq[pt][pr].x, uq[pt][pr].z, false, false), sy = __builtin_amdgcn_permlane32_swap(uq[pt][pr].y, uq[pt][pr].w, false, false);
            const int i0 = 8 * pr;
            const unsigned a0 = pk2(bflo(sx[0]) * (acc[pt][i0 + 0] + bv), bfhi(sx[0]) * (acc[pt][i0 + 1] + bv)), a1 = pk2(bflo(sy[0]) * (acc[pt][i0 + 2] + bv), bfhi(sy[0]) * (acc[pt][i0 + 3] + bv));
            const unsigned b0 = pk2(bflo(sx[1]) * (acc[pt][i0 + 4] + bv), bfhi(sx[1]) * (acc[pt][i0 + 5] + bv)), b1 = pk2(bflo(sy[1]) * (acc[pt][i0 + 6] + bv), bfhi(sy[1]) * (acc[pt][i0 + 7] + bv));
            const auto tx = __builtin_amdgcn_permlane32_swap(a0, b0, false, false), ty = __builtin_amdgcn_permlane32_swap(a1, b1, false, false);
            u32x4 o; o.x = tx[0]; o.y = ty[0]; o.z = tx[1]; o.w = ty[1];
            *(u32x4*)(MIX + mix_off((size_t)(row0 + pp), 512 + 128 * gq + 32 * dtl + 8 * (2 * pr + hh))) = o; } }
}
DI void sgu_unit(Frame& F, int unit, int j) {
    constexpr int VP = 544;
    const int row0 = unit * 128, t0 = (unit & 31) * 128; const int w = F.wave; int lane = F.lane, r = lane & 31, hh = lane >> 5;
    const bf16_t* PROJ = (const bf16_t*)(F.ws + WS_PROJ) + (size_t)(unit >> 5) * PBLK; bf16_t* MIX = (bf16_t*)(F.ws + WS_MIX);
    LAS bf16_t* Vn = (LAS bf16_t*)(F.lds + VN_OFF); LAS float* ST = (LAS float*)(F.lds + SGST_OFF);
    const float* lng = F.in[7] + j * 512; const float* lnb = F.in[8] + j * 512;
    LAS float* LNG = (LAS float*)(F.lds + SGST_OFF + 1024); LAS float* LNB = LNG + 512;
    const int dtl = w & 3, pt0 = 2 * (w >> 2);
    {
        const int tid_o = opaque(F.tid); u32x4 raw[16];
#pragma unroll
        for (int i = 0; i < 16; ++i) { const int pc = tid_o + 512 * i, q = pc >> 6, cp = (pc & 63) * 8; raw[i] = *(const u32x4*)(PROJ + 5 * M512B + (size_t)(t0 + q) * 512 + cp); }
        if (tid_o < 128) *(LAS f32x4*)(LNG + 4 * tid_o) = *(const f32x4*)(lng + 4 * tid_o); else if (tid_o < 256) *(LAS f32x4*)(LNB + 4 * (tid_o - 128)) = *(const f32x4*)(lnb + 4 * (tid_o - 128));
#pragma unroll
        for (int i = 0; i < 16; ++i) { const int pc = tid_o + 512 * i, q = pc >> 6, cp = (pc & 63) * 8; *(LAS u32x4*)(Vn + q * VP + cp) = raw[i]; }
    }
    bf16x8 waA[8][2], waB[8][2]; u32x4 uqA[2][2], uqB[2][2]; float bsA[2], bsB[2];
    { const bf16_t* WM = (const bf16_t*)(F.ws + WS_WM) + (size_t)(j * 4) * 128 * 128; const float* bs = F.in[10] + (j * 4) * 128;
#pragma unroll
      for (int ks = 0; ks < 8; ++ks)
#pragma unroll
          for (int pt = 0; pt < 2; ++pt) waA[ks][pt] = *(const bf16x8*)(WM + ((size_t)((pt0 + pt) * 8 + ks) * 64 + 32 * hh + r) * 8);
#pragma unroll
      for (int pt = 0; pt < 2; ++pt) { bsA[pt] = bs[32 * (pt0 + pt) + r];
#pragma unroll
          for (int pr = 0; pr < 2; ++pr) uqA[pt][pr] = *(const u32x4*)(PROJ + 4 * M512B + ((((size_t)((t0 >> 5) + pt0 + pt) * 16 + dtl) * 2 + pr) * 64 + 32 * hh + r) * 8); } }
    LBAR();
    {
        const int tid_o = opaque(F.tid), q = tid_o >> 2, part = tid_o & 3; float s1 = 0.f, s2 = 0.f;
#pragma unroll
        for (int k = 0; k < 16; ++k) { const u32x4 v = *(const LAS u32x4*)(Vn + q * VP + (part + 4 * k) * 8);
            const float x0 = bflo(v.x), x1 = bfhi(v.x), x2 = bflo(v.y), x3 = bfhi(v.y), x4 = bflo(v.z), x5 = bfhi(v.z), x6 = bflo(v.w), x7 = bfhi(v.w);
            s1 += ((x0 + x1) + (x2 + x3)) + ((x4 + x5) + (x6 + x7));
            s2 += ((x0 * x0 + x1 * x1) + (x2 * x2 + x3 * x3)) + ((x4 * x4 + x5 * x5) + (x6 * x6 + x7 * x7)); }
        s1 += dpp_f<0xB1>(s1); s1 += dpp_f<0x4E>(s1); s2 += dpp_f<0xB1>(s2); s2 += dpp_f<0x4E>(s2);
        const float mean = s1 * (1.0f / 512.0f), var = fmaxf(s2 * (1.0f / 512.0f) - mean * mean, 0.f);
        if (part == 0) { ST[2 * q] = mean; ST[2 * q + 1] = 1.0f / sqrtf(var + EPS); }
    }
    LBAR();
    {
        const int tid_o = opaque(F.tid), cp = (tid_o & 63) * 8;
        const f32x4 g0 = *(const LAS f32x4*)(LNG + cp), g1 = *(const LAS f32x4*)(LNG + cp + 4), b0 = *(const LAS f32x4*)(LNB + cp), b1 = *(const LAS f32x4*)(LNB + cp + 4);
#pragma unroll
        for (int i = 0; i < 16; ++i) { const int q = (tid_o >> 6) + 8 * i; LAS u32x4* pv = (LAS u32x4*)(Vn + q * VP + cp); const u32x4 v = *pv; const float mean = ST[2 * q], rs = ST[2 * q + 1];
            u32x4 o; o.x = pk2((bflo(v.x) - mean) * rs * g0.x + b0.x, (bfhi(v.x) - mean) * rs * g0.y + b0.y); o.y = pk2((bflo(v.y) - mean) * rs * g0.z + b0.z, (bfhi(v.y) - mean) * rs * g0.w + b0.w);
            o.z = pk2((bflo(v.z) - mean) * rs * g1.x + b1.x, (bfhi(v.z) - mean) * rs * g1.y + b1.y); o.w = pk2((bflo(v.w) - mean) * rs * g1.z + b1.z, (bfhi(v.w) - mean) * rs * g1.w + b1.w);
            *pv = o; }
    }
    LBAR();
    lane = opaque(F.lane); r = lane & 31; hh = lane >> 5;
    sgu_group(F, j, 0, row0, t0, dtl, pt0, r, hh, PROJ, MIX, Vn, VP, waA, uqA, bsA, waB, uqB, bsB);
    sgu_group(F, j, 1, row0, t0, dtl, pt0, r, hh, PROJ, MIX, Vn, VP, waB, uqB, bsB, waA, uqA, bsA);
    sgu_group(F, j, 2, row0, t0, dtl, pt0, r, hh, PROJ, MIX, Vn, VP, waA, uqA, bsA, waB, uqB, bsB);
    sgu_group(F, j, 3, row0, t0, dtl, pt0, r, hh, PROJ, MIX, Vn, VP, waB, uqB, bsB, waA, uqA, bsA);
    LBAR();
}

static_assert(BATCH == pg8::NXCD && MROWS / pg8::BM / pg8::NXCD == SEQ / pg8::BM && (SEQ / pg8::BM) % pg8::WGM == 0 && SEQ / pg8::BM == 16, "the unit order deals row blocks 16x .. 16x+15 (batch element x) to the workgroups with blockIdx % 8 == x");
struct Args { const float* in[19]; float* out; unsigned char* ws; int ph_lo, ph_hi; };
__global__ void __launch_bounds__(512, 2) fwd(Args args) {
    extern __shared__ __attribute__((aligned(16))) unsigned char lds_raw[];
    Frame F;
    F.lds = (LAS unsigned char*)lds_raw;
    const int wave_s = __builtin_amdgcn_readfirstlane(threadIdx.x >> 6);
    F.tid = threadIdx.x; F.lane = F.tid & 63; F.wave = wave_s; F.G = gridDim.x; F.blk = (int)((blockIdx.x & ~7u) | ((blockIdx.x + GRP_ROT) & 7u));
    F.in = (const float* const __attribute__((address_space(4)))*)__builtin_amdgcn_kernarg_segment_ptr();
    F.H = args.out; F.ws = args.ws;
    volatile LAS unsigned* MISC = (volatile LAS unsigned*)(F.lds + LDSCTL_OFF);
    if (F.tid < 64) MISC[F.tid] = 0u;
    __syncthreads();
    if (ONE_LAUNCH) { (void)xcd_barrier_post((unsigned*)(F.ws + WS_CTL), MISC + 8, F.tid); if (F.tid == 0) __hip_atomic_store((unsigned*)(F.ws + WS_CTL) + XB_IDS + blockIdx.x, xb_xcc_id() + 1u, __ATOMIC_RELAXED, __HIP_MEMORY_SCOPE_AGENT); }
    const int lo = ONE_LAUNCH ? 0 : args.ph_lo, hi = ONE_LAUNCH ? NPHASE : args.ph_hi;
#define IN(k) (lo <= (k) && (k) < hi)
#define REFRESH() do { F.lane = opaque((int)__builtin_amdgcn_mbcnt_hi(~0u, __builtin_amdgcn_mbcnt_lo(~0u, 0u))); F.wave = wave_s; F.tid = wave_s * 64 + F.lane; \
        { unsigned long long z_ = 0ull; asm volatile("" : "+s"(z_)); F.ws = args.ws + z_; int g_, b_; asm volatile("v_mov_b32 %0, %2\n\tv_mov_b32 %1, %3" : "=v"(g_), "=v"(b_) : "s"((int)gridDim.x), "s"((int)((blockIdx.x & ~7u) | ((blockIdx.x + GRP_ROT) & 7u)))); F.G = __builtin_amdgcn_readfirstlane(g_); F.blk = __builtin_amdgcn_readfirstlane(b_); } } while (0)
#define SEAM(k, ty) do { if (ONE_LAUNCH && IN((k) + 1)) GBAR((k) == 0, ty); } while (0)
#define GBAR(first, ty) GBAR2(first, ty, 0)
#define GBAR2(first, ty, oct) do { { REFRESH(); \
        const unsigned md_ = (first) ? 0u : (unsigned)__builtin_amdgcn_readfirstlane((int)((volatile LAS unsigned*)(F.lds + LDSCTL_OFF))[12]); \
        unsigned ta_ = 0u; if (TPROBE) { ta_ = (unsigned)__builtin_amdgcn_s_memrealtime(); if (((TP_PHASE_MASK >> (ty)) & 1u) && F.tid == 0) TPW[13] = TPW[13] + (ta_ - TPW[14]); } \
        if (md_ == 0u) { XcdBarrier bb_; bb_.bar = (unsigned*)(F.ws + WS_CTL); bb_.x = xb_xcc_id(); bb_.st = (volatile LAS unsigned*)(F.lds + LDSCTL_OFF) + 8; xcd_barrier(bb_, F.tid); } \
        else if (oct) grp_barrier((unsigned*)(F.ws + WS_CTL), 24u + ((unsigned)F.blk & 7u) * 4u + ((unsigned)F.blk >> 6), 8u, md_ == 2u, F.tid);        \
        else grp_barrier((unsigned*)(F.ws + WS_CTL), (unsigned)F.blk & 7u, (unsigned)F.G >> 3, md_ == 2u, F.tid); \
        if (TPROBE && F.tid == 0) { const unsigned tb_ = (unsigned)__builtin_amdgcn_s_memrealtime(); TPW[14] = tb_; if ((TP_SEAM_MASK >> (ty)) & 1u) TPW[13] = TPW[13] + (tb_ - ta_); } } } while (0)
#define SS ((const float*)(F.ws + WS_SS))
#define HB ((bf16_t*)(F.ws + WS_HB))
#define MIX ((bf16_t*)(F.ws + WS_MIX))
#define PROJ ((bf16_t*)(F.ws + WS_PROJ))

#define TPW ((volatile LAS unsigned*)(F.lds + LDSCTL_OFF))
    if (TPROBE && F.tid == 0) { TPW[13] = 0u; TPW[14] = (unsigned)__builtin_amdgcn_s_memrealtime(); }
    if ((PH_MASK & 1) && IN(0)) { REPS(1) { REFRESH(); p0_prologue(F); } SEAM(0, 0); }
    if (ONE_LAUNCH) {
        REFRESH();
        if (F.G == 256 && F.tid < 64) {
            unsigned* bar = (unsigned*)(F.ws + WS_CTL);
            const unsigned mine = xb_xcc_id() + 1u, theirs = (F.tid < 32) ? xb_ld(bar + XB_IDS + (blockIdx.x & 7) + 8 * F.tid) : mine;
            const bool all_same = __builtin_amdgcn_ballot_w64(theirs != mine) == 0ull;
            if (F.tid == 0) ((volatile LAS unsigned*)(F.lds + LDSCTL_OFF))[12] = all_same ? 2u : 1u;
        }
        __syncthreads();
    }
    for (int L = 0; L < DEPTH; ++L) {
        const int pb = 1 + 6 * L, j = L >> 1;
        if (IN(pb)) {
            REFRESH();
            pg8::Gemm g{HB, W_in(F, L), MROWS, NIN, DM, 0, 3}; pg8::StaticOrder S; S.init(MROWS, NIN, F.G, F.blk);
            if (L & 1) { if (PH_MASK & 2) REPS(2) { rstd_table(F, S, SS); EpiInC E{PROJ, (const LAS float*)(F.lds + RSTD_OFF)}; pg8::gemm_phase<EpiInC, pg8::StaticOrder, GEMM_ALIGN, GEMM_SP2>(F.lds, g, S, E, F.tid); } if (PH_MASK & 4) gate_step(F, L); }
            else if (PH_MASK & 8) REPS(8) { rstd_table(F, S, SS); EpiInA E{PROJ, (const LAS float*)(F.lds + RSTD_OFF), (const float*)(F.ws + WS_COS), (const float*)(F.ws + WS_SIN)}; pg8::gemm_phase<EpiInA, pg8::StaticOrder, GEMM_ALIGN, GEMM_SP2>(F.lds, g, S, E, F.tid); }
            SEAM(pb, 1);
        }
        if (IN(pb + 1)) {
            REFRESH();
            for (int u0 = F.blk; u0 < 256; u0 += F.G) { int u = (F.G == 256) ? ((u0 & 7) * 32 + (u0 >> 3)) : u0; asm volatile("" : "+v"(u)); u = __builtin_amdgcn_readfirstlane(u);
                if (L & 1) { if (PH_MASK & 16) { if ((u & 7) != 7) la_pass1<1>(F, u); else { mlstm_scan(F, u >> 5, (u >> 3) & 3, 7); __syncthreads(); mlstm_save(F, u); __syncthreads(); } } }
                else { if ((PH_MASK & 32) && (u & 7) != 7) la_pass1<0>(F, u); } }
            const unsigned mdm_ = (unsigned)__builtin_amdgcn_readfirstlane((int)((volatile LAS unsigned*)(F.lds + LDSCTL_OFF))[12]);
            const unsigned oct_ = 24u + ((unsigned)F.blk & 7u) * 4u + ((unsigned)F.blk >> 6);
            if (ONE_LAUNCH && mdm_ != 0u) grp_arrive((unsigned*)(F.ws + WS_CTL), oct_, 8u, mdm_ == 2u, F.tid, (volatile LAS unsigned*)(F.lds + LDSCTL_OFF) + 15);
            if (!(L & 1) && (PH_MASK & 64)) for (int u0 = F.blk; u0 < 256; u0 += F.G) { int u = (F.G == 256) ? ((u0 & 7) * 32 + (u0 >> 3)) : u0; asm volatile("" : "+v"(u)); u = __builtin_amdgcn_readfirstlane(u); sgu_unit(F, u, j); }
            if (ONE_LAUNCH) { if (mdm_ != 0u) { REFRESH(); grp_wait((unsigned*)(F.ws + WS_CTL), oct_, F.tid, (volatile LAS unsigned*)(F.lds + LDSCTL_OFF) + 15); } else GBAR2(false, 2, 1); }
        }
        if (IN(pb + 2)) {
            REFRESH();
            for (int u0 = F.blk; u0 < 256; u0 += F.G) { int u = (F.G == 256) ? ((u0 & 7) * 32 + (u0 >> 3)) : u0; asm volatile("" : "+v"(u)); u = __builtin_amdgcn_readfirstlane(u);
                { FS_T0(6); if (L & 1) state_scan<1>(F, u); else state_scan<0>(F, u); FS_T1(6); } }
            if (F.G == 256) {
                int u = (F.blk & 7) * 32 + (F.blk >> 3); asm volatile("" : "+v"(u)); u = __builtin_amdgcn_readfirstlane(u);
                auto bar = [&]() { GBAR2(false, 7, 1); };
                if (L & 1) { if (PH_MASK & 128) la_pass2<1>(F, u, j, bar); } else { if (PH_MASK & 256) la_pass2<0>(F, u, j, bar); }
            } else {
                GBAR2(false, 7, 1);
                REFRESH();
                for (int u0 = F.blk; u0 < 256; u0 += F.G) { const int u = u0;
                    if (L & 1) { if (PH_MASK & 128) la_pass2<1>(F, u, j); } else { if (PH_MASK & 256) la_pass2<0>(F, u, j); } } }
            SEAM(pb + 2, 3);
        }
        if (IN(pb + 3)) {
            REFRESH();
            pg8::Gemm g{MIX, W_out(F, L), MROWS, DM, DM, 0, 3}; pg8::StaticOrder S; S.init(MROWS, DM, F.G, F.blk);
            if (PH_MASK & 512) for (int rep_ = 0; rep_ < ((DUP_MASK & 512) ? 3 : 1); ++rep_) { EpiRes E{HB, (float*)(F.ws + WS_SS), (rep_ == 1) ? -1.f : 1.f}; pg8::gemm_phase<EpiRes, pg8::StaticOrder, GEMM_ALIGN, GEMM_SP2>(F.lds, g, S, E, F.tid); if (ONE_LAUNCH && rep_ + 1 < ((DUP_MASK & 512) ? 3 : 1)) { REFRESH(); XcdBarrier bb_; bb_.bar = (unsigned*)(F.ws + WS_CTL); bb_.x = xb_xcc_id(); bb_.st = (volatile LAS unsigned*)(F.lds + LDSCTL_OFF) + 8; xcd_barrier(bb_, F.tid); } }
            SEAM(pb + 3, 4);
        }
        if (IN(pb + 4)) {
            REFRESH();
            pg8::Gemm g{HB, W_up(F, L), MROWS, NUP, DM, 0, 3}; pg8::StaticOrder S; S.init(MROWS, NUP, F.G, F.blk);
            if (PH_MASK & 1024) REPS(1024) { rstd_table(F, S, SS); EpiSwiGLU E{PROJ, (const LAS float*)(F.lds + RSTD_OFF)}; pg8::gemm_phase<EpiSwiGLU, pg8::StaticOrder, GEMM_ALIGN, GEMM_SP2>(F.lds, g, S, E, F.tid); }
            SEAM(pb + 4, 5);
        }
        if (IN(pb + 5)) {
            REFRESH();
            pg8::Gemm g{PROJ, W_down(F, L), MROWS, DM, DFF, (PBLK - (size_t)SEQ * DFF) * 2, 3}; pg8::StaticOrder S; S.init(MROWS, DM, F.G, F.blk);
            if (PH_MASK & 2048) for (int rep_ = 0; rep_ < ((DUP_MASK & 2048) ? 3 : 1); ++rep_) { EpiRes E{HB, (float*)(F.ws + WS_SS), (rep_ == 1) ? -1.f : 1.f}; pg8::gemm_phase<EpiRes, pg8::StaticOrder, GEMM_ALIGN, GEMM_SP2>(F.lds, g, S, E, F.tid); if (ONE_LAUNCH && rep_ + 1 < ((DUP_MASK & 2048) ? 3 : 1)) { REFRESH(); XcdBarrier bb_; bb_.bar = (unsigned*)(F.ws + WS_CTL); bb_.x = xb_xcc_id(); bb_.st = (volatile LAS unsigned*)(F.lds + LDSCTL_OFF) + 8; xcd_barrier(bb_, F.tid); } }
            SEAM(pb + 5, 6);
        }
    }
    if ((PH_MASK & 4096) && IN(NPHASE - 1)) { REFRESH(); final_norm(F); }
    if (TPROBE) {
        REFRESH();
        if (((TP_PHASE_MASK >> 7) & 1u) && F.tid == 0) TPW[13] = TPW[13] + ((unsigned)__builtin_amdgcn_s_memrealtime() - TPW[14]);
        if (TP_STAT == 4 && F.tid == 0) __hip_atomic_store((unsigned*)(F.ws + WS_CTL) + 8192 + 1024 + F.blk, (unsigned)__builtin_amdgcn_s_memrealtime(), __ATOMIC_RELAXED, __HIP_MEMORY_SCOPE_AGENT);
        if (TP_END) { const unsigned te_ = (unsigned)__builtin_amdgcn_s_memrealtime(); { XcdBarrier bb_; bb_.bar = (unsigned*)(F.ws + WS_CTL); bb_.x = xb_xcc_id(); bb_.st = (volatile LAS unsigned*)(F.lds + LDSCTL_OFF) + 8; xcd_barrier(bb_, F.tid); }
            if (F.tid == 0) TPW[13] = TPW[13] + ((unsigned)__builtin_amdgcn_s_memrealtime() - te_); }
        const unsigned tp_acc = TPW[13];
        unsigned* tpc = (unsigned*)(F.ws + WS_CTL) + 8192;
        if (F.tid == 0) { (void)xb_add(tpc, tp_acc); __hip_atomic_store(tpc + 16 + 2 * blockIdx.x, tp_acc, __ATOMIC_RELAXED, __HIP_MEMORY_SCOPE_AGENT); __hip_atomic_store(tpc + 17 + 2 * blockIdx.x, xb_xcc_id(), __ATOMIC_RELAXED, __HIP_MEMORY_SCOPE_AGENT); }
        { XcdBarrier bb_; bb_.bar = (unsigned*)(F.ws + WS_CTL); bb_.x = xb_xcc_id(); bb_.st = (volatile LAS unsigned*)(F.lds + LDSCTL_OFF) + 8; xcd_barrier(bb_, F.tid); }
        if (TP_STAT == 3 && blockIdx.x == 0) {
            volatile LAS unsigned* sm = (volatile LAS unsigned*)F.lds; LAS unsigned* sma = (LAS unsigned*)F.lds;
            if (F.tid < 64) sm[F.tid] = 0u;
            __syncthreads();
            const unsigned myx = F.tid < F.G ? (xb_ld(tpc + 17 + 2 * F.tid) & 15u) : 0u;
            if (F.tid < F.G) __hip_atomic_fetch_add(sma + 48 + myx, 1u, __ATOMIC_RELAXED, __HIP_MEMORY_SCOPE_WORKGROUP);
            for (int k = 0; k < NPHASE - 1; ++k) {
                if (F.tid < 17) sm[F.tid] = 0u;
                __syncthreads();
                if (F.tid < F.G) { const unsigned a_ = xb_ld(tpc + 1024 + k * 256 + F.tid); __hip_atomic_fetch_max(sma + myx, a_, __ATOMIC_RELAXED, __HIP_MEMORY_SCOPE_WORKGROUP); __hip_atomic_fetch_max(sma + 16, a_, __ATOMIC_RELAXED, __HIP_MEMORY_SCOPE_WORKGROUP); }
                __syncthreads();
                if (F.tid < 16 && ((TP_SEAM_MASK >> k) & 1u)) sm[32 + F.tid] = sm[32 + F.tid] + (sm[16] - sm[F.tid]);
                __syncthreads();
            }
            if (F.tid == 0) { unsigned mn = 0xffffffffu; for (int x = 0; x < 16; ++x) if (sm[48 + x]) mn = sm[32 + x] < mn ? sm[32 + x] : mn; sm[60] = mn; }
            __syncthreads();
        }
        if (TP_STAT == 4 && blockIdx.x == 0) {
            volatile LAS unsigned* sm = (volatile LAS unsigned*)F.lds; LAS unsigned* sma = (LAS unsigned*)F.lds;
            if (F.tid < 64) sm[F.tid] = 0u;
            __syncthreads();
            if (F.tid < F.G) { const unsigned a_ = xb_ld(tpc + 1024 + F.tid); __hip_atomic_fetch_max(sma + (F.tid & 7), a_, __ATOMIC_RELAXED, __HIP_MEMORY_SCOPE_WORKGROUP); }
            __syncthreads();
            if (F.tid == 0) { unsigned mx = sm[0], mn = sm[0], ix = 0u; for (unsigned x = 1; x < 8; ++x) { if ((int)(sm[x] - mx) > 0) { mx = sm[x]; ix = x; } if ((int)(sm[x] - mn) < 0) mn = sm[x]; }
                unsigned rg = (mx - mn) / 100u; rg = rg > 199u ? 199u : rg; const unsigned hw = xb_ld(tpc + 17 + 2 * ((ix - GRP_ROT) & 7u)) & 15u; sm[60] = (200u * hw + rg) * 100u; }
            __syncthreads();
        }
        if (blockIdx.x == 0 && F.tid == 0) {
            unsigned long long dl = (unsigned long long)xb_ld(tpc) * TP_SCALE / (unsigned)F.G + TP_FIXED;
            if (TP_STAT) {
                volatile LAS unsigned* sm = (volatile LAS unsigned*)F.lds;
                for (int x = 0; x < 32; ++x) sm[x] = 0u;
                for (int i = 0; i < F.G; ++i) { const unsigned w_ = xb_ld(tpc + 16 + 2 * i), x_ = xb_ld(tpc + 17 + 2 * i) & 15u; sm[x_] = sm[x_] + w_; sm[16 + x_] = sm[16 + x_] + 1u; }
                unsigned mx = 0u, mn = 0xffffffffu; unsigned long long dev = 0ull;
                for (int x = 0; x < 16; ++x) if (sm[16 + x]) { const unsigned m_ = sm[x] / sm[16 + x]; mx = m_ > mx ? m_ : mx; mn = m_ < mn ? m_ : mn; }
                if (TP_STAT == 2) {
                    for (int i = 0; i < F.G; ++i) { const unsigned w_ = xb_ld(tpc + 16 + 2 * i), x_ = xb_ld(tpc + 17 + 2 * i) & 15u; const unsigned m_ = sm[x_] / sm[16 + x_]; dev += w_ > m_ ? w_ - m_ : m_ - w_; }
                    dl = dev * TP_SCALE / (unsigned)F.G;
                } else if (TP_STAT == 3) dl = (unsigned long long)sm[60] * TP_SCALE;
                else if (TP_STAT == 4) dl = sm[60];
                else dl = (unsigned long long)(mx - mn) * TP_SCALE;
            }
            const unsigned long long t0 = __builtin_amdgcn_s_memrealtime();
            while (__builtin_amdgcn_s_memrealtime() - t0 < dl) __builtin_amdgcn_s_sleep(8);
        }
    }
#undef IN
#undef SEAM
#undef REFRESH
#undef SS
#undef HB
#undef MIX
#undef PROJ
}

extern "C" void kernel_launch(void* const* d_in, const int* in_sizes, int n_in, void* d_out, int out_size, void* d_ws, size_t ws_size, hipStream_t stream) {
    static int grid = 0;
    if (grid == 0) {
        if (n_in != 19 || out_size != MROWS * DM || ws_size < WS_END) { fprintf(stderr, "kernel_launch: unexpected problem shape (n_in %d, out %d, ws %zu)\n", n_in, out_size, ws_size); grid = -1; return; }
        int dev = 0, cus = 0, per_cu = 0;
        if (hipGetDevice(&dev) != hipSuccess || hipDeviceGetAttribute(&cus, hipDeviceAttributeMultiprocessorCount, dev) != hipSuccess) { grid = -1; return; }
        if (hipFuncSetAttribute((const void*)fwd, hipFuncAttributeMaxDynamicSharedMemorySize, LDS_BYTES) != hipSuccess) { fprintf(stderr, "kernel_launch: hipFuncSetAttribute failed\n"); grid = -1; return; }
        if (hipOccupancyMaxActiveBlocksPerMultiprocessor(&per_cu, (const void*)fwd, 512, LDS_BYTES) != hipSuccess || per_cu < 1) { fprintf(stderr, "kernel_launch: occupancy query says %d\n", per_cu); (void)hipGetLastError(); grid = -1; return; }
        grid = cus;
    }
    if (grid < 0) return;
    (void)hipMemsetAsync((char*)d_ws + WS_CTL, 0, CTL_ZERO_BYTES, stream);
    Args a{};
    for (int i = 0; i < 19; ++i) a.in[i] = (const float*)d_in[i];
    a.out = (float*)d_out; a.ws = (unsigned char*)d_ws;
    if (ONE_LAUNCH) { a.ph_lo = 0; a.ph_hi = NPHASE; hipLaunchKernelGGL(fwd, dim3(grid), dim3(512), LDS_BYTES, stream, a); }
    else for (int p = 0; p < NPHASE; ++p) { a.ph_lo = p; a.ph_hi = p + 1; hipLaunchKernelGGL(fwd, dim3(grid), dim3(512), LDS_BYTES, stream, a); }
}
```
